# Optimizing an MI355X kernel written in HIP

```python
import jax, jax.numpy as jnp
from jax import lax
import numpy as np

D_MODEL = 2048
BATCH = 32
SEQ = 256
DEPTH = 2
DEC_BATCH = 2
DEC_SEQ = 2048
PAST_LEN = 512

GRID_W = 64
HEAD_DIM = 128
CONV_WIDTH = D_MODEL // 2
CONV_TAPS = 3
GQA_HEADS = (D_MODEL // 2) // HEAD_DIM
GQA_KV_HEADS = 2
NA_HEADS = D_MODEL // HEAD_DIM
NA_WIN_ROWS = 8
NA_WIN_COLS = 16
D_FF = 4 * D_MODEL
N_EVEN = (DEPTH + 1) // 2
N_ODD = DEPTH // 2
QUERY_BLOCK = 128
ROPE_THETA = 10000.0
ROPE_AXIS_DIM = HEAD_DIM // 2
NORM_EPS = 1e-6
MIX_WIDTH = CONV_WIDTH + GQA_HEADS * HEAD_DIM
AB_IN = 3 * CONV_WIDTH + (GQA_HEADS + 2 * GQA_KV_HEADS) * HEAD_DIM

kernel_name = "hybrid_dit_prefix_conv_gqa_natten"


def _rms_norm(x, g):
    xf = x.astype(jnp.float32)
    y = xf * lax.rsqrt(jnp.mean(xf * xf, axis=-1, keepdims=True) + NORM_EPS)
    return (y * g.astype(jnp.float32)).astype(x.dtype)


def _modulation(cond, w, b):
    m = jax.nn.silu(cond) @ w + b
    return [t[:, None, :] for t in jnp.split(m, 6, axis=-1)]


def _ada(x, g, shift, scale):
    return _rms_norm(x, g) * (1 + scale) + shift


def _short_conv(u, w):
    up = jnp.pad(u, ((0, 0), (1, 1), (0, 0)))
    return up[:, :-2] * w[0] + up[:, 1:-1] * w[1] + up[:, 2:] * w[2]


def _axial_rope(x):
    T = x.shape[1]
    t = jnp.arange(T)
    half = ROPE_AXIS_DIM // 2
    inv = ROPE_THETA ** (-jnp.arange(half, dtype=jnp.float32) / half)

    def rot(xa, pos):
        ang = pos.astype(jnp.float32)[:, None] * inv
        cos = jnp.cos(ang)[None, :, None, :]
        sin = jnp.sin(ang)[None, :, None, :]
        x1, x2 = xa[..., :half], xa[..., half:]
        return jnp.concatenate([x1 * cos - x2 * sin, x1 * sin + x2 * cos], axis=-1)

    xf = x.astype(jnp.float32)
    out = jnp.concatenate([rot(xf[..., :ROPE_AXIS_DIM], t // GRID_W),
                           rot(xf[..., ROPE_AXIS_DIM:], t % GRID_W)], axis=-1)
    return out.astype(x.dtype)


def _block_attention(q, k, v):
    B, S, Hq, D = q.shape
    Hkv = k.shape[2]
    G = Hq // Hkv
    nb = S // QUERY_BLOCK
    qb = q.reshape(B, nb, QUERY_BLOCK, Hkv, G, D).transpose(1, 0, 2, 3, 4, 5)
    scale = D ** -0.5

    def one(qblk):
        s = jnp.einsum('bqhgd,bkhd->bhgqk', qblk, k).astype(jnp.float32) * scale
        p = jax.nn.softmax(s, axis=-1).astype(v.dtype)
        return jnp.einsum('bhgqk,bkhd->bqhgd', p, v)

    o = lax.map(one, qb)
    return o.transpose(1, 0, 2, 3, 4, 5).reshape(B, S, Hq * D)


def _neighbourhood_attention(q, k, v, ck, cv, rel_bias):
    B, T, H, D = q.shape
    rows = T // GRID_W
    wr = min(NA_WIN_ROWS, rows)
    wc = NA_WIN_COLS
    nk = wr * wc
    r = jnp.arange(rows)
    col = jnp.arange(GRID_W)
    krow = jnp.clip(r - wr // 2, 0, rows - wr)[:, None] + jnp.arange(wr)
    kcol = jnp.clip(col - wc // 2, 0, GRID_W - wc)[:, None] + jnp.arange(wc)
    idx = (krow[:, None, :, None] * GRID_W + kcol[None, :, None, :]).reshape(rows, GRID_W, nk)
    drow = krow - r[:, None] + (NA_WIN_ROWS - 1)
    dcol = kcol - col[:, None] + (NA_WIN_COLS - 1)
    qr = q.reshape(B, rows, GRID_W, H, D).transpose(1, 0, 2, 3, 4)
    scale = D ** -0.5

    def one(args):
        q_blk, idx_blk, drow_blk = args
        kg = k[:, idx_blk]
        vg = v[:, idx_blk]
        bias = rel_bias[:, drow_blk[None, :, None], dcol[:, None, :]].reshape(H, GRID_W, nk)
        s_loc = jnp.einsum('bqhd,bqkhd->bhqk', q_blk, kg).astype(jnp.float32) * scale \
            + bias.astype(jnp.float32)[None]
        s_ctx = jnp.einsum('bqhd,bkhd->bhqk', q_blk, ck).astype(jnp.float32) * scale
        p = jax.nn.softmax(jnp.concatenate([s_loc, s_ctx], axis=-1), axis=-1).astype(v.dtype)
        return (jnp.einsum('bhqk,bqkhd->bqhd', p[..., :nk], vg)
                + jnp.einsum('bhqk,bkhd->bqhd', p[..., nk:], cv))

    o = lax.map(one, (qr, idx, drow))
    return o.transpose(1, 0, 2, 3, 4).reshape(B, T, H * D)


def _ab_project(h, w_in, q_norm, k_norm):
    B, T, _ = h.shape
    z = h @ w_in
    c1 = CONV_WIDTH
    c2 = 2 * c1
    c3 = 3 * c1
    c4 = c3 + GQA_HEADS * HEAD_DIM
    c5 = c4 + GQA_KV_HEADS * HEAD_DIM
    gate_b, gate_c, xa = z[..., :c1], z[..., c1:c2], z[..., c2:c3]
    q = _rms_norm(z[..., c3:c4].reshape(B, T, GQA_HEADS, HEAD_DIM), q_norm)
    k = _rms_norm(z[..., c4:c5].reshape(B, T, GQA_KV_HEADS, HEAD_DIM), k_norm)
    v = z[..., c5:].reshape(B, T, GQA_KV_HEADS, HEAD_DIM)
    return gate_b, gate_c, xa, q, k, v


def _ab_context(h, w_in, conv_w, q_norm, k_norm, w_out):
    gb, gc, xa, q, k, v = _ab_project(h, w_in, q_norm, k_norm)
    a = gb * _short_conv(gc * xa, conv_w)
    b = _block_attention(q, k, v)
    return jnp.concatenate([a, b], axis=-1) @ w_out, k, v


def _ab_latent(h, ctx_k, ctx_v, w_in, conv_w, q_norm, k_norm, w_out):
    gb, gc, xa, q, k, v = _ab_project(h, w_in, q_norm, k_norm)
    a = gb * _short_conv(gc * xa, conv_w)
    q = _axial_rope(q)
    k = _axial_rope(k)
    b = _block_attention(q, jnp.concatenate([ctx_k, k], axis=1),
                         jnp.concatenate([ctx_v, v], axis=1))
    return jnp.concatenate([a, b], axis=-1) @ w_out


def _na_project(h, w_qkv):
    B, T, _ = h.shape
    q, k, v = jnp.split(h @ w_qkv, 3, axis=-1)
    shp = (B, T, NA_HEADS, HEAD_DIM)
    return q.reshape(shp), k.reshape(shp), v.reshape(shp)


def _na_context(h, w_qkv, w_out):
    q, k, v = _na_project(h, w_qkv)
    return _block_attention(q, k, v) @ w_out, k, v


def _na_latent(h, ctx_k, ctx_v, w_qkv, rel_bias, w_out):
    q, k, v = _na_project(h, w_qkv)
    return _neighbourhood_attention(q, k, v, ctx_k, ctx_v, rel_bias) @ w_out


def _mlp(h, w1, w2):
    return jnp.square(jax.nn.relu(h @ w1)) @ w2


def setup_inputs(seed: int = 0) -> dict:
    key = jax.random.key(seed)
    ks = jax.random.split(key, 23)

    def nrm(k, shape, scale=1.0):
        return jax.random.normal(k, shape, jnp.float32) * scale

    return {
        "x_prompt": nrm(ks[0], (BATCH, SEQ, D_MODEL)),
        "x_sample": nrm(ks[1], (DEC_BATCH, DEC_SEQ, D_MODEL)),
        "cache_attn_k": nrm(ks[2], (DEC_BATCH, N_EVEN, PAST_LEN, GQA_KV_HEADS, HEAD_DIM)),
        "cache_attn_v": nrm(ks[3], (DEC_BATCH, N_EVEN, PAST_LEN, GQA_KV_HEADS, HEAD_DIM)),
        "cache_na_k": nrm(ks[4], (DEC_BATCH, N_ODD, PAST_LEN, NA_HEADS, HEAD_DIM)),
        "cache_na_v": nrm(ks[5], (DEC_BATCH, N_ODD, PAST_LEN, NA_HEADS, HEAD_DIM)),
        "c": nrm(ks[6], (DEC_BATCH, D_MODEL)),
        "c_ctx": nrm(ks[7], (D_MODEL,)),
        "mod_w": nrm(ks[8], (DEPTH, D_MODEL, 6 * D_MODEL), D_MODEL ** -0.5),
        "mod_b": nrm(ks[9], (DEPTH, 6 * D_MODEL), 0.01),
        "norm1_g": 1.0 + nrm(ks[10], (DEPTH, D_MODEL), 0.02),
        "norm2_g": 1.0 + nrm(ks[11], (DEPTH, D_MODEL), 0.02),
        "ab_w_in": nrm(ks[12], (N_EVEN, D_MODEL, AB_IN), D_MODEL ** -0.5),
        "ab_conv_w": nrm(ks[13], (N_EVEN, CONV_TAPS, CONV_WIDTH), CONV_TAPS ** -0.5),
        "ab_q_norm": 1.0 + nrm(ks[14], (N_EVEN, HEAD_DIM), 0.02),
        "ab_k_norm": 1.0 + nrm(ks[15], (N_EVEN, HEAD_DIM), 0.02),
        "ab_w_out": nrm(ks[16], (N_EVEN, MIX_WIDTH, D_MODEL), MIX_WIDTH ** -0.5),
        "na_w_qkv": nrm(ks[17], (N_ODD, D_MODEL, 3 * NA_HEADS * HEAD_DIM), D_MODEL ** -0.5),
        "na_rel_bias": nrm(ks[18], (N_ODD, NA_HEADS, 2 * NA_WIN_ROWS - 1, 2 * NA_WIN_COLS - 1), 0.1),
        "na_w_out": nrm(ks[19], (N_ODD, NA_HEADS * HEAD_DIM, D_MODEL), (NA_HEADS * HEAD_DIM) ** -0.5),
        "mlp_w1": nrm(ks[20], (DEPTH, D_MODEL, D_FF), D_MODEL ** -0.5),
        "mlp_w2": nrm(ks[21], (DEPTH, D_FF, D_MODEL), D_FF ** -0.5),
        "final_norm_g": 1.0 + nrm(ks[22], (D_MODEL,), 0.02),
    }


def reference(x_prompt, x_sample, cache_attn_k, cache_attn_v, cache_na_k, cache_na_v, c, c_ctx,
              mod_w, mod_b, norm1_g, norm2_g, ab_w_in, ab_conv_w, ab_q_norm, ab_k_norm, ab_w_out,
              na_w_qkv, na_rel_bias, na_w_out, mlp_w1, mlp_w2, final_norm_g):
    xp = x_prompt
    xs = x_sample
    cond_ctx = c_ctx[None, :]
    new_ak, new_av, new_nk, new_nv = [], [], [], []
    for i in range(DEPTH):
        j = i // 2
        sp1, cp1, gp1, sp2, cp2, gp2 = _modulation(cond_ctx, mod_w[i], mod_b[i])
        ss1, cs1, gs1, ss2, cs2, gs2 = _modulation(c, mod_w[i], mod_b[i])
        hp = _ada(xp, norm1_g[i], sp1, cp1)
        hs = _ada(xs, norm1_g[i], ss1, cs1)
        if i % 2 == 0:
            op, kp, vp = _ab_context(hp, ab_w_in[j], ab_conv_w[j], ab_q_norm[j], ab_k_norm[j],
                                     ab_w_out[j])
            os_ = _ab_latent(hs, cache_attn_k[:, j], cache_attn_v[:, j], ab_w_in[j], ab_conv_w[j],
                             ab_q_norm[j], ab_k_norm[j], ab_w_out[j])
            new_ak.append(kp)
            new_av.append(vp)
        else:
            op, kp, vp = _na_context(hp, na_w_qkv[j], na_w_out[j])
            os_ = _na_latent(hs, cache_na_k[:, j], cache_na_v[:, j], na_w_qkv[j], na_rel_bias[j],
                             na_w_out[j])
            new_nk.append(kp)
            new_nv.append(vp)
        xp = xp + gp1 * op
        xs = xs + gs1 * os_
        xp = xp + gp2 * _mlp(_ada(xp, norm2_g[i], sp2, cp2), mlp_w1[i], mlp_w2[i])
        xs = xs + gs2 * _mlp(_ada(xs, norm2_g[i], ss2, cs2), mlp_w1[i], mlp_w2[i])
    y_prompt = _rms_norm(xp, final_norm_g)
    y_sample = _rms_norm(xs, final_norm_g)
    new_attn_k = jnp.stack(new_ak, axis=1)
    new_attn_v = jnp.stack(new_av, axis=1)
    new_na_k = jnp.stack(new_nk, axis=1)
    new_na_v = jnp.stack(new_nv, axis=1)
    return (y_prompt, y_sample, new_attn_k, new_attn_v, new_na_k, new_na_v)
```

```cpp
#include <hip/hip_runtime.h>
#include <hip/hip_cooperative_groups.h>
#include <cstdio>
#include <cstdint>
namespace cg = cooperative_groups;

#ifndef MK_PER_PHASE
#define MK_PER_PHASE 0
#endif

#ifndef PROBE_STOP
#define PROBE_STOP 0
#endif
#ifndef PROBE_SRC
#define PROBE_SRC 0
#endif
#define LAS __attribute__((address_space(3)))
#define PG8_LAS __attribute__((address_space(3)))
typedef unsigned short bf16_t;
typedef short bf16x8 __attribute__((ext_vector_type(8)));
typedef short v4i16_t __attribute__((ext_vector_type(4)));
typedef float f32x4 __attribute__((ext_vector_type(4)));
typedef float f32x2 __attribute__((ext_vector_type(2)));
typedef unsigned u32x4 __attribute__((ext_vector_type(4)));
typedef unsigned u32x2 __attribute__((ext_vector_type(2)));

__device__ __forceinline__ float bf2f(unsigned h) { return __uint_as_float(h << 16); }
typedef __bf16 bf16x2_t __attribute__((ext_vector_type(2)));
__device__ __forceinline__ unsigned cvt_pk_bf16(float lo, float hi) { f32x2 v = {lo, hi}; bf16x2_t r = __builtin_convertvector(v, bf16x2_t); return __builtin_bit_cast(unsigned, r); }
__device__ __forceinline__ float wave_sum(float v) {
#pragma unroll
    for (int o = 1; o < 64; o <<= 1) v += __shfl_xor(v, o);
    return v;
}

namespace pg8 {
constexpr int BM = 256, BK = 64, HALF = 128, HTB = HALF * BK * 2  , STAGE_BYTES = 8 * HTB, NXCD = 8, WGM = 8;

__host__ __device__ __forceinline__ int lds_byte(int r, int c) { const int st = (r >> 4) * 2 + (c >> 5), rr = r & 15, cc = c & 31, ob = rr * 64 + cc * 2; return st * 1024 + (ob ^ (((ob >> 9) & 1) << 5)); }
__host__ __device__ __forceinline__ void stage_rc(int b, int& R, int& C) { const int st = b / 1024, sb = b % 1024, swz = sb ^ (((sb >> 9) & 1) << 5); R = (st >> 1) * 16 + swz / 64; C = (st & 1) * 32 + (swz % 64) / 2; }
__host__ __device__ __forceinline__ int perm32(int rho) { const int n = rho >> 4, i = rho & 15; return 8 * (i >> 2) + 4 * n + (i & 3); }
struct Unit { int pm, pn; };
struct Gemm { const bf16_t* A; const bf16_t* Bt; int M, N, K; };
struct StaticOrder {
    int nM, nN, nwg, G, c;
    __host__ __device__ void init(int M, int N, int G_, int c_) { nM = M / BM; nN = N / BM; nwg = nM * nN; G = G_; c = c_; }
    __host__ __device__ bool next(int i, Unit& u) const {
        const long L = (long)i * G + c; if (L >= nwg) return false;
        int wgid = (int)L; { const int q = nwg / NXCD, r = nwg % NXCD, xcd = wgid % NXCD, off = wgid / NXCD; wgid = (xcd < r ? xcd * (q + 1) : r * (q + 1) + (xcd - r) * q) + off; }
        const int nig = WGM * nN, gid = wgid / nig, fm = gid * WGM, gsz = (nM - fm) < WGM ? (nM - fm) : WGM;
        u.pm = fm + ((wgid % nig) % gsz); u.pn = (wgid % nig) / gsz; return true;
    }
    __device__ __forceinline__ void a_ready(const Unit&) const {}
    __device__ __forceinline__ void done(const Unit&) const {}
};
template <class Epi, class Sched>
__device__ __forceinline__ void gemm_phase(PG8_LAS unsigned char* lds, const Gemm g, const Sched& S, const Epi& E) {
    int tid_ = threadIdx.x; asm volatile("" : "+v"(tid_));
    const int tid = tid_, wid = __builtin_amdgcn_readfirstlane(tid >> 6), lane = tid & 63, wr = wid >> 2, wc = wid & 3, fr = lane & 15, fq = lane >> 4;
    const int K = g.K, nt = K / BK;
    unsigned voffA[2], voffB[2];
#pragma unroll
    for (int i = 0; i < 2; ++i) { int R, C; stage_rc(tid * 16 + i * 8192, R, C); const int Rb = Epi::PERM ? ((R & ~31) + perm32(R & 31)) : R;
        voffA[i] = (unsigned)(R * K + C) * 2u; voffB[i] = (unsigned)(Rb * K + C) * 2u; }
    const size_t kstep = (size_t)(BK * 2);
    const size_t hstep = (size_t)HALF * K * 2;
    const size_t tstep = 2 * hstep;
    const unsigned ldsw = (unsigned)wid * 1024u;
    const int aoff = lds_byte(wr * 64 + fr, fq * 8), boff = lds_byte(wc * 32 + fr, fq * 8);
#define PG8_SA(b, h) (((b) * 2 + (h)) * HTB)
#define PG8_SB(b, h) ((4 + (b) * 2 + (h)) * HTB)
#define PG8_STAGE(bufoff, gbase, voff) do { _Pragma("unroll") for (int _i = 0; _i < 2; ++_i) \
        __builtin_amdgcn_global_load_lds((const unsigned*)((const char*)(gbase) + (voff)[_i]), (PG8_LAS unsigned*)(lds + (bufoff) + ldsw + _i * 8192), 16, 0, 0); } while (0)
#define PG8_LDA(dst, b, h) do { _Pragma("unroll") for (int m = 0; m < 4; ++m) _Pragma("unroll") for (int k = 0; k < 2; ++k) dst[m][k] = *(const PG8_LAS bf16x8*)(lds + PG8_SA(b, h) + aoff + m * 2048 + k * 1024); } while (0)
#define PG8_LDB(dst, b, h) do { _Pragma("unroll") for (int n = 0; n < 2; ++n) _Pragma("unroll") for (int k = 0; k < 2; ++k) dst[n][k] = *(const PG8_LAS bf16x8*)(lds + PG8_SB(b, h) + boff + n * 2048 + k * 1024); } while (0)
#define PG8_MMA(ai, bj, At, Bt) do { __builtin_amdgcn_s_setprio(1); _Pragma("unroll") for (int m = 0; m < 4; ++m) _Pragma("unroll") for (int n = 0; n < 2; ++n) _Pragma("unroll") for (int k = 0; k < 2; ++k) \
        acc[ai][bj][m][n] = __builtin_amdgcn_mfma_f32_16x16x32_bf16(Bt[n][k], At[m][k], acc[ai][bj][m][n], 0, 0, 0); __builtin_amdgcn_s_setprio(0); } while (0)
#define PG8_WAIT_V(n) asm volatile("s_waitcnt vmcnt(" #n ")" ::: "memory")
#define PG8_WAIT_L(n) asm volatile("s_waitcnt lgkmcnt(" #n ")" ::: "memory")
#define PG8_BAR __builtin_amdgcn_s_barrier()
#define PG8_SCHED __builtin_amdgcn_sched_barrier(0)
    Unit cur, nxt; int ui = 0;
    if (!S.next(0, cur)) return;
    f32x4 acc[2][2][4][2];
#pragma unroll
    for (int a = 0; a < 2; ++a)
#pragma unroll
        for (int b = 0; b < 2; ++b)
#pragma unroll
            for (int m = 0; m < 4; ++m)
#pragma unroll
                for (int n = 0; n < 2; ++n) acc[a][b][m][n] = (f32x4){0.f, 0.f, 0.f, 0.f};
    bf16x8 At[4][2], B0[2][2], B1[2][2];
    const char* cA = (const char*)g.A + (size_t)cur.pm * tstep; const char* cB = (const char*)g.Bt + (size_t)cur.pn * tstep;
    S.a_ready(cur);
    PG8_STAGE(PG8_SB(0, 0), cB, voffB); PG8_STAGE(PG8_SA(0, 0), cA, voffA); PG8_STAGE(PG8_SB(0, 1), cB + hstep, voffB); PG8_STAGE(PG8_SA(0, 1), cA + hstep, voffA);
    if (wr == 1) PG8_BAR;
    PG8_WAIT_V(4); PG8_BAR;
    PG8_STAGE(PG8_SB(1, 0), cB + kstep, voffB); PG8_STAGE(PG8_SA(1, 0), cA + kstep, voffA); PG8_STAGE(PG8_SB(1, 1), cB + hstep + kstep, voffB);
    PG8_WAIT_V(6); PG8_BAR;
    for (;;) {
        const bool has_next = S.next(ui + 1, nxt);
        const char* nA = has_next ? (const char*)g.A + (size_t)nxt.pm * tstep : cA; const char* nB = has_next ? (const char*)g.Bt + (size_t)nxt.pn * tstep : cB;
        for (int t = 0; t < nt; t += 2) {
            const bool last = (t == nt - 2);
            const char* a1 = cA + (size_t)(t + 1) * kstep;
            const char* a2 = last ? nA : cA + (size_t)(t + 2) * kstep; const char* b2 = last ? nB : cB + (size_t)(t + 2) * kstep;
            const char* a3 = a2 + kstep; const char* b3 = b2 + kstep;
            if (last && has_next) S.a_ready(nxt);
            PG8_LDB(B0, 0, 0); PG8_SCHED; PG8_LDA(At, 0, 0); PG8_STAGE(PG8_SA(1, 1), a1 + hstep, voffA);
            PG8_WAIT_L(8); PG8_BAR; PG8_WAIT_L(0); PG8_MMA(0, 0, At, B0); PG8_BAR; PG8_SCHED;
            PG8_LDB(B1, 0, 1); PG8_STAGE(PG8_SB(0, 0), b2, voffB);
            PG8_BAR; PG8_WAIT_L(0); PG8_MMA(0, 1, At, B1); PG8_BAR;
            PG8_LDA(At, 0, 1); PG8_STAGE(PG8_SA(0, 0), a2, voffA);
            PG8_BAR; PG8_WAIT_L(0); PG8_MMA(1, 0, At, B0); PG8_BAR; PG8_SCHED;
            PG8_STAGE(PG8_SB(0, 1), b2 + hstep, voffB);
            PG8_WAIT_V(6); PG8_BAR; PG8_MMA(1, 1, At, B1); PG8_BAR;
            PG8_LDB(B0, 1, 0); PG8_SCHED; PG8_LDA(At, 1, 0); PG8_STAGE(PG8_SA(0, 1), a2 + hstep, voffA);
            PG8_WAIT_L(8); PG8_BAR; PG8_WAIT_L(0); PG8_MMA(0, 0, At, B0); PG8_BAR; PG8_SCHED;
            PG8_LDB(B1, 1, 1); PG8_STAGE(PG8_SB(1, 0), b3, voffB);
            PG8_BAR; PG8_WAIT_L(0); PG8_MMA(0, 1, At, B1); PG8_BAR;
            PG8_LDA(At, 1, 1); PG8_STAGE(PG8_SA(1, 0), a3, voffA);
            PG8_BAR; PG8_WAIT_L(0); PG8_MMA(1, 0, At, B0); PG8_BAR; PG8_SCHED;
            PG8_STAGE(PG8_SB(1, 1), b3 + hstep, voffB);
            PG8_WAIT_V(6); PG8_BAR; PG8_MMA(1, 1, At, B1); PG8_BAR;
        }
        if constexpr (!Epi::AFTER_DRAIN) { E(acc, cur, wr, wc, fr, fq); S.done(cur); }
        if (!has_next) break;
#pragma unroll
        for (int a = 0; a < 2; ++a)
#pragma unroll
            for (int b = 0; b < 2; ++b)
#pragma unroll
                for (int m = 0; m < 4; ++m)
#pragma unroll
                    for (int n = 0; n < 2; ++n) acc[a][b][m][n] = (f32x4){0.f, 0.f, 0.f, 0.f};
        cur = nxt; cA = nA; cB = nB; ++ui;
    }
    PG8_WAIT_V(0);
    if (wr == 0) PG8_BAR;
    PG8_BAR;
    if constexpr (Epi::AFTER_DRAIN) { E.fused(acc, cur, wr, wc, fr, fq, lds, wid, lane); S.done(cur); }
#undef PG8_SA
#undef PG8_SB
#undef PG8_STAGE
#undef PG8_LDA
#undef PG8_LDB
#undef PG8_MMA
#undef PG8_WAIT_V
#undef PG8_WAIT_L
#undef PG8_BAR
#undef PG8_SCHED
}
}

constexpr int D = 2048, MCTX = 8192, MLAT = 4096, MTOT = 12288, FFN = 8192, ABIN = 4608, NQKV = 6144, MODW = 12288;
constexpr float EPS = 1e-6f;
constexpr size_t WS_MOD = 0;
constexpr size_t WS_WIN = 1u << 20;
constexpr size_t WS_WO0 = WS_WIN + (size_t)ABIN * D * 2;
constexpr size_t WS_WQKV = WS_WO0 + (size_t)D * D * 2;
constexpr size_t WS_WO1 = WS_WQKV + (size_t)NQKV * D * 2;
constexpr size_t WS_W1 = WS_WO1 + (size_t)D * D * 2;
constexpr size_t WS_W2 = WS_W1 + 2 * (size_t)FFN * D * 2;
constexpr size_t WS_XN = WS_W2 + 2 * (size_t)FFN * D * 2;
constexpr size_t WS_H = WS_XN + (size_t)MTOT * D * 2;
constexpr size_t WS_Z = WS_H + (size_t)MTOT * FFN * 2;
constexpr size_t WS_AB = WS_Z + (size_t)MTOT * NQKV * 2;
constexpr size_t WS_Q0 = WS_AB + (size_t)MTOT * D * 2;
constexpr size_t WS_K0 = WS_Q0 + (size_t)MTOT * 1024 * 2;
constexpr size_t WS_V0 = WS_K0 + (size_t)(MTOT + 1024) * 256 * 2;
constexpr size_t WS_CNK = WS_V0 + (size_t)(MTOT + 1024) * 256 * 2;
constexpr size_t WS_CNV = WS_CNK + (size_t)1024 * 2048 * 2;
constexpr size_t WS_X = WS_CNV + (size_t)1024 * 2048 * 2;
constexpr size_t WS_END = WS_X + (size_t)MTOT * D * 4;
constexpr int LDS_BYTES = 131072;

constexpr size_t OUT_YP = 0, OUT_YS = (size_t)MCTX * D, OUT_AK = OUT_YS + (size_t)MLAT * D, OUT_AV = OUT_AK + (size_t)MCTX * 256,
                 OUT_NK = OUT_AV + (size_t)MCTX * 256, OUT_NV = OUT_NK + (size_t)MCTX * D;

struct Params {
    const float* in[23];
    float* out;
    unsigned char* ws;
    int ph_lo, ph_hi;
};

template <int ACT, bool SIDE> struct EpiBf16 {
    static constexpr bool PERM = true, AFTER_DRAIN = false;
    bf16_t* O; int ldc; float* kout; float* vout; int split_tiles; size_t split_stride;
    __device__ __forceinline__ void operator()(const f32x4 (&acc)[2][2][4][2], const pg8::Unit& u, int wr, int wc, int fr, int fq) const {
        const int row0 = u.pm * 256 + wr * 64 + fr, col0 = u.pn * 256 + wc * 32 + 8 * fq;
        const int spt = split_tiles ? u.pn / split_tiles : 0; bf16_t* Ob = O + (size_t)spt * split_stride; const int ocol0 = col0 - spt * split_tiles * 256;
        const bool side = SIDE && (u.pm < 32) && (u.pn >= 8);
        float* sbase = nullptr; int scol0 = 0;
        if (SIDE) { sbase = (u.pn < 16) ? kout : vout; scol0 = col0 - ((u.pn < 16) ? 2048 : 4096); }
#pragma unroll
        for (int ai = 0; ai < 2; ++ai)
#pragma unroll
            for (int m = 0; m < 4; ++m) {
                const int row = row0 + ai * 128 + m * 16;
                bf16_t* rowp = Ob + (size_t)row * ldc + ocol0;
#pragma unroll
                for (int bj = 0; bj < 2; ++bj) {
                    f32x4 v0 = acc[ai][bj][m][0], v1 = acc[ai][bj][m][1];
                    if (SIDE) { if (side) { float* sp = sbase + (size_t)row * 2048 + scol0 + bj * 128; *(f32x4*)sp = v0; *(f32x4*)(sp + 4) = v1; } }
                    if (ACT == 1) {
#pragma unroll
                        for (int j = 0; j < 4; ++j) { float a = fmaxf(v0[j], 0.f), b = fmaxf(v1[j], 0.f); v0[j] = a * a; v1[j] = b * b; }
                    }
                    u32x4 o; o.x = cvt_pk_bf16(v0[0], v0[1]); o.y = cvt_pk_bf16(v0[2], v0[3]); o.z = cvt_pk_bf16(v1[0], v1[1]); o.w = cvt_pk_bf16(v1[2], v1[3]);
                    *(u32x4*)(rowp + bj * 128) = o;
                }
            }
    }
};
struct EpiResid {
    static constexpr bool PERM = false, AFTER_DRAIN = false;
    const float* src_lo; const float* src_hi;
    float* X; const float* gate;
    __device__ __forceinline__ void operator()(const f32x4 (&acc)[2][2][4][2], const pg8::Unit& u, int wr, int wc, int fr, int fq) const {
        const int row0 = u.pm * 256 + wr * 64 + fr, col0 = u.pn * 256 + wc * 32 + 4 * fq;
        const int cond = (u.pm < 32) ? 0 : 1 + ((u.pm - 32) >> 3);
        const float* gp = gate + (size_t)cond * MODW + col0;
        const float* sb = (u.pm < 32) ? src_lo : src_hi;
        f32x4 gv[2][2];
#pragma unroll
        for (int bj = 0; bj < 2; ++bj)
#pragma unroll
            for (int n = 0; n < 2; ++n) gv[bj][n] = *(const f32x4*)(gp + bj * 128 + n * 16);
#pragma unroll
        for (int ai = 0; ai < 2; ++ai)
#pragma unroll
            for (int m = 0; m < 4; ++m) {
                const size_t off = (size_t)(row0 + ai * 128 + m * 16) * D + col0;
#pragma unroll
                for (int bj = 0; bj < 2; ++bj)
#pragma unroll
                    for (int n = 0; n < 2; ++n) {
                        const f32x4 r = *(const f32x4*)(sb + off + bj * 128 + n * 16);
                        *(f32x4*)(X + off + bj * 128 + n * 16) = r + gv[bj][n] * acc[ai][bj][m][n];
                    }
            }
    }
};

__device__ __forceinline__ unsigned f2bf(float f) { unsigned u = __float_as_uint(f); return (u + 0x7fffu + ((u >> 16) & 1u)) >> 16; }
__device__ __forceinline__ unsigned pk2(float lo, float hi) { return f2bf(lo) | (f2bf(hi) << 16); }
__device__ __forceinline__ void p0_transpose_item(const float* W, int K, int N, bf16_t* WT, LAS float* scr, int item, int lane) {
    const int nblk = N / 32, kb = item / nblk, nb = item % nblk, k0 = 64 * kb, n0 = 32 * nb;
#pragma unroll 8
    for (int i = 0; i < 32; ++i) { const int kk = 2 * i + (lane >> 5); scr[kk * 33 + (lane & 31)] = W[(size_t)(k0 + kk) * N + n0 + (lane & 31)]; }
    asm volatile("s_waitcnt lgkmcnt(0)" ::: "memory");
    const int c = lane & 7;
#pragma unroll
    for (int j = 0; j < 4; ++j) { const int n = (lane >> 3) + 8 * j; const LAS float* s = scr + (8 * c) * 33 + n;
        u32x4 o; o.x = pk2(s[0 * 33], s[1 * 33]); o.y = pk2(s[2 * 33], s[3 * 33]); o.z = pk2(s[4 * 33], s[5 * 33]); o.w = pk2(s[6 * 33], s[7 * 33]);
        *(u32x4*)(WT + (size_t)(n0 + n) * K + k0 + 8 * c) = o; }
    asm volatile("s_waitcnt lgkmcnt(0)" ::: "memory");
}
__device__ __forceinline__ void cvt_linear(const float* src, bf16_t* dst, int n, int gtid, int gthreads) {
    for (int i = gtid * 4; i < n; i += gthreads * 4) { const f32x4 v = *(const f32x4*)(src + i); u32x2 o; o.x = cvt_pk_bf16(v[0], v[1]); o.y = cvt_pk_bf16(v[2], v[3]); *(u32x2*)(dst + i) = o; }
}
__device__ __forceinline__ void p0_prologue(const Params& p, LAS unsigned char* lds) {
    int tid_ = threadIdx.x; asm volatile("" : "+v"(tid_));
    const int tid = tid_, lane = tid & 63, wave = __builtin_amdgcn_readfirstlane(tid >> 6), G = gridDim.x;
    unsigned char* ws = p.ws;
    {
        LAS float* sc = (LAS float*)(lds + 69632);
        LAS float* red = (LAS float*)(lds + 69632 + 24576);
        const float* cvec = p.in[6]; const float* cctx = p.in[7];
        for (int i = tid; i < 3 * 2048; i += 512) { const int c = i >> 11, k = i & 2047; const float x = (c == 0) ? cctx[k] : cvec[(c - 1) * 2048 + k]; sc[i] = x / (1.f + __expf(-x)); }
        __syncthreads();
        float* MOD = (float*)(ws + WS_MOD);
        for (int item = blockIdx.x; item < 256; item += G) {
            const int l = item >> 7, cgp = item & 127, ln = lane < 48 ? lane : 47;
            const float* W = p.in[8] + (size_t)l * 2048 * MODW + cgp * 96 + ln * 2;
            float a00 = 0.f, a01 = 0.f, a10 = 0.f, a11 = 0.f, a20 = 0.f, a21 = 0.f;
            const int kb = wave * 256;
#pragma unroll 8
            for (int k = 0; k < 256; ++k) {
                const f32x2 w = *(const f32x2*)(W + (size_t)(kb + k) * MODW);
                const float s0 = sc[kb + k], s1 = sc[2048 + kb + k], s2 = sc[4096 + kb + k];
                a00 += s0 * w.x; a01 += s0 * w.y; a10 += s1 * w.x; a11 += s1 * w.y; a20 += s2 * w.x; a21 += s2 * w.y;
            }
            if (lane < 48) { LAS float* r = red + wave * 288 + lane * 2; r[0] = a00; r[1] = a01; r[96] = a10; r[97] = a11; r[192] = a20; r[193] = a21; }
            __syncthreads();
            if (tid < 288) { const int c = tid / 96, j = tid % 96; float s = 0.f;
#pragma unroll
                for (int w = 0; w < 8; ++w) s += red[w * 288 + tid];
                MOD[(size_t)(l * 3 + c) * MODW + cgp * 96 + j] = s + p.in[9][l * MODW + cgp * 96 + j]; }
            __syncthreads();
        }
    }
    {
        LAS float* scr = (LAS float*)(lds + wave * 8448);
        const int gw = blockIdx.x * 8 + wave, NGW = G * 8;
        constexpr int I_IN = 32 * (ABIN / 32), I_O = 32 * (D / 32), I_QKV = 32 * (NQKV / 32), I_1 = 32 * (FFN / 32), I_2 = (FFN / 64) * (D / 32);
        constexpr int NITEMS = I_IN + 2 * I_O + I_QKV + 2 * I_1 + 2 * I_2;
        for (int it = gw; it < NITEMS; it += NGW) {
            int r = it;
            if (r < I_IN) { p0_transpose_item(p.in[12], D, ABIN, (bf16_t*)(ws + WS_WIN), scr, r, lane); continue; } r -= I_IN;
            if (r < I_O) { p0_transpose_item(p.in[16], D, D, (bf16_t*)(ws + WS_WO0), scr, r, lane); continue; } r -= I_O;
            if (r < I_QKV) { p0_transpose_item(p.in[17], D, NQKV, (bf16_t*)(ws + WS_WQKV), scr, r, lane); continue; } r -= I_QKV;
            if (r < I_O) { p0_transpose_item(p.in[19], D, D, (bf16_t*)(ws + WS_WO1), scr, r, lane); continue; } r -= I_O;
            if (r < 2 * I_1) { const int l = r / I_1; p0_transpose_item(p.in[20] + (size_t)l * D * FFN, D, FFN, (bf16_t*)(ws + WS_W1) + (size_t)l * FFN * D, scr, r - l * I_1, lane); continue; } r -= 2 * I_1;
            { const int l = r / I_2; p0_transpose_item(p.in[21] + (size_t)l * D * FFN, FFN, D, (bf16_t*)(ws + WS_W2) + (size_t)l * FFN * D, scr, r - l * I_2, lane); }
        }
    }
    {
        const int gtid = blockIdx.x * 512 + tid, gth = G * 512;
        cvt_linear(p.in[2], (bf16_t*)(ws + WS_K0) + (size_t)MTOT * 256, 1024 * 256, gtid, gth);
        cvt_linear(p.in[3], (bf16_t*)(ws + WS_V0) + (size_t)MTOT * 256, 1024 * 256, gtid, gth);
        cvt_linear(p.in[4], (bf16_t*)(ws + WS_CNK), 1024 * 2048, gtid, gth);
        cvt_linear(p.in[5], (bf16_t*)(ws + WS_CNV), 1024 * 2048, gtid, gth);
    }
}

template <bool OUT_F32>
__device__ __forceinline__ void norm_phase(const float* src_lo, const float* src_hi, const float* gain, const float* mod, int shift_off, int scale_off, bf16_t* dst_bf, float* dst_f) {
    int tid_ = threadIdx.x; asm volatile("" : "+v"(tid_));
    const int tid = tid_, lane = tid & 63, wave = tid >> 6, G = gridDim.x;
    const int gw = blockIdx.x * 8 + wave, NGW = G * 8, per = (MTOT + NGW - 1) / NGW;
    const int r_beg = gw * per, r_end = (r_beg + per < MTOT) ? r_beg + per : MTOT;
    int cur = -1; f32x4 A[8], B[8];
    for (int row = r_beg; row < r_end; ++row) {
        const int cond = (row < MCTX) ? 0 : 1 + ((row - MCTX) >> 11);
        if (cond != cur) {
            cur = cond;
#pragma unroll
            for (int j = 0; j < 8; ++j) {
                const int col = 4 * lane + 256 * j; const f32x4 g = *(const f32x4*)(gain + col);
                if (mod) { const f32x4 sc = *(const f32x4*)(mod + (size_t)cond * MODW + scale_off + col); A[j] = g * (sc + 1.f); B[j] = *(const f32x4*)(mod + (size_t)cond * MODW + shift_off + col); }
                else { A[j] = g; B[j] = (f32x4){0.f, 0.f, 0.f, 0.f}; }
            }
        }
        const float* xr = ((row < MCTX) ? src_lo : src_hi) + (size_t)row * D + 4 * lane;
        f32x4 v[8]; float s = 0.f;
#pragma unroll
        for (int j = 0; j < 8; ++j) { v[j] = *(const f32x4*)(xr + 256 * j); s += (v[j].x * v[j].x + v[j].y * v[j].y) + (v[j].z * v[j].z + v[j].w * v[j].w); }
        const float rstd = rsqrtf(wave_sum(s) * (1.f / D) + EPS);
#pragma unroll
        for (int j = 0; j < 8; ++j) {
            const f32x4 y = v[j] * rstd * A[j] + B[j];
            if (OUT_F32) *(f32x4*)(dst_f + (size_t)row * D + 4 * lane + 256 * j) = y;
            else { u32x2 o; o.x = cvt_pk_bf16(y[0], y[1]); o.y = cvt_pk_bf16(y[2], y[3]); *(u32x2*)(dst_bf + (size_t)row * D + 4 * lane + 256 * j) = o; }
        }
    }
}

__device__ __forceinline__ void unpack8(const u32x4 r, float (&f)[8]) {
    f[0] = bf2f(r.x & 0xffffu); f[1] = __uint_as_float(r.x & 0xffff0000u); f[2] = bf2f(r.y & 0xffffu); f[3] = __uint_as_float(r.y & 0xffff0000u);
    f[4] = bf2f(r.z & 0xffffu); f[5] = __uint_as_float(r.z & 0xffff0000u); f[6] = bf2f(r.w & 0xffffu); f[7] = __uint_as_float(r.w & 0xffff0000u);
}
__device__ __forceinline__ void ew0_phase(const Params& p) {
    int tid_ = threadIdx.x; asm volatile("" : "+v"(tid_));
    const int tid = tid_, lane = tid & 63, wave = tid >> 6, G = gridDim.x;
    const int gw = blockIdx.x * 8 + wave, NGW = G * 8;
    unsigned char* ws = p.ws;
    const bf16_t* Z = (const bf16_t*)(ws + WS_Z);
    bf16_t* AB = (bf16_t*)(ws + WS_AB); bf16_t* Q0 = (bf16_t*)(ws + WS_Q0); bf16_t* K0 = (bf16_t*)(ws + WS_K0); bf16_t* V0 = (bf16_t*)(ws + WS_V0);
    const float* convw = p.in[13]; const float* qn = p.in[14]; const float* kn = p.in[15];
    const int ri = lane & 31, chunk = lane >> 5, da = chunk * 64 + ri, db = da + 32;
    const float inv = __builtin_amdgcn_exp2f(-(float)ri * (13.287712379549449f / 32.f));
    const float qwa = qn[da], qwb = qn[db], kwa = kn[da], kwb = kn[db];
    for (int tok = gw; tok < MTOT; tok += NGW) {
        const bool lat = tok >= MCTX;
        const int t = lat ? ((tok - MCTX) & 2047) : (tok & 255), slen = lat ? 2048 : 256;
        const bf16_t* zr = Z + (size_t)tok * ABIN;
#pragma unroll
        for (int j = 0; j < 2; ++j) {
            const int ch = j * 512 + lane * 8;
            float gb[8], acc[8];
            unpack8(*(const u32x4*)(zr + ch), gb);
#pragma unroll
            for (int e = 0; e < 8; ++e) acc[e] = 0.f;
#pragma unroll
            for (int dt = -1; dt <= 1; ++dt) {
                if (t + dt >= 0 && t + dt < slen) {
                    float gc[8], xa[8];
                    unpack8(*(const u32x4*)(zr + dt * ABIN + 1024 + ch), gc);
                    unpack8(*(const u32x4*)(zr + dt * ABIN + 2048 + ch), xa);
                    const f32x4 w0 = *(const f32x4*)(convw + (dt + 1) * 1024 + ch), w1 = *(const f32x4*)(convw + (dt + 1) * 1024 + ch + 4);
#pragma unroll
                    for (int e = 0; e < 4; ++e) { acc[e] += w0[e] * (gc[e] * xa[e]); acc[4 + e] += w1[e] * (gc[4 + e] * xa[4 + e]); }
                }
            }
            u32x4 o; o.x = cvt_pk_bf16(gb[0] * acc[0], gb[1] * acc[1]); o.y = cvt_pk_bf16(gb[2] * acc[2], gb[3] * acc[3]);
            o.z = cvt_pk_bf16(gb[4] * acc[4], gb[5] * acc[5]); o.w = cvt_pk_bf16(gb[6] * acc[6], gb[7] * acc[7]);
            *(u32x4*)(AB + (size_t)tok * D + ch) = o;
        }
        float cs = 1.f, sn = 0.f;
        if (lat) { const float pos = (float)(chunk == 0 ? (t >> 6) : (t & 63)); const float ang = pos * inv; cs = __cosf(ang); sn = __sinf(ang); }
#pragma unroll
        for (int hh = 0; hh < 10; ++hh) {
            const bf16_t* hp = zr + 3072 + hh * 128;
            const float va = bf2f(hp[da]), vb = bf2f(hp[db]);
            const float rstd = rsqrtf(wave_sum(va * va + vb * vb) * (1.f / 128.f) + EPS);
            const float na = va * rstd * (hh < 8 ? qwa : kwa), nb = vb * rstd * (hh < 8 ? qwb : kwb);
            const float ra = na * cs - nb * sn, rb = na * sn + nb * cs;
            if (hh < 8) { bf16_t* q = Q0 + (size_t)tok * 1024 + hh * 128; q[da] = (bf16_t)f2bf(ra); q[db] = (bf16_t)f2bf(rb); }
            else {
                const int kvh = hh - 8;
                bf16_t* k = K0 + (size_t)tok * 256 + kvh * 128; k[da] = (bf16_t)f2bf(ra); k[db] = (bf16_t)f2bf(rb);
                if (!lat) { float* ok = p.out + OUT_AK + (size_t)tok * 256 + kvh * 128; ok[da] = na; ok[db] = nb; }
            }
        }
        {
            const u32x2 r = *(const u32x2*)(zr + 4352 + lane * 4);
            *(u32x2*)(V0 + (size_t)tok * 256 + lane * 4) = r;
            if (!lat) { f32x4 o; o[0] = bf2f(r.x & 0xffffu); o[1] = __uint_as_float(r.x & 0xffff0000u); o[2] = bf2f(r.y & 0xffffu); o[3] = __uint_as_float(r.y & 0xffff0000u);
                *(f32x4*)(p.out + OUT_AV + (size_t)tok * 256 + lane * 4) = o; }
        }
    }
}

constexpr int KSTR = 272, VSTR = 288, LDS_KT = 0, LDS_VT = 2 * 64 * KSTR, LDS_BIAS = LDS_VT + 2 * 64 * VSTR;
constexpr float SCL2 = 0.08838834764831845f * 1.4426950408889634f, LOG2E = 1.4426950408889634f;
struct AttnArgs {
    const bf16_t* q; int qstride; int qrow0;
    bf16_t* o; int ostride;
    const bf16_t* kA; const bf16_t* vA; int strideA, ntA;
    const bf16_t* kB; const bf16_t* vB; int strideB, ntB;
    int r0, krlo; const float* bias;
};
__device__ __forceinline__ v4i16_t vtr(const LAS unsigned char* p) { return __builtin_amdgcn_ds_read_tr16_b64_v4i16((LAS v4i16_t*)p); }

template <int NA>
__device__ __forceinline__ void attn_run(LAS unsigned char* lds, const AttnArgs& a) {
    int tid_ = threadIdx.x; asm volatile("" : "+v"(tid_));
    const int tid = tid_, lane = tid & 63, wave = __builtin_amdgcn_readfirstlane(tid >> 6), fr = lane & 15, fq = lane >> 4;
    bf16x8 Qf[2][4];
#pragma unroll
    for (int qb = 0; qb < 2; ++qb)
#pragma unroll
        for (int dc = 0; dc < 4; ++dc) Qf[qb][dc] = *(const bf16x8*)(a.q + (size_t)(a.qrow0 + wave * 32 + qb * 16 + fr) * a.qstride + dc * 32 + fq * 8);
    f32x4 O[2][8];
#pragma unroll
    for (int qb = 0; qb < 2; ++qb)
#pragma unroll
        for (int db = 0; db < 8; ++db) O[qb][db] = (f32x4){0.f, 0.f, 0.f, 0.f};
    float mrun[2] = {-1e30f, -1e30f}, lrun[2] = {0.f, 0.f};
    LAS float* biasL = (LAS float*)(lds + LDS_BIAS);
    if (NA) { for (int i = tid; i < 465; i += 512) biasL[i] = a.bias[i]; }
    const int nt = a.ntA + a.ntB;
    const int lrow = tid >> 3, lch = tid & 7;
    u32x4 kr0, kr1, vr0, vr1;
#define ATT_GLOAD(t) do { const bool inA = (t) < a.ntA; const int tt = inA ? (t) : (t) - a.ntA; const int st = inA ? a.strideA : a.strideB; \
        const bf16_t* kp = (inA ? a.kA : a.kB) + (size_t)(tt * 64 + lrow) * st + lch * 8; const bf16_t* vp = (inA ? a.vA : a.vB) + (size_t)(tt * 64 + lrow) * st + lch * 8; \
        kr0 = *(const u32x4*)kp; kr1 = *(const u32x4*)(kp + 64); vr0 = *(const u32x4*)vp; vr1 = *(const u32x4*)(vp + 64); } while (0)
#define ATT_LWRITE(b) do { LAS unsigned char* kd = lds + LDS_KT + (b) * 64 * KSTR + lrow * KSTR + lch * 16; LAS unsigned char* vd = lds + LDS_VT + (b) * 64 * VSTR + lrow * VSTR + lch * 16; \
        *(LAS u32x4*)kd = kr0; *(LAS u32x4*)(kd + 128) = kr1; *(LAS u32x4*)vd = vr0; *(LAS u32x4*)(vd + 128) = vr1; } while (0)
    ATT_GLOAD(0); ATT_LWRITE(0); __syncthreads();
    const int rw = NA ? a.r0 + (wave >> 1) : 0;
    const int kr_lo_w = NA ? (rw - 4 < 0 ? 0 : (rw - 4 > 24 ? 24 : rw - 4)) : 0;
    for (int t = 0; t < nt; ++t) {
        if (t + 1 < nt) ATT_GLOAD(t + 1);
        bool active = true; int kr = 0; const bool local = NA && t >= a.ntA;
        if (local) { kr = a.krlo + (t - a.ntA); active = (kr >= kr_lo_w) && (kr < kr_lo_w + 8); }
        if (active) {
            const LAS unsigned char* Kt = lds + LDS_KT + (t & 1) * 64 * KSTR;
            const LAS unsigned char* Vt = lds + LDS_VT + (t & 1) * 64 * VSTR;
            f32x4 S[2][4];
#pragma unroll
            for (int qb = 0; qb < 2; ++qb)
#pragma unroll
                for (int kb = 0; kb < 4; ++kb) S[qb][kb] = (f32x4){0.f, 0.f, 0.f, 0.f};
#pragma unroll
            for (int kb = 0; kb < 4; ++kb)
#pragma unroll
                for (int dc = 0; dc < 4; ++dc) {
                    const bf16x8 kf = *(const LAS bf16x8*)(Kt + (kb * 16 + fr) * KSTR + dc * 64 + fq * 16);
                    S[0][kb] = __builtin_amdgcn_mfma_f32_16x16x32_bf16(kf, Qf[0][dc], S[0][kb], 0, 0, 0);
                    S[1][kb] = __builtin_amdgcn_mfma_f32_16x16x32_bf16(kf, Qf[1][dc], S[1][kb], 0, 0, 0);
                }
            bf16x8 Pf[2][2];
#pragma unroll
            for (int qb = 0; qb < 2; ++qb) {
                if (local) {
                    const int c = (wave & 1) * 32 + qb * 16 + fr;
                    const int kc0 = c - 8 < 0 ? 0 : (c - 8 > 48 ? 48 : c - 8);
                    const LAS float* brow = biasL + (kr - rw + 7) * 31 + 15 - c;
#pragma unroll
                    for (int kb = 0; kb < 4; ++kb)
#pragma unroll
                        for (int j = 0; j < 4; ++j) { const int kc = kb * 16 + 4 * fq + j; const bool ok = (kc >= kc0) && (kc < kc0 + 16);
                            const float bv = brow[ok ? kc : c];
                            S[qb][kb][j] = ok ? (S[qb][kb][j] * SCL2 + bv * LOG2E) : -1e30f; }
                } else {
#pragma unroll
                    for (int kb = 0; kb < 4; ++kb) S[qb][kb] = S[qb][kb] * SCL2;
                }
                float mx = -1e30f;
#pragma unroll
                for (int kb = 0; kb < 4; ++kb) mx = fmaxf(mx, fmaxf(fmaxf(S[qb][kb][0], S[qb][kb][1]), fmaxf(S[qb][kb][2], S[qb][kb][3])));
                mx = fmaxf(mx, __shfl_xor(mx, 16)); mx = fmaxf(mx, __shfl_xor(mx, 32));
                const float mn = fmaxf(mrun[qb], mx), alpha = __builtin_amdgcn_exp2f(mrun[qb] - mn);
                mrun[qb] = mn;
                float rs = 0.f;
#pragma unroll
                for (int kb = 0; kb < 4; ++kb)
#pragma unroll
                    for (int j = 0; j < 4; ++j) { const float pv = __builtin_amdgcn_exp2f(S[qb][kb][j] - mn); S[qb][kb][j] = pv; rs += pv; }
                lrun[qb] = lrun[qb] * alpha + rs;
#pragma unroll
                for (int db = 0; db < 8; ++db) O[qb][db] = O[qb][db] * alpha;
#pragma unroll
                for (int c2 = 0; c2 < 2; ++c2) {
                    u32x4 pk; pk.x = cvt_pk_bf16(S[qb][2 * c2][0], S[qb][2 * c2][1]); pk.y = cvt_pk_bf16(S[qb][2 * c2][2], S[qb][2 * c2][3]);
                    pk.z = cvt_pk_bf16(S[qb][2 * c2 + 1][0], S[qb][2 * c2 + 1][1]); pk.w = cvt_pk_bf16(S[qb][2 * c2 + 1][2], S[qb][2 * c2 + 1][3]);
                    Pf[qb][c2] = __builtin_bit_cast(bf16x8, pk);
                }
            }
            const LAS unsigned char* vb = Vt + (4 * fq + (fr >> 2)) * VSTR + (fr & 3) * 8;
#pragma unroll
            for (int c2 = 0; c2 < 2; ++c2)
#pragma unroll
                for (int db = 0; db < 8; ++db) {
                    const v4i16_t lo = vtr(vb + (c2 * 32) * VSTR + db * 32), hi = vtr(vb + (c2 * 32 + 16) * VSTR + db * 32);
                    bf16x8 vf; vf[0] = lo[0]; vf[1] = lo[1]; vf[2] = lo[2]; vf[3] = lo[3]; vf[4] = hi[0]; vf[5] = hi[1]; vf[6] = hi[2]; vf[7] = hi[3];
                    O[0][db] = __builtin_amdgcn_mfma_f32_16x16x32_bf16(vf, Pf[0][c2], O[0][db], 0, 0, 0);
                    O[1][db] = __builtin_amdgcn_mfma_f32_16x16x32_bf16(vf, Pf[1][c2], O[1][db], 0, 0, 0);
                }
        }
        if (t + 1 < nt) ATT_LWRITE((t + 1) & 1);
        __syncthreads();
    }
#undef ATT_GLOAD
#undef ATT_LWRITE
#pragma unroll
    for (int qb = 0; qb < 2; ++qb) {
        float lt = lrun[qb]; lt += __shfl_xor(lt, 16); lt += __shfl_xor(lt, 32);
        const float il = 1.f / lt;
        bf16_t* op = a.o + (size_t)(a.qrow0 + wave * 32 + qb * 16 + fr) * a.ostride + 4 * fq;
#pragma unroll
        for (int db = 0; db < 8; ++db) { const f32x4 v = O[qb][db] * il; u32x2 o; o.x = cvt_pk_bf16(v[0], v[1]); o.y = cvt_pk_bf16(v[2], v[3]); *(u32x2*)(op + db * 16) = o; }
    }
}

__device__ __forceinline__ void attn0_phase(const Params& p, LAS unsigned char* lds) {
    unsigned char* ws = p.ws; const int G = gridDim.x;
    const bf16_t* Q0 = (const bf16_t*)(ws + WS_Q0); const bf16_t* K0 = (const bf16_t*)(ws + WS_K0); const bf16_t* V0 = (const bf16_t*)(ws + WS_V0);
    bf16_t* AB = (bf16_t*)(ws + WS_AB);
    for (int i = blockIdx.x; i < 512; i += G) {
        if (i >= 256 && i < 384) continue;
        AttnArgs a;
        if (i < 128) { const int b = i >> 6, h = (i >> 3) & 7, qblk = i & 7, kvh = h >> 2;
            a.q = Q0 + h * 128; a.qstride = 1024; a.qrow0 = MCTX + b * 2048 + qblk * 256; a.o = AB + 1024 + h * 128; a.ostride = D;
            a.kA = K0 + (size_t)(MTOT + b * 512) * 256 + kvh * 128; a.vA = V0 + (size_t)(MTOT + b * 512) * 256 + kvh * 128; a.strideA = 256; a.ntA = 8;
            a.kB = K0 + (size_t)(MCTX + b * 2048) * 256 + kvh * 128; a.vB = V0 + (size_t)(MCTX + b * 2048) * 256 + kvh * 128; a.strideB = 256; a.ntB = 32;
        } else { const int j = (i < 256) ? i - 128 : i - 256, b = j >> 3, h = j & 7, kvh = h >> 2;
            a.q = Q0 + h * 128; a.qstride = 1024; a.qrow0 = b * 256; a.o = AB + 1024 + h * 128; a.ostride = D;
            a.kA = K0 + (size_t)(b * 256) * 256 + kvh * 128; a.vA = V0 + (size_t)(b * 256) * 256 + kvh * 128; a.strideA = 256; a.ntA = 4;
            a.kB = a.kA; a.vB = a.vA; a.strideB = 256; a.ntB = 0;
        }
        a.r0 = 0; a.krlo = 0; a.bias = nullptr;
        attn_run<0>(lds, a);
    }
}
__device__ __forceinline__ void attn1_phase(const Params& p, LAS unsigned char* lds, bf16_t* AO) {
    unsigned char* ws = p.ws; const int G = gridDim.x;
    const bf16_t* Q1 = (const bf16_t*)(ws + WS_Z); const bf16_t* K1 = Q1 + (size_t)MTOT * D; const bf16_t* V1 = K1 + (size_t)MTOT * D;
    const bf16_t* CNK = (const bf16_t*)(ws + WS_CNK); const bf16_t* CNV = (const bf16_t*)(ws + WS_CNV);
    for (int i = blockIdx.x; i < 256; i += G) {
        AttnArgs a;
        const int b = i >> 7, h = (i >> 3) & 15, rg = i & 7, r0 = rg * 4;
        const int lo = r0 - 4 < 0 ? 0 : (r0 - 4 > 24 ? 24 : r0 - 4), hi0 = r0 - 1 < 0 ? 0 : (r0 - 1 > 24 ? 24 : r0 - 1), hi = hi0 + 7;
        a.q = Q1 + h * 128; a.qstride = D; a.qrow0 = MCTX + b * 2048 + r0 * 64; a.o = AO + h * 128; a.ostride = D;
        a.kA = CNK + (size_t)(b * 512) * 2048 + h * 128; a.vA = CNV + (size_t)(b * 512) * 2048 + h * 128; a.strideA = 2048; a.ntA = 8;
        a.kB = K1 + (size_t)(MCTX + b * 2048 + lo * 64) * D + h * 128; a.vB = V1 + (size_t)(MCTX + b * 2048 + lo * 64) * D + h * 128; a.strideB = D; a.ntB = hi - lo + 1;
        a.r0 = r0; a.krlo = lo; a.bias = p.in[18] + h * 465;
        attn_run<1>(lds, a);
    }
    for (int j = blockIdx.x; j < 512; j += G) {
        AttnArgs a;
        const int b = j >> 4, h = j & 15;
        a.q = Q1 + h * 128; a.qstride = D; a.qrow0 = b * 256; a.o = AO + h * 128; a.ostride = D;
        a.kA = K1 + (size_t)(b * 256) * D + h * 128; a.vA = V1 + (size_t)(b * 256) * D + h * 128; a.strideA = D; a.ntA = 4;
        a.kB = a.kA; a.vB = a.vA; a.strideB = D; a.ntB = 0;
        a.r0 = 0; a.krlo = 0; a.bias = nullptr;
        attn_run<0>(lds, a);
    }
}

constexpr int NPHASE = 18;
__global__ void __launch_bounds__(512, 2) mega_fwd(Params p) {
    extern __shared__ __attribute__((aligned(16))) unsigned char lds_raw[];
    LAS unsigned char* lds = (LAS unsigned char*)lds_raw;
    cg::grid_group grid = cg::this_grid();
    unsigned char* ws = p.ws;
    const int G = gridDim.x;
    float* MOD = (float*)(ws + WS_MOD);
    bf16_t* XN = (bf16_t*)(ws + WS_XN); float* X = (float*)(ws + WS_X);
    bf16_t* Z = (bf16_t*)(ws + WS_Z); bf16_t* AB = (bf16_t*)(ws + WS_AB); bf16_t* H = (bf16_t*)(ws + WS_H);
#define RUN(k) (p.ph_lo <= (k) && (k) < p.ph_hi)
#define GRID_SYNC() do { asm volatile("s_waitcnt vmcnt(0) lgkmcnt(0)" ::: "memory"); grid.sync(); __builtin_amdgcn_fence(__ATOMIC_ACQUIRE, "agent"); asm volatile("s_waitcnt vmcnt(0)" ::: "memory"); } while (0)
#define SEAM(k) do { if (p.ph_lo <= (k) && (k) + 1 < p.ph_hi) GRID_SYNC(); } while (0)
    if (RUN(0)) p0_prologue(p, lds);
    SEAM(0);
    for (int l = 0; l < 2; ++l) {
        const int k0 = 1 + 8 * l;
        const float* modl = MOD + (size_t)l * 3 * MODW;
        const float* xin_lo = (l == 0) ? p.in[0] : X;
        const float* xin_hi = (l == 0) ? p.in[1] - (size_t)MCTX * D : X;
        if (RUN(k0)) norm_phase<false>(xin_lo, xin_hi, p.in[10] + l * D, modl, 0, D, XN, nullptr);
        SEAM(k0);
        if (RUN(k0 + 1)) {
            if (l == 0) { pg8::Gemm g{XN, (const bf16_t*)(ws + WS_WIN), MTOT, ABIN, D}; pg8::StaticOrder S; S.init(MTOT, ABIN, G, (int)blockIdx.x);
                EpiBf16<0, false> E{Z, ABIN, nullptr, nullptr, 0, 0}; pg8::gemm_phase(lds, g, S, E); }
            else { pg8::Gemm g{XN, (const bf16_t*)(ws + WS_WQKV), MTOT, NQKV, D}; pg8::StaticOrder S; S.init(MTOT, NQKV, G, (int)blockIdx.x);
                EpiBf16<0, true> E{Z, D, p.out + OUT_NK, p.out + OUT_NV, 8, (size_t)MTOT * D}; pg8::gemm_phase(lds, g, S, E); }
        }
        SEAM(k0 + 1);
        if (l == 0) { if (RUN(k0 + 2)) ew0_phase(p); SEAM(k0 + 2); }
        if (RUN(k0 + 3)) { if (l == 0) attn0_phase(p, lds); else attn1_phase(p, lds, AB); }
        SEAM(k0 + 3);
        if (RUN(k0 + 4)) { pg8::Gemm g{AB, (const bf16_t*)(ws + (l == 0 ? WS_WO0 : WS_WO1)), MTOT, D, D}; pg8::StaticOrder S; S.init(MTOT, D, G, (int)blockIdx.x);
            EpiResid E{xin_lo, xin_hi, X, modl + 2 * D}; pg8::gemm_phase(lds, g, S, E); }
        SEAM(k0 + 4);
        if (RUN(k0 + 5)) norm_phase<false>(X, X, p.in[11] + l * D, modl, 3 * D, 4 * D, XN, nullptr);
        SEAM(k0 + 5);
        if (RUN(k0 + 6)) { pg8::Gemm g{XN, (const bf16_t*)(ws + WS_W1) + (size_t)l * FFN * D, MTOT, FFN, D}; pg8::StaticOrder S; S.init(MTOT, FFN, G, (int)blockIdx.x);
            EpiBf16<1, false> E{H, FFN, nullptr, nullptr, 0, 0}; pg8::gemm_phase(lds, g, S, E); }
        SEAM(k0 + 6);
        if (RUN(k0 + 7)) { pg8::Gemm g{H, (const bf16_t*)(ws + WS_W2) + (size_t)l * FFN * D, MTOT, D, FFN}; pg8::StaticOrder S; S.init(MTOT, D, G, (int)blockIdx.x);
            EpiResid E{X, X, X, modl + 5 * D}; pg8::gemm_phase(lds, g, S, E); }
        SEAM(k0 + 7);
    }
#if PROBE_STOP > 0
    GRID_SYNC();
    {
        const size_t n = (size_t)MTOT * D, gt = (size_t)blockIdx.x * 512 + threadIdx.x, gs = (size_t)G * 512;
        const bf16_t* sb = PROBE_SRC == 1 ? XN : PROBE_SRC == 2 ? AB : PROBE_SRC == 3 ? Z : PROBE_SRC == 5 ? Z + (size_t)4096 * NQKV : (const bf16_t*)(ws + WS_Q0);
#if PROBE_SRC == 6
        attn1_phase(p, lds, XN);
        GRID_SYNC();
        for (size_t i = gt; i < n; i += gs) p.out[i] = bf2f(AB[i]) - bf2f(XN[i]);
#else
        for (size_t i = gt; i < n; i += gs) p.out[i] = (PROBE_SRC == 0) ? X[i] : bf2f(sb[i]);
#endif
#if PROBE_STOP < 4
        for (size_t i = gt; i < (size_t)2 * MCTX * 256; i += gs) p.out[OUT_AK + i] = 0.f;
#endif
        for (size_t i = gt; i < (size_t)2 * MCTX * D; i += gs) p.out[OUT_NK + i] = 0.f;
    }
#else
    if (RUN(17)) norm_phase<true>(X, X, p.in[22], nullptr, 0, 0, nullptr, p.out);
#endif
#undef RUN
#undef SEAM
#undef GRID_SYNC
}

extern "C" void kernel_launch(void* const* d_in, const int* in_sizes, int n_in, void* d_out, int out_size, void* d_ws, size_t ws_size, hipStream_t stream) {
    static int grid = 0;
    if (grid == 0) {
        if (n_in != 23 || ws_size < WS_END) { fprintf(stderr, "kernel_launch: expected 23 inputs and >= %zu bytes of workspace (got %d, %zu)\n", (size_t)WS_END, n_in, ws_size); grid = -1; return; }
        int dev = 0, cus = 0, per_cu = 0;
        (void)hipGetDevice(&dev);
        (void)hipDeviceGetAttribute(&cus, hipDeviceAttributeMultiprocessorCount, dev);
        if (hipFuncSetAttribute((const void*)mega_fwd, hipFuncAttributeMaxDynamicSharedMemorySize, LDS_BYTES) != hipSuccess) { fprintf(stderr, "kernel_launch: hipFuncSetAttribute failed\n"); grid = -1; return; }
        if (hipOccupancyMaxActiveBlocksPerMultiprocessor(&per_cu, (const void*)mega_fwd, 512, LDS_BYTES) != hipSuccess || per_cu < 1) { fprintf(stderr, "kernel_launch: occupancy query failed (%d)\n", per_cu); grid = -1; return; }
        grid = cus * (per_cu > 1 ? 1 : per_cu);
        fprintf(stderr, "kernel_launch: grid %d (cus %d, per_cu %d)\n", grid, cus, per_cu);
    }
    if (grid < 0) return;
    Params p{};
    for (int i = 0; i < 23; ++i) p.in[i] = (const float*)d_in[i];
    p.out = (float*)d_out; p.ws = (unsigned char*)d_ws;
#if MK_PER_PHASE
    for (int k = 0; k < NPHASE; ++k) {
        if (k == 11) continue;
        p.ph_lo = k; p.ph_hi = k + 1;
        void* args[] = {&p};
        hipError_t e = hipLaunchCooperativeKernel((const void*)mega_fwd, dim3(grid), dim3(512), args, LDS_BYTES, stream);
        if (e != hipSuccess) { fprintf(stderr, "launch %d failed: %s\n", k, hipGetErrorString(e)); break; }
    }
#else
    p.ph_lo = 0; p.ph_hi = PROBE_STOP > 0 ? PROBE_STOP : NPHASE;
    void* args[] = {&p};
    hipError_t e = hipLaunchCooperativeKernel((const void*)mega_fwd, dim3(grid), dim3(512), args, LDS_BYTES, stream);
    if (e != hipSuccess) fprintf(stderr, "cooperative launch failed: %s (grid %d)\n", hipGetErrorString(e), grid);
#endif
}
```

```cpp
#include <hip/hip_runtime.h>
#include <hip/hip_cooperative_groups.h>
#include <cstdio>
#include <cstdint>
namespace cg = cooperative_groups;

#ifndef MK_PER_PHASE
#define MK_PER_PHASE 0
#endif

#ifndef REP_NG
#define REP_NG 1
#endif
#ifndef REP_P0
#define REP_P0 REP_NG
#endif
#ifndef REP_NORM
#define REP_NORM REP_NG
#endif
#ifndef REP_EW
#define REP_EW REP_NG
#endif
#ifndef REP_ATT
#define REP_ATT REP_NG
#endif
#ifndef REP_G
#define REP_G 1
#endif
#ifndef PROBE_STOP
#define PROBE_STOP 0
#endif
#ifndef PROBE_SRC
#define PROBE_SRC 0
#endif
#define LAS __attribute__((address_space(3)))
#define PG8_LAS __attribute__((address_space(3)))
typedef unsigned short bf16_t;
typedef short bf16x8 __attribute__((ext_vector_type(8)));
typedef short v4i16_t __attribute__((ext_vector_type(4)));
typedef float f32x4 __attribute__((ext_vector_type(4)));
typedef float f32x2 __attribute__((ext_vector_type(2)));
typedef unsigned u32x4 __attribute__((ext_vector_type(4)));
typedef unsigned u32x2 __attribute__((ext_vector_type(2)));

__device__ __forceinline__ float bf2f(unsigned h) { return __uint_as_float(h << 16); }
typedef __bf16 bf16x2_t __attribute__((ext_vector_type(2)));
__device__ __forceinline__ unsigned cvt_pk_bf16(float lo, float hi) { f32x2 v = {lo, hi}; bf16x2_t r = __builtin_convertvector(v, bf16x2_t); return __builtin_bit_cast(unsigned, r); }
__device__ __forceinline__ float wave_sum(float v) {
#pragma unroll
    for (int o = 1; o < 64; o <<= 1) v += __shfl_xor(v, o);
    return v;
}

namespace pg8 {
constexpr int BM = 256, BK = 64, HALF = 128, HTB = HALF * BK * 2  , STAGE_BYTES = 8 * HTB, NXCD = 8, WGM = 8;

__host__ __device__ __forceinline__ int lds_byte(int r, int c) { const int st = (r >> 4) * 2 + (c >> 5), rr = r & 15, cc = c & 31, ob = rr * 64 + cc * 2; return st * 1024 + (ob ^ (((ob >> 9) & 1) << 5)); }
__host__ __device__ __forceinline__ void stage_rc(int b, int& R, int& C) { const int st = b / 1024, sb = b % 1024, swz = sb ^ (((sb >> 9) & 1) << 5); R = (st >> 1) * 16 + swz / 64; C = (st & 1) * 32 + (swz % 64) / 2; }
__host__ __device__ __forceinline__ int perm32(int rho) { const int n = rho >> 4, i = rho & 15; return 8 * (i >> 2) + 4 * n + (i & 3); }
struct Unit { int pm, pn; };
struct Gemm { const bf16_t* A; const bf16_t* Bt; int M, N, K; };
struct StaticOrder {
    int nM, nN, nwg, G, c;
    __host__ __device__ void init(int M, int N, int G_, int c_) { nM = M / BM; nN = N / BM; nwg = nM * nN; G = G_; c = c_; }
    __host__ __device__ bool next(int i, Unit& u) const {
        const long L = (long)i * G + c; if (L >= nwg) return false;
        int wgid = (int)L; { const int q = nwg / NXCD, r = nwg % NXCD, xcd = wgid % NXCD, off = wgid / NXCD; wgid = (xcd < r ? xcd * (q + 1) : r * (q + 1) + (xcd - r) * q) + off; }
        const int nig = WGM * nN, gid = wgid / nig, fm = gid * WGM, gsz = (nM - fm) < WGM ? (nM - fm) : WGM;
        u.pm = fm + ((wgid % nig) % gsz); u.pn = (wgid % nig) / gsz; return true;
    }
    __device__ __forceinline__ void a_ready(const Unit&) const {}
    __device__ __forceinline__ void done(const Unit&) const {}
};
template <class Epi, class Sched>
__device__ __forceinline__ void gemm_phase(PG8_LAS unsigned char* lds, const Gemm g, const Sched& S, const Epi& E) {
    int tid_ = threadIdx.x; asm volatile("" : "+v"(tid_));
    const int tid = tid_, wid = __builtin_amdgcn_readfirstlane(tid >> 6), lane = tid & 63, wr = wid >> 2, wc = wid & 3, fr = lane & 15, fq = lane >> 4;
    const int K = g.K, nt = K / BK;
    unsigned voffA[2], voffB[2];
#pragma unroll
    for (int i = 0; i < 2; ++i) { int R, C; stage_rc(tid * 16 + i * 8192, R, C); const int Rb = Epi::PERM ? ((R & ~31) + perm32(R & 31)) : R;
        voffA[i] = (unsigned)(R * K + C) * 2u; voffB[i] = (unsigned)(Rb * K + C) * 2u; }
    const size_t kstep = (size_t)(BK * 2);
    const size_t hstep = (size_t)HALF * K * 2;
    const size_t tstep = 2 * hstep;
    const unsigned ldsw = (unsigned)wid * 1024u;
    const int aoff = lds_byte(wr * 64 + fr, fq * 8), boff = lds_byte(wc * 32 + fr, fq * 8);
#define PG8_SA(b, h) (((b) * 2 + (h)) * HTB)
#define PG8_SB(b, h) ((4 + (b) * 2 + (h)) * HTB)
#define PG8_STAGE(bufoff, gbase, voff) do { _Pragma("unroll") for (int _i = 0; _i < 2; ++_i) \
        __builtin_amdgcn_global_load_lds((const unsigned*)((const char*)(gbase) + (voff)[_i]), (PG8_LAS unsigned*)(lds + (bufoff) + ldsw + _i * 8192), 16, 0, 0); } while (0)
#define PG8_LDA(dst, b, h) do { _Pragma("unroll") for (int m = 0; m < 4; ++m) _Pragma("unroll") for (int k = 0; k < 2; ++k) dst[m][k] = *(const PG8_LAS bf16x8*)(lds + PG8_SA(b, h) + aoff + m * 2048 + k * 1024); } while (0)
#define PG8_LDB(dst, b, h) do { _Pragma("unroll") for (int n = 0; n < 2; ++n) _Pragma("unroll") for (int k = 0; k < 2; ++k) dst[n][k] = *(const PG8_LAS bf16x8*)(lds + PG8_SB(b, h) + boff + n * 2048 + k * 1024); } while (0)
#define PG8_MMA(ai, bj, At, Bt) do { __builtin_amdgcn_s_setprio(1); _Pragma("unroll") for (int m = 0; m < 4; ++m) _Pragma("unroll") for (int n = 0; n < 2; ++n) _Pragma("unroll") for (int k = 0; k < 2; ++k) \
        acc[ai][bj][m][n] = __builtin_amdgcn_mfma_f32_16x16x32_bf16(Bt[n][k], At[m][k], acc[ai][bj][m][n], 0, 0, 0); __builtin_amdgcn_s_setprio(0); } while (0)
#define PG8_WAIT_V(n) asm volatile("s_waitcnt vmcnt(" #n ")" ::: "memory")
#define PG8_WAIT_L(n) asm volatile("s_waitcnt lgkmcnt(" #n ")" ::: "memory")
#define PG8_BAR __builtin_amdgcn_s_barrier()
#define PG8_SCHED __builtin_amdgcn_sched_barrier(0)
    Unit cur, nxt; int ui = 0;
    if (!S.next(0, cur)) return;
    f32x4 acc[2][2][4][2];
#pragma unroll
    for (int a = 0; a < 2; ++a)
#pragma unroll
        for (int b = 0; b < 2; ++b)
#pragma unroll
            for (int m = 0; m < 4; ++m)
#pragma unroll
                for (int n = 0; n < 2; ++n) acc[a][b][m][n] = (f32x4){0.f, 0.f, 0.f, 0.f};
    bf16x8 At[4][2], B0[2][2], B1[2][2];
    const char* cA = (const char*)g.A + (size_t)cur.pm * tstep; const char* cB = (const char*)g.Bt + (size_t)cur.pn * tstep;
    S.a_ready(cur);
    PG8_STAGE(PG8_SB(0, 0), cB, voffB); PG8_STAGE(PG8_SA(0, 0), cA, voffA); PG8_STAGE(PG8_SB(0, 1), cB + hstep, voffB); PG8_STAGE(PG8_SA(0, 1), cA + hstep, voffA);
    if (wr == 1) PG8_BAR;
    PG8_WAIT_V(4); PG8_BAR;
    PG8_STAGE(PG8_SB(1, 0), cB + kstep, voffB); PG8_STAGE(PG8_SA(1, 0), cA + kstep, voffA); PG8_STAGE(PG8_SB(1, 1), cB + hstep + kstep, voffB);
    PG8_WAIT_V(6); PG8_BAR;
    for (;;) {
        const bool has_next = S.next(ui + 1, nxt);
        const char* nA = has_next ? (const char*)g.A + (size_t)nxt.pm * tstep : cA; const char* nB = has_next ? (const char*)g.Bt + (size_t)nxt.pn * tstep : cB;
        for (int t = 0; t < nt; t += 2) {
            const bool last = (t == nt - 2);
            const char* a1 = cA + (size_t)(t + 1) * kstep;
            const char* a2 = last ? nA : cA + (size_t)(t + 2) * kstep; const char* b2 = last ? nB : cB + (size_t)(t + 2) * kstep;
            const char* a3 = a2 + kstep; const char* b3 = b2 + kstep;
            if (last && has_next) S.a_ready(nxt);
            PG8_LDB(B0, 0, 0); PG8_SCHED; PG8_LDA(At, 0, 0); PG8_STAGE(PG8_SA(1, 1), a1 + hstep, voffA);
            PG8_WAIT_L(8); PG8_BAR; PG8_WAIT_L(0); PG8_MMA(0, 0, At, B0); PG8_BAR; PG8_SCHED;
            PG8_LDB(B1, 0, 1); PG8_STAGE(PG8_SB(0, 0), b2, voffB);
            PG8_BAR; PG8_WAIT_L(0); PG8_MMA(0, 1, At, B1); PG8_BAR;
            PG8_LDA(At, 0, 1); PG8_STAGE(PG8_SA(0, 0), a2, voffA);
            PG8_BAR; PG8_WAIT_L(0); PG8_MMA(1, 0, At, B0); PG8_BAR; PG8_SCHED;
            PG8_STAGE(PG8_SB(0, 1), b2 + hstep, voffB);
            PG8_WAIT_V(6); PG8_BAR; PG8_MMA(1, 1, At, B1); PG8_BAR;
            PG8_LDB(B0, 1, 0); PG8_SCHED; PG8_LDA(At, 1, 0); PG8_STAGE(PG8_SA(0, 1), a2 + hstep, voffA);
            PG8_WAIT_L(8); PG8_BAR; PG8_WAIT_L(0); PG8_MMA(0, 0, At, B0); PG8_BAR; PG8_SCHED;
            PG8_LDB(B1, 1, 1); PG8_STAGE(PG8_SB(1, 0), b3, voffB);
            PG8_BAR; PG8_WAIT_L(0); PG8_MMA(0, 1, At, B1); PG8_BAR;
            PG8_LDA(At, 1, 1); PG8_STAGE(PG8_SA(1, 0), a3, voffA);
            PG8_BAR; PG8_WAIT_L(0); PG8_MMA(1, 0, At, B0); PG8_BAR; PG8_SCHED;
            PG8_STAGE(PG8_SB(1, 1), b3 + hstep, voffB);
            PG8_WAIT_V(6); PG8_BAR; PG8_MMA(1, 1, At, B1); PG8_BAR;
        }
        if constexpr (!Epi::AFTER_DRAIN) { E(acc, cur, wr, wc, fr, fq); S.done(cur); }
        if (!has_next) break;
#pragma unroll
        for (int a = 0; a < 2; ++a)
#pragma unroll
            for (int b = 0; b < 2; ++b)
#pragma unroll
                for (int m = 0; m < 4; ++m)
#pragma unroll
                    for (int n = 0; n < 2; ++n) acc[a][b][m][n] = (f32x4){0.f, 0.f, 0.f, 0.f};
        cur = nxt; cA = nA; cB = nB; ++ui;
    }
    PG8_WAIT_V(0);
    if (wr == 0) PG8_BAR;
    PG8_BAR;
    if constexpr (Epi::AFTER_DRAIN) { E.fused(acc, cur, wr, wc, fr, fq, lds, wid, lane); S.done(cur); }
#undef PG8_SA
#undef PG8_SB
#undef PG8_STAGE
#undef PG8_LDA
#undef PG8_LDB
#undef PG8_MMA
#undef PG8_WAIT_V
#undef PG8_WAIT_L
#undef PG8_BAR
#undef PG8_SCHED
}
}

constexpr int D = 2048, MCTX = 8192, MLAT = 4096, MTOT = 12288, FFN = 8192, ABIN = 4608, NQKV = 6144, MODW = 12288;
constexpr float EPS = 1e-6f;
constexpr size_t WS_MOD = 0;
constexpr size_t WS_BAR = 512u << 10;
constexpr size_t WS_WIN = 1u << 20;
constexpr size_t WS_WO0 = WS_WIN + (size_t)ABIN * D * 2;
constexpr size_t WS_WQKV = WS_WO0 + (size_t)D * D * 2;
constexpr size_t WS_WO1 = WS_WQKV + (size_t)NQKV * D * 2;
constexpr size_t WS_W1 = WS_WO1 + (size_t)D * D * 2;
constexpr size_t WS_W2 = WS_W1 + 2 * (size_t)FFN * D * 2;
constexpr size_t WS_XN = WS_W2 + 2 * (size_t)FFN * D * 2;
constexpr size_t WS_H = WS_XN + (size_t)MTOT * D * 2;
constexpr size_t WS_Z = WS_H + (size_t)MTOT * FFN * 2;
constexpr size_t WS_AB = WS_Z + (size_t)MTOT * NQKV * 2;
constexpr size_t WS_Q0 = WS_AB + (size_t)MTOT * D * 2;
constexpr size_t WS_K0 = WS_Q0 + (size_t)MTOT * 1024 * 2;
constexpr size_t WS_V0 = WS_K0 + (size_t)(MTOT + 1024) * 256 * 2;
constexpr size_t WS_CNK = WS_V0 + (size_t)(MTOT + 1024) * 256 * 2;
constexpr size_t WS_CNV = WS_CNK + (size_t)1024 * 2048 * 2;
constexpr size_t WS_X = WS_CNV + (size_t)1024 * 2048 * 2;
constexpr size_t WS_END = WS_X + (size_t)MTOT * D * 4;
constexpr int LDS_BYTES = 131072 + 256;

constexpr size_t OUT_YP = 0, OUT_YS = (size_t)MCTX * D, OUT_AK = OUT_YS + (size_t)MLAT * D, OUT_AV = OUT_AK + (size_t)MCTX * 256,
                 OUT_NK = OUT_AV + (size_t)MCTX * 256, OUT_NV = OUT_NK + (size_t)MCTX * D;

struct Params {
    const float* in[23];
    float* out;
    unsigned char* ws;
    int ph_lo, ph_hi;
};

template <int ACT, bool SIDE> struct EpiBf16 {
    static constexpr bool PERM = true, AFTER_DRAIN = false;
    bf16_t* O; int ldc; float* kout; float* vout; int split_tiles; size_t split_stride;
    __device__ __forceinline__ void operator()(const f32x4 (&acc)[2][2][4][2], const pg8::Unit& u, int wr, int wc, int fr, int fq) const {
        const int row0 = u.pm * 256 + wr * 64 + fr, col0 = u.pn * 256 + wc * 32 + 8 * fq;
        const int spt = split_tiles ? u.pn / split_tiles : 0; bf16_t* Ob = O + (size_t)spt * split_stride; const int ocol0 = col0 - spt * split_tiles * 256;
        const bool side = SIDE && (u.pm < 32) && (u.pn >= 8);
        float* sbase = nullptr; int scol0 = 0;
        if (SIDE) { sbase = (u.pn < 16) ? kout : vout; scol0 = col0 - ((u.pn < 16) ? 2048 : 4096); }
#pragma unroll
        for (int ai = 0; ai < 2; ++ai)
#pragma unroll
            for (int m = 0; m < 4; ++m) {
                const int row = row0 + ai * 128 + m * 16;
                bf16_t* rowp = Ob + (size_t)row * ldc + ocol0;
#pragma unroll
                for (int bj = 0; bj < 2; ++bj) {
                    f32x4 v0 = acc[ai][bj][m][0], v1 = acc[ai][bj][m][1];
                    if (SIDE) { if (side) { float* sp = sbase + (size_t)row * 2048 + scol0 + bj * 128; *(f32x4*)sp = v0; *(f32x4*)(sp + 4) = v1; } }
                    if (ACT == 1) {
#pragma unroll
                        for (int j = 0; j < 4; ++j) { float a = fmaxf(v0[j], 0.f), b = fmaxf(v1[j], 0.f); v0[j] = a * a; v1[j] = b * b; }
                    }
                    u32x4 o; o.x = cvt_pk_bf16(v0[0], v0[1]); o.y = cvt_pk_bf16(v0[2], v0[3]); o.z = cvt_pk_bf16(v1[0], v1[1]); o.w = cvt_pk_bf16(v1[2], v1[3]);
                    *(u32x4*)(rowp + bj * 128) = o;
                }
            }
    }
};
struct EpiResid {
    static constexpr bool PERM = false, AFTER_DRAIN = false;
    const float* src_lo; const float* src_hi;
    float* X; const float* gate;
    __device__ __forceinline__ void operator()(const f32x4 (&acc)[2][2][4][2], const pg8::Unit& u, int wr, int wc, int fr, int fq) const {
        const int row0 = u.pm * 256 + wr * 64 + fr, col0 = u.pn * 256 + wc * 32 + 4 * fq;
        const int cond = (u.pm < 32) ? 0 : 1 + ((u.pm - 32) >> 3);
        const float* gp = gate + (size_t)cond * MODW + col0;
        const float* sb = (u.pm < 32) ? src_lo : src_hi;
        f32x4 gv[2][2];
#pragma unroll
        for (int bj = 0; bj < 2; ++bj)
#pragma unroll
            for (int n = 0; n < 2; ++n) gv[bj][n] = *(const f32x4*)(gp + bj * 128 + n * 16);
#pragma unroll
        for (int ai = 0; ai < 2; ++ai)
#pragma unroll
            for (int m = 0; m < 4; ++m) {
                const size_t off = (size_t)(row0 + ai * 128 + m * 16) * D + col0;
#pragma unroll
                for (int bj = 0; bj < 2; ++bj)
#pragma unroll
                    for (int n = 0; n < 2; ++n) {
                        const f32x4 r = *(const f32x4*)(sb + off + bj * 128 + n * 16);
                        *(f32x4*)(X + off + bj * 128 + n * 16) = r + gv[bj][n] * acc[ai][bj][m][n];
                    }
            }
    }
};

__device__ __forceinline__ unsigned f2bf(float f) { unsigned u = __float_as_uint(f); return (u + 0x7fffu + ((u >> 16) & 1u)) >> 16; }
__device__ __forceinline__ unsigned pk2(float lo, float hi) { return f2bf(lo) | (f2bf(hi) << 16); }
__device__ __forceinline__ void p0_transpose_item(const float* W, int K, int N, bf16_t* WT, LAS float* scr, int item, int lane) {
    const int nblk = N / 32, kb = item / nblk, nb = item % nblk, k0 = 64 * kb, n0 = 32 * nb;
#pragma unroll 8
    for (int i = 0; i < 32; ++i) { const int kk = 2 * i + (lane >> 5); scr[kk * 33 + (lane & 31)] = W[(size_t)(k0 + kk) * N + n0 + (lane & 31)]; }
    asm volatile("s_waitcnt lgkmcnt(0)" ::: "memory");
    const int c = lane & 7;
#pragma unroll
    for (int j = 0; j < 4; ++j) { const int n = (lane >> 3) + 8 * j; const LAS float* s = scr + (8 * c) * 33 + n;
        u32x4 o; o.x = pk2(s[0 * 33], s[1 * 33]); o.y = pk2(s[2 * 33], s[3 * 33]); o.z = pk2(s[4 * 33], s[5 * 33]); o.w = pk2(s[6 * 33], s[7 * 33]);
        *(u32x4*)(WT + (size_t)(n0 + n) * K + k0 + 8 * c) = o; }
    asm volatile("s_waitcnt lgkmcnt(0)" ::: "memory");
}
__device__ __forceinline__ void cvt_linear(const float* src, bf16_t* dst, int n, int gtid, int gthreads) {
    for (int i = gtid * 4; i < n; i += gthreads * 4) { const f32x4 v = *(const f32x4*)(src + i); u32x2 o; o.x = cvt_pk_bf16(v[0], v[1]); o.y = cvt_pk_bf16(v[2], v[3]); *(u32x2*)(dst + i) = o; }
}
__device__ __forceinline__ void p0_prologue(const Params& p, LAS unsigned char* lds) {
    int tid_ = threadIdx.x; asm volatile("" : "+v"(tid_));
    const int tid = tid_, lane = tid & 63, wave = __builtin_amdgcn_readfirstlane(tid >> 6), G = gridDim.x;
    unsigned char* ws = p.ws;
    {
        LAS float* sc = (LAS float*)(lds + 69632);
        LAS float* red = (LAS float*)(lds + 69632 + 24576);
        const float* cvec = p.in[6]; const float* cctx = p.in[7];
        for (int i = tid; i < 3 * 2048; i += 512) { const int c = i >> 11, k = i & 2047; const float x = (c == 0) ? cctx[k] : cvec[(c - 1) * 2048 + k]; sc[i] = x / (1.f + __expf(-x)); }
        __syncthreads();
        float* MOD = (float*)(ws + WS_MOD);
        for (int item = blockIdx.x; item < 256; item += G) {
            const int l = item >> 7, cgp = item & 127, ln = lane < 48 ? lane : 47;
            const float* W = p.in[8] + (size_t)l * 2048 * MODW + cgp * 96 + ln * 2;
            float a00 = 0.f, a01 = 0.f, a10 = 0.f, a11 = 0.f, a20 = 0.f, a21 = 0.f;
            const int kb = wave * 256;
#pragma unroll 8
            for (int k = 0; k < 256; ++k) {
                const f32x2 w = *(const f32x2*)(W + (size_t)(kb + k) * MODW);
                const float s0 = sc[kb + k], s1 = sc[2048 + kb + k], s2 = sc[4096 + kb + k];
                a00 += s0 * w.x; a01 += s0 * w.y; a10 += s1 * w.x; a11 += s1 * w.y; a20 += s2 * w.x; a21 += s2 * w.y;
            }
            if (lane < 48) { LAS float* r = red + wave * 288 + lane * 2; r[0] = a00; r[1] = a01; r[96] = a10; r[97] = a11; r[192] = a20; r[193] = a21; }
            __syncthreads();
            if (tid < 288) { const int c = tid / 96, j = tid % 96; float s = 0.f;
#pragma unroll
                for (int w = 0; w < 8; ++w) s += red[w * 288 + tid];
                MOD[(size_t)(l * 3 + c) * MODW + cgp * 96 + j] = s + p.in[9][l * MODW + cgp * 96 + j]; }
            __syncthreads();
        }
    }
    {
        LAS float* scr = (LAS float*)(lds + wave * 8448);
        const int gw = blockIdx.x * 8 + wave, NGW = G * 8;
        constexpr int I_IN = 32 * (ABIN / 32), I_O = 32 * (D / 32), I_QKV = 32 * (NQKV / 32), I_1 = 32 * (FFN / 32), I_2 = (FFN / 64) * (D / 32);
        constexpr int NITEMS = I_IN + 2 * I_O + I_QKV + 2 * I_1 + 2 * I_2;
        for (int it = gw; it < NITEMS; it += NGW) {
            int r = it;
            if (r < I_IN) { p0_transpose_item(p.in[12], D, ABIN, (bf16_t*)(ws + WS_WIN), scr, r, lane); continue; } r -= I_IN;
            if (r < I_O) { p0_transpose_item(p.in[16], D, D, (bf16_t*)(ws + WS_WO0), scr, r, lane); continue; } r -= I_O;
            if (r < I_QKV) { p0_transpose_item(p.in[17], D, NQKV, (bf16_t*)(ws + WS_WQKV), scr, r, lane); continue; } r -= I_QKV;
            if (r < I_O) { p0_transpose_item(p.in[19], D, D, (bf16_t*)(ws + WS_WO1), scr, r, lane); continue; } r -= I_O;
            if (r < 2 * I_1) { const int l = r / I_1; p0_transpose_item(p.in[20] + (size_t)l * D * FFN, D, FFN, (bf16_t*)(ws + WS_W1) + (size_t)l * FFN * D, scr, r - l * I_1, lane); continue; } r -= 2 * I_1;
            { const int l = r / I_2; p0_transpose_item(p.in[21] + (size_t)l * D * FFN, FFN, D, (bf16_t*)(ws + WS_W2) + (size_t)l * FFN * D, scr, r - l * I_2, lane); }
        }
    }
    {
        const int gtid = blockIdx.x * 512 + tid, gth = G * 512;
        cvt_linear(p.in[2], (bf16_t*)(ws + WS_K0) + (size_t)MTOT * 256, 1024 * 256, gtid, gth);
        cvt_linear(p.in[3], (bf16_t*)(ws + WS_V0) + (size_t)MTOT * 256, 1024 * 256, gtid, gth);
        cvt_linear(p.in[4], (bf16_t*)(ws + WS_CNK), 1024 * 2048, gtid, gth);
        cvt_linear(p.in[5], (bf16_t*)(ws + WS_CNV), 1024 * 2048, gtid, gth);
    }
}

template <bool OUT_F32>
__device__ __forceinline__ void norm_phase(const float* src_lo, const float* src_hi, const float* gain, const float* mod, int shift_off, int scale_off, bf16_t* dst_bf, float* dst_f) {
    int tid_ = threadIdx.x; asm volatile("" : "+v"(tid_));
    const int tid = tid_, lane = tid & 63, wave = tid >> 6, G = gridDim.x;
    const int gw = blockIdx.x * 8 + wave, NGW = G * 8, per = (MTOT + NGW - 1) / NGW;
    const int r_beg = gw * per, r_end = (r_beg + per < MTOT) ? r_beg + per : MTOT;
    int cur = -1; f32x4 A[8], B[8];
    for (int row = r_beg; row < r_end; ++row) {
        const int cond = (row < MCTX) ? 0 : 1 + ((row - MCTX) >> 11);
        if (cond != cur) {
            cur = cond;
#pragma unroll
            for (int j = 0; j < 8; ++j) {
                const int col = 4 * lane + 256 * j; const f32x4 g = *(const f32x4*)(gain + col);
                if (mod) { const f32x4 sc = *(const f32x4*)(mod + (size_t)cond * MODW + scale_off + col); A[j] = g * (sc + 1.f); B[j] = *(const f32x4*)(mod + (size_t)cond * MODW + shift_off + col); }
                else { A[j] = g; B[j] = (f32x4){0.f, 0.f, 0.f, 0.f}; }
            }
        }
        const float* xr = ((row < MCTX) ? src_lo : src_hi) + (size_t)row * D + 4 * lane;
        f32x4 v[8]; float s = 0.f;
#pragma unroll
        for (int j = 0; j < 8; ++j) { v[j] = *(const f32x4*)(xr + 256 * j); s += (v[j].x * v[j].x + v[j].y * v[j].y) + (v[j].z * v[j].z + v[j].w * v[j].w); }
        const float rstd = rsqrtf(wave_sum(s) * (1.f / D) + EPS);
#pragma unroll
        for (int j = 0; j < 8; ++j) {
            const f32x4 y = v[j] * rstd * A[j] + B[j];
            if (OUT_F32) *(f32x4*)(dst_f + (size_t)row * D + 4 * lane + 256 * j) = y;
            else { u32x2 o; o.x = cvt_pk_bf16(y[0], y[1]); o.y = cvt_pk_bf16(y[2], y[3]); *(u32x2*)(dst_bf + (size_t)row * D + 4 * lane + 256 * j) = o; }
        }
    }
}

__device__ __forceinline__ void unpack8(const u32x4 r, float (&f)[8]) {
    f[0] = bf2f(r.x & 0xffffu); f[1] = __uint_as_float(r.x & 0xffff0000u); f[2] = bf2f(r.y & 0xffffu); f[3] = __uint_as_float(r.y & 0xffff0000u);
    f[4] = bf2f(r.z & 0xffffu); f[5] = __uint_as_float(r.z & 0xffff0000u); f[6] = bf2f(r.w & 0xffffu); f[7] = __uint_as_float(r.w & 0xffff0000u);
}
__device__ __forceinline__ void ew0_phase(const Params& p) {
    int tid_ = threadIdx.x; asm volatile("" : "+v"(tid_));
    const int tid = tid_, lane = tid & 63, wave = tid >> 6, G = gridDim.x;
    const int gw = blockIdx.x * 8 + wave, NGW = G * 8;
    unsigned char* ws = p.ws;
    const bf16_t* Z = (const bf16_t*)(ws + WS_Z);
    bf16_t* AB = (bf16_t*)(ws + WS_AB); bf16_t* Q0 = (bf16_t*)(ws + WS_Q0); bf16_t* K0 = (bf16_t*)(ws + WS_K0); bf16_t* V0 = (bf16_t*)(ws + WS_V0);
    const float* convw = p.in[13]; const float* qn = p.in[14]; const float* kn = p.in[15];
    const int ri = lane & 31, chunk = lane >> 5, da = chunk * 64 + ri, db = da + 32;
    const float inv = __builtin_amdgcn_exp2f(-(float)ri * (13.287712379549449f / 32.f));
    const float qwa = qn[da], qwb = qn[db], kwa = kn[da], kwb = kn[db];
    for (int tok = gw; tok < MTOT; tok += NGW) {
        const bool lat = tok >= MCTX;
        const int t = lat ? ((tok - MCTX) & 2047) : (tok & 255), slen = lat ? 2048 : 256;
        const bf16_t* zr = Z + (size_t)tok * ABIN;
#pragma unroll
        for (int j = 0; j < 2; ++j) {
            const int ch = j * 512 + lane * 8;
            float gb[8], acc[8];
            unpack8(*(const u32x4*)(zr + ch), gb);
#pragma unroll
            for (int e = 0; e < 8; ++e) acc[e] = 0.f;
#pragma unroll
            for (int dt = -1; dt <= 1; ++dt) {
                if (t + dt >= 0 && t + dt < slen) {
                    float gc[8], xa[8];
                    unpack8(*(const u32x4*)(zr + dt * ABIN + 1024 + ch), gc);
                    unpack8(*(const u32x4*)(zr + dt * ABIN + 2048 + ch), xa);
                    const f32x4 w0 = *(const f32x4*)(convw + (dt + 1) * 1024 + ch), w1 = *(const f32x4*)(convw + (dt + 1) * 1024 + ch + 4);
#pragma unroll
                    for (int e = 0; e < 4; ++e) { acc[e] += w0[e] * (gc[e] * xa[e]); acc[4 + e] += w1[e] * (gc[4 + e] * xa[4 + e]); }
                }
            }
            u32x4 o; o.x = cvt_pk_bf16(gb[0] * acc[0], gb[1] * acc[1]); o.y = cvt_pk_bf16(gb[2] * acc[2], gb[3] * acc[3]);
            o.z = cvt_pk_bf16(gb[4] * acc[4], gb[5] * acc[5]); o.w = cvt_pk_bf16(gb[6] * acc[6], gb[7] * acc[7]);
            *(u32x4*)(AB + (size_t)tok * D + ch) = o;
        }
        float cs = 1.f, sn = 0.f;
        if (lat) { const float pos = (float)(chunk == 0 ? (t >> 6) : (t & 63)); const float ang = pos * inv; cs = __cosf(ang); sn = __sinf(ang); }
#pragma unroll
        for (int hh = 0; hh < 10; ++hh) {
            const bf16_t* hp = zr + 3072 + hh * 128;
            const float va = bf2f(hp[da]), vb = bf2f(hp[db]);
            const float rstd = rsqrtf(wave_sum(va * va + vb * vb) * (1.f / 128.f) + EPS);
            const float na = va * rstd * (hh < 8 ? qwa : kwa), nb = vb * rstd * (hh < 8 ? qwb : kwb);
            const float ra = na * cs - nb * sn, rb = na * sn + nb * cs;
            if (hh < 8) { bf16_t* q = Q0 + (size_t)tok * 1024 + hh * 128; q[da] = (bf16_t)f2bf(ra); q[db] = (bf16_t)f2bf(rb); }
            else {
                const int kvh = hh - 8;
                bf16_t* k = K0 + (size_t)tok * 256 + kvh * 128; k[da] = (bf16_t)f2bf(ra); k[db] = (bf16_t)f2bf(rb);
                if (!lat) { float* ok = p.out + OUT_AK + (size_t)tok * 256 + kvh * 128; ok[da] = na; ok[db] = nb; }
            }
        }
        {
            const u32x2 r = *(const u32x2*)(zr + 4352 + lane * 4);
            *(u32x2*)(V0 + (size_t)tok * 256 + lane * 4) = r;
            if (!lat) { f32x4 o; o[0] = bf2f(r.x & 0xffffu); o[1] = __uint_as_float(r.x & 0xffff0000u); o[2] = bf2f(r.y & 0xffffu); o[3] = __uint_as_float(r.y & 0xffff0000u);
                *(f32x4*)(p.out + OUT_AV + (size_t)tok * 256 + lane * 4) = o; }
        }
    }
}

constexpr int KSTR = 272, VSTR = 288, LDS_KT = 0, LDS_VT = 2 * 64 * KSTR, LDS_BIAS = LDS_VT + 2 * 64 * VSTR;
constexpr float SCL2 = 0.08838834764831845f * 1.4426950408889634f, LOG2E = 1.4426950408889634f;
struct AttnArgs {
    const bf16_t* q; int qstride; int qrow0;
    bf16_t* o; int ostride;
    const bf16_t* kA; const bf16_t* vA; int strideA, ntA;
    const bf16_t* kB; const bf16_t* vB; int strideB, ntB;
    int r0, krlo; const float* bias;
};
__device__ __forceinline__ v4i16_t vtr(const LAS unsigned char* p) { return __builtin_amdgcn_ds_read_tr16_b64_v4i16((LAS v4i16_t*)p); }

template <int NA>
__device__ __forceinline__ void attn_run(LAS unsigned char* lds, const AttnArgs& a) {
    int tid_ = threadIdx.x; asm volatile("" : "+v"(tid_));
    const int tid = tid_, lane = tid & 63, wave = __builtin_amdgcn_readfirstlane(tid >> 6), fr = lane & 15, fq = lane >> 4;
    bf16x8 Qf[2][4];
#pragma unroll
    for (int qb = 0; qb < 2; ++qb)
#pragma unroll
        for (int dc = 0; dc < 4; ++dc) Qf[qb][dc] = *(const bf16x8*)(a.q + (size_t)(a.qrow0 + wave * 32 + qb * 16 + fr) * a.qstride + dc * 32 + fq * 8);
    f32x4 O[2][8];
#pragma unroll
    for (int qb = 0; qb < 2; ++qb)
#pragma unroll
        for (int db = 0; db < 8; ++db) O[qb][db] = (f32x4){0.f, 0.f, 0.f, 0.f};
    float mrun[2] = {-1e30f, -1e30f}, lrun[2] = {0.f, 0.f};
    LAS float* biasL = (LAS float*)(lds + LDS_BIAS);
    if (NA) { for (int i = tid; i < 465; i += 512) biasL[i] = a.bias[i]; }
    const int nt = a.ntA + a.ntB;
    const int lrow = tid >> 3, lch = tid & 7;
    u32x4 kr0, kr1, vr0, vr1;
#define ATT_GLOAD(t) do { const bool inA = (t) < a.ntA; const int tt = inA ? (t) : (t) - a.ntA; const int st = inA ? a.strideA : a.strideB; \
        const bf16_t* kp = (inA ? a.kA : a.kB) + (size_t)(tt * 64 + lrow) * st + lch * 8; const bf16_t* vp = (inA ? a.vA : a.vB) + (size_t)(tt * 64 + lrow) * st + lch * 8; \
        kr0 = *(const u32x4*)kp; kr1 = *(const u32x4*)(kp + 64); vr0 = *(const u32x4*)vp; vr1 = *(const u32x4*)(vp + 64); } while (0)
#define ATT_LWRITE(b) do { LAS unsigned char* kd = lds + LDS_KT + (b) * 64 * KSTR + lrow * KSTR + lch * 16; LAS unsigned char* vd = lds + LDS_VT + (b) * 64 * VSTR + lrow * VSTR + lch * 16; \
        *(LAS u32x4*)kd = kr0; *(LAS u32x4*)(kd + 128) = kr1; *(LAS u32x4*)vd = vr0; *(LAS u32x4*)(vd + 128) = vr1; } while (0)
    ATT_GLOAD(0); ATT_LWRITE(0); __syncthreads();
    const int rw = NA ? a.r0 + (wave >> 1) : 0;
    const int kr_lo_w = NA ? (rw - 4 < 0 ? 0 : (rw - 4 > 24 ? 24 : rw - 4)) : 0;
    for (int t = 0; t < nt; ++t) {
        if (t + 1 < nt) ATT_GLOAD(t + 1);
        bool active = true; int kr = 0; const bool local = NA && t >= a.ntA;
        if (local) { kr = a.krlo + (t - a.ntA); active = (kr >= kr_lo_w) && (kr < kr_lo_w + 8); }
        if (active) {
            const LAS unsigned char* Kt = lds + LDS_KT + (t & 1) * 64 * KSTR;
            const LAS unsigned char* Vt = lds + LDS_VT + (t & 1) * 64 * VSTR;
            f32x4 S[2][4];
#pragma unroll
            for (int qb = 0; qb < 2; ++qb)
#pragma unroll
                for (int kb = 0; kb < 4; ++kb) S[qb][kb] = (f32x4){0.f, 0.f, 0.f, 0.f};
#pragma unroll
            for (int kb = 0; kb < 4; ++kb)
#pragma unroll
                for (int dc = 0; dc < 4; ++dc) {
                    const bf16x8 kf = *(const LAS bf16x8*)(Kt + (kb * 16 + fr) * KSTR + dc * 64 + fq * 16);
                    S[0][kb] = __builtin_amdgcn_mfma_f32_16x16x32_bf16(kf, Qf[0][dc], S[0][kb], 0, 0, 0);
                    S[1][kb] = __builtin_amdgcn_mfma_f32_16x16x32_bf16(kf, Qf[1][dc], S[1][kb], 0, 0, 0);
                }
            bf16x8 Pf[2][2];
#pragma unroll
            for (int qb = 0; qb < 2; ++qb) {
                if (local) {
                    const int c = (wave & 1) * 32 + qb * 16 + fr;
                    const int kc0 = c - 8 < 0 ? 0 : (c - 8 > 48 ? 48 : c - 8);
                    const LAS float* brow = biasL + (kr - rw + 7) * 31 + 15 - c;
#pragma unroll
                    for (int kb = 0; kb < 4; ++kb)
#pragma unroll
                        for (int j = 0; j < 4; ++j) { const int kc = kb * 16 + 4 * fq + j; const bool ok = (kc >= kc0) && (kc < kc0 + 16);
                            const float bv = brow[ok ? kc : c];
                            S[qb][kb][j] = ok ? (S[qb][kb][j] * SCL2 + bv * LOG2E) : -1e30f; }
                } else {
#pragma unroll
                    for (int kb = 0; kb < 4; ++kb) S[qb][kb] = S[qb][kb] * SCL2;
                }
                float mx = -1e30f;
#pragma unroll
                for (int kb = 0; kb < 4; ++kb) mx = fmaxf(mx, fmaxf(fmaxf(S[qb][kb][0], S[qb][kb][1]), fmaxf(S[qb][kb][2], S[qb][kb][3])));
                mx = fmaxf(mx, __shfl_xor(mx, 16)); mx = fmaxf(mx, __shfl_xor(mx, 32));
                const float mn = fmaxf(mrun[qb], mx), alpha = __builtin_amdgcn_exp2f(mrun[qb] - mn);
                mrun[qb] = mn;
                float rs = 0.f;
#pragma unroll
                for (int kb = 0; kb < 4; ++kb)
#pragma unroll
                    for (int j = 0; j < 4; ++j) { const float pv = __builtin_amdgcn_exp2f(S[qb][kb][j] - mn); S[qb][kb][j] = pv; rs += pv; }
                lrun[qb] = lrun[qb] * alpha + rs;
#pragma unroll
                for (int db = 0; db < 8; ++db) O[qb][db] = O[qb][db] * alpha;
#pragma unroll
                for (int c2 = 0; c2 < 2; ++c2) {
                    u32x4 pk; pk.x = cvt_pk_bf16(S[qb][2 * c2][0], S[qb][2 * c2][1]); pk.y = cvt_pk_bf16(S[qb][2 * c2][2], S[qb][2 * c2][3]);
                    pk.z = cvt_pk_bf16(S[qb][2 * c2 + 1][0], S[qb][2 * c2 + 1][1]); pk.w = cvt_pk_bf16(S[qb][2 * c2 + 1][2], S[qb][2 * c2 + 1][3]);
                    Pf[qb][c2] = __builtin_bit_cast(bf16x8, pk);
                }
            }
            const LAS unsigned char* vb = Vt + (4 * fq + (fr >> 2)) * VSTR + (fr & 3) * 8;
#pragma unroll
            for (int c2 = 0; c2 < 2; ++c2)
#pragma unroll
                for (int db = 0; db < 8; ++db) {
                    const v4i16_t lo = vtr(vb + (c2 * 32) * VSTR + db * 32), hi = vtr(vb + (c2 * 32 + 16) * VSTR + db * 32);
                    bf16x8 vf; vf[0] = lo[0]; vf[1] = lo[1]; vf[2] = lo[2]; vf[3] = lo[3]; vf[4] = hi[0]; vf[5] = hi[1]; vf[6] = hi[2]; vf[7] = hi[3];
                    O[0][db] = __builtin_amdgcn_mfma_f32_16x16x32_bf16(vf, Pf[0][c2], O[0][db], 0, 0, 0);
                    O[1][db] = __builtin_amdgcn_mfma_f32_16x16x32_bf16(vf, Pf[1][c2], O[1][db], 0, 0, 0);
                }
        }
        if (t + 1 < nt) ATT_LWRITE((t + 1) & 1);
        __syncthreads();
    }
#undef ATT_GLOAD
#undef ATT_LWRITE
#pragma unroll
    for (int qb = 0; qb < 2; ++qb) {
        float lt = lrun[qb]; lt += __shfl_xor(lt, 16); lt += __shfl_xor(lt, 32);
        const float il = 1.f / lt;
        bf16_t* op = a.o + (size_t)(a.qrow0 + wave * 32 + qb * 16 + fr) * a.ostride + 4 * fq;
#pragma unroll
        for (int db = 0; db < 8; ++db) { const f32x4 v = O[qb][db] * il; u32x2 o; o.x = cvt_pk_bf16(v[0], v[1]); o.y = cvt_pk_bf16(v[2], v[3]); *(u32x2*)(op + db * 16) = o; }
    }
}

__device__ __forceinline__ void attn0_phase(const Params& p, LAS unsigned char* lds) {
    unsigned char* ws = p.ws; const int G = gridDim.x;
    const bf16_t* Q0 = (const bf16_t*)(ws + WS_Q0); const bf16_t* K0 = (const bf16_t*)(ws + WS_K0); const bf16_t* V0 = (const bf16_t*)(ws + WS_V0);
    bf16_t* AB = (bf16_t*)(ws + WS_AB);
    for (int i = blockIdx.x; i < 512; i += G) {
        if (i >= 256 && i < 384) continue;
        AttnArgs a;
        if (i < 128) { const int b = i >> 6, h = (i >> 3) & 7, qblk = i & 7, kvh = h >> 2;
            a.q = Q0 + h * 128; a.qstride = 1024; a.qrow0 = MCTX + b * 2048 + qblk * 256; a.o = AB + 1024 + h * 128; a.ostride = D;
            a.kA = K0 + (size_t)(MTOT + b * 512) * 256 + kvh * 128; a.vA = V0 + (size_t)(MTOT + b * 512) * 256 + kvh * 128; a.strideA = 256; a.ntA = 8;
            a.kB = K0 + (size_t)(MCTX + b * 2048) * 256 + kvh * 128; a.vB = V0 + (size_t)(MCTX + b * 2048) * 256 + kvh * 128; a.strideB = 256; a.ntB = 32;
        } else { const int j = (i < 256) ? i - 128 : i - 256, b = j >> 3, h = j & 7, kvh = h >> 2;
            a.q = Q0 + h * 128; a.qstride = 1024; a.qrow0 = b * 256; a.o = AB + 1024 + h * 128; a.ostride = D;
            a.kA = K0 + (size_t)(b * 256) * 256 + kvh * 128; a.vA = V0 + (size_t)(b * 256) * 256 + kvh * 128; a.strideA = 256; a.ntA = 4;
            a.kB = a.kA; a.vB = a.vA; a.strideB = 256; a.ntB = 0;
        }
        a.r0 = 0; a.krlo = 0; a.bias = nullptr;
        attn_run<0>(lds, a);
    }
}
__device__ __forceinline__ void attn1_phase(const Params& p, LAS unsigned char* lds, bf16_t* AO) {
    unsigned char* ws = p.ws; const int G = gridDim.x;
    const bf16_t* Q1 = (const bf16_t*)(ws + WS_Z); const bf16_t* K1 = Q1 + (size_t)MTOT * D; const bf16_t* V1 = K1 + (size_t)MTOT * D;
    const bf16_t* CNK = (const bf16_t*)(ws + WS_CNK); const bf16_t* CNV = (const bf16_t*)(ws + WS_CNV);
    for (int i = blockIdx.x; i < 256; i += G) {
        AttnArgs a;
        const int b = i >> 7, h = (i >> 3) & 15, rg = i & 7, r0 = rg * 4;
        const int lo = r0 - 4 < 0 ? 0 : (r0 - 4 > 24 ? 24 : r0 - 4), hi0 = r0 - 1 < 0 ? 0 : (r0 - 1 > 24 ? 24 : r0 - 1), hi = hi0 + 7;
        a.q = Q1 + h * 128; a.qstride = D; a.qrow0 = MCTX + b * 2048 + r0 * 64; a.o = AO + h * 128; a.ostride = D;
        a.kA = CNK + (size_t)(b * 512) * 2048 + h * 128; a.vA = CNV + (size_t)(b * 512) * 2048 + h * 128; a.strideA = 2048; a.ntA = 8;
        a.kB = K1 + (size_t)(MCTX + b * 2048 + lo * 64) * D + h * 128; a.vB = V1 + (size_t)(MCTX + b * 2048 + lo * 64) * D + h * 128; a.strideB = D; a.ntB = hi - lo + 1;
        a.r0 = r0; a.krlo = lo; a.bias = p.in[18] + h * 465;
        attn_run<1>(lds, a);
    }
    for (int j = blockIdx.x; j < 512; j += G) {
        AttnArgs a;
        const int b = j >> 4, h = j & 15;
        a.q = Q1 + h * 128; a.qstride = D; a.qrow0 = b * 256; a.o = AO + h * 128; a.ostride = D;
        a.kA = K1 + (size_t)(b * 256) * D + h * 128; a.vA = V1 + (size_t)(b * 256) * D + h * 128; a.strideA = D; a.ntA = 4;
        a.kB = a.kA; a.vB = a.vA; a.strideB = D; a.ntB = 0;
        a.r0 = 0; a.krlo = 0; a.bias = nullptr;
        attn_run<0>(lds, a);
    }
}

#define XB_TMO      128
#define XB_XCNT(j)  (256  + 64 * (j))
#define XB_XSUB(j)  (1280 + 64 * (j))
#define XB_XGEN(j)  (2304 + 64 * (j))
#define XB_TOP      3328
#define XB_TOPGEN   3392
#define XCD_BAR_WORDS 3456
#define XB_SPIN_CAP (1u << 18)

__device__ __forceinline__ unsigned xb_ld(unsigned* p)              { return __hip_atomic_load(p, __ATOMIC_RELAXED, __HIP_MEMORY_SCOPE_AGENT); }
__device__ __forceinline__ unsigned xb_add(unsigned* p, unsigned v) { return __hip_atomic_fetch_add(p, v, __ATOMIC_RELAXED, __HIP_MEMORY_SCOPE_AGENT); }
__device__ __forceinline__ unsigned xb_xcc_id() { return (unsigned)__builtin_amdgcn_s_getreg((3 << 11) | 20) & 0xFu; }
#define XB_SPIN(cond, bar) do { unsigned _sp = 0; while (cond) { __builtin_amdgcn_s_sleep(1); \
    if ((++_sp & 255u) == 0u) { if (xb_ld(&(bar)[XB_TMO])) break; if (_sp > XB_SPIN_CAP) { atomicAdd(&(bar)[XB_TMO], 1u); break; } } } } while (0)

struct XcdBarrier {
    unsigned* bar; unsigned x;
    volatile LAS unsigned* st;
};

__device__ __forceinline__ XcdBarrier xcd_barrier_post(unsigned* bar, volatile LAS unsigned* st) {
    XcdBarrier b; b.bar = bar; b.x = xb_xcc_id(); b.st = st;
    if (threadIdx.x == 0) (void)xb_add(&bar[XB_XCNT(b.x)], 1u);
    return b;
}
__device__ __forceinline__ void xcd_barrier_complete(unsigned* bar, unsigned x, unsigned& nloc, unsigned& nx) {
    const unsigned G = gridDim.x * gridDim.y * gridDim.z;
    unsigned sum, cnt, mine, sp = 0u;
    for (;;) {
        sum = 0u; cnt = 0u; mine = 0u;
#pragma unroll
        for (unsigned j = 0; j < 16; ++j) { const unsigned c = xb_ld(&bar[XB_XCNT(j)]); sum += c; cnt += (c > 0u) ? 1u : 0u; mine = (j == x) ? c : mine; }
        if (sum == G) break;
        __builtin_amdgcn_s_sleep(1);
        if ((++sp & 255u) == 0u) { if (xb_ld(&bar[XB_TMO])) break; if (sp > XB_SPIN_CAP) { atomicAdd(&bar[XB_TMO], 1u); break; } }
    }
    nloc = mine > 0u ? mine : 1u; nx = cnt > 0u ? cnt : 1u;
}

__device__ __forceinline__ void xcd_barrier(const XcdBarrier& b) {
    asm volatile("s_waitcnt vmcnt(0)" ::: "memory");
    __syncthreads();
    if (threadIdx.x == 0) {
        unsigned* bar = b.bar;
        __builtin_amdgcn_s_waitcnt(0);
        unsigned nloc = b.st[0], nx = b.st[1];
        if (nloc == 0u) { xcd_barrier_complete(bar, b.x, nloc, nx); b.st[0] = nloc; b.st[1] = nx; }
        const unsigned old = xb_add(&bar[XB_XSUB(b.x)], 1u);
        const unsigned gen = old / nloc;
        if (old + 1u == (gen + 1u) * nloc) {
            __builtin_amdgcn_fence(__ATOMIC_RELEASE, "agent");
            asm volatile("s_waitcnt vmcnt(0)" ::: "memory");
            const unsigned og = xb_add(&bar[XB_TOP], 1u);
            const unsigned tg = og / nx;
            if (og + 1u == (tg + 1u) * nx) xb_add(&bar[XB_TOPGEN], 1u);
            else XB_SPIN(xb_ld(&bar[XB_TOPGEN]) == tg, bar);
            __builtin_amdgcn_fence(__ATOMIC_ACQUIRE, "agent");
            xb_add(&bar[XB_XGEN(b.x)], 1u);
            asm volatile("s_waitcnt vmcnt(0)" ::: "memory");
        } else {
            XB_SPIN(xb_ld(&bar[XB_XGEN(b.x)]) == gen, bar);
            __builtin_amdgcn_fence(__ATOMIC_ACQUIRE, "agent");
            asm volatile("s_waitcnt vmcnt(0)" ::: "memory");
        }
    }
    __syncthreads();
}


constexpr int NPHASE = 18;
__global__ void __launch_bounds__(512, 2) mega_fwd(Params p) {
    extern __shared__ __attribute__((aligned(16))) unsigned char lds_raw[];
    LAS unsigned char* lds = (LAS unsigned char*)lds_raw;
    cg::grid_group grid = cg::this_grid();
    if (threadIdx.x < 64) ((LAS unsigned*)(lds + 131072))[threadIdx.x] = 0u;
    __syncthreads();
    XcdBarrier xbar = xcd_barrier_post((unsigned*)(p.ws + WS_BAR), (volatile LAS unsigned*)(lds + 131072));
    unsigned char* ws = p.ws;
    const int G = gridDim.x;
    float* MOD = (float*)(ws + WS_MOD);
    bf16_t* XN = (bf16_t*)(ws + WS_XN); float* X = (float*)(ws + WS_X);
    bf16_t* Z = (bf16_t*)(ws + WS_Z); bf16_t* AB = (bf16_t*)(ws + WS_AB); bf16_t* H = (bf16_t*)(ws + WS_H);
#define RUN(k) (p.ph_lo <= (k) && (k) < p.ph_hi)
#define GRID_SYNC_CG() do { asm volatile("s_waitcnt vmcnt(0) lgkmcnt(0)" ::: "memory"); grid.sync(); __builtin_amdgcn_fence(__ATOMIC_ACQUIRE, "agent"); asm volatile("s_waitcnt vmcnt(0)" ::: "memory"); } while (0)
#define GRID_SYNC() do { xcd_barrier(xbar); } while (0)
#define REPEAT(n, stmt) do { for (int rep_ = 0; rep_ < (n); ++rep_) { stmt; if (rep_ + 1 < (n)) GRID_SYNC(); } } while (0)
#define SEAM(k) do { if (p.ph_lo <= (k) && (k) + 1 < p.ph_hi) GRID_SYNC(); } while (0)
    if (RUN(0)) REPEAT(REP_P0, p0_prologue(p, lds));
    if (p.ph_lo <= 0 && 1 < p.ph_hi) GRID_SYNC_CG();
    for (int l = 0; l < 2; ++l) {
        const int k0 = 1 + 8 * l;
        const float* modl = MOD + (size_t)l * 3 * MODW;
        const float* xin_lo = (l == 0) ? p.in[0] : X;
        const float* xin_hi = (l == 0) ? p.in[1] - (size_t)MCTX * D : X;
        if (RUN(k0)) REPEAT(REP_NORM, norm_phase<false>(xin_lo, xin_hi, p.in[10] + l * D, modl, 0, D, XN, nullptr));
        SEAM(k0);
        if (RUN(k0 + 1)) for (int repg_ = 0; repg_ < REP_G; ++repg_) {
            if (repg_) GRID_SYNC();
            if (l == 0) { pg8::Gemm g{XN, (const bf16_t*)(ws + WS_WIN), MTOT, ABIN, D}; pg8::StaticOrder S; S.init(MTOT, ABIN, G, (int)blockIdx.x);
                EpiBf16<0, false> E{Z, ABIN, nullptr, nullptr, 0, 0}; pg8::gemm_phase(lds, g, S, E); }
            else { pg8::Gemm g{XN, (const bf16_t*)(ws + WS_WQKV), MTOT, NQKV, D}; pg8::StaticOrder S; S.init(MTOT, NQKV, G, (int)blockIdx.x);
                EpiBf16<0, true> E{Z, D, p.out + OUT_NK, p.out + OUT_NV, 8, (size_t)MTOT * D}; pg8::gemm_phase(lds, g, S, E); }
        }
        SEAM(k0 + 1);
        if (l == 0) { if (RUN(k0 + 2)) REPEAT(REP_EW, ew0_phase(p)); SEAM(k0 + 2); }
        if (RUN(k0 + 3)) REPEAT(REP_ATT, if (l == 0) attn0_phase(p, lds); else attn1_phase(p, lds, AB));
        SEAM(k0 + 3);
        if (RUN(k0 + 4)) { pg8::Gemm g{AB, (const bf16_t*)(ws + (l == 0 ? WS_WO0 : WS_WO1)), MTOT, D, D}; pg8::StaticOrder S; S.init(MTOT, D, G, (int)blockIdx.x);
            EpiResid E{xin_lo, xin_hi, X, modl + 2 * D}; pg8::gemm_phase(lds, g, S, E); }
        SEAM(k0 + 4);
        if (RUN(k0 + 5)) REPEAT(REP_NORM, norm_phase<false>(X, X, p.in[11] + l * D, modl, 3 * D, 4 * D, XN, nullptr));
        SEAM(k0 + 5);
        if (RUN(k0 + 6)) for (int repg_ = 0; repg_ < REP_G; ++repg_) { if (repg_) GRID_SYNC(); pg8::Gemm g{XN, (const bf16_t*)(ws + WS_W1) + (size_t)l * FFN * D, MTOT, FFN, D}; pg8::StaticOrder S; S.init(MTOT, FFN, G, (int)blockIdx.x);
            EpiBf16<1, false> E{H, FFN, nullptr, nullptr, 0, 0}; pg8::gemm_phase(lds, g, S, E); }
        SEAM(k0 + 6);
        if (RUN(k0 + 7)) { pg8::Gemm g{H, (const bf16_t*)(ws + WS_W2) + (size_t)l * FFN * D, MTOT, D, FFN}; pg8::StaticOrder S; S.init(MTOT, D, G, (int)blockIdx.x);
            EpiResid E{X, X, X, modl + 5 * D}; pg8::gemm_phase(lds, g, S, E); }
        SEAM(k0 + 7);
    }
#if PROBE_STOP > 0
    GRID_SYNC();
    {
        const size_t n = (size_t)MTOT * D, gt = (size_t)blockIdx.x * 512 + threadIdx.x, gs = (size_t)G * 512;
        const bf16_t* sb = PROBE_SRC == 1 ? XN : PROBE_SRC == 2 ? AB : PROBE_SRC == 3 ? Z : PROBE_SRC == 5 ? Z + (size_t)4096 * NQKV : (const bf16_t*)(ws + WS_Q0);
#if PROBE_SRC == 6
        attn1_phase(p, lds, XN);
        GRID_SYNC();
        for (size_t i = gt; i < n; i += gs) p.out[i] = bf2f(AB[i]) - bf2f(XN[i]);
#else
        for (size_t i = gt; i < n; i += gs) p.out[i] = (PROBE_SRC == 0) ? X[i] : bf2f(sb[i]);
#endif
#if PROBE_STOP < 4
        for (size_t i = gt; i < (size_t)2 * MCTX * 256; i += gs) p.out[OUT_AK + i] = 0.f;
#endif
        for (size_t i = gt; i < (size_t)2 * MCTX * D; i += gs) p.out[OUT_NK + i] = 0.f;
    }
#else
    if (RUN(17)) REPEAT(REP_NORM, norm_phase<true>(X, X, p.in[22], nullptr, 0, 0, nullptr, p.out));
#endif
#undef RUN
#undef SEAM
#undef REPEAT
#undef GRID_SYNC
#undef GRID_SYNC_CG
}

extern "C" void kernel_launch(void* const* d_in, const int* in_sizes, int n_in, void* d_out, int out_size, void* d_ws, size_t ws_size, hipStream_t stream) {
    static int grid = 0;
    if (grid == 0) {
        if (n_in != 23 || ws_size < WS_END) { fprintf(stderr, "kernel_launch: expected 23 inputs and >= %zu bytes of workspace (got %d, %zu)\n", (size_t)WS_END, n_in, ws_size); grid = -1; return; }
        int dev = 0, cus = 0, per_cu = 0;
        (void)hipGetDevice(&dev);
        (void)hipDeviceGetAttribute(&cus, hipDeviceAttributeMultiprocessorCount, dev);
        if (hipFuncSetAttribute((const void*)mega_fwd, hipFuncAttributeMaxDynamicSharedMemorySize, LDS_BYTES) != hipSuccess) { fprintf(stderr, "kernel_launch: hipFuncSetAttribute failed\n"); grid = -1; return; }
        if (hipOccupancyMaxActiveBlocksPerMultiprocessor(&per_cu, (const void*)mega_fwd, 512, LDS_BYTES) != hipSuccess || per_cu < 1) { fprintf(stderr, "kernel_launch: occupancy query failed (%d)\n", per_cu); grid = -1; return; }
        grid = cus * (per_cu > 1 ? 1 : per_cu);
        fprintf(stderr, "kernel_launch: grid %d (cus %d, per_cu %d)\n", grid, cus, per_cu);
    }
    if (grid < 0) return;
    (void)hipMemsetAsync((char*)d_ws + WS_BAR, 0, XCD_BAR_WORDS * 4, stream);
    Params p{};
    for (int i = 0; i < 23; ++i) p.in[i] = (const float*)d_in[i];
    p.out = (float*)d_out; p.ws = (unsigned char*)d_ws;
#if MK_PER_PHASE
    for (int k = 0; k < NPHASE; ++k) {
        if (k == 11) continue;
        p.ph_lo = k; p.ph_hi = k + 1;
        void* args[] = {&p};
        hipError_t e = hipLaunchCooperativeKernel((const void*)mega_fwd, dim3(grid), dim3(512), args, LDS_BYTES, stream);
        if (e != hipSuccess) { fprintf(stderr, "launch %d failed: %s\n", k, hipGetErrorString(e)); break; }
    }
#else
    p.ph_lo = 0; p.ph_hi = PROBE_STOP > 0 ? PROBE_STOP : NPHASE;
    void* args[] = {&p};
    hipError_t e = hipLaunchCooperativeKernel((const void*)mega_fwd, dim3(grid), dim3(512), args, LDS_BYTES, stream);
    if (e != hipSuccess) fprintf(stderr, "cooperative launch failed: %s (grid %d)\n", hipGetErrorString(e), grid);
#endif
}
```

```cpp
#include <hip/hip_runtime.h>
#include <hip/hip_cooperative_groups.h>
#include <cstdio>
#include <cstdint>
namespace cg = cooperative_groups;

#ifndef MK_PER_PHASE
#define MK_PER_PHASE 0
#endif

#ifndef REP_NG
#define REP_NG 1
#endif
#ifndef REP_P0
#define REP_P0 REP_NG
#endif
#ifndef REP_NORM
#define REP_NORM REP_NG
#endif
#ifndef REP_EW
#define REP_EW REP_NG
#endif
#ifndef REP_ATT
#define REP_ATT REP_NG
#endif
#ifndef REP_G
#define REP_G 1
#endif
#ifndef PROBE_STOP
#define PROBE_STOP 0
#endif
#ifndef PROBE_SRC
#define PROBE_SRC 0
#endif
#define LAS __attribute__((address_space(3)))
#define PG8_LAS __attribute__((address_space(3)))
typedef unsigned short bf16_t;
typedef short bf16x8 __attribute__((ext_vector_type(8)));
typedef short v4i16_t __attribute__((ext_vector_type(4)));
typedef float f32x4 __attribute__((ext_vector_type(4)));
typedef float f32x2 __attribute__((ext_vector_type(2)));
typedef unsigned u32x4 __attribute__((ext_vector_type(4)));
typedef unsigned u32x2 __attribute__((ext_vector_type(2)));

__device__ __forceinline__ float bf2f(unsigned h) { return __uint_as_float(h << 16); }
typedef __bf16 bf16x2_t __attribute__((ext_vector_type(2)));
__device__ __forceinline__ unsigned cvt_pk_bf16(float lo, float hi) { f32x2 v = {lo, hi}; bf16x2_t r = __builtin_convertvector(v, bf16x2_t); return __builtin_bit_cast(unsigned, r); }
__device__ __forceinline__ float wave_sum(float v) {
#pragma unroll
    for (int o = 1; o < 64; o <<= 1) v += __shfl_xor(v, o);
    return v;
}

constexpr size_t WS_TS_OFS = 595591168ull;
constexpr size_t WS_FLAGS_OFS = (512u << 10) + 16384;
namespace pg8 {
constexpr int BM = 256, BK = 64, HALF = 128, HTB = HALF * BK * 2  , STAGE_BYTES = 8 * HTB, NXCD = 8, WGM = 8;

__host__ __device__ __forceinline__ int lds_byte(int r, int c) { const int st = (r >> 4) * 2 + (c >> 5), rr = r & 15, cc = c & 31, ob = rr * 64 + cc * 2; return st * 1024 + (ob ^ (((ob >> 9) & 1) << 5)); }
__host__ __device__ __forceinline__ void stage_rc(int b, int& R, int& C) { const int st = b / 1024, sb = b % 1024, swz = sb ^ (((sb >> 9) & 1) << 5); R = (st >> 1) * 16 + swz / 64; C = (st & 1) * 32 + (swz % 64) / 2; }
__host__ __device__ __forceinline__ int perm32(int rho) { const int n = rho >> 4, i = rho & 15; return 8 * (i >> 2) + 4 * n + (i & 3); }
struct Unit { int pm, pn, code; };
struct Gemm { const bf16_t* A; const bf16_t* Bt; int M, N, K; };
struct StaticOrder {
    int nM, nN, nwg, G, c, ntk, R, tail, fofs; unsigned char* wsb;
    __device__ __forceinline__ int kt0(const Unit& u) const { return (u.code & 3) == 2 ? (ntk >> 1) : 0; }
    __device__ __forceinline__ int nkt(const Unit& u) const { return (u.code & 3) ? (ntk >> 1) : ntk; }
    __host__ __device__ void init(int M, int N, int G_, int c_, int K, unsigned char* wsb_, int fofs_) {
        nM = M / BM; nN = N / BM; nwg = nM * nN; G = G_; c = c_; ntk = K / BK; wsb = wsb_; fofs = fofs_;
        R = nwg / G; tail = nwg - R * G;
        if (fofs_ < 0 || 2 * tail > G || (ntk & 3)) tail = 0;
    }
    __host__ __device__ bool next(int i, Unit& u) const {
        long L;
        if (tail) {
            if (i < R) { L = (long)i * G + c; u.code = 0; }
            else if (i == R && c < 2 * tail) { L = (long)R * G + (c >> 1); u.code = (1 + (c & 1)) | ((c >> 1) << 2); }
            else return false;
        } else { L = (long)i * G + c; if (L >= nwg) return false; u.code = 0; }
        int wgid = (int)L; { const int q = nwg / NXCD, r = nwg % NXCD, xcd = wgid % NXCD, off = wgid / NXCD; wgid = (xcd < r ? xcd * (q + 1) : r * (q + 1) + (xcd - r) * q) + off; }
        const int nig = WGM * nN, gid = wgid / nig, fm = gid * WGM, gsz = (nM - fm) < WGM ? (nM - fm) : WGM;
        u.pm = fm + ((wgid % nig) % gsz); u.pn = (wgid % nig) / gsz; return true;
    }
    __device__ __forceinline__ void a_ready(const Unit&) const {}
    __device__ __forceinline__ void done(const Unit&) const {}
};
template <class Epi, class Sched>
__device__ __forceinline__ void gemm_phase(PG8_LAS unsigned char* lds, const Gemm g, const Sched& S, const Epi& E) {
    int tid_ = threadIdx.x; asm volatile("" : "+v"(tid_));
    const int tid = tid_, wid = __builtin_amdgcn_readfirstlane(tid >> 6), lane = tid & 63, wr = wid >> 2, wc = wid & 3, fr = lane & 15, fq = lane >> 4;
    const int K = g.K;
    unsigned voffA[2], voffB[2];
#pragma unroll
    for (int i = 0; i < 2; ++i) { int R, C; stage_rc(tid * 16 + i * 8192, R, C); const int Rb = Epi::PERM ? ((R & ~31) + perm32(R & 31)) : R;
        voffA[i] = (unsigned)(R * K + C) * 2u; voffB[i] = (unsigned)(Rb * K + C) * 2u; }
    const size_t kstep = (size_t)(BK * 2);
    const size_t hstep = (size_t)HALF * K * 2;
    const size_t tstep = 2 * hstep;
    const unsigned ldsw = (unsigned)wid * 1024u;
    const int aoff = lds_byte(wr * 64 + fr, fq * 8), boff = lds_byte(wc * 32 + fr, fq * 8);
#define PG8_SA(b, h) (((b) * 2 + (h)) * HTB)
#define PG8_SB(b, h) ((4 + (b) * 2 + (h)) * HTB)
#define PG8_STAGE(bufoff, gbase, voff) do { _Pragma("unroll") for (int _i = 0; _i < 2; ++_i) \
        __builtin_amdgcn_global_load_lds((const unsigned*)((const char*)(gbase) + (voff)[_i]), (PG8_LAS unsigned*)(lds + (bufoff) + ldsw + _i * 8192), 16, 0, 0); } while (0)
#define PG8_LDA(dst, b, h) do { _Pragma("unroll") for (int m = 0; m < 4; ++m) _Pragma("unroll") for (int k = 0; k < 2; ++k) dst[m][k] = *(const PG8_LAS bf16x8*)(lds + PG8_SA(b, h) + aoff + m * 2048 + k * 1024); } while (0)
#define PG8_LDB(dst, b, h) do { _Pragma("unroll") for (int n = 0; n < 2; ++n) _Pragma("unroll") for (int k = 0; k < 2; ++k) dst[n][k] = *(const PG8_LAS bf16x8*)(lds + PG8_SB(b, h) + boff + n * 2048 + k * 1024); } while (0)
#define PG8_MMA(ai, bj, At, Bt) do { __builtin_amdgcn_s_setprio(1); _Pragma("unroll") for (int m = 0; m < 4; ++m) _Pragma("unroll") for (int n = 0; n < 2; ++n) _Pragma("unroll") for (int k = 0; k < 2; ++k) \
        acc[ai][bj][m][n] = __builtin_amdgcn_mfma_f32_16x16x32_bf16(Bt[n][k], At[m][k], acc[ai][bj][m][n], 0, 0, 0); __builtin_amdgcn_s_setprio(0); } while (0)
#define PG8_WAIT_V(n) asm volatile("s_waitcnt vmcnt(" #n ")" ::: "memory")
#define PG8_WAIT_L(n) asm volatile("s_waitcnt lgkmcnt(" #n ")" ::: "memory")
#define PG8_BAR __builtin_amdgcn_s_barrier()
#define PG8_SCHED __builtin_amdgcn_sched_barrier(0)
    Unit cur, nxt; int ui = 0;
    if (!S.next(0, cur)) return;
    f32x4 acc[2][2][4][2];
#pragma unroll
    for (int a = 0; a < 2; ++a)
#pragma unroll
        for (int b = 0; b < 2; ++b)
#pragma unroll
            for (int m = 0; m < 4; ++m)
#pragma unroll
                for (int n = 0; n < 2; ++n) acc[a][b][m][n] = (f32x4){0.f, 0.f, 0.f, 0.f};
    bf16x8 At[4][2], B0[2][2], B1[2][2];
    const char* cA = (const char*)g.A + (size_t)cur.pm * tstep + (size_t)S.kt0(cur) * kstep; const char* cB = (const char*)g.Bt + (size_t)cur.pn * tstep + (size_t)S.kt0(cur) * kstep;
    S.a_ready(cur);
    PG8_STAGE(PG8_SB(0, 0), cB, voffB); PG8_STAGE(PG8_SA(0, 0), cA, voffA); PG8_STAGE(PG8_SB(0, 1), cB + hstep, voffB); PG8_STAGE(PG8_SA(0, 1), cA + hstep, voffA);
    if (wr == 1) PG8_BAR;
    PG8_WAIT_V(4); PG8_BAR;
    PG8_STAGE(PG8_SB(1, 0), cB + kstep, voffB); PG8_STAGE(PG8_SA(1, 0), cA + kstep, voffA); PG8_STAGE(PG8_SB(1, 1), cB + hstep + kstep, voffB);
    PG8_WAIT_V(6); PG8_BAR;
    for (;;) {
        const bool has_next = S.next(ui + 1, nxt);
        const char* nA = has_next ? (const char*)g.A + (size_t)nxt.pm * tstep + (size_t)S.kt0(nxt) * kstep : cA; const char* nB = has_next ? (const char*)g.Bt + (size_t)nxt.pn * tstep + (size_t)S.kt0(nxt) * kstep : cB;
        const int nt = S.nkt(cur);
        for (int t = 0; t < nt; t += 2) {
            const bool last = (t == nt - 2);
            const char* a1 = cA + (size_t)(t + 1) * kstep;
            const char* a2 = last ? nA : cA + (size_t)(t + 2) * kstep; const char* b2 = last ? nB : cB + (size_t)(t + 2) * kstep;
            const char* a3 = a2 + kstep; const char* b3 = b2 + kstep;
            if (last && has_next) S.a_ready(nxt);
            PG8_LDB(B0, 0, 0); PG8_SCHED; PG8_LDA(At, 0, 0); PG8_STAGE(PG8_SA(1, 1), a1 + hstep, voffA);
            PG8_WAIT_L(8); PG8_BAR; PG8_WAIT_L(0); PG8_MMA(0, 0, At, B0); PG8_BAR; PG8_SCHED;
            PG8_LDB(B1, 0, 1); PG8_STAGE(PG8_SB(0, 0), b2, voffB);
            PG8_BAR; PG8_WAIT_L(0); PG8_MMA(0, 1, At, B1); PG8_BAR;
            PG8_LDA(At, 0, 1); PG8_STAGE(PG8_SA(0, 0), a2, voffA);
            PG8_BAR; PG8_WAIT_L(0); PG8_MMA(1, 0, At, B0); PG8_BAR; PG8_SCHED;
            PG8_STAGE(PG8_SB(0, 1), b2 + hstep, voffB);
            PG8_WAIT_V(6); PG8_BAR; PG8_MMA(1, 1, At, B1); PG8_BAR;
            PG8_LDB(B0, 1, 0); PG8_SCHED; PG8_LDA(At, 1, 0); PG8_STAGE(PG8_SA(0, 1), a2 + hstep, voffA);
            PG8_WAIT_L(8); PG8_BAR; PG8_WAIT_L(0); PG8_MMA(0, 0, At, B0); PG8_BAR; PG8_SCHED;
            PG8_LDB(B1, 1, 1); PG8_STAGE(PG8_SB(1, 0), b3, voffB);
            PG8_BAR; PG8_WAIT_L(0); PG8_MMA(0, 1, At, B1); PG8_BAR;
            PG8_LDA(At, 1, 1); PG8_STAGE(PG8_SA(1, 0), a3, voffA);
            PG8_BAR; PG8_WAIT_L(0); PG8_MMA(1, 0, At, B0); PG8_BAR; PG8_SCHED;
            PG8_STAGE(PG8_SB(1, 1), b3 + hstep, voffB);
            PG8_WAIT_V(6); PG8_BAR; PG8_MMA(1, 1, At, B1); PG8_BAR;
        }
        const int role = cur.code & 3, slot = cur.code >> 2;
        if (role == 2) {
            f32x4* sp = (f32x4*)(S.wsb + WS_TS_OFS) + (size_t)slot * (32 * 512) + tid;
#pragma unroll
            for (int a = 0; a < 2; ++a)
#pragma unroll
                for (int b = 0; b < 2; ++b)
#pragma unroll
                    for (int m = 0; m < 4; ++m)
#pragma unroll
                        for (int n = 0; n < 2; ++n) asm volatile("global_store_dwordx4 %0, %1, off sc1" :: "v"(sp + (((a * 2 + b) * 4 + m) * 2 + n) * 512), "v"(acc[a][b][m][n]) : "memory");
            asm volatile("s_waitcnt vmcnt(0)" ::: "memory");
            if (lane == 0) __hip_atomic_store((unsigned*)(S.wsb + WS_FLAGS_OFS) + S.fofs + slot * 8 + wid, 1u, __ATOMIC_RELAXED, __HIP_MEMORY_SCOPE_AGENT);
        } else {
            if (role == 1) {
                unsigned spins = 0;
                while (__hip_atomic_load((unsigned*)(S.wsb + WS_FLAGS_OFS) + S.fofs + slot * 8 + wid, __ATOMIC_RELAXED, __HIP_MEMORY_SCOPE_AGENT) == 0u) { __builtin_amdgcn_s_sleep(2); if (++spins > (1u << 22)) break; }
                __builtin_amdgcn_fence(__ATOMIC_ACQUIRE, "agent");
                asm volatile("s_waitcnt vmcnt(0)" ::: "memory");
                const f32x4* sp = (const f32x4*)(S.wsb + WS_TS_OFS) + (size_t)slot * (32 * 512) + tid;
#pragma unroll
                for (int a = 0; a < 2; ++a)
#pragma unroll
                    for (int b = 0; b < 2; ++b)
#pragma unroll
                        for (int m = 0; m < 4; ++m)
#pragma unroll
                            for (int n = 0; n < 2; ++n) { acc[a][b][m][n] += sp[(((a * 2 + b) * 4 + m) * 2 + n) * 512]; asm volatile("" ::: "memory"); }
            }
            E(acc, cur, wr, wc, fr, fq);
        }
        if (!has_next) break;
#pragma unroll
        for (int a = 0; a < 2; ++a)
#pragma unroll
            for (int b = 0; b < 2; ++b)
#pragma unroll
                for (int m = 0; m < 4; ++m)
#pragma unroll
                    for (int n = 0; n < 2; ++n) acc[a][b][m][n] = (f32x4){0.f, 0.f, 0.f, 0.f};
        cur = nxt; cA = nA; cB = nB; ++ui;
    }
    PG8_WAIT_V(0);
    if (wr == 0) PG8_BAR;
    PG8_BAR;
    if constexpr (Epi::AFTER_DRAIN) { E.fused(acc, cur, wr, wc, fr, fq, lds, wid, lane); S.done(cur); }
#undef PG8_SA
#undef PG8_SB
#undef PG8_STAGE
#undef PG8_LDA
#undef PG8_LDB
#undef PG8_MMA
#undef PG8_WAIT_V
#undef PG8_WAIT_L
#undef PG8_BAR
#undef PG8_SCHED
}
}

constexpr int D = 2048, MCTX = 8192, MLAT = 4096, MTOT = 12288, FFN = 8192, ABIN = 4608, NQKV = 6144, MODW = 12288;
constexpr float EPS = 1e-6f;
constexpr size_t WS_MOD = 0;
constexpr size_t WS_BAR = 512u << 10;
constexpr size_t WS_WIN = 1u << 20;
constexpr size_t WS_WO0 = WS_WIN + (size_t)ABIN * D * 2;
constexpr size_t WS_WQKV = WS_WO0 + (size_t)D * D * 2;
constexpr size_t WS_WO1 = WS_WQKV + (size_t)NQKV * D * 2;
constexpr size_t WS_W1 = WS_WO1 + (size_t)D * D * 2;
constexpr size_t WS_W2 = WS_W1 + 2 * (size_t)FFN * D * 2;
constexpr size_t WS_XN = WS_W2 + 2 * (size_t)FFN * D * 2;
constexpr size_t WS_H = WS_XN + (size_t)MTOT * D * 2;
constexpr size_t WS_Z = WS_H;
constexpr size_t WS_AB = WS_H + (size_t)MTOT * NQKV * 2;
constexpr size_t WS_Q0 = WS_H + (size_t)MTOT * FFN * 2;
constexpr size_t WS_K0 = WS_Q0 + (size_t)MTOT * 1024 * 2;
constexpr size_t WS_V0 = WS_K0 + (size_t)(MTOT + 1024) * 256 * 2;
constexpr size_t WS_CNK = WS_V0 + (size_t)(MTOT + 1024) * 256 * 2;
constexpr size_t WS_CNV = WS_CNK + (size_t)1024 * 2048 * 2;
constexpr size_t WS_X = WS_CNV + (size_t)1024 * 2048 * 2;
constexpr size_t WS_TS = WS_X + (size_t)MTOT * D * 4;
constexpr size_t WS_END = WS_TS + (size_t)128 * 32 * 512 * 16;
constexpr size_t WS_FLAGS = WS_BAR + 16384;
static_assert(WS_TS == WS_TS_OFS && WS_FLAGS == WS_FLAGS_OFS, "early offsets");
constexpr int LDS_BYTES = 131072 + 256;

constexpr size_t OUT_YP = 0, OUT_YS = (size_t)MCTX * D, OUT_AK = OUT_YS + (size_t)MLAT * D, OUT_AV = OUT_AK + (size_t)MCTX * 256,
                 OUT_NK = OUT_AV + (size_t)MCTX * 256, OUT_NV = OUT_NK + (size_t)MCTX * D;

struct Params {
    const float* in[23];
    float* out;
    unsigned char* ws;
    int ph_lo, ph_hi;
};

template <int ACT, bool SIDE> struct EpiBf16 {
    static constexpr bool PERM = true, AFTER_DRAIN = false;
    bf16_t* O; int ldc; float* kout; float* vout; int split_tiles; size_t split_stride;
    __device__ __forceinline__ void operator()(const f32x4 (&acc)[2][2][4][2], const pg8::Unit& u, int wr, int wc, int fr, int fq) const {
        const int row0 = u.pm * 256 + wr * 64 + fr, col0 = u.pn * 256 + wc * 32 + 8 * fq;
        const int spt = split_tiles ? u.pn / split_tiles : 0; bf16_t* Ob = O + (size_t)spt * split_stride; const int ocol0 = col0 - spt * split_tiles * 256;
        const bool side = SIDE && (u.pm < 32) && (u.pn >= 8);
        float* sbase = nullptr; int scol0 = 0;
        if (SIDE) { sbase = (u.pn < 16) ? kout : vout; scol0 = col0 - ((u.pn < 16) ? 2048 : 4096); }
#pragma unroll
        for (int ai = 0; ai < 2; ++ai)
#pragma unroll
            for (int m = 0; m < 4; ++m) {
                const int row = row0 + ai * 128 + m * 16;
                bf16_t* rowp = Ob + (size_t)row * ldc + ocol0;
#pragma unroll
                for (int bj = 0; bj < 2; ++bj) {
                    f32x4 v0 = acc[ai][bj][m][0], v1 = acc[ai][bj][m][1];
                    if (SIDE) { if (side) { float* sp = sbase + (size_t)row * 2048 + scol0 + bj * 128; *(f32x4*)sp = v0; *(f32x4*)(sp + 4) = v1; } }
                    if (ACT == 1) {
#pragma unroll
                        for (int j = 0; j < 4; ++j) { float a = fmaxf(v0[j], 0.f), b = fmaxf(v1[j], 0.f); v0[j] = a * a; v1[j] = b * b; }
                    }
                    u32x4 o; o.x = cvt_pk_bf16(v0[0], v0[1]); o.y = cvt_pk_bf16(v0[2], v0[3]); o.z = cvt_pk_bf16(v1[0], v1[1]); o.w = cvt_pk_bf16(v1[2], v1[3]);
                    *(u32x4*)(rowp + bj * 128) = o;
                }
            }
    }
};
struct EpiResid {
    static constexpr bool PERM = false, AFTER_DRAIN = false;
    const float* src_lo; const float* src_hi;
    float* X; const float* gate;
    __device__ __forceinline__ void operator()(const f32x4 (&acc)[2][2][4][2], const pg8::Unit& u, int wr, int wc, int fr, int fq) const {
        const int row0 = u.pm * 256 + wr * 64 + fr, col0 = u.pn * 256 + wc * 32 + 4 * fq;
        const int cond = (u.pm < 32) ? 0 : 1 + ((u.pm - 32) >> 3);
        const float* gp = gate + (size_t)cond * MODW + col0;
        const float* sb = (u.pm < 32) ? src_lo : src_hi;
        f32x4 gv[2][2];
#pragma unroll
        for (int bj = 0; bj < 2; ++bj)
#pragma unroll
            for (int n = 0; n < 2; ++n) gv[bj][n] = *(const f32x4*)(gp + bj * 128 + n * 16);
#pragma unroll
        for (int ai = 0; ai < 2; ++ai)
#pragma unroll
            for (int m = 0; m < 4; ++m) {
                const size_t off = (size_t)(row0 + ai * 128 + m * 16) * D + col0;
#pragma unroll
                for (int bj = 0; bj < 2; ++bj)
#pragma unroll
                    for (int n = 0; n < 2; ++n) {
                        const f32x4 r = *(const f32x4*)(sb + off + bj * 128 + n * 16);
                        *(f32x4*)(X + off + bj * 128 + n * 16) = r + gv[bj][n] * acc[ai][bj][m][n];
                    }
            }
    }
};

__device__ __forceinline__ unsigned f2bf(float f) { unsigned u = __float_as_uint(f); return (u + 0x7fffu + ((u >> 16) & 1u)) >> 16; }
__device__ __forceinline__ unsigned pk2(float lo, float hi) { return f2bf(lo) | (f2bf(hi) << 16); }
__device__ __forceinline__ void p0_transpose_item(const float* W, int K, int N, bf16_t* WT, LAS float* scr, int item, int lane) {
    const int nblk = N / 32, kb = item / nblk, nb = item % nblk, k0 = 64 * kb, n0 = 32 * nb;
#pragma unroll 8
    for (int i = 0; i < 32; ++i) { const int kk = 2 * i + (lane >> 5); scr[kk * 33 + (lane & 31)] = W[(size_t)(k0 + kk) * N + n0 + (lane & 31)]; }
    asm volatile("s_waitcnt lgkmcnt(0)" ::: "memory");
    const int c = lane & 7;
#pragma unroll
    for (int j = 0; j < 4; ++j) { const int n = (lane >> 3) + 8 * j; const LAS float* s = scr + (8 * c) * 33 + n;
        u32x4 o; o.x = pk2(s[0 * 33], s[1 * 33]); o.y = pk2(s[2 * 33], s[3 * 33]); o.z = pk2(s[4 * 33], s[5 * 33]); o.w = pk2(s[6 * 33], s[7 * 33]);
        *(u32x4*)(WT + (size_t)(n0 + n) * K + k0 + 8 * c) = o; }
    asm volatile("s_waitcnt lgkmcnt(0)" ::: "memory");
}
__device__ __forceinline__ void cvt_linear(const float* src, bf16_t* dst, int n, int gtid, int gthreads) {
    for (int i = gtid * 4; i < n; i += gthreads * 4) { const f32x4 v = *(const f32x4*)(src + i); u32x2 o; o.x = cvt_pk_bf16(v[0], v[1]); o.y = cvt_pk_bf16(v[2], v[3]); *(u32x2*)(dst + i) = o; }
}
__device__ __forceinline__ void p0_prologue(const Params& p, LAS unsigned char* lds) {
    int tid_ = threadIdx.x; asm volatile("" : "+v"(tid_));
    const int tid = tid_, lane = tid & 63, wave = __builtin_amdgcn_readfirstlane(tid >> 6), G = gridDim.x;
    unsigned char* ws = p.ws;
    {
        LAS float* sc = (LAS float*)(lds + 69632);
        LAS float* red = (LAS float*)(lds + 69632 + 24576);
        const float* cvec = p.in[6]; const float* cctx = p.in[7];
        for (int i = tid; i < 3 * 2048; i += 512) { const int c = i >> 11, k = i & 2047; const float x = (c == 0) ? cctx[k] : cvec[(c - 1) * 2048 + k]; sc[i] = x / (1.f + __expf(-x)); }
        __syncthreads();
        float* MOD = (float*)(ws + WS_MOD);
        for (int item = blockIdx.x; item < 256; item += G) {
            const int l = item >> 7, cgp = item & 127, ln = lane < 48 ? lane : 47;
            const float* W = p.in[8] + (size_t)l * 2048 * MODW + cgp * 96 + ln * 2;
            float a00 = 0.f, a01 = 0.f, a10 = 0.f, a11 = 0.f, a20 = 0.f, a21 = 0.f;
            const int kb = wave * 256;
#pragma unroll 8
            for (int k = 0; k < 256; ++k) {
                const f32x2 w = *(const f32x2*)(W + (size_t)(kb + k) * MODW);
                const float s0 = sc[kb + k], s1 = sc[2048 + kb + k], s2 = sc[4096 + kb + k];
                a00 += s0 * w.x; a01 += s0 * w.y; a10 += s1 * w.x; a11 += s1 * w.y; a20 += s2 * w.x; a21 += s2 * w.y;
            }
            if (lane < 48) { LAS float* r = red + wave * 288 + lane * 2; r[0] = a00; r[1] = a01; r[96] = a10; r[97] = a11; r[192] = a20; r[193] = a21; }
            __syncthreads();
            if (tid < 288) { const int c = tid / 96, j = tid % 96; float s = 0.f;
#pragma unroll
                for (int w = 0; w < 8; ++w) s += red[w * 288 + tid];
                MOD[(size_t)(l * 3 + c) * MODW + cgp * 96 + j] = s + p.in[9][l * MODW + cgp * 96 + j]; }
            __syncthreads();
        }
    }
    {
        LAS float* scr = (LAS float*)(lds + wave * 8448);
        const int gw = blockIdx.x * 8 + wave, NGW = G * 8;
        constexpr int I_IN = 32 * (ABIN / 32), I_O = 32 * (D / 32), I_QKV = 32 * (NQKV / 32), I_1 = 32 * (FFN / 32), I_2 = (FFN / 64) * (D / 32);
        constexpr int NITEMS = I_IN + 2 * I_O + I_QKV + 2 * I_1 + 2 * I_2;
        for (int it = gw; it < NITEMS; it += NGW) {
            int r = it;
            if (r < I_IN) { p0_transpose_item(p.in[12], D, ABIN, (bf16_t*)(ws + WS_WIN), scr, r, lane); continue; } r -= I_IN;
            if (r < I_O) { p0_transpose_item(p.in[16], D, D, (bf16_t*)(ws + WS_WO0), scr, r, lane); continue; } r -= I_O;
            if (r < I_QKV) { p0_transpose_item(p.in[17], D, NQKV, (bf16_t*)(ws + WS_WQKV), scr, r, lane); continue; } r -= I_QKV;
            if (r < I_O) { p0_transpose_item(p.in[19], D, D, (bf16_t*)(ws + WS_WO1), scr, r, lane); continue; } r -= I_O;
            if (r < 2 * I_1) { const int l = r / I_1; p0_transpose_item(p.in[20] + (size_t)l * D * FFN, D, FFN, (bf16_t*)(ws + WS_W1) + (size_t)l * FFN * D, scr, r - l * I_1, lane); continue; } r -= 2 * I_1;
            { const int l = r / I_2; p0_transpose_item(p.in[21] + (size_t)l * D * FFN, FFN, D, (bf16_t*)(ws + WS_W2) + (size_t)l * FFN * D, scr, r - l * I_2, lane); }
        }
    }
    {
        const int gtid = blockIdx.x * 512 + tid, gth = G * 512;
        cvt_linear(p.in[2], (bf16_t*)(ws + WS_K0) + (size_t)MTOT * 256, 1024 * 256, gtid, gth);
        cvt_linear(p.in[3], (bf16_t*)(ws + WS_V0) + (size_t)MTOT * 256, 1024 * 256, gtid, gth);
        cvt_linear(p.in[4], (bf16_t*)(ws + WS_CNK), 1024 * 2048, gtid, gth);
        cvt_linear(p.in[5], (bf16_t*)(ws + WS_CNV), 1024 * 2048, gtid, gth);
    }
}

template <bool OUT_F32>
__device__ __forceinline__ void norm_phase(const float* src_lo, const float* src_hi, const float* gain, const float* mod, int shift_off, int scale_off, bf16_t* dst_bf, float* dst_f) {
    int tid_ = threadIdx.x; asm volatile("" : "+v"(tid_));
    const int tid = tid_, lane = tid & 63, wave = tid >> 6, G = gridDim.x;
    const int gw = blockIdx.x * 8 + wave, NGW = G * 8, per = (MTOT + NGW - 1) / NGW;
    const int r_beg = gw * per, r_end = (r_beg + per < MTOT) ? r_beg + per : MTOT;
    int cur = -1; f32x4 A[8], B[8];
    for (int row = r_beg; row < r_end; ++row) {
        const int cond = (row < MCTX) ? 0 : 1 + ((row - MCTX) >> 11);
        if (cond != cur) {
            cur = cond;
#pragma unroll
            for (int j = 0; j < 8; ++j) {
                const int col = 4 * lane + 256 * j; const f32x4 g = *(const f32x4*)(gain + col);
                if (mod) { const f32x4 sc = *(const f32x4*)(mod + (size_t)cond * MODW + scale_off + col); A[j] = g * (sc + 1.f); B[j] = *(const f32x4*)(mod + (size_t)cond * MODW + shift_off + col); }
                else { A[j] = g; B[j] = (f32x4){0.f, 0.f, 0.f, 0.f}; }
            }
        }
        const float* xr = ((row < MCTX) ? src_lo : src_hi) + (size_t)row * D + 4 * lane;
        f32x4 v[8]; float s = 0.f;
#pragma unroll
        for (int j = 0; j < 8; ++j) { v[j] = *(const f32x4*)(xr + 256 * j); s += (v[j].x * v[j].x + v[j].y * v[j].y) + (v[j].z * v[j].z + v[j].w * v[j].w); }
        const float rstd = rsqrtf(wave_sum(s) * (1.f / D) + EPS);
#pragma unroll
        for (int j = 0; j < 8; ++j) {
            const f32x4 y = v[j] * rstd * A[j] + B[j];
            if (OUT_F32) *(f32x4*)(dst_f + (size_t)row * D + 4 * lane + 256 * j) = y;
            else { u32x2 o; o.x = cvt_pk_bf16(y[0], y[1]); o.y = cvt_pk_bf16(y[2], y[3]); *(u32x2*)(dst_bf + (size_t)row * D + 4 * lane + 256 * j) = o; }
        }
    }
}

__device__ __forceinline__ void unpack8(const u32x4 r, float (&f)[8]) {
    f[0] = bf2f(r.x & 0xffffu); f[1] = __uint_as_float(r.x & 0xffff0000u); f[2] = bf2f(r.y & 0xffffu); f[3] = __uint_as_float(r.y & 0xffff0000u);
    f[4] = bf2f(r.z & 0xffffu); f[5] = __uint_as_float(r.z & 0xffff0000u); f[6] = bf2f(r.w & 0xffffu); f[7] = __uint_as_float(r.w & 0xffff0000u);
}
__device__ __forceinline__ void ew0_phase(const Params& p) {
    int tid_ = threadIdx.x; asm volatile("" : "+v"(tid_));
    const int tid = tid_, lane = tid & 63, wave = tid >> 6, G = gridDim.x;
    const int gw = blockIdx.x * 8 + wave, NGW = G * 8;
    unsigned char* ws = p.ws;
    const bf16_t* Z = (const bf16_t*)(ws + WS_Z);
    bf16_t* AB = (bf16_t*)(ws + WS_AB); bf16_t* Q0 = (bf16_t*)(ws + WS_Q0); bf16_t* K0 = (bf16_t*)(ws + WS_K0); bf16_t* V0 = (bf16_t*)(ws + WS_V0);
    const float* convw = p.in[13]; const float* qn = p.in[14]; const float* kn = p.in[15];
    const int ri = lane & 31, chunk = lane >> 5, da = chunk * 64 + ri, db = da + 32;
    const float inv = __builtin_amdgcn_exp2f(-(float)ri * (13.287712379549449f / 32.f));
    const float qwa = qn[da], qwb = qn[db], kwa = kn[da], kwb = kn[db];
    for (int tok = gw; tok < MTOT; tok += NGW) {
        const bool lat = tok >= MCTX;
        const int t = lat ? ((tok - MCTX) & 2047) : (tok & 255), slen = lat ? 2048 : 256;
        const bf16_t* zr = Z + (size_t)tok * ABIN;
#pragma unroll
        for (int j = 0; j < 2; ++j) {
            const int ch = j * 512 + lane * 8;
            float gb[8], acc[8];
            unpack8(*(const u32x4*)(zr + ch), gb);
#pragma unroll
            for (int e = 0; e < 8; ++e) acc[e] = 0.f;
#pragma unroll
            for (int dt = -1; dt <= 1; ++dt) {
                if (t + dt >= 0 && t + dt < slen) {
                    float gc[8], xa[8];
                    unpack8(*(const u32x4*)(zr + dt * ABIN + 1024 + ch), gc);
                    unpack8(*(const u32x4*)(zr + dt * ABIN + 2048 + ch), xa);
                    const f32x4 w0 = *(const f32x4*)(convw + (dt + 1) * 1024 + ch), w1 = *(const f32x4*)(convw + (dt + 1) * 1024 + ch + 4);
#pragma unroll
                    for (int e = 0; e < 4; ++e) { acc[e] += w0[e] * (gc[e] * xa[e]); acc[4 + e] += w1[e] * (gc[4 + e] * xa[4 + e]); }
                }
            }
            u32x4 o; o.x = cvt_pk_bf16(gb[0] * acc[0], gb[1] * acc[1]); o.y = cvt_pk_bf16(gb[2] * acc[2], gb[3] * acc[3]);
            o.z = cvt_pk_bf16(gb[4] * acc[4], gb[5] * acc[5]); o.w = cvt_pk_bf16(gb[6] * acc[6], gb[7] * acc[7]);
            *(u32x4*)(AB + (size_t)tok * D + ch) = o;
        }
        float cs = 1.f, sn = 0.f;
        if (lat) { const float pos = (float)(chunk == 0 ? (t >> 6) : (t & 63)); const float ang = pos * inv; cs = __cosf(ang); sn = __sinf(ang); }
#pragma unroll
        for (int hh = 0; hh < 10; ++hh) {
            const bf16_t* hp = zr + 3072 + hh * 128;
            const float va = bf2f(hp[da]), vb = bf2f(hp[db]);
            const float rstd = rsqrtf(wave_sum(va * va + vb * vb) * (1.f / 128.f) + EPS);
            const float na = va * rstd * (hh < 8 ? qwa : kwa), nb = vb * rstd * (hh < 8 ? qwb : kwb);
            const float ra = na * cs - nb * sn, rb = na * sn + nb * cs;
            if (hh < 8) { bf16_t* q = Q0 + (size_t)tok * 1024 + hh * 128; q[da] = (bf16_t)f2bf(ra); q[db] = (bf16_t)f2bf(rb); }
            else {
                const int kvh = hh - 8;
                bf16_t* k = K0 + (size_t)tok * 256 + kvh * 128; k[da] = (bf16_t)f2bf(ra); k[db] = (bf16_t)f2bf(rb);
                if (!lat) { float* ok = p.out + OUT_AK + (size_t)tok * 256 + kvh * 128; ok[da] = na; ok[db] = nb; }
            }
        }
        {
            const u32x2 r = *(const u32x2*)(zr + 4352 + lane * 4);
            *(u32x2*)(V0 + (size_t)tok * 256 + lane * 4) = r;
            if (!lat) { f32x4 o; o[0] = bf2f(r.x & 0xffffu); o[1] = __uint_as_float(r.x & 0xffff0000u); o[2] = bf2f(r.y & 0xffffu); o[3] = __uint_as_float(r.y & 0xffff0000u);
                *(f32x4*)(p.out + OUT_AV + (size_t)tok * 256 + lane * 4) = o; }
        }
    }
}

constexpr int KSTR = 272, VSTR = 288, LDS_KT = 0, LDS_VT = 2 * 64 * KSTR, LDS_BIAS = LDS_VT + 2 * 64 * VSTR;
constexpr float SCL2 = 0.08838834764831845f * 1.4426950408889634f, LOG2E = 1.4426950408889634f;
struct AttnArgs {
    const bf16_t* q; int qstride; int qrow0;
    bf16_t* o; int ostride;
    const bf16_t* kA; const bf16_t* vA; int strideA, ntA;
    const bf16_t* kB; const bf16_t* vB; int strideB, ntB;
    int r0, krlo; const float* bias;
};
__device__ __forceinline__ v4i16_t vtr(const LAS unsigned char* p) { return __builtin_amdgcn_ds_read_tr16_b64_v4i16((LAS v4i16_t*)p); }

template <int NA>
__device__ __forceinline__ void attn_run(LAS unsigned char* lds, const AttnArgs& a) {
    int tid_ = threadIdx.x; asm volatile("" : "+v"(tid_));
    const int tid = tid_, lane = tid & 63, wave = __builtin_amdgcn_readfirstlane(tid >> 6), fr = lane & 15, fq = lane >> 4;
    bf16x8 Qf[2][4];
#pragma unroll
    for (int qb = 0; qb < 2; ++qb)
#pragma unroll
        for (int dc = 0; dc < 4; ++dc) Qf[qb][dc] = *(const bf16x8*)(a.q + (size_t)(a.qrow0 + wave * 32 + qb * 16 + fr) * a.qstride + dc * 32 + fq * 8);
    f32x4 O[2][8];
#pragma unroll
    for (int qb = 0; qb < 2; ++qb)
#pragma unroll
        for (int db = 0; db < 8; ++db) O[qb][db] = (f32x4){0.f, 0.f, 0.f, 0.f};
    float mrun[2] = {-1e30f, -1e30f}, lrun[2] = {0.f, 0.f};
    LAS float* biasL = (LAS float*)(lds + LDS_BIAS);
    if (NA) { for (int i = tid; i < 465; i += 512) biasL[i] = a.bias[i]; }
    const int nt = a.ntA + a.ntB;
    const int lrow = tid >> 3, lch = tid & 7;
    u32x4 kr0, kr1, vr0, vr1;
#define ATT_GLOAD(t) do { const bool inA = (t) < a.ntA; const int tt = inA ? (t) : (t) - a.ntA; const int st = inA ? a.strideA : a.strideB; \
        const bf16_t* kp = (inA ? a.kA : a.kB) + (size_t)(tt * 64 + lrow) * st + lch * 8; const bf16_t* vp = (inA ? a.vA : a.vB) + (size_t)(tt * 64 + lrow) * st + lch * 8; \
        kr0 = *(const u32x4*)kp; kr1 = *(const u32x4*)(kp + 64); vr0 = *(const u32x4*)vp; vr1 = *(const u32x4*)(vp + 64); } while (0)
#define ATT_LWRITE(b) do { LAS unsigned char* kd = lds + LDS_KT + (b) * 64 * KSTR + lrow * KSTR + lch * 16; LAS unsigned char* vd = lds + LDS_VT + (b) * 64 * VSTR + lrow * VSTR + lch * 16; \
        *(LAS u32x4*)kd = kr0; *(LAS u32x4*)(kd + 128) = kr1; *(LAS u32x4*)vd = vr0; *(LAS u32x4*)(vd + 128) = vr1; } while (0)
    ATT_GLOAD(0); ATT_LWRITE(0); __syncthreads();
    const int rw = NA ? a.r0 + (wave >> 1) : 0;
    const int kr_lo_w = NA ? (rw - 4 < 0 ? 0 : (rw - 4 > 24 ? 24 : rw - 4)) : 0;
    for (int t = 0; t < nt; ++t) {
        if (t + 1 < nt) ATT_GLOAD(t + 1);
        bool active = true; int kr = 0; const bool local = NA && t >= a.ntA;
        if (local) { kr = a.krlo + (t - a.ntA); active = (kr >= kr_lo_w) && (kr < kr_lo_w + 8); }
        if (active) {
            const LAS unsigned char* Kt = lds + LDS_KT + (t & 1) * 64 * KSTR;
            const LAS unsigned char* Vt = lds + LDS_VT + (t & 1) * 64 * VSTR;
            f32x4 S[2][4];
#pragma unroll
            for (int qb = 0; qb < 2; ++qb)
#pragma unroll
                for (int kb = 0; kb < 4; ++kb) S[qb][kb] = (f32x4){0.f, 0.f, 0.f, 0.f};
#pragma unroll
            for (int kb = 0; kb < 4; ++kb)
#pragma unroll
                for (int dc = 0; dc < 4; ++dc) {
                    const bf16x8 kf = *(const LAS bf16x8*)(Kt + (kb * 16 + fr) * KSTR + dc * 64 + fq * 16);
                    S[0][kb] = __builtin_amdgcn_mfma_f32_16x16x32_bf16(kf, Qf[0][dc], S[0][kb], 0, 0, 0);
                    S[1][kb] = __builtin_amdgcn_mfma_f32_16x16x32_bf16(kf, Qf[1][dc], S[1][kb], 0, 0, 0);
                }
            bf16x8 Pf[2][2];
#pragma unroll
            for (int qb = 0; qb < 2; ++qb) {
                if (local) {
                    const int c = (wave & 1) * 32 + qb * 16 + fr;
                    const int kc0 = c - 8 < 0 ? 0 : (c - 8 > 48 ? 48 : c - 8);
                    const LAS float* brow = biasL + (kr - rw + 7) * 31 + 15 - c;
#pragma unroll
                    for (int kb = 0; kb < 4; ++kb)
#pragma unroll
                        for (int j = 0; j < 4; ++j) { const int kc = kb * 16 + 4 * fq + j; const bool ok = (kc >= kc0) && (kc < kc0 + 16);
                            const float bv = brow[ok ? kc : c];
                            S[qb][kb][j] = ok ? (S[qb][kb][j] * SCL2 + bv * LOG2E) : -1e30f; }
                } else {
#pragma unroll
                    for (int kb = 0; kb < 4; ++kb) S[qb][kb] = S[qb][kb] * SCL2;
                }
                float mx = -1e30f;
#pragma unroll
                for (int kb = 0; kb < 4; ++kb) mx = fmaxf(mx, fmaxf(fmaxf(S[qb][kb][0], S[qb][kb][1]), fmaxf(S[qb][kb][2], S[qb][kb][3])));
                mx = fmaxf(mx, __shfl_xor(mx, 16)); mx = fmaxf(mx, __shfl_xor(mx, 32));
                const float mn = fmaxf(mrun[qb], mx), alpha = __builtin_amdgcn_exp2f(mrun[qb] - mn);
                mrun[qb] = mn;
                float rs = 0.f;
#pragma unroll
                for (int kb = 0; kb < 4; ++kb)
#pragma unroll
                    for (int j = 0; j < 4; ++j) { const float pv = __builtin_amdgcn_exp2f(S[qb][kb][j] - mn); S[qb][kb][j] = pv; rs += pv; }
                lrun[qb] = lrun[qb] * alpha + rs;
#pragma unroll
                for (int db = 0; db < 8; ++db) O[qb][db] = O[qb][db] * alpha;
#pragma unroll
                for (int c2 = 0; c2 < 2; ++c2) {
                    u32x4 pk; pk.x = cvt_pk_bf16(S[qb][2 * c2][0], S[qb][2 * c2][1]); pk.y = cvt_pk_bf16(S[qb][2 * c2][2], S[qb][2 * c2][3]);
                    pk.z = cvt_pk_bf16(S[qb][2 * c2 + 1][0], S[qb][2 * c2 + 1][1]); pk.w = cvt_pk_bf16(S[qb][2 * c2 + 1][2], S[qb][2 * c2 + 1][3]);
                    Pf[qb][c2] = __builtin_bit_cast(bf16x8, pk);
                }
            }
            const LAS unsigned char* vb = Vt + (4 * fq + (fr >> 2)) * VSTR + (fr & 3) * 8;
#pragma unroll
            for (int c2 = 0; c2 < 2; ++c2)
#pragma unroll
                for (int db = 0; db < 8; ++db) {
                    const v4i16_t lo = vtr(vb + (c2 * 32) * VSTR + db * 32), hi = vtr(vb + (c2 * 32 + 16) * VSTR + db * 32);
                    bf16x8 vf; vf[0] = lo[0]; vf[1] = lo[1]; vf[2] = lo[2]; vf[3] = lo[3]; vf[4] = hi[0]; vf[5] = hi[1]; vf[6] = hi[2]; vf[7] = hi[3];
                    O[0][db] = __builtin_amdgcn_mfma_f32_16x16x32_bf16(vf, Pf[0][c2], O[0][db], 0, 0, 0);
                    O[1][db] = __builtin_amdgcn_mfma_f32_16x16x32_bf16(vf, Pf[1][c2], O[1][db], 0, 0, 0);
                }
        }
        if (t + 1 < nt) ATT_LWRITE((t + 1) & 1);
        __syncthreads();
    }
#undef ATT_GLOAD
#undef ATT_LWRITE
#pragma unroll
    for (int qb = 0; qb < 2; ++qb) {
        float lt = lrun[qb]; lt += __shfl_xor(lt, 16); lt += __shfl_xor(lt, 32);
        const float il = 1.f / lt;
        bf16_t* op = a.o + (size_t)(a.qrow0 + wave * 32 + qb * 16 + fr) * a.ostride + 4 * fq;
#pragma unroll
        for (int db = 0; db < 8; ++db) { const f32x4 v = O[qb][db] * il; u32x2 o; o.x = cvt_pk_bf16(v[0], v[1]); o.y = cvt_pk_bf16(v[2], v[3]); *(u32x2*)(op + db * 16) = o; }
    }
}

__device__ __forceinline__ void attn0_phase(const Params& p, LAS unsigned char* lds) {
    unsigned char* ws = p.ws; const int G = gridDim.x;
    const bf16_t* Q0 = (const bf16_t*)(ws + WS_Q0); const bf16_t* K0 = (const bf16_t*)(ws + WS_K0); const bf16_t* V0 = (const bf16_t*)(ws + WS_V0);
    bf16_t* AB = (bf16_t*)(ws + WS_AB);
    for (int i = blockIdx.x; i < 512; i += G) {
        if (i >= 256 && i < 384) continue;
        AttnArgs a;
        if (i < 128) { const int b = i >> 6, h = (i >> 3) & 7, qblk = i & 7, kvh = h >> 2;
            a.q = Q0 + h * 128; a.qstride = 1024; a.qrow0 = MCTX + b * 2048 + qblk * 256; a.o = AB + 1024 + h * 128; a.ostride = D;
            a.kA = K0 + (size_t)(MTOT + b * 512) * 256 + kvh * 128; a.vA = V0 + (size_t)(MTOT + b * 512) * 256 + kvh * 128; a.strideA = 256; a.ntA = 8;
            a.kB = K0 + (size_t)(MCTX + b * 2048) * 256 + kvh * 128; a.vB = V0 + (size_t)(MCTX + b * 2048) * 256 + kvh * 128; a.strideB = 256; a.ntB = 32;
        } else { const int j = (i < 256) ? i - 128 : i - 256, b = j >> 3, h = j & 7, kvh = h >> 2;
            a.q = Q0 + h * 128; a.qstride = 1024; a.qrow0 = b * 256; a.o = AB + 1024 + h * 128; a.ostride = D;
            a.kA = K0 + (size_t)(b * 256) * 256 + kvh * 128; a.vA = V0 + (size_t)(b * 256) * 256 + kvh * 128; a.strideA = 256; a.ntA = 4;
            a.kB = a.kA; a.vB = a.vA; a.strideB = 256; a.ntB = 0;
        }
        a.r0 = 0; a.krlo = 0; a.bias = nullptr;
        attn_run<0>(lds, a);
    }
}
__device__ __forceinline__ void attn1_phase(const Params& p, LAS unsigned char* lds, bf16_t* AO) {
    unsigned char* ws = p.ws; const int G = gridDim.x;
    const bf16_t* Q1 = (const bf16_t*)(ws + WS_Z); const bf16_t* K1 = Q1 + (size_t)MTOT * D; const bf16_t* V1 = K1 + (size_t)MTOT * D;
    const bf16_t* CNK = (const bf16_t*)(ws + WS_CNK); const bf16_t* CNV = (const bf16_t*)(ws + WS_CNV);
    for (int i = blockIdx.x; i < 256; i += G) {
        AttnArgs a;
        const int b = i >> 7, h = (i >> 3) & 15, rg = i & 7, r0 = rg * 4;
        const int lo = r0 - 4 < 0 ? 0 : (r0 - 4 > 24 ? 24 : r0 - 4), hi0 = r0 - 1 < 0 ? 0 : (r0 - 1 > 24 ? 24 : r0 - 1), hi = hi0 + 7;
        a.q = Q1 + h * 128; a.qstride = D; a.qrow0 = MCTX + b * 2048 + r0 * 64; a.o = AO + h * 128; a.ostride = D;
        a.kA = CNK + (size_t)(b * 512) * 2048 + h * 128; a.vA = CNV + (size_t)(b * 512) * 2048 + h * 128; a.strideA = 2048; a.ntA = 8;
        a.kB = K1 + (size_t)(MCTX + b * 2048 + lo * 64) * D + h * 128; a.vB = V1 + (size_t)(MCTX + b * 2048 + lo * 64) * D + h * 128; a.strideB = D; a.ntB = hi - lo + 1;
        a.r0 = r0; a.krlo = lo; a.bias = p.in[18] + h * 465;
        attn_run<1>(lds, a);
    }
    for (int j = blockIdx.x; j < 512; j += G) {
        AttnArgs a;
        const int b = j >> 4, h = j & 15;
        a.q = Q1 + h * 128; a.qstride = D; a.qrow0 = b * 256; a.o = AO + h * 128; a.ostride = D;
        a.kA = K1 + (size_t)(b * 256) * D + h * 128; a.vA = V1 + (size_t)(b * 256) * D + h * 128; a.strideA = D; a.ntA = 4;
        a.kB = a.kA; a.vB = a.vA; a.strideB = D; a.ntB = 0;
        a.r0 = 0; a.krlo = 0; a.bias = nullptr;
        attn_run<0>(lds, a);
    }
}

#define XB_TMO      128
#define XB_XCNT(j)  (256  + 64 * (j))
#define XB_XSUB(j)  (1280 + 64 * (j))
#define XB_XGEN(j)  (2304 + 64 * (j))
#define XB_TOP      3328
#define XB_TOPGEN   3392
#define XCD_BAR_WORDS 3456
#define XB_SPIN_CAP (1u << 18)

__device__ __forceinline__ unsigned xb_ld(unsigned* p)              { return __hip_atomic_load(p, __ATOMIC_RELAXED, __HIP_MEMORY_SCOPE_AGENT); }
__device__ __forceinline__ unsigned xb_add(unsigned* p, unsigned v) { return __hip_atomic_fetch_add(p, v, __ATOMIC_RELAXED, __HIP_MEMORY_SCOPE_AGENT); }
__device__ __forceinline__ unsigned xb_xcc_id() { return (unsigned)__builtin_amdgcn_s_getreg((3 << 11) | 20) & 0xFu; }
#define XB_SPIN(cond, bar) do { unsigned _sp = 0; while (cond) { __builtin_amdgcn_s_sleep(1); \
    if ((++_sp & 255u) == 0u) { if (xb_ld(&(bar)[XB_TMO])) break; if (_sp > XB_SPIN_CAP) { atomicAdd(&(bar)[XB_TMO], 1u); break; } } } } while (0)

struct XcdBarrier {
    unsigned* bar; unsigned x;
    volatile LAS unsigned* st;
};

__device__ __forceinline__ XcdBarrier xcd_barrier_post(unsigned* bar, volatile LAS unsigned* st) {
    XcdBarrier b; b.bar = bar; b.x = xb_xcc_id(); b.st = st;
    if (threadIdx.x == 0) (void)xb_add(&bar[XB_XCNT(b.x)], 1u);
    return b;
}
__device__ __forceinline__ void xcd_barrier_complete(unsigned* bar, unsigned x, unsigned& nloc, unsigned& nx) {
    const unsigned G = gridDim.x * gridDim.y * gridDim.z;
    unsigned sum, cnt, mine, sp = 0u;
    for (;;) {
        sum = 0u; cnt = 0u; mine = 0u;
#pragma unroll
        for (unsigned j = 0; j < 16; ++j) { const unsigned c = xb_ld(&bar[XB_XCNT(j)]); sum += c; cnt += (c > 0u) ? 1u : 0u; mine = (j == x) ? c : mine; }
        if (sum == G) break;
        __builtin_amdgcn_s_sleep(1);
        if ((++sp & 255u) == 0u) { if (xb_ld(&bar[XB_TMO])) break; if (sp > XB_SPIN_CAP) { atomicAdd(&bar[XB_TMO], 1u); break; } }
    }
    nloc = mine > 0u ? mine : 1u; nx = cnt > 0u ? cnt : 1u;
}

__device__ __forceinline__ void xcd_barrier(const XcdBarrier& b) {
    asm volatile("s_waitcnt vmcnt(0)" ::: "memory");
    __syncthreads();
    if (threadIdx.x == 0) {
        unsigned* bar = b.bar;
        __builtin_amdgcn_s_waitcnt(0);
        unsigned nloc = b.st[0], nx = b.st[1];
        if (nloc == 0u) { xcd_barrier_complete(bar, b.x, nloc, nx); b.st[0] = nloc; b.st[1] = nx; }
        const unsigned old = xb_add(&bar[XB_XSUB(b.x)], 1u);
        const unsigned gen = old / nloc;
        if (old + 1u == (gen + 1u) * nloc) {
            __builtin_amdgcn_fence(__ATOMIC_RELEASE, "agent");
            asm volatile("s_waitcnt vmcnt(0)" ::: "memory");
            const unsigned og = xb_add(&bar[XB_TOP], 1u);
            const unsigned tg = og / nx;
            if (og + 1u == (tg + 1u) * nx) xb_add(&bar[XB_TOPGEN], 1u);
            else XB_SPIN(xb_ld(&bar[XB_TOPGEN]) == tg, bar);
            __builtin_amdgcn_fence(__ATOMIC_ACQUIRE, "agent");
            xb_add(&bar[XB_XGEN(b.x)], 1u);
            asm volatile("s_waitcnt vmcnt(0)" ::: "memory");
        } else {
            XB_SPIN(xb_ld(&bar[XB_XGEN(b.x)]) == gen, bar);
            __builtin_amdgcn_fence(__ATOMIC_ACQUIRE, "agent");
            asm volatile("s_waitcnt vmcnt(0)" ::: "memory");
        }
    }
    __syncthreads();
}


constexpr int NPHASE = 18;
__global__ void __launch_bounds__(512, 2) mega_fwd(Params p) {
    extern __shared__ __attribute__((aligned(16))) unsigned char lds_raw[];
    LAS unsigned char* lds = (LAS unsigned char*)lds_raw;
    cg::grid_group grid = cg::this_grid();
    if (threadIdx.x < 64) ((LAS unsigned*)(lds + 131072))[threadIdx.x] = 0u;
    __syncthreads();
    XcdBarrier xbar = xcd_barrier_post((unsigned*)(p.ws + WS_BAR), (volatile LAS unsigned*)(lds + 131072));
    unsigned char* ws = p.ws;
    const int G = gridDim.x;
    float* MOD = (float*)(ws + WS_MOD);
    bf16_t* XN = (bf16_t*)(ws + WS_XN); float* X = (float*)(ws + WS_X);
    bf16_t* Z = (bf16_t*)(ws + WS_Z); bf16_t* AB = (bf16_t*)(ws + WS_AB); bf16_t* H = (bf16_t*)(ws + WS_H);
#define RUN(k) (p.ph_lo <= (k) && (k) < p.ph_hi)
#define GRID_SYNC_CG() do { asm volatile("s_waitcnt vmcnt(0) lgkmcnt(0)" ::: "memory"); grid.sync(); __builtin_amdgcn_fence(__ATOMIC_ACQUIRE, "agent"); asm volatile("s_waitcnt vmcnt(0)" ::: "memory"); } while (0)
#define GRID_SYNC() do { xcd_barrier(xbar); } while (0)
#define REPEAT(n, stmt) do { for (int rep_ = 0; rep_ < (n); ++rep_) { stmt; if (rep_ + 1 < (n)) GRID_SYNC(); } } while (0)
#define SEAM(k) do { if (p.ph_lo <= (k) && (k) + 1 < p.ph_hi) GRID_SYNC(); } while (0)
    if (RUN(0)) REPEAT(REP_P0, p0_prologue(p, lds));
    if (p.ph_lo <= 0 && 1 < p.ph_hi) GRID_SYNC_CG();
    for (int l = 0; l < 2; ++l) {
        const int k0 = 1 + 8 * l;
        const float* modl = MOD + (size_t)l * 3 * MODW;
        const float* xin_lo = (l == 0) ? p.in[0] : X;
        const float* xin_hi = (l == 0) ? p.in[1] - (size_t)MCTX * D : X;
        if (RUN(k0)) REPEAT(REP_NORM, norm_phase<false>(xin_lo, xin_hi, p.in[10] + l * D, modl, 0, D, XN, nullptr));
        SEAM(k0);
        if (RUN(k0 + 1)) for (int repg_ = 0; repg_ < REP_G; ++repg_) {
            if (repg_) GRID_SYNC();
            if (l == 0) { pg8::Gemm g{XN, (const bf16_t*)(ws + WS_WIN), MTOT, ABIN, D}; pg8::StaticOrder S; S.init(MTOT, ABIN, G, (int)blockIdx.x, D, ws, -1);
                EpiBf16<0, false> E{Z, ABIN, nullptr, nullptr, 0, 0}; pg8::gemm_phase(lds, g, S, E); }
            else { pg8::Gemm g{XN, (const bf16_t*)(ws + WS_WQKV), MTOT, NQKV, D}; pg8::StaticOrder S; S.init(MTOT, NQKV, G, (int)blockIdx.x, D, ws, -1);
                EpiBf16<0, true> E{Z, D, p.out + OUT_NK, p.out + OUT_NV, 8, (size_t)MTOT * D}; pg8::gemm_phase(lds, g, S, E); }
        }
        SEAM(k0 + 1);
        if (l == 0) { if (RUN(k0 + 2)) REPEAT(REP_EW, ew0_phase(p)); SEAM(k0 + 2); }
        if (RUN(k0 + 3)) REPEAT(REP_ATT, if (l == 0) attn0_phase(p, lds); else attn1_phase(p, lds, AB));
        SEAM(k0 + 3);
        if (RUN(k0 + 4)) { pg8::Gemm g{AB, (const bf16_t*)(ws + (l == 0 ? WS_WO0 : WS_WO1)), MTOT, D, D}; pg8::StaticOrder S; S.init(MTOT, D, G, (int)blockIdx.x, D, ws, -1);
            EpiResid E{xin_lo, xin_hi, X, modl + 2 * D}; pg8::gemm_phase(lds, g, S, E); }
        SEAM(k0 + 4);
        if (RUN(k0 + 5)) REPEAT(REP_NORM, norm_phase<false>(X, X, p.in[11] + l * D, modl, 3 * D, 4 * D, XN, nullptr));
        SEAM(k0 + 5);
        if (RUN(k0 + 6)) for (int repg_ = 0; repg_ < REP_G; ++repg_) { if (repg_) GRID_SYNC(); pg8::Gemm g{XN, (const bf16_t*)(ws + WS_W1) + (size_t)l * FFN * D, MTOT, FFN, D}; pg8::StaticOrder S; S.init(MTOT, FFN, G, (int)blockIdx.x, D, ws, -1);
            EpiBf16<1, false> E{H, FFN, nullptr, nullptr, 0, 0}; pg8::gemm_phase(lds, g, S, E); }
        SEAM(k0 + 6);
        if (RUN(k0 + 7)) { pg8::Gemm g{H, (const bf16_t*)(ws + WS_W2) + (size_t)l * FFN * D, MTOT, D, FFN}; pg8::StaticOrder S; S.init(MTOT, D, G, (int)blockIdx.x, FFN, ws, (l * 4 + 3) * 1024);
            EpiResid E{X, X, X, modl + 5 * D}; pg8::gemm_phase(lds, g, S, E); }
        SEAM(k0 + 7);
    }
#if PROBE_STOP > 0
    GRID_SYNC();
    {
        const size_t n = (size_t)MTOT * D, gt = (size_t)blockIdx.x * 512 + threadIdx.x, gs = (size_t)G * 512;
        const bf16_t* sb = PROBE_SRC == 1 ? XN : PROBE_SRC == 2 ? AB : PROBE_SRC == 3 ? Z : PROBE_SRC == 5 ? Z + (size_t)4096 * NQKV : (const bf16_t*)(ws + WS_Q0);
#if PROBE_SRC == 6
        attn1_phase(p, lds, XN);
        GRID_SYNC();
        for (size_t i = gt; i < n; i += gs) p.out[i] = bf2f(AB[i]) - bf2f(XN[i]);
#else
        for (size_t i = gt; i < n; i += gs) p.out[i] = (PROBE_SRC == 0) ? X[i] : bf2f(sb[i]);
#endif
#if PROBE_STOP < 4
        for (size_t i = gt; i < (size_t)2 * MCTX * 256; i += gs) p.out[OUT_AK + i] = 0.f;
#endif
        for (size_t i = gt; i < (size_t)2 * MCTX * D; i += gs) p.out[OUT_NK + i] = 0.f;
    }
#else
    if (RUN(17)) REPEAT(REP_NORM, norm_phase<true>(X, X, p.in[22], nullptr, 0, 0, nullptr, p.out));
#endif
#undef RUN
#undef SEAM
#undef REPEAT
#undef GRID_SYNC
#undef GRID_SYNC_CG
}

extern "C" void kernel_launch(void* const* d_in, const int* in_sizes, int n_in, void* d_out, int out_size, void* d_ws, size_t ws_size, hipStream_t stream) {
    static int grid = 0;
    if (grid == 0) {
        if (n_in != 23 || ws_size < WS_END) { fprintf(stderr, "kernel_launch: expected 23 inputs and >= %zu bytes of workspace (got %d, %zu)\n", (size_t)WS_END, n_in, ws_size); grid = -1; return; }
        int dev = 0, cus = 0, per_cu = 0;
        (void)hipGetDevice(&dev);
        (void)hipDeviceGetAttribute(&cus, hipDeviceAttributeMultiprocessorCount, dev);
        if (hipFuncSetAttribute((const void*)mega_fwd, hipFuncAttributeMaxDynamicSharedMemorySize, LDS_BYTES) != hipSuccess) { fprintf(stderr, "kernel_launch: hipFuncSetAttribute failed\n"); grid = -1; return; }
        if (hipOccupancyMaxActiveBlocksPerMultiprocessor(&per_cu, (const void*)mega_fwd, 512, LDS_BYTES) != hipSuccess || per_cu < 1) { fprintf(stderr, "kernel_launch: occupancy query failed (%d)\n", per_cu); grid = -1; return; }
        grid = cus * (per_cu > 1 ? 1 : per_cu);
        fprintf(stderr, "kernel_launch: grid %d (cus %d, per_cu %d)\n", grid, cus, per_cu);
    }
    if (grid < 0) return;
    (void)hipMemsetAsync((char*)d_ws + WS_BAR, 0, 65536, stream);
    Params p{};
    for (int i = 0; i < 23; ++i) p.in[i] = (const float*)d_in[i];
    p.out = (float*)d_out; p.ws = (unsigned char*)d_ws;
#if MK_PER_PHASE
    for (int k = 0; k < NPHASE; ++k) {
        if (k == 11) continue;
        p.ph_lo = k; p.ph_hi = k + 1;
        void* args[] = {&p};
        hipError_t e = hipLaunchCooperativeKernel((const void*)mega_fwd, dim3(grid), dim3(512), args, LDS_BYTES, stream);
        if (e != hipSuccess) { fprintf(stderr, "launch %d failed: %s\n", k, hipGetErrorString(e)); break; }
    }
#else
    p.ph_lo = 0; p.ph_hi = PROBE_STOP > 0 ? PROBE_STOP : NPHASE;
    void* args[] = {&p};
    hipError_t e = hipLaunchCooperativeKernel((const void*)mega_fwd, dim3(grid), dim3(512), args, LDS_BYTES, stream);
    if (e != hipSuccess) fprintf(stderr, "cooperative launch failed: %s (grid %d)\n", hipGetErrorString(e), grid);
#endif
}
```

```cpp
#include <hip/hip_runtime.h>
#include <hip/hip_cooperative_groups.h>
#include <cstdio>
#include <cstdint>
namespace cg = cooperative_groups;

#ifndef MK_PER_PHASE
#define MK_PER_PHASE 0
#endif

#ifndef REP_NG
#define REP_NG 1
#endif
#ifndef REP_P0
#define REP_P0 REP_NG
#endif
#ifndef REP_NORM
#define REP_NORM REP_NG
#endif
#ifndef REP_EW
#define REP_EW REP_NG
#endif
#ifndef REP_ATT
#define REP_ATT REP_NG
#endif
#ifndef REP_G
#define REP_G 1
#endif
#ifndef PROBE_STOP
#define PROBE_STOP 0
#endif
#ifndef PROBE_SRC
#define PROBE_SRC 0
#endif
#define LAS __attribute__((address_space(3)))
#define PG8_LAS __attribute__((address_space(3)))
typedef unsigned short bf16_t;
typedef short bf16x8 __attribute__((ext_vector_type(8)));
typedef short v4i16_t __attribute__((ext_vector_type(4)));
typedef float f32x4 __attribute__((ext_vector_type(4)));
typedef float f32x2 __attribute__((ext_vector_type(2)));
typedef unsigned u32x4 __attribute__((ext_vector_type(4)));
typedef unsigned u32x2 __attribute__((ext_vector_type(2)));

__device__ __forceinline__ float bf2f(unsigned h) { return __uint_as_float(h << 16); }
typedef __bf16 bf16x2_t __attribute__((ext_vector_type(2)));
__device__ __forceinline__ unsigned cvt_pk_bf16(float lo, float hi) { f32x2 v = {lo, hi}; bf16x2_t r = __builtin_convertvector(v, bf16x2_t); return __builtin_bit_cast(unsigned, r); }
__device__ __forceinline__ float wave_sum(float v) {
#pragma unroll
    for (int o = 1; o < 64; o <<= 1) v += __shfl_xor(v, o);
    return v;
}

constexpr size_t WS_TS_OFS = 595591168ull;
constexpr size_t WS_FLAGS_OFS = (512u << 10) + 16384;
namespace pg8 {
constexpr int BM = 256, BK = 64, HALF = 128, HTB = HALF * BK * 2  , STAGE_BYTES = 8 * HTB, NXCD = 8, WGM = 8;

__host__ __device__ __forceinline__ int lds_byte(int r, int c) { const int st = (r >> 4) * 2 + (c >> 5), rr = r & 15, cc = c & 31, ob = rr * 64 + cc * 2; return st * 1024 + (ob ^ (((ob >> 9) & 1) << 5)); }
__host__ __device__ __forceinline__ void stage_rc(int b, int& R, int& C) { const int st = b / 1024, sb = b % 1024, swz = sb ^ (((sb >> 9) & 1) << 5); R = (st >> 1) * 16 + swz / 64; C = (st & 1) * 32 + (swz % 64) / 2; }
__host__ __device__ __forceinline__ int perm32(int rho) { const int n = rho >> 4, i = rho & 15; return 8 * (i >> 2) + 4 * n + (i & 3); }
struct Unit { int pm, pn, code; };
struct Gemm { const bf16_t* A; const bf16_t* Bt; int M, N, K; };
struct StaticOrder {
    int nM, nN, nwg, G, c, ntk, R, tail, fofs; unsigned char* wsb;
    __device__ __forceinline__ int kt0(const Unit& u) const { return (u.code & 3) == 2 ? (ntk >> 1) : 0; }
    __device__ __forceinline__ int nkt(const Unit& u) const { return (u.code & 3) ? (ntk >> 1) : ntk; }
    __host__ __device__ void init(int M, int N, int G_, int c_, int K, unsigned char* wsb_, int fofs_) {
        nM = M / BM; nN = N / BM; nwg = nM * nN; G = G_; c = c_; ntk = K / BK; wsb = wsb_; fofs = fofs_;
        R = nwg / G; tail = nwg - R * G;
        if (fofs_ < 0 || 2 * tail > G || (ntk & 3)) tail = 0;
    }
    __host__ __device__ bool next(int i, Unit& u) const {
        long L;
        if (tail) {
            if (i < R) { L = (long)i * G + c; u.code = 0; }
            else if (i == R && c < 2 * tail) { L = (long)R * G + (c >> 1); u.code = (1 + (c & 1)) | ((c >> 1) << 2); }
            else return false;
        } else { L = (long)i * G + c; if (L >= nwg) return false; u.code = 0; }
        int wgid = (int)L; { const int q = nwg / NXCD, r = nwg % NXCD, xcd = wgid % NXCD, off = wgid / NXCD; wgid = (xcd < r ? xcd * (q + 1) : r * (q + 1) + (xcd - r) * q) + off; }
        const int nig = WGM * nN, gid = wgid / nig, fm = gid * WGM, gsz = (nM - fm) < WGM ? (nM - fm) : WGM;
        u.pm = fm + ((wgid % nig) % gsz); u.pn = (wgid % nig) / gsz; return true;
    }
    __device__ __forceinline__ void a_ready(const Unit&) const {}
    __device__ __forceinline__ void done(const Unit&) const {}
};
template <class Epi, class Sched>
__device__ __forceinline__ void gemm_phase(PG8_LAS unsigned char* lds, const Gemm g, const Sched& S, const Epi& E) {
    int tid_ = threadIdx.x; asm volatile("" : "+v"(tid_));
    const int tid = tid_, wid = __builtin_amdgcn_readfirstlane(tid >> 6), lane = tid & 63, wr = wid >> 2, wc = wid & 3, fr = lane & 15, fq = lane >> 4;
    const int K = g.K;
    unsigned voffA[2], voffB[2];
#pragma unroll
    for (int i = 0; i < 2; ++i) { int R, C; stage_rc(tid * 16 + i * 8192, R, C); const int Rb = Epi::PERM ? ((R & ~31) + perm32(R & 31)) : R;
        voffA[i] = (unsigned)(R * K + C) * 2u; voffB[i] = (unsigned)(Rb * K + C) * 2u; }
    const size_t kstep = (size_t)(BK * 2);
    const size_t hstep = (size_t)HALF * K * 2;
    const size_t tstep = 2 * hstep;
    const unsigned ldsw = (unsigned)wid * 1024u;
    const int aoff = lds_byte(wr * 64 + fr, fq * 8), boff = lds_byte(wc * 32 + fr, fq * 8);
#define PG8_SA(b, h) (((b) * 2 + (h)) * HTB)
#define PG8_SB(b, h) ((4 + (b) * 2 + (h)) * HTB)
#define PG8_STAGE(bufoff, gbase, voff) do { _Pragma("unroll") for (int _i = 0; _i < 2; ++_i) \
        __builtin_amdgcn_global_load_lds((const unsigned*)((const char*)(gbase) + (voff)[_i]), (PG8_LAS unsigned*)(lds + (bufoff) + ldsw + _i * 8192), 16, 0, 0); } while (0)
#define PG8_LDA(dst, b, h) do { _Pragma("unroll") for (int m = 0; m < 4; ++m) _Pragma("unroll") for (int k = 0; k < 2; ++k) dst[m][k] = *(const PG8_LAS bf16x8*)(lds + PG8_SA(b, h) + aoff + m * 2048 + k * 1024); } while (0)
#define PG8_LDB(dst, b, h) do { _Pragma("unroll") for (int n = 0; n < 2; ++n) _Pragma("unroll") for (int k = 0; k < 2; ++k) dst[n][k] = *(const PG8_LAS bf16x8*)(lds + PG8_SB(b, h) + boff + n * 2048 + k * 1024); } while (0)
#define PG8_MMA(ai, bj, At, Bt) do { __builtin_amdgcn_s_setprio(1); _Pragma("unroll") for (int m = 0; m < 4; ++m) _Pragma("unroll") for (int n = 0; n < 2; ++n) _Pragma("unroll") for (int k = 0; k < 2; ++k) \
        acc[ai][bj][m][n] = __builtin_amdgcn_mfma_f32_16x16x32_bf16(Bt[n][k], At[m][k], acc[ai][bj][m][n], 0, 0, 0); __builtin_amdgcn_s_setprio(0); } while (0)
#define PG8_WAIT_V(n) asm volatile("s_waitcnt vmcnt(" #n ")" ::: "memory")
#define PG8_WAIT_L(n) asm volatile("s_waitcnt lgkmcnt(" #n ")" ::: "memory")
#define PG8_BAR __builtin_amdgcn_s_barrier()
#define PG8_SCHED __builtin_amdgcn_sched_barrier(0)
    Unit cur, nxt; int ui = 0;
    if (!S.next(0, cur)) return;
    f32x4 acc[2][2][4][2];
#pragma unroll
    for (int a = 0; a < 2; ++a)
#pragma unroll
        for (int b = 0; b < 2; ++b)
#pragma unroll
            for (int m = 0; m < 4; ++m)
#pragma unroll
                for (int n = 0; n < 2; ++n) acc[a][b][m][n] = (f32x4){0.f, 0.f, 0.f, 0.f};
    bf16x8 At[4][2], B0[2][2], B1[2][2];
    const char* cA = (const char*)g.A + (size_t)cur.pm * tstep + (size_t)S.kt0(cur) * kstep; const char* cB = (const char*)g.Bt + (size_t)cur.pn * tstep + (size_t)S.kt0(cur) * kstep;
    S.a_ready(cur);
    PG8_STAGE(PG8_SB(0, 0), cB, voffB); PG8_STAGE(PG8_SB(0, 1), cB + hstep, voffB); PG8_STAGE(PG8_SA(0, 0), cA, voffA); PG8_STAGE(PG8_SA(0, 1), cA + hstep, voffA);
    if (wr == 1) PG8_BAR;
    PG8_WAIT_V(2); PG8_BAR;
    PG8_STAGE(PG8_SB(1, 0), cB + kstep, voffB); PG8_STAGE(PG8_SA(1, 0), cA + kstep, voffA); PG8_STAGE(PG8_SB(1, 1), cB + hstep + kstep, voffB);
    PG8_WAIT_V(6); PG8_BAR;
    for (;;) {
        const bool has_next = S.next(ui + 1, nxt);
        const char* nA = has_next ? (const char*)g.A + (size_t)nxt.pm * tstep + (size_t)S.kt0(nxt) * kstep : cA; const char* nB = has_next ? (const char*)g.Bt + (size_t)nxt.pn * tstep + (size_t)S.kt0(nxt) * kstep : cB;
        const int nt = S.nkt(cur);
        for (int t = 0; t < nt; t += 2) {
            const bool last = (t == nt - 2);
            const char* a1 = cA + (size_t)(t + 1) * kstep;
            const char* a2 = last ? nA : cA + (size_t)(t + 2) * kstep; const char* b2 = last ? nB : cB + (size_t)(t + 2) * kstep;
            const char* a3 = a2 + kstep; const char* b3 = b2 + kstep;
            if (last && has_next) S.a_ready(nxt);
            PG8_LDB(B0, 0, 0); PG8_LDB(B1, 0, 1); PG8_SCHED; PG8_LDA(At, 0, 0); PG8_STAGE(PG8_SA(1, 1), a1 + hstep, voffA);
            PG8_WAIT_V(8); PG8_WAIT_L(0); PG8_BAR; PG8_MMA(0, 0, At, B0); PG8_MMA(0, 1, At, B1); PG8_BAR; PG8_SCHED;
            PG8_LDA(At, 0, 1); PG8_STAGE(PG8_SB(0, 0), b2, voffB); PG8_STAGE(PG8_SB(0, 1), b2 + hstep, voffB); PG8_STAGE(PG8_SA(0, 0), a2, voffA);
            PG8_WAIT_V(8); PG8_WAIT_L(0); PG8_BAR; PG8_MMA(1, 0, At, B0); PG8_MMA(1, 1, At, B1); PG8_BAR; PG8_SCHED;
            PG8_LDB(B0, 1, 0); PG8_LDB(B1, 1, 1); PG8_SCHED; PG8_LDA(At, 1, 0); PG8_STAGE(PG8_SA(0, 1), a2 + hstep, voffA);
            PG8_WAIT_V(8); PG8_WAIT_L(0); PG8_BAR; PG8_MMA(0, 0, At, B0); PG8_MMA(0, 1, At, B1); PG8_BAR; PG8_SCHED;
            PG8_LDA(At, 1, 1); PG8_STAGE(PG8_SB(1, 0), b3, voffB); PG8_STAGE(PG8_SB(1, 1), b3 + hstep, voffB); PG8_STAGE(PG8_SA(1, 0), a3, voffA);
            PG8_WAIT_V(8); PG8_WAIT_L(0); PG8_BAR; PG8_MMA(1, 0, At, B0); PG8_MMA(1, 1, At, B1); PG8_BAR; PG8_SCHED;
        }
        if (wr == 0) PG8_BAR;
        const int role = cur.code & 3, slot = cur.code >> 2;
        if (role == 2) {
            f32x4* sp = (f32x4*)(S.wsb + WS_TS_OFS) + (size_t)slot * (32 * 512) + tid;
#pragma unroll
            for (int a = 0; a < 2; ++a)
#pragma unroll
                for (int b = 0; b < 2; ++b)
#pragma unroll
                    for (int m = 0; m < 4; ++m)
#pragma unroll
                        for (int n = 0; n < 2; ++n) asm volatile("global_store_dwordx4 %0, %1, off sc1" :: "v"(sp + (((a * 2 + b) * 4 + m) * 2 + n) * 512), "v"(acc[a][b][m][n]) : "memory");
            asm volatile("s_waitcnt vmcnt(0)" ::: "memory");
            if (lane == 0) __hip_atomic_store((unsigned*)(S.wsb + WS_FLAGS_OFS) + S.fofs + slot * 8 + wid, 1u, __ATOMIC_RELAXED, __HIP_MEMORY_SCOPE_AGENT);
        } else {
            if (role == 1) {
                unsigned spins = 0;
                while (__hip_atomic_load((unsigned*)(S.wsb + WS_FLAGS_OFS) + S.fofs + slot * 8 + wid, __ATOMIC_RELAXED, __HIP_MEMORY_SCOPE_AGENT) == 0u) { __builtin_amdgcn_s_sleep(2); if (++spins > (1u << 22)) break; }
                __builtin_amdgcn_fence(__ATOMIC_ACQUIRE, "agent");
                asm volatile("s_waitcnt vmcnt(0)" ::: "memory");
                const f32x4* sp = (const f32x4*)(S.wsb + WS_TS_OFS) + (size_t)slot * (32 * 512) + tid;
#pragma unroll
                for (int a = 0; a < 2; ++a)
#pragma unroll
                    for (int b = 0; b < 2; ++b)
#pragma unroll
                        for (int m = 0; m < 4; ++m)
#pragma unroll
                            for (int n = 0; n < 2; ++n) { acc[a][b][m][n] += sp[(((a * 2 + b) * 4 + m) * 2 + n) * 512]; asm volatile("" ::: "memory"); }
            }
            E(acc, cur, wr, wc, fr, fq);
        }
        if (!has_next) break;
#pragma unroll
        for (int a = 0; a < 2; ++a)
#pragma unroll
            for (int b = 0; b < 2; ++b)
#pragma unroll
                for (int m = 0; m < 4; ++m)
#pragma unroll
                    for (int n = 0; n < 2; ++n) acc[a][b][m][n] = (f32x4){0.f, 0.f, 0.f, 0.f};
        cur = nxt; cA = nA; cB = nB; ++ui;
        if (wr == 1) PG8_BAR;
    }
    PG8_WAIT_V(0);
    PG8_BAR;
    if constexpr (Epi::AFTER_DRAIN) { E.fused(acc, cur, wr, wc, fr, fq, lds, wid, lane); S.done(cur); }
#undef PG8_SA
#undef PG8_SB
#undef PG8_STAGE
#undef PG8_LDA
#undef PG8_LDB
#undef PG8_MMA
#undef PG8_WAIT_V
#undef PG8_WAIT_L
#undef PG8_BAR
#undef PG8_SCHED
}
}

constexpr int D = 2048, MCTX = 8192, MLAT = 4096, MTOT = 12288, FFN = 8192, ABIN = 4608, NQKV = 6144, MODW = 12288;
constexpr float EPS = 1e-6f;
constexpr size_t WS_MOD = 0;
constexpr size_t WS_BAR = 512u << 10;
constexpr size_t WS_WIN = 1u << 20;
constexpr size_t WS_WO0 = WS_WIN + (size_t)ABIN * D * 2;
constexpr size_t WS_WQKV = WS_WO0 + (size_t)D * D * 2;
constexpr size_t WS_WO1 = WS_WQKV + (size_t)NQKV * D * 2;
constexpr size_t WS_W1 = WS_WO1 + (size_t)D * D * 2;
constexpr size_t WS_W2 = WS_W1 + 2 * (size_t)FFN * D * 2;
constexpr size_t WS_XN = WS_W2 + 2 * (size_t)FFN * D * 2;
constexpr size_t WS_H = WS_XN + (size_t)MTOT * D * 2;
constexpr size_t WS_Z = WS_H;
constexpr size_t WS_AB = WS_H + (size_t)MTOT * NQKV * 2;
constexpr size_t WS_Q0 = WS_H + (size_t)MTOT * FFN * 2;
constexpr size_t WS_K0 = WS_Q0 + (size_t)MTOT * 1024 * 2;
constexpr size_t WS_V0 = WS_K0 + (size_t)(MTOT + 1024) * 256 * 2;
constexpr size_t WS_CNK = WS_V0 + (size_t)(MTOT + 1024) * 256 * 2;
constexpr size_t WS_CNV = WS_CNK + (size_t)1024 * 2048 * 2;
constexpr size_t WS_X = WS_CNV + (size_t)1024 * 2048 * 2;
constexpr size_t WS_TS = WS_X + (size_t)MTOT * D * 4;
constexpr size_t WS_END = WS_TS + (size_t)128 * 32 * 512 * 16;
constexpr size_t WS_FLAGS = WS_BAR + 16384;
static_assert(WS_TS == WS_TS_OFS && WS_FLAGS == WS_FLAGS_OFS, "early offsets");
constexpr int LDS_BYTES = 131072 + 256;

constexpr size_t OUT_YP = 0, OUT_YS = (size_t)MCTX * D, OUT_AK = OUT_YS + (size_t)MLAT * D, OUT_AV = OUT_AK + (size_t)MCTX * 256,
                 OUT_NK = OUT_AV + (size_t)MCTX * 256, OUT_NV = OUT_NK + (size_t)MCTX * D;

struct Params {
    const float* in[23];
    float* out;
    unsigned char* ws;
    int ph_lo, ph_hi;
};

template <int ACT, bool SIDE> struct EpiBf16 {
    static constexpr bool PERM = true, AFTER_DRAIN = false;
    bf16_t* O; int ldc; float* kout; float* vout; int split_tiles; size_t split_stride;
    __device__ __forceinline__ void operator()(const f32x4 (&acc)[2][2][4][2], const pg8::Unit& u, int wr, int wc, int fr, int fq) const {
        const int row0 = u.pm * 256 + wr * 64 + fr, col0 = u.pn * 256 + wc * 32 + 8 * fq;
        const int spt = split_tiles ? u.pn / split_tiles : 0; bf16_t* Ob = O + (size_t)spt * split_stride; const int ocol0 = col0 - spt * split_tiles * 256;
        const bool side = SIDE && (u.pm < 32) && (u.pn >= 8);
        float* sbase = nullptr; int scol0 = 0;
        if (SIDE) { sbase = (u.pn < 16) ? kout : vout; scol0 = col0 - ((u.pn < 16) ? 2048 : 4096); }
#pragma unroll
        for (int ai = 0; ai < 2; ++ai)
#pragma unroll
            for (int m = 0; m < 4; ++m) {
                const int row = row0 + ai * 128 + m * 16;
                bf16_t* rowp = Ob + (size_t)row * ldc + ocol0;
#pragma unroll
                for (int bj = 0; bj < 2; ++bj) {
                    f32x4 v0 = acc[ai][bj][m][0], v1 = acc[ai][bj][m][1];
                    if (SIDE) { if (side) { float* sp = sbase + (size_t)row * 2048 + scol0 + bj * 128; *(f32x4*)sp = v0; *(f32x4*)(sp + 4) = v1; } }
                    if (ACT == 1) {
#pragma unroll
                        for (int j = 0; j < 4; ++j) { float a = fmaxf(v0[j], 0.f), b = fmaxf(v1[j], 0.f); v0[j] = a * a; v1[j] = b * b; }
                    }
                    u32x4 o; o.x = cvt_pk_bf16(v0[0], v0[1]); o.y = cvt_pk_bf16(v0[2], v0[3]); o.z = cvt_pk_bf16(v1[0], v1[1]); o.w = cvt_pk_bf16(v1[2], v1[3]);
                    *(u32x4*)(rowp + bj * 128) = o;
                }
            }
    }
};
struct EpiResid {
    static constexpr bool PERM = false, AFTER_DRAIN = false;
    const float* src_lo; const float* src_hi;
    float* X; const float* gate;
    __device__ __forceinline__ void operator()(const f32x4 (&acc)[2][2][4][2], const pg8::Unit& u, int wr, int wc, int fr, int fq) const {
        const int row0 = u.pm * 256 + wr * 64 + fr, col0 = u.pn * 256 + wc * 32 + 4 * fq;
        const int cond = (u.pm < 32) ? 0 : 1 + ((u.pm - 32) >> 3);
        const float* gp = gate + (size_t)cond * MODW + col0;
        const float* sb = (u.pm < 32) ? src_lo : src_hi;
        f32x4 gv[2][2];
#pragma unroll
        for (int bj = 0; bj < 2; ++bj)
#pragma unroll
            for (int n = 0; n < 2; ++n) gv[bj][n] = *(const f32x4*)(gp + bj * 128 + n * 16);
#pragma unroll
        for (int ai = 0; ai < 2; ++ai)
#pragma unroll
            for (int m = 0; m < 4; ++m) {
                const size_t off = (size_t)(row0 + ai * 128 + m * 16) * D + col0;
#pragma unroll
                for (int bj = 0; bj < 2; ++bj)
#pragma unroll
                    for (int n = 0; n < 2; ++n) {
                        const f32x4 r = *(const f32x4*)(sb + off + bj * 128 + n * 16);
                        *(f32x4*)(X + off + bj * 128 + n * 16) = r + gv[bj][n] * acc[ai][bj][m][n];
                    }
            }
    }
};

__device__ __forceinline__ unsigned f2bf(float f) { unsigned u = __float_as_uint(f); return (u + 0x7fffu + ((u >> 16) & 1u)) >> 16; }
__device__ __forceinline__ unsigned pk2(float lo, float hi) { return f2bf(lo) | (f2bf(hi) << 16); }
__device__ __forceinline__ void p0_transpose_item(const float* W, int K, int N, bf16_t* WT, LAS float* scr, int item, int lane) {
    const int nblk = N / 32, kb = item / nblk, nb = item % nblk, k0 = 64 * kb, n0 = 32 * nb;
#pragma unroll 8
    for (int i = 0; i < 32; ++i) { const int kk = 2 * i + (lane >> 5); scr[kk * 33 + (lane & 31)] = W[(size_t)(k0 + kk) * N + n0 + (lane & 31)]; }
    asm volatile("s_waitcnt lgkmcnt(0)" ::: "memory");
    const int c = lane & 7;
#pragma unroll
    for (int j = 0; j < 4; ++j) { const int n = (lane >> 3) + 8 * j; const LAS float* s = scr + (8 * c) * 33 + n;
        u32x4 o; o.x = pk2(s[0 * 33], s[1 * 33]); o.y = pk2(s[2 * 33], s[3 * 33]); o.z = pk2(s[4 * 33], s[5 * 33]); o.w = pk2(s[6 * 33], s[7 * 33]);
        *(u32x4*)(WT + (size_t)(n0 + n) * K + k0 + 8 * c) = o; }
    asm volatile("s_waitcnt lgkmcnt(0)" ::: "memory");
}
__device__ __forceinline__ void cvt_linear(const float* src, bf16_t* dst, int n, int gtid, int gthreads) {
    for (int i = gtid * 4; i < n; i += gthreads * 4) { const f32x4 v = *(const f32x4*)(src + i); u32x2 o; o.x = cvt_pk_bf16(v[0], v[1]); o.y = cvt_pk_bf16(v[2], v[3]); *(u32x2*)(dst + i) = o; }
}
__device__ __forceinline__ void p0_prologue(const Params& p, LAS unsigned char* lds) {
    int tid_ = threadIdx.x; asm volatile("" : "+v"(tid_));
    const int tid = tid_, lane = tid & 63, wave = __builtin_amdgcn_readfirstlane(tid >> 6), G = gridDim.x;
    unsigned char* ws = p.ws;
    {
        LAS float* sc = (LAS float*)(lds + 69632);
        LAS float* red = (LAS float*)(lds + 69632 + 24576);
        const float* cvec = p.in[6]; const float* cctx = p.in[7];
        for (int i = tid; i < 3 * 2048; i += 512) { const int c = i >> 11, k = i & 2047; const float x = (c == 0) ? cctx[k] : cvec[(c - 1) * 2048 + k]; sc[i] = x / (1.f + __expf(-x)); }
        __syncthreads();
        float* MOD = (float*)(ws + WS_MOD);
        for (int item = blockIdx.x; item < 256; item += G) {
            const int l = item >> 7, cgp = item & 127, ln = lane < 48 ? lane : 47;
            const float* W = p.in[8] + (size_t)l * 2048 * MODW + cgp * 96 + ln * 2;
            float a00 = 0.f, a01 = 0.f, a10 = 0.f, a11 = 0.f, a20 = 0.f, a21 = 0.f;
            const int kb = wave * 256;
#pragma unroll 8
            for (int k = 0; k < 256; ++k) {
                const f32x2 w = *(const f32x2*)(W + (size_t)(kb + k) * MODW);
                const float s0 = sc[kb + k], s1 = sc[2048 + kb + k], s2 = sc[4096 + kb + k];
                a00 += s0 * w.x; a01 += s0 * w.y; a10 += s1 * w.x; a11 += s1 * w.y; a20 += s2 * w.x; a21 += s2 * w.y;
            }
            if (lane < 48) { LAS float* r = red + wave * 288 + lane * 2; r[0] = a00; r[1] = a01; r[96] = a10; r[97] = a11; r[192] = a20; r[193] = a21; }
            __syncthreads();
            if (tid < 288) { const int c = tid / 96, j = tid % 96; float s = 0.f;
#pragma unroll
                for (int w = 0; w < 8; ++w) s += red[w * 288 + tid];
                MOD[(size_t)(l * 3 + c) * MODW + cgp * 96 + j] = s + p.in[9][l * MODW + cgp * 96 + j]; }
            __syncthreads();
        }
    }
    {
        LAS float* scr = (LAS float*)(lds + wave * 8448);
        const int gw = blockIdx.x * 8 + wave, NGW = G * 8;
        constexpr int I_IN = 32 * (ABIN / 32), I_O = 32 * (D / 32), I_QKV = 32 * (NQKV / 32), I_1 = 32 * (FFN / 32), I_2 = (FFN / 64) * (D / 32);
        constexpr int NITEMS = I_IN + 2 * I_O + I_QKV + 2 * I_1 + 2 * I_2;
        for (int it = gw; it < NITEMS; it += NGW) {
            int r = it;
            if (r < I_IN) { p0_transpose_item(p.in[12], D, ABIN, (bf16_t*)(ws + WS_WIN), scr, r, lane); continue; } r -= I_IN;
            if (r < I_O) { p0_transpose_item(p.in[16], D, D, (bf16_t*)(ws + WS_WO0), scr, r, lane); continue; } r -= I_O;
            if (r < I_QKV) { p0_transpose_item(p.in[17], D, NQKV, (bf16_t*)(ws + WS_WQKV), scr, r, lane); continue; } r -= I_QKV;
            if (r < I_O) { p0_transpose_item(p.in[19], D, D, (bf16_t*)(ws + WS_WO1), scr, r, lane); continue; } r -= I_O;
            if (r < 2 * I_1) { const int l = r / I_1; p0_transpose_item(p.in[20] + (size_t)l * D * FFN, D, FFN, (bf16_t*)(ws + WS_W1) + (size_t)l * FFN * D, scr, r - l * I_1, lane); continue; } r -= 2 * I_1;
            { const int l = r / I_2; p0_transpose_item(p.in[21] + (size_t)l * D * FFN, FFN, D, (bf16_t*)(ws + WS_W2) + (size_t)l * FFN * D, scr, r - l * I_2, lane); }
        }
    }
    {
        const int gtid = blockIdx.x * 512 + tid, gth = G * 512;
        cvt_linear(p.in[2], (bf16_t*)(ws + WS_K0) + (size_t)MTOT * 256, 1024 * 256, gtid, gth);
        cvt_linear(p.in[3], (bf16_t*)(ws + WS_V0) + (size_t)MTOT * 256, 1024 * 256, gtid, gth);
        cvt_linear(p.in[4], (bf16_t*)(ws + WS_CNK), 1024 * 2048, gtid, gth);
        cvt_linear(p.in[5], (bf16_t*)(ws + WS_CNV), 1024 * 2048, gtid, gth);
    }
}

template <bool OUT_F32>
__device__ __forceinline__ void norm_phase(const float* src_lo, const float* src_hi, const float* gain, const float* mod, int shift_off, int scale_off, bf16_t* dst_bf, float* dst_f) {
    int tid_ = threadIdx.x; asm volatile("" : "+v"(tid_));
    const int tid = tid_, lane = tid & 63, wave = tid >> 6, G = gridDim.x;
    const int gw = blockIdx.x * 8 + wave, NGW = G * 8, per = (MTOT + NGW - 1) / NGW;
    const int r_beg = gw * per, r_end = (r_beg + per < MTOT) ? r_beg + per : MTOT;
    int cur = -1; f32x4 A[8], B[8];
    for (int row = r_beg; row < r_end; ++row) {
        const int cond = (row < MCTX) ? 0 : 1 + ((row - MCTX) >> 11);
        if (cond != cur) {
            cur = cond;
#pragma unroll
            for (int j = 0; j < 8; ++j) {
                const int col = 4 * lane + 256 * j; const f32x4 g = *(const f32x4*)(gain + col);
                if (mod) { const f32x4 sc = *(const f32x4*)(mod + (size_t)cond * MODW + scale_off + col); A[j] = g * (sc + 1.f); B[j] = *(const f32x4*)(mod + (size_t)cond * MODW + shift_off + col); }
                else { A[j] = g; B[j] = (f32x4){0.f, 0.f, 0.f, 0.f}; }
            }
        }
        const float* xr = ((row < MCTX) ? src_lo : src_hi) + (size_t)row * D + 4 * lane;
        f32x4 v[8]; float s = 0.f;
#pragma unroll
        for (int j = 0; j < 8; ++j) { v[j] = *(const f32x4*)(xr + 256 * j); s += (v[j].x * v[j].x + v[j].y * v[j].y) + (v[j].z * v[j].z + v[j].w * v[j].w); }
        const float rstd = rsqrtf(wave_sum(s) * (1.f / D) + EPS);
#pragma unroll
        for (int j = 0; j < 8; ++j) {
            const f32x4 y = v[j] * rstd * A[j] + B[j];
            if (OUT_F32) *(f32x4*)(dst_f + (size_t)row * D + 4 * lane + 256 * j) = y;
            else { u32x2 o; o.x = cvt_pk_bf16(y[0], y[1]); o.y = cvt_pk_bf16(y[2], y[3]); *(u32x2*)(dst_bf + (size_t)row * D + 4 * lane + 256 * j) = o; }
        }
    }
}

__device__ __forceinline__ void unpack8(const u32x4 r, float (&f)[8]) {
    f[0] = bf2f(r.x & 0xffffu); f[1] = __uint_as_float(r.x & 0xffff0000u); f[2] = bf2f(r.y & 0xffffu); f[3] = __uint_as_float(r.y & 0xffff0000u);
    f[4] = bf2f(r.z & 0xffffu); f[5] = __uint_as_float(r.z & 0xffff0000u); f[6] = bf2f(r.w & 0xffffu); f[7] = __uint_as_float(r.w & 0xffff0000u);
}
__device__ __forceinline__ void ew0_phase(const Params& p) {
    int tid_ = threadIdx.x; asm volatile("" : "+v"(tid_));
    const int tid = tid_, lane = tid & 63, wave = tid >> 6, G = gridDim.x;
    const int gw = blockIdx.x * 8 + wave, NGW = G * 8;
    unsigned char* ws = p.ws;
    const bf16_t* Z = (const bf16_t*)(ws + WS_Z);
    bf16_t* AB = (bf16_t*)(ws + WS_AB); bf16_t* Q0 = (bf16_t*)(ws + WS_Q0); bf16_t* K0 = (bf16_t*)(ws + WS_K0); bf16_t* V0 = (bf16_t*)(ws + WS_V0);
    const float* convw = p.in[13]; const float* qn = p.in[14]; const float* kn = p.in[15];
    const int ri = lane & 31, chunk = lane >> 5, da = chunk * 64 + ri, db = da + 32;
    const float inv = __builtin_amdgcn_exp2f(-(float)ri * (13.287712379549449f / 32.f));
    const float qwa = qn[da], qwb = qn[db], kwa = kn[da], kwb = kn[db];
    for (int tok = gw; tok < MTOT; tok += NGW) {
        const bool lat = tok >= MCTX;
        const int t = lat ? ((tok - MCTX) & 2047) : (tok & 255), slen = lat ? 2048 : 256;
        const bf16_t* zr = Z + (size_t)tok * ABIN;
#pragma unroll
        for (int j = 0; j < 2; ++j) {
            const int ch = j * 512 + lane * 8;
            float gb[8], acc[8];
            unpack8(*(const u32x4*)(zr + ch), gb);
#pragma unroll
            for (int e = 0; e < 8; ++e) acc[e] = 0.f;
#pragma unroll
            for (int dt = -1; dt <= 1; ++dt) {
                if (t + dt >= 0 && t + dt < slen) {
                    float gc[8], xa[8];
                    unpack8(*(const u32x4*)(zr + dt * ABIN + 1024 + ch), gc);
                    unpack8(*(const u32x4*)(zr + dt * ABIN + 2048 + ch), xa);
                    const f32x4 w0 = *(const f32x4*)(convw + (dt + 1) * 1024 + ch), w1 = *(const f32x4*)(convw + (dt + 1) * 1024 + ch + 4);
#pragma unroll
                    for (int e = 0; e < 4; ++e) { acc[e] += w0[e] * (gc[e] * xa[e]); acc[4 + e] += w1[e] * (gc[4 + e] * xa[4 + e]); }
                }
            }
            u32x4 o; o.x = cvt_pk_bf16(gb[0] * acc[0], gb[1] * acc[1]); o.y = cvt_pk_bf16(gb[2] * acc[2], gb[3] * acc[3]);
            o.z = cvt_pk_bf16(gb[4] * acc[4], gb[5] * acc[5]); o.w = cvt_pk_bf16(gb[6] * acc[6], gb[7] * acc[7]);
            *(u32x4*)(AB + (size_t)tok * D + ch) = o;
        }
        float cs = 1.f, sn = 0.f;
        if (lat) { const float pos = (float)(chunk == 0 ? (t >> 6) : (t & 63)); const float ang = pos * inv; cs = __cosf(ang); sn = __sinf(ang); }
#pragma unroll
        for (int hh = 0; hh < 10; ++hh) {
            const bf16_t* hp = zr + 3072 + hh * 128;
            const float va = bf2f(hp[da]), vb = bf2f(hp[db]);
            const float rstd = rsqrtf(wave_sum(va * va + vb * vb) * (1.f / 128.f) + EPS);
            const float na = va * rstd * (hh < 8 ? qwa : kwa), nb = vb * rstd * (hh < 8 ? qwb : kwb);
            const float ra = na * cs - nb * sn, rb = na * sn + nb * cs;
            if (hh < 8) { bf16_t* q = Q0 + (size_t)tok * 1024 + hh * 128; q[da] = (bf16_t)f2bf(ra); q[db] = (bf16_t)f2bf(rb); }
            else {
                const int kvh = hh - 8;
                bf16_t* k = K0 + (size_t)tok * 256 + kvh * 128; k[da] = (bf16_t)f2bf(ra); k[db] = (bf16_t)f2bf(rb);
                if (!lat) { float* ok = p.out + OUT_AK + (size_t)tok * 256 + kvh * 128; ok[da] = na; ok[db] = nb; }
            }
        }
        {
            const u32x2 r = *(const u32x2*)(zr + 4352 + lane * 4);
            *(u32x2*)(V0 + (size_t)tok * 256 + lane * 4) = r;
            if (!lat) { f32x4 o; o[0] = bf2f(r.x & 0xffffu); o[1] = __uint_as_float(r.x & 0xffff0000u); o[2] = bf2f(r.y & 0xffffu); o[3] = __uint_as_float(r.y & 0xffff0000u);
                *(f32x4*)(p.out + OUT_AV + (size_t)tok * 256 + lane * 4) = o; }
        }
    }
}

constexpr int KSTR = 272, VSTR = 288, LDS_KT = 0, LDS_VT = 2 * 64 * KSTR, LDS_BIAS = LDS_VT + 2 * 64 * VSTR;
constexpr float SCL2 = 0.08838834764831845f * 1.4426950408889634f, LOG2E = 1.4426950408889634f;
struct AttnArgs {
    const bf16_t* q; int qstride; int qrow0;
    bf16_t* o; int ostride;
    const bf16_t* kA; const bf16_t* vA; int strideA, ntA;
    const bf16_t* kB; const bf16_t* vB; int strideB, ntB;
    int r0, krlo; const float* bias;
};
__device__ __forceinline__ v4i16_t vtr(const LAS unsigned char* p) { return __builtin_amdgcn_ds_read_tr16_b64_v4i16((LAS v4i16_t*)p); }

template <int NA>
__device__ __forceinline__ void attn_run(LAS unsigned char* lds, const AttnArgs& a) {
    int tid_ = threadIdx.x; asm volatile("" : "+v"(tid_));
    const int tid = tid_, lane = tid & 63, wave = __builtin_amdgcn_readfirstlane(tid >> 6), fr = lane & 15, fq = lane >> 4;
    bf16x8 Qf[2][4];
#pragma unroll
    for (int qb = 0; qb < 2; ++qb)
#pragma unroll
        for (int dc = 0; dc < 4; ++dc) Qf[qb][dc] = *(const bf16x8*)(a.q + (size_t)(a.qrow0 + wave * 32 + qb * 16 + fr) * a.qstride + dc * 32 + fq * 8);
    f32x4 O[2][8];
#pragma unroll
    for (int qb = 0; qb < 2; ++qb)
#pragma unroll
        for (int db = 0; db < 8; ++db) O[qb][db] = (f32x4){0.f, 0.f, 0.f, 0.f};
    float mrun[2] = {-1e30f, -1e30f}, lrun[2] = {0.f, 0.f};
    LAS float* biasL = (LAS float*)(lds + LDS_BIAS);
    if (NA) { for (int i = tid; i < 465; i += 512) biasL[i] = a.bias[i]; }
    const int nt = a.ntA + a.ntB;
    const int lrow = tid >> 3, lch = tid & 7;
    u32x4 kr0, kr1, vr0, vr1;
#define ATT_GLOAD(t) do { const bool inA = (t) < a.ntA; const int tt = inA ? (t) : (t) - a.ntA; const int st = inA ? a.strideA : a.strideB; \
        const bf16_t* kp = (inA ? a.kA : a.kB) + (size_t)(tt * 64 + lrow) * st + lch * 8; const bf16_t* vp = (inA ? a.vA : a.vB) + (size_t)(tt * 64 + lrow) * st + lch * 8; \
        kr0 = *(const u32x4*)kp; kr1 = *(const u32x4*)(kp + 64); vr0 = *(const u32x4*)vp; vr1 = *(const u32x4*)(vp + 64); } while (0)
#define ATT_LWRITE(b) do { LAS unsigned char* kd = lds + LDS_KT + (b) * 64 * KSTR + lrow * KSTR + lch * 16; LAS unsigned char* vd = lds + LDS_VT + (b) * 64 * VSTR + lrow * VSTR + lch * 16; \
        *(LAS u32x4*)kd = kr0; *(LAS u32x4*)(kd + 128) = kr1; *(LAS u32x4*)vd = vr0; *(LAS u32x4*)(vd + 128) = vr1; } while (0)
    ATT_GLOAD(0); ATT_LWRITE(0); __syncthreads();
    const int rw = NA ? a.r0 + (wave >> 1) : 0;
    const int kr_lo_w = NA ? (rw - 4 < 0 ? 0 : (rw - 4 > 24 ? 24 : rw - 4)) : 0;
    for (int t = 0; t < nt; ++t) {
        if (t + 1 < nt) ATT_GLOAD(t + 1);
        bool active = true; int kr = 0; const bool local = NA && t >= a.ntA;
        if (local) { kr = a.krlo + (t - a.ntA); active = (kr >= kr_lo_w) && (kr < kr_lo_w + 8); }
        if (active) {
            const LAS unsigned char* Kt = lds + LDS_KT + (t & 1) * 64 * KSTR;
            const LAS unsigned char* Vt = lds + LDS_VT + (t & 1) * 64 * VSTR;
            f32x4 S[2][4];
#pragma unroll
            for (int qb = 0; qb < 2; ++qb)
#pragma unroll
                for (int kb = 0; kb < 4; ++kb) S[qb][kb] = (f32x4){0.f, 0.f, 0.f, 0.f};
#pragma unroll
            for (int kb = 0; kb < 4; ++kb)
#pragma unroll
                for (int dc = 0; dc < 4; ++dc) {
                    const bf16x8 kf = *(const LAS bf16x8*)(Kt + (kb * 16 + fr) * KSTR + dc * 64 + fq * 16);
                    S[0][kb] = __builtin_amdgcn_mfma_f32_16x16x32_bf16(kf, Qf[0][dc], S[0][kb], 0, 0, 0);
                    S[1][kb] = __builtin_amdgcn_mfma_f32_16x16x32_bf16(kf, Qf[1][dc], S[1][kb], 0, 0, 0);
                }
            bf16x8 Pf[2][2];
#pragma unroll
            for (int qb = 0; qb < 2; ++qb) {
                if (local) {
                    const int c = (wave & 1) * 32 + qb * 16 + fr;
                    const int kc0 = c - 8 < 0 ? 0 : (c - 8 > 48 ? 48 : c - 8);
                    const LAS float* brow = biasL + (kr - rw + 7) * 31 + 15 - c;
#pragma unroll
                    for (int kb = 0; kb < 4; ++kb)
#pragma unroll
                        for (int j = 0; j < 4; ++j) { const int kc = kb * 16 + 4 * fq + j; const bool ok = (kc >= kc0) && (kc < kc0 + 16);
                            const float bv = brow[ok ? kc : c];
                            S[qb][kb][j] = ok ? (S[qb][kb][j] * SCL2 + bv * LOG2E) : -1e30f; }
                } else {
#pragma unroll
                    for (int kb = 0; kb < 4; ++kb) S[qb][kb] = S[qb][kb] * SCL2;
                }
                float mx = -1e30f;
#pragma unroll
                for (int kb = 0; kb < 4; ++kb) mx = fmaxf(mx, fmaxf(fmaxf(S[qb][kb][0], S[qb][kb][1]), fmaxf(S[qb][kb][2], S[qb][kb][3])));
                mx = fmaxf(mx, __shfl_xor(mx, 16)); mx = fmaxf(mx, __shfl_xor(mx, 32));
                const float mn = fmaxf(mrun[qb], mx), alpha = __builtin_amdgcn_exp2f(mrun[qb] - mn);
                mrun[qb] = mn;
                float rs = 0.f;
#pragma unroll
                for (int kb = 0; kb < 4; ++kb)
#pragma unroll
                    for (int j = 0; j < 4; ++j) { const float pv = __builtin_amdgcn_exp2f(S[qb][kb][j] - mn); S[qb][kb][j] = pv; rs += pv; }
                lrun[qb] = lrun[qb] * alpha + rs;
#pragma unroll
                for (int db = 0; db < 8; ++db) O[qb][db] = O[qb][db] * alpha;
#pragma unroll
                for (int c2 = 0; c2 < 2; ++c2) {
                    u32x4 pk; pk.x = cvt_pk_bf16(S[qb][2 * c2][0], S[qb][2 * c2][1]); pk.y = cvt_pk_bf16(S[qb][2 * c2][2], S[qb][2 * c2][3]);
                    pk.z = cvt_pk_bf16(S[qb][2 * c2 + 1][0], S[qb][2 * c2 + 1][1]); pk.w = cvt_pk_bf16(S[qb][2 * c2 + 1][2], S[qb][2 * c2 + 1][3]);
                    Pf[qb][c2] = __builtin_bit_cast(bf16x8, pk);
                }
            }
            const LAS unsigned char* vb = Vt + (4 * fq + (fr >> 2)) * VSTR + (fr & 3) * 8;
#pragma unroll
            for (int c2 = 0; c2 < 2; ++c2)
#pragma unroll
                for (int db = 0; db < 8; ++db) {
                    const v4i16_t lo = vtr(vb + (c2 * 32) * VSTR + db * 32), hi = vtr(vb + (c2 * 32 + 16) * VSTR + db * 32);
                    bf16x8 vf; vf[0] = lo[0]; vf[1] = lo[1]; vf[2] = lo[2]; vf[3] = lo[3]; vf[4] = hi[0]; vf[5] = hi[1]; vf[6] = hi[2]; vf[7] = hi[3];
                    O[0][db] = __builtin_amdgcn_mfma_f32_16x16x32_bf16(vf, Pf[0][c2], O[0][db], 0, 0, 0);
                    O[1][db] = __builtin_amdgcn_mfma_f32_16x16x32_bf16(vf, Pf[1][c2], O[1][db], 0, 0, 0);
                }
        }
        if (t + 1 < nt) ATT_LWRITE((t + 1) & 1);
        __syncthreads();
    }
#undef ATT_GLOAD
#undef ATT_LWRITE
#pragma unroll
    for (int qb = 0; qb < 2; ++qb) {
        float lt = lrun[qb]; lt += __shfl_xor(lt, 16); lt += __shfl_xor(lt, 32);
        const float il = 1.f / lt;
        bf16_t* op = a.o + (size_t)(a.qrow0 + wave * 32 + qb * 16 + fr) * a.ostride + 4 * fq;
#pragma unroll
        for (int db = 0; db < 8; ++db) { const f32x4 v = O[qb][db] * il; u32x2 o; o.x = cvt_pk_bf16(v[0], v[1]); o.y = cvt_pk_bf16(v[2], v[3]); *(u32x2*)(op + db * 16) = o; }
    }
}

__device__ __forceinline__ void attn0_phase(const Params& p, LAS unsigned char* lds) {
    unsigned char* ws = p.ws; const int G = gridDim.x;
    const bf16_t* Q0 = (const bf16_t*)(ws + WS_Q0); const bf16_t* K0 = (const bf16_t*)(ws + WS_K0); const bf16_t* V0 = (const bf16_t*)(ws + WS_V0);
    bf16_t* AB = (bf16_t*)(ws + WS_AB);
    for (int i = blockIdx.x; i < 512; i += G) {
        if (i >= 256 && i < 384) continue;
        AttnArgs a;
        if (i < 128) { const int b = i >> 6, h = (i >> 3) & 7, qblk = i & 7, kvh = h >> 2;
            a.q = Q0 + h * 128; a.qstride = 1024; a.qrow0 = MCTX + b * 2048 + qblk * 256; a.o = AB + 1024 + h * 128; a.ostride = D;
            a.kA = K0 + (size_t)(MTOT + b * 512) * 256 + kvh * 128; a.vA = V0 + (size_t)(MTOT + b * 512) * 256 + kvh * 128; a.strideA = 256; a.ntA = 8;
            a.kB = K0 + (size_t)(MCTX + b * 2048) * 256 + kvh * 128; a.vB = V0 + (size_t)(MCTX + b * 2048) * 256 + kvh * 128; a.strideB = 256; a.ntB = 32;
        } else { const int j = (i < 256) ? i - 128 : i - 256, b = j >> 3, h = j & 7, kvh = h >> 2;
            a.q = Q0 + h * 128; a.qstride = 1024; a.qrow0 = b * 256; a.o = AB + 1024 + h * 128; a.ostride = D;
            a.kA = K0 + (size_t)(b * 256) * 256 + kvh * 128; a.vA = V0 + (size_t)(b * 256) * 256 + kvh * 128; a.strideA = 256; a.ntA = 4;
            a.kB = a.kA; a.vB = a.vA; a.strideB = 256; a.ntB = 0;
        }
        a.r0 = 0; a.krlo = 0; a.bias = nullptr;
        attn_run<0>(lds, a);
    }
}
__device__ __forceinline__ void attn1_phase(const Params& p, LAS unsigned char* lds, bf16_t* AO) {
    unsigned char* ws = p.ws; const int G = gridDim.x;
    const bf16_t* Q1 = (const bf16_t*)(ws + WS_Z); const bf16_t* K1 = Q1 + (size_t)MTOT * D; const bf16_t* V1 = K1 + (size_t)MTOT * D;
    const bf16_t* CNK = (const bf16_t*)(ws + WS_CNK); const bf16_t* CNV = (const bf16_t*)(ws + WS_CNV);
    for (int i = blockIdx.x; i < 256; i += G) {
        AttnArgs a;
        const int b = i >> 7, h = (i >> 3) & 15, rg = i & 7, r0 = rg * 4;
        const int lo = r0 - 4 < 0 ? 0 : (r0 - 4 > 24 ? 24 : r0 - 4), hi0 = r0 - 1 < 0 ? 0 : (r0 - 1 > 24 ? 24 : r0 - 1), hi = hi0 + 7;
        a.q = Q1 + h * 128; a.qstride = D; a.qrow0 = MCTX + b * 2048 + r0 * 64; a.o = AO + h * 128; a.ostride = D;
        a.kA = CNK + (size_t)(b * 512) * 2048 + h * 128; a.vA = CNV + (size_t)(b * 512) * 2048 + h * 128; a.strideA = 2048; a.ntA = 8;
        a.kB = K1 + (size_t)(MCTX + b * 2048 + lo * 64) * D + h * 128; a.vB = V1 + (size_t)(MCTX + b * 2048 + lo * 64) * D + h * 128; a.strideB = D; a.ntB = hi - lo + 1;
        a.r0 = r0; a.krlo = lo; a.bias = p.in[18] + h * 465;
        attn_run<1>(lds, a);
    }
    for (int j = blockIdx.x; j < 512; j += G) {
        AttnArgs a;
        const int b = j >> 4, h = j & 15;
        a.q = Q1 + h * 128; a.qstride = D; a.qrow0 = b * 256; a.o = AO + h * 128; a.ostride = D;
        a.kA = K1 + (size_t)(b * 256) * D + h * 128; a.vA = V1 + (size_t)(b * 256) * D + h * 128; a.strideA = D; a.ntA = 4;
        a.kB = a.kA; a.vB = a.vA; a.strideB = D; a.ntB = 0;
        a.r0 = 0; a.krlo = 0; a.bias = nullptr;
        attn_run<0>(lds, a);
    }
}

#define XB_TMO      128
#define XB_XCNT(j)  (256  + 64 * (j))
#define XB_XSUB(j)  (1280 + 64 * (j))
#define XB_XGEN(j)  (2304 + 64 * (j))
#define XB_TOP      3328
#define XB_TOPGEN   3392
#define XCD_BAR_WORDS 3456
#define XB_SPIN_CAP (1u << 18)

__device__ __forceinline__ unsigned xb_ld(unsigned* p)              { return __hip_atomic_load(p, __ATOMIC_RELAXED, __HIP_MEMORY_SCOPE_AGENT); }
__device__ __forceinline__ unsigned xb_add(unsigned* p, unsigned v) { return __hip_atomic_fetch_add(p, v, __ATOMIC_RELAXED, __HIP_MEMORY_SCOPE_AGENT); }
__device__ __forceinline__ unsigned xb_xcc_id() { return (unsigned)__builtin_amdgcn_s_getreg((3 << 11) | 20) & 0xFu; }
#define XB_SPIN(cond, bar) do { unsigned _sp = 0; while (cond) { __builtin_amdgcn_s_sleep(1); \
    if ((++_sp & 255u) == 0u) { if (xb_ld(&(bar)[XB_TMO])) break; if (_sp > XB_SPIN_CAP) { atomicAdd(&(bar)[XB_TMO], 1u); break; } } } } while (0)

struct XcdBarrier {
    unsigned* bar; unsigned x;
    volatile LAS unsigned* st;
};

__device__ __forceinline__ XcdBarrier xcd_barrier_post(unsigned* bar, volatile LAS unsigned* st) {
    XcdBarrier b; b.bar = bar; b.x = xb_xcc_id(); b.st = st;
    if (threadIdx.x == 0) (void)xb_add(&bar[XB_XCNT(b.x)], 1u);
    return b;
}
__device__ __forceinline__ void xcd_barrier_complete(unsigned* bar, unsigned x, unsigned& nloc, unsigned& nx) {
    const unsigned G = gridDim.x * gridDim.y * gridDim.z;
    unsigned sum, cnt, mine, sp = 0u;
    for (;;) {
        sum = 0u; cnt = 0u; mine = 0u;
#pragma unroll
        for (unsigned j = 0; j < 16; ++j) { const unsigned c = xb_ld(&bar[XB_XCNT(j)]); sum += c; cnt += (c > 0u) ? 1u : 0u; mine = (j == x) ? c : mine; }
        if (sum == G) break;
        __builtin_amdgcn_s_sleep(1);
        if ((++sp & 255u) == 0u) { if (xb_ld(&bar[XB_TMO])) break; if (sp > XB_SPIN_CAP) { atomicAdd(&bar[XB_TMO], 1u); break; } }
    }
    nloc = mine > 0u ? mine : 1u; nx = cnt > 0u ? cnt : 1u;
}

__device__ __forceinline__ void xcd_barrier(const XcdBarrier& b) {
    asm volatile("s_waitcnt vmcnt(0)" ::: "memory");
    __syncthreads();
    if (threadIdx.x == 0) {
        unsigned* bar = b.bar;
        __builtin_amdgcn_s_waitcnt(0);
        unsigned nloc = b.st[0], nx = b.st[1];
        if (nloc == 0u) { xcd_barrier_complete(bar, b.x, nloc, nx); b.st[0] = nloc; b.st[1] = nx; }
        const unsigned old = xb_add(&bar[XB_XSUB(b.x)], 1u);
        const unsigned gen = old / nloc;
        if (old + 1u == (gen + 1u) * nloc) {
            __builtin_amdgcn_fence(__ATOMIC_RELEASE, "agent");
            asm volatile("s_waitcnt vmcnt(0)" ::: "memory");
            const unsigned og = xb_add(&bar[XB_TOP], 1u);
            const unsigned tg = og / nx;
            if (og + 1u == (tg + 1u) * nx) xb_add(&bar[XB_TOPGEN], 1u);
            else XB_SPIN(xb_ld(&bar[XB_TOPGEN]) == tg, bar);
            __builtin_amdgcn_fence(__ATOMIC_ACQUIRE, "agent");
            xb_add(&bar[XB_XGEN(b.x)], 1u);
            asm volatile("s_waitcnt vmcnt(0)" ::: "memory");
        } else {
            XB_SPIN(xb_ld(&bar[XB_XGEN(b.x)]) == gen, bar);
            __builtin_amdgcn_fence(__ATOMIC_ACQUIRE, "agent");
            asm volatile("s_waitcnt vmcnt(0)" ::: "memory");
        }
    }
    __syncthreads();
}


constexpr int NPHASE = 18;
__global__ void __launch_bounds__(512, 2) mega_fwd(Params p) {
    extern __shared__ __attribute__((aligned(16))) unsigned char lds_raw[];
    LAS unsigned char* lds = (LAS unsigned char*)lds_raw;
    cg::grid_group grid = cg::this_grid();
    if (threadIdx.x < 64) ((LAS unsigned*)(lds + 131072))[threadIdx.x] = 0u;
    __syncthreads();
    XcdBarrier xbar = xcd_barrier_post((unsigned*)(p.ws + WS_BAR), (volatile LAS unsigned*)(lds + 131072));
    unsigned char* ws = p.ws;
    const int G = gridDim.x;
    float* MOD = (float*)(ws + WS_MOD);
    bf16_t* XN = (bf16_t*)(ws + WS_XN); float* X = (float*)(ws + WS_X);
    bf16_t* Z = (bf16_t*)(ws + WS_Z); bf16_t* AB = (bf16_t*)(ws + WS_AB); bf16_t* H = (bf16_t*)(ws + WS_H);
#define RUN(k) (p.ph_lo <= (k) && (k) < p.ph_hi)
#define GRID_SYNC_CG() do { asm volatile("s_waitcnt vmcnt(0) lgkmcnt(0)" ::: "memory"); grid.sync(); __builtin_amdgcn_fence(__ATOMIC_ACQUIRE, "agent"); asm volatile("s_waitcnt vmcnt(0)" ::: "memory"); } while (0)
#define GRID_SYNC() do { xcd_barrier(xbar); } while (0)
#define REPEAT(n, stmt) do { for (int rep_ = 0; rep_ < (n); ++rep_) { stmt; if (rep_ + 1 < (n)) GRID_SYNC(); } } while (0)
#define SEAM(k) do { if (p.ph_lo <= (k) && (k) + 1 < p.ph_hi) GRID_SYNC(); } while (0)
    if (RUN(0)) REPEAT(REP_P0, p0_prologue(p, lds));
    if (p.ph_lo <= 0 && 1 < p.ph_hi) GRID_SYNC_CG();
    for (int l = 0; l < 2; ++l) {
        const int k0 = 1 + 8 * l;
        const float* modl = MOD + (size_t)l * 3 * MODW;
        const float* xin_lo = (l == 0) ? p.in[0] : X;
        const float* xin_hi = (l == 0) ? p.in[1] - (size_t)MCTX * D : X;
        if (RUN(k0)) REPEAT(REP_NORM, norm_phase<false>(xin_lo, xin_hi, p.in[10] + l * D, modl, 0, D, XN, nullptr));
        SEAM(k0);
        if (RUN(k0 + 1)) for (int repg_ = 0; repg_ < REP_G; ++repg_) {
            if (repg_) GRID_SYNC();
            if (l == 0) { pg8::Gemm g{XN, (const bf16_t*)(ws + WS_WIN), MTOT, ABIN, D}; pg8::StaticOrder S; S.init(MTOT, ABIN, G, (int)blockIdx.x, D, ws, -1);
                EpiBf16<0, false> E{Z, ABIN, nullptr, nullptr, 0, 0}; pg8::gemm_phase(lds, g, S, E); }
            else { pg8::Gemm g{XN, (const bf16_t*)(ws + WS_WQKV), MTOT, NQKV, D}; pg8::StaticOrder S; S.init(MTOT, NQKV, G, (int)blockIdx.x, D, ws, -1);
                EpiBf16<0, true> E{Z, D, p.out + OUT_NK, p.out + OUT_NV, 8, (size_t)MTOT * D}; pg8::gemm_phase(lds, g, S, E); }
        }
        SEAM(k0 + 1);
        if (l == 0) { if (RUN(k0 + 2)) REPEAT(REP_EW, ew0_phase(p)); SEAM(k0 + 2); }
        if (RUN(k0 + 3)) REPEAT(REP_ATT, if (l == 0) attn0_phase(p, lds); else attn1_phase(p, lds, AB));
        SEAM(k0 + 3);
        if (RUN(k0 + 4)) { pg8::Gemm g{AB, (const bf16_t*)(ws + (l == 0 ? WS_WO0 : WS_WO1)), MTOT, D, D}; pg8::StaticOrder S; S.init(MTOT, D, G, (int)blockIdx.x, D, ws, -1);
            EpiResid E{xin_lo, xin_hi, X, modl + 2 * D}; pg8::gemm_phase(lds, g, S, E); }
        SEAM(k0 + 4);
        if (RUN(k0 + 5)) REPEAT(REP_NORM, norm_phase<false>(X, X, p.in[11] + l * D, modl, 3 * D, 4 * D, XN, nullptr));
        SEAM(k0 + 5);
        if (RUN(k0 + 6)) for (int repg_ = 0; repg_ < REP_G; ++repg_) { if (repg_) GRID_SYNC(); pg8::Gemm g{XN, (const bf16_t*)(ws + WS_W1) + (size_t)l * FFN * D, MTOT, FFN, D}; pg8::StaticOrder S; S.init(MTOT, FFN, G, (int)blockIdx.x, D, ws, -1);
            EpiBf16<1, false> E{H, FFN, nullptr, nullptr, 0, 0}; pg8::gemm_phase(lds, g, S, E); }
        SEAM(k0 + 6);
        if (RUN(k0 + 7)) { pg8::Gemm g{H, (const bf16_t*)(ws + WS_W2) + (size_t)l * FFN * D, MTOT, D, FFN}; pg8::StaticOrder S; S.init(MTOT, D, G, (int)blockIdx.x, FFN, ws, (l * 4 + 3) * 1024);
            EpiResid E{X, X, X, modl + 5 * D}; pg8::gemm_phase(lds, g, S, E); }
        SEAM(k0 + 7);
    }
#if PROBE_STOP > 0
    GRID_SYNC();
    {
        const size_t n = (size_t)MTOT * D, gt = (size_t)blockIdx.x * 512 + threadIdx.x, gs = (size_t)G * 512;
        const bf16_t* sb = PROBE_SRC == 1 ? XN : PROBE_SRC == 2 ? AB : PROBE_SRC == 3 ? Z : PROBE_SRC == 5 ? Z + (size_t)4096 * NQKV : (const bf16_t*)(ws + WS_Q0);
#if PROBE_SRC == 6
        attn1_phase(p, lds, XN);
        GRID_SYNC();
        for (size_t i = gt; i < n; i += gs) p.out[i] = bf2f(AB[i]) - bf2f(XN[i]);
#else
        for (size_t i = gt; i < n; i += gs) p.out[i] = (PROBE_SRC == 0) ? X[i] : bf2f(sb[i]);
#endif
#if PROBE_STOP < 4
        for (size_t i = gt; i < (size_t)2 * MCTX * 256; i += gs) p.out[OUT_AK + i] = 0.f;
#endif
        for (size_t i = gt; i < (size_t)2 * MCTX * D; i += gs) p.out[OUT_NK + i] = 0.f;
    }
#else
    if (RUN(17)) REPEAT(REP_NORM, norm_phase<true>(X, X, p.in[22], nullptr, 0, 0, nullptr, p.out));
#endif
#undef RUN
#undef SEAM
#undef REPEAT
#undef GRID_SYNC
#undef GRID_SYNC_CG
}

extern "C" void kernel_launch(void* const* d_in, const int* in_sizes, int n_in, void* d_out, int out_size, void* d_ws, size_t ws_size, hipStream_t stream) {
    static int grid = 0;
    if (grid == 0) {
        if (n_in != 23 || ws_size < WS_END) { fprintf(stderr, "kernel_launch: expected 23 inputs and >= %zu bytes of workspace (got %d, %zu)\n", (size_t)WS_END, n_in, ws_size); grid = -1; return; }
        int dev = 0, cus = 0, per_cu = 0;
        (void)hipGetDevice(&dev);
        (void)hipDeviceGetAttribute(&cus, hipDeviceAttributeMultiprocessorCount, dev);
        if (hipFuncSetAttribute((const void*)mega_fwd, hipFuncAttributeMaxDynamicSharedMemorySize, LDS_BYTES) != hipSuccess) { fprintf(stderr, "kernel_launch: hipFuncSetAttribute failed\n"); grid = -1; return; }
        if (hipOccupancyMaxActiveBlocksPerMultiprocessor(&per_cu, (const void*)mega_fwd, 512, LDS_BYTES) != hipSuccess || per_cu < 1) { fprintf(stderr, "kernel_launch: occupancy query failed (%d)\n", per_cu); grid = -1; return; }
        grid = cus * (per_cu > 1 ? 1 : per_cu);
        fprintf(stderr, "kernel_launch: grid %d (cus %d, per_cu %d)\n", grid, cus, per_cu);
    }
    if (grid < 0) return;
    (void)hipMemsetAsync((char*)d_ws + WS_BAR, 0, 65536, stream);
    Params p{};
    for (int i = 0; i < 23; ++i) p.in[i] = (const float*)d_in[i];
    p.out = (float*)d_out; p.ws = (unsigned char*)d_ws;
#if MK_PER_PHASE
    for (int k = 0; k < NPHASE; ++k) {
        if (k == 11) continue;
        p.ph_lo = k; p.ph_hi = k + 1;
        void* args[] = {&p};
        hipError_t e = hipLaunchCooperativeKernel((const void*)mega_fwd, dim3(grid), dim3(512), args, LDS_BYTES, stream);
        if (e != hipSuccess) { fprintf(stderr, "launch %d failed: %s\n", k, hipGetErrorString(e)); break; }
    }
#else
    p.ph_lo = 0; p.ph_hi = PROBE_STOP > 0 ? PROBE_STOP : NPHASE;
    void* args[] = {&p};
    hipError_t e = hipLaunchCooperativeKernel((const void*)mega_fwd, dim3(grid), dim3(512), args, LDS_BYTES, stream);
    if (e != hipSuccess) fprintf(stderr, "cooperative launch failed: %s (grid %d)\n", hipGetErrorString(e), grid);
#endif
}
```

```cpp
#include <hip/hip_runtime.h>
#include <hip/hip_cooperative_groups.h>
#include <cstdio>
#include <cstdint>
namespace cg = cooperative_groups;

#ifndef MK_PER_PHASE
#define MK_PER_PHASE 0
#endif

#ifndef REP_NG
#define REP_NG 1
#endif
#ifndef REP_P0
#define REP_P0 REP_NG
#endif
#ifndef REP_NORM
#define REP_NORM REP_NG
#endif
#ifndef REP_EW
#define REP_EW REP_NG
#endif
#ifndef REP_ATT
#define REP_ATT REP_NG
#endif
#ifndef REP_G
#define REP_G 1
#endif
#ifndef PROBE_STOP
#define PROBE_STOP 0
#endif
#ifndef PROBE_SRC
#define PROBE_SRC 0
#endif
#define LAS __attribute__((address_space(3)))
#define PG8_LAS __attribute__((address_space(3)))
typedef unsigned short bf16_t;
typedef short bf16x8 __attribute__((ext_vector_type(8)));
typedef short v4i16_t __attribute__((ext_vector_type(4)));
typedef float f32x4 __attribute__((ext_vector_type(4)));
typedef float f32x2 __attribute__((ext_vector_type(2)));
typedef unsigned u32x4 __attribute__((ext_vector_type(4)));
typedef unsigned u32x2 __attribute__((ext_vector_type(2)));

__device__ __forceinline__ float bf2f(unsigned h) { return __uint_as_float(h << 16); }
typedef __bf16 bf16x2_t __attribute__((ext_vector_type(2)));
__device__ __forceinline__ unsigned cvt_pk_bf16(float lo, float hi) { f32x2 v = {lo, hi}; bf16x2_t r = __builtin_convertvector(v, bf16x2_t); return __builtin_bit_cast(unsigned, r); }
__device__ __forceinline__ float wave_sum(float v) {
#pragma unroll
    for (int o = 1; o < 64; o <<= 1) v += __shfl_xor(v, o);
    return v;
}

constexpr size_t WS_TS_OFS = 595591168ull;
constexpr size_t WS_FLAGS_OFS = (512u << 10) + 16384;
namespace pg8 {
constexpr int BM = 256, BK = 64, HALF = 128, HTB = HALF * BK * 2  , STAGE_BYTES = 8 * HTB, NXCD = 8, WGM = 4;

__host__ __device__ __forceinline__ int lds_byte(int r, int c) { const int st = (r >> 4) * 2 + (c >> 5), rr = r & 15, cc = c & 31, ob = rr * 64 + cc * 2; return st * 1024 + (ob ^ (((ob >> 9) & 1) << 5)); }
__host__ __device__ __forceinline__ void stage_rc(int b, int& R, int& C) { const int st = b / 1024, sb = b % 1024, swz = sb ^ (((sb >> 9) & 1) << 5); R = (st >> 1) * 16 + swz / 64; C = (st & 1) * 32 + (swz % 64) / 2; }
__host__ __device__ __forceinline__ int perm32(int rho) { const int n = rho >> 4, i = rho & 15; return 8 * (i >> 2) + 4 * n + (i & 3); }
struct Unit { int pm, pn, code; };
struct Gemm { const bf16_t* A; const bf16_t* Bt; int M, N, K; };
struct StaticOrder {
    int nM, nN, nwg, G, c, ntk, R, tail, fofs; unsigned char* wsb;
    __device__ __forceinline__ int kt0(const Unit& u) const { return (u.code & 3) == 2 ? (ntk >> 1) : 0; }
    __device__ __forceinline__ int nkt(const Unit& u) const { return (u.code & 3) ? (ntk >> 1) : ntk; }
    __host__ __device__ void init(int M, int N, int G_, int c_, int K, unsigned char* wsb_, int fofs_) {
        nM = M / BM; nN = N / BM; nwg = nM * nN; G = G_; c = c_; ntk = K / BK; wsb = wsb_; fofs = fofs_;
        R = nwg / G; tail = nwg - R * G;
        if (fofs_ < 0 || 2 * tail > G || (ntk & 3)) tail = 0;
    }
    __host__ __device__ bool next(int i, Unit& u) const {
        long L;
        if (tail) {
            if (i < R) { L = (long)i * G + c; u.code = 0; }
            else if (i == R && c < 2 * tail) { L = (long)R * G + (c >> 1); u.code = (1 + (c & 1)) | ((c >> 1) << 2); }
            else return false;
        } else { L = (long)i * G + c; if (L >= nwg) return false; u.code = 0; }
        int wgid = (int)L; { const int q = nwg / NXCD, r = nwg % NXCD, xcd = wgid % NXCD, off = wgid / NXCD; wgid = (xcd < r ? xcd * (q + 1) : r * (q + 1) + (xcd - r) * q) + off; }
        const int nig = WGM * nN, gid = wgid / nig, fm = gid * WGM, gsz = (nM - fm) < WGM ? (nM - fm) : WGM;
        u.pm = fm + ((wgid % nig) % gsz); u.pn = (wgid % nig) / gsz; return true;
    }
    __device__ __forceinline__ void a_ready(const Unit&) const {}
    __device__ __forceinline__ void done(const Unit&) const {}
};
template <class Epi, class Sched>
__device__ __forceinline__ void gemm_phase(PG8_LAS unsigned char* lds, const Gemm g, const Sched& S, const Epi& E) {
    int tid_ = threadIdx.x; asm volatile("" : "+v"(tid_));
    const int tid = tid_, wid = __builtin_amdgcn_readfirstlane(tid >> 6), lane = tid & 63, wr = wid >> 2, wc = wid & 3, fr = lane & 15, fq = lane >> 4;
    const int K = g.K;
    unsigned voffA[2], voffB[2];
#pragma unroll
    for (int i = 0; i < 2; ++i) { int R, C; stage_rc(tid * 16 + i * 8192, R, C); const int Rb = Epi::PERM ? ((R & ~31) + perm32(R & 31)) : R;
        voffA[i] = (unsigned)(R * K + C) * 2u; voffB[i] = (unsigned)(Rb * K + C) * 2u; }
    const size_t kstep = (size_t)(BK * 2);
    const size_t hstep = (size_t)HALF * K * 2;
    const size_t tstep = 2 * hstep;
    const unsigned ldsw = (unsigned)wid * 1024u;
    const int aoff = lds_byte(wr * 64 + fr, fq * 8), boff = lds_byte(wc * 32 + fr, fq * 8);
#define PG8_SA(b, h) (((b) * 2 + (h)) * HTB)
#define PG8_SB(b, h) ((4 + (b) * 2 + (h)) * HTB)
#define PG8_STAGE(bufoff, gbase, voff) do { _Pragma("unroll") for (int _i = 0; _i < 2; ++_i) \
        __builtin_amdgcn_global_load_lds((const unsigned*)((const char*)(gbase) + (voff)[_i]), (PG8_LAS unsigned*)(lds + (bufoff) + ldsw + _i * 8192), 16, 0, 0); } while (0)
#define PG8_LDA(dst, b, h) do { _Pragma("unroll") for (int m = 0; m < 4; ++m) _Pragma("unroll") for (int k = 0; k < 2; ++k) dst[m][k] = *(const PG8_LAS bf16x8*)(lds + PG8_SA(b, h) + aoff + m * 2048 + k * 1024); } while (0)
#define PG8_LDB(dst, b, h) do { _Pragma("unroll") for (int n = 0; n < 2; ++n) _Pragma("unroll") for (int k = 0; k < 2; ++k) dst[n][k] = *(const PG8_LAS bf16x8*)(lds + PG8_SB(b, h) + boff + n * 2048 + k * 1024); } while (0)
#define PG8_MMA(ai, bj, At, Bt) do { __builtin_amdgcn_s_setprio(1); _Pragma("unroll") for (int m = 0; m < 4; ++m) _Pragma("unroll") for (int n = 0; n < 2; ++n) _Pragma("unroll") for (int k = 0; k < 2; ++k) \
        acc[ai][bj][m][n] = __builtin_amdgcn_mfma_f32_16x16x32_bf16(Bt[n][k], At[m][k], acc[ai][bj][m][n], 0, 0, 0); __builtin_amdgcn_s_setprio(0); } while (0)
#define PG8_WAIT_V(n) asm volatile("s_waitcnt vmcnt(" #n ")" ::: "memory")
#define PG8_WAIT_L(n) asm volatile("s_waitcnt lgkmcnt(" #n ")" ::: "memory")
#define PG8_BAR __builtin_amdgcn_s_barrier()
#define PG8_SCHED __builtin_amdgcn_sched_barrier(0)
    Unit cur, nxt; int ui = 0;
    if (!S.next(0, cur)) return;
    f32x4 acc[2][2][4][2];
#pragma unroll
    for (int a = 0; a < 2; ++a)
#pragma unroll
        for (int b = 0; b < 2; ++b)
#pragma unroll
            for (int m = 0; m < 4; ++m)
#pragma unroll
                for (int n = 0; n < 2; ++n) acc[a][b][m][n] = (f32x4){0.f, 0.f, 0.f, 0.f};
    bf16x8 At[4][2], B0[2][2], B1[2][2];
    const char* cA = (const char*)g.A + (size_t)cur.pm * tstep + (size_t)S.kt0(cur) * kstep; const char* cB = (const char*)g.Bt + (size_t)cur.pn * tstep + (size_t)S.kt0(cur) * kstep;
    S.a_ready(cur);
    PG8_STAGE(PG8_SB(0, 0), cB, voffB); PG8_STAGE(PG8_SB(0, 1), cB + hstep, voffB); PG8_STAGE(PG8_SA(0, 0), cA, voffA); PG8_STAGE(PG8_SA(0, 1), cA + hstep, voffA);
    if (wr == 1) PG8_BAR;
    PG8_WAIT_V(2); PG8_BAR;
    PG8_STAGE(PG8_SB(1, 0), cB + kstep, voffB); PG8_STAGE(PG8_SA(1, 0), cA + kstep, voffA); PG8_STAGE(PG8_SB(1, 1), cB + hstep + kstep, voffB);
    PG8_WAIT_V(6); PG8_BAR;
    for (;;) {
        const bool has_next = S.next(ui + 1, nxt);
        const char* nA = has_next ? (const char*)g.A + (size_t)nxt.pm * tstep + (size_t)S.kt0(nxt) * kstep : cA; const char* nB = has_next ? (const char*)g.Bt + (size_t)nxt.pn * tstep + (size_t)S.kt0(nxt) * kstep : cB;
        const int nt = S.nkt(cur);
        for (int t = 0; t < nt; t += 2) {
            const bool last = (t == nt - 2);
            const char* a1 = cA + (size_t)(t + 1) * kstep;
            const char* a2 = last ? nA : cA + (size_t)(t + 2) * kstep; const char* b2 = last ? nB : cB + (size_t)(t + 2) * kstep;
            const char* a3 = a2 + kstep; const char* b3 = b2 + kstep;
            if (last && has_next) S.a_ready(nxt);
            PG8_LDB(B0, 0, 0); PG8_LDB(B1, 0, 1); PG8_SCHED; PG8_LDA(At, 0, 0); PG8_STAGE(PG8_SA(1, 1), a1 + hstep, voffA);
            PG8_WAIT_V(8); PG8_WAIT_L(0); PG8_BAR; PG8_MMA(0, 0, At, B0); PG8_MMA(0, 1, At, B1); PG8_BAR; PG8_SCHED;
            PG8_LDA(At, 0, 1); PG8_STAGE(PG8_SB(0, 0), b2, voffB); PG8_STAGE(PG8_SB(0, 1), b2 + hstep, voffB); PG8_STAGE(PG8_SA(0, 0), a2, voffA);
            PG8_WAIT_V(8); PG8_WAIT_L(0); PG8_BAR; PG8_MMA(1, 0, At, B0); PG8_MMA(1, 1, At, B1); PG8_BAR; PG8_SCHED;
            PG8_LDB(B0, 1, 0); PG8_LDB(B1, 1, 1); PG8_SCHED; PG8_LDA(At, 1, 0); PG8_STAGE(PG8_SA(0, 1), a2 + hstep, voffA);
            PG8_WAIT_V(8); PG8_WAIT_L(0); PG8_BAR; PG8_MMA(0, 0, At, B0); PG8_MMA(0, 1, At, B1); PG8_BAR; PG8_SCHED;
            PG8_LDA(At, 1, 1); PG8_STAGE(PG8_SB(1, 0), b3, voffB); PG8_STAGE(PG8_SB(1, 1), b3 + hstep, voffB); PG8_STAGE(PG8_SA(1, 0), a3, voffA);
            PG8_WAIT_V(8); PG8_WAIT_L(0); PG8_BAR; PG8_MMA(1, 0, At, B0); PG8_MMA(1, 1, At, B1); PG8_BAR; PG8_SCHED;
        }
        if (wr == 0) PG8_BAR;
        const int role = cur.code & 3, slot = cur.code >> 2;
        if (role == 2) {
            f32x4* sp = (f32x4*)(S.wsb + WS_TS_OFS) + (size_t)slot * (32 * 512) + tid;
#pragma unroll
            for (int a = 0; a < 2; ++a)
#pragma unroll
                for (int b = 0; b < 2; ++b)
#pragma unroll
                    for (int m = 0; m < 4; ++m)
#pragma unroll
                        for (int n = 0; n < 2; ++n) asm volatile("global_store_dwordx4 %0, %1, off sc1" :: "v"(sp + (((a * 2 + b) * 4 + m) * 2 + n) * 512), "v"(acc[a][b][m][n]) : "memory");
            asm volatile("s_waitcnt vmcnt(0)" ::: "memory");
            if (lane == 0) __hip_atomic_store((unsigned*)(S.wsb + WS_FLAGS_OFS) + S.fofs + slot * 8 + wid, 1u, __ATOMIC_RELAXED, __HIP_MEMORY_SCOPE_AGENT);
        } else {
            if (role == 1) {
                unsigned spins = 0;
                while (__hip_atomic_load((unsigned*)(S.wsb + WS_FLAGS_OFS) + S.fofs + slot * 8 + wid, __ATOMIC_RELAXED, __HIP_MEMORY_SCOPE_AGENT) == 0u) { __builtin_amdgcn_s_sleep(2); if (++spins > (1u << 22)) break; }
                __builtin_amdgcn_fence(__ATOMIC_ACQUIRE, "agent");
                asm volatile("s_waitcnt vmcnt(0)" ::: "memory");
                const f32x4* sp = (const f32x4*)(S.wsb + WS_TS_OFS) + (size_t)slot * (32 * 512) + tid;
#pragma unroll
                for (int a = 0; a < 2; ++a)
#pragma unroll
                    for (int b = 0; b < 2; ++b)
#pragma unroll
                        for (int m = 0; m < 4; ++m)
#pragma unroll
                            for (int n = 0; n < 2; ++n) { acc[a][b][m][n] += sp[(((a * 2 + b) * 4 + m) * 2 + n) * 512]; asm volatile("" ::: "memory"); }
            }
            E(acc, cur, wr, wc, fr, fq);
        }
        if (!has_next) break;
#pragma unroll
        for (int a = 0; a < 2; ++a)
#pragma unroll
            for (int b = 0; b < 2; ++b)
#pragma unroll
                for (int m = 0; m < 4; ++m)
#pragma unroll
                    for (int n = 0; n < 2; ++n) acc[a][b][m][n] = (f32x4){0.f, 0.f, 0.f, 0.f};
        cur = nxt; cA = nA; cB = nB; ++ui;
        if (wr == 1) PG8_BAR;
    }
    PG8_WAIT_V(0);
    PG8_BAR;
    if constexpr (Epi::AFTER_DRAIN) { E.fused(acc, cur, wr, wc, fr, fq, lds, wid, lane); S.done(cur); }
#undef PG8_SA
#undef PG8_SB
#undef PG8_STAGE
#undef PG8_LDA
#undef PG8_LDB
#undef PG8_MMA
#undef PG8_WAIT_V
#undef PG8_WAIT_L
#undef PG8_BAR
#undef PG8_SCHED
}
}

constexpr int D = 2048, MCTX = 8192, MLAT = 4096, MTOT = 12288, FFN = 8192, ABIN = 4608, NQKV = 6144, MODW = 12288;
constexpr float EPS = 1e-6f;
constexpr size_t WS_MOD = 0;
constexpr size_t WS_BAR = 512u << 10;
constexpr size_t WS_WIN = 1u << 20;
constexpr size_t WS_WO0 = WS_WIN + (size_t)ABIN * D * 2;
constexpr size_t WS_WQKV = WS_WO0 + (size_t)D * D * 2;
constexpr size_t WS_WO1 = WS_WQKV + (size_t)NQKV * D * 2;
constexpr size_t WS_W1 = WS_WO1 + (size_t)D * D * 2;
constexpr size_t WS_W2 = WS_W1 + 2 * (size_t)FFN * D * 2;
constexpr size_t WS_XN = WS_W2 + 2 * (size_t)FFN * D * 2;
constexpr size_t WS_H = WS_XN + (size_t)MTOT * D * 2;
constexpr size_t WS_Z = WS_H;
constexpr size_t WS_AB = WS_H + (size_t)MTOT * NQKV * 2;
constexpr size_t WS_Q0 = WS_H + (size_t)MTOT * FFN * 2;
constexpr size_t WS_K0 = WS_Q0 + (size_t)MTOT * 1024 * 2;
constexpr size_t WS_V0 = WS_K0 + (size_t)(MTOT + 1024) * 256 * 2;
constexpr size_t WS_CNK = WS_V0 + (size_t)(MTOT + 1024) * 256 * 2;
constexpr size_t WS_CNV = WS_CNK + (size_t)1024 * 2048 * 2;
constexpr size_t WS_X = WS_CNV + (size_t)1024 * 2048 * 2;
constexpr size_t WS_TS = WS_X + (size_t)MTOT * D * 4;
constexpr size_t WS_END = WS_TS + (size_t)128 * 32 * 512 * 16;
constexpr size_t WS_FLAGS = WS_BAR + 16384;
static_assert(WS_TS == WS_TS_OFS && WS_FLAGS == WS_FLAGS_OFS, "early offsets");
constexpr int LDS_BYTES = 131072 + 256;

constexpr size_t OUT_YP = 0, OUT_YS = (size_t)MCTX * D, OUT_AK = OUT_YS + (size_t)MLAT * D, OUT_AV = OUT_AK + (size_t)MCTX * 256,
                 OUT_NK = OUT_AV + (size_t)MCTX * 256, OUT_NV = OUT_NK + (size_t)MCTX * D;

struct Params {
    const float* in[23];
    float* out;
    unsigned char* ws;
    int ph_lo, ph_hi;
};

template <int ACT, bool SIDE> struct EpiBf16 {
    static constexpr bool PERM = true, AFTER_DRAIN = false;
    bf16_t* O; int ldc; float* kout; float* vout; int split_tiles; size_t split_stride;
    __device__ __forceinline__ void operator()(const f32x4 (&acc)[2][2][4][2], const pg8::Unit& u, int wr, int wc, int fr, int fq) const {
        const int row0 = u.pm * 256 + wr * 64 + fr, col0 = u.pn * 256 + wc * 32 + 8 * fq;
        const int spt = split_tiles ? u.pn / split_tiles : 0; bf16_t* Ob = O + (size_t)spt * split_stride; const int ocol0 = col0 - spt * split_tiles * 256;
        const bool side = SIDE && (u.pm < 32) && (u.pn >= 8);
        float* sbase = nullptr; int scol0 = 0;
        if (SIDE) { sbase = (u.pn < 16) ? kout : vout; scol0 = col0 - ((u.pn < 16) ? 2048 : 4096); }
#pragma unroll
        for (int ai = 0; ai < 2; ++ai)
#pragma unroll
            for (int m = 0; m < 4; ++m) {
                const int row = row0 + ai * 128 + m * 16;
                bf16_t* rowp = Ob + (size_t)row * ldc + ocol0;
#pragma unroll
                for (int bj = 0; bj < 2; ++bj) {
                    f32x4 v0 = acc[ai][bj][m][0], v1 = acc[ai][bj][m][1];
                    if (SIDE) { if (side) { float* sp = sbase + (size_t)row * 2048 + scol0 + bj * 128; *(f32x4*)sp = v0; *(f32x4*)(sp + 4) = v1; } }
                    if (ACT == 1) {
#pragma unroll
                        for (int j = 0; j < 4; ++j) { float a = fmaxf(v0[j], 0.f), b = fmaxf(v1[j], 0.f); v0[j] = a * a; v1[j] = b * b; }
                    }
                    u32x4 o; o.x = cvt_pk_bf16(v0[0], v0[1]); o.y = cvt_pk_bf16(v0[2], v0[3]); o.z = cvt_pk_bf16(v1[0], v1[1]); o.w = cvt_pk_bf16(v1[2], v1[3]);
                    *(u32x4*)(rowp + bj * 128) = o;
                }
            }
    }
};
struct EpiResid {
    static constexpr bool PERM = false, AFTER_DRAIN = false;
    const float* src_lo; const float* src_hi;
    float* X; const float* gate;
    __device__ __forceinline__ void operator()(const f32x4 (&acc)[2][2][4][2], const pg8::Unit& u, int wr, int wc, int fr, int fq) const {
        const int row0 = u.pm * 256 + wr * 64 + fr, col0 = u.pn * 256 + wc * 32 + 4 * fq;
        const int cond = (u.pm < 32) ? 0 : 1 + ((u.pm - 32) >> 3);
        const float* gp = gate + (size_t)cond * MODW + col0;
        const float* sb = (u.pm < 32) ? src_lo : src_hi;
        f32x4 gv[2][2];
#pragma unroll
        for (int bj = 0; bj < 2; ++bj)
#pragma unroll
            for (int n = 0; n < 2; ++n) gv[bj][n] = *(const f32x4*)(gp + bj * 128 + n * 16);
#pragma unroll
        for (int ai = 0; ai < 2; ++ai)
#pragma unroll
            for (int m = 0; m < 4; ++m) {
                const size_t off = (size_t)(row0 + ai * 128 + m * 16) * D + col0;
#pragma unroll
                for (int bj = 0; bj < 2; ++bj)
#pragma unroll
                    for (int n = 0; n < 2; ++n) {
                        const f32x4 r = *(const f32x4*)(sb + off + bj * 128 + n * 16);
                        *(f32x4*)(X + off + bj * 128 + n * 16) = r + gv[bj][n] * acc[ai][bj][m][n];
                    }
            }
    }
};

__device__ __forceinline__ unsigned f2bf(float f) { unsigned u = __float_as_uint(f); return (u + 0x7fffu + ((u >> 16) & 1u)) >> 16; }
__device__ __forceinline__ unsigned pk2(float lo, float hi) { return f2bf(lo) | (f2bf(hi) << 16); }
__device__ __forceinline__ void p0_transpose_item(const float* W, int K, int N, bf16_t* WT, LAS float* scr, int item, int lane) {
    const int nblk = N / 32, kb = item / nblk, nb = item % nblk, k0 = 64 * kb, n0 = 32 * nb;
#pragma unroll 8
    for (int i = 0; i < 32; ++i) { const int kk = 2 * i + (lane >> 5); scr[kk * 33 + (lane & 31)] = W[(size_t)(k0 + kk) * N + n0 + (lane & 31)]; }
    asm volatile("s_waitcnt lgkmcnt(0)" ::: "memory");
    const int c = lane & 7;
#pragma unroll
    for (int j = 0; j < 4; ++j) { const int n = (lane >> 3) + 8 * j; const LAS float* s = scr + (8 * c) * 33 + n;
        u32x4 o; o.x = pk2(s[0 * 33], s[1 * 33]); o.y = pk2(s[2 * 33], s[3 * 33]); o.z = pk2(s[4 * 33], s[5 * 33]); o.w = pk2(s[6 * 33], s[7 * 33]);
        *(u32x4*)(WT + (size_t)(n0 + n) * K + k0 + 8 * c) = o; }
    asm volatile("s_waitcnt lgkmcnt(0)" ::: "memory");
}
__device__ __forceinline__ void cvt_linear(const float* src, bf16_t* dst, int n, int gtid, int gthreads) {
    for (int i = gtid * 4; i < n; i += gthreads * 4) { const f32x4 v = *(const f32x4*)(src + i); u32x2 o; o.x = cvt_pk_bf16(v[0], v[1]); o.y = cvt_pk_bf16(v[2], v[3]); *(u32x2*)(dst + i) = o; }
}
__device__ __forceinline__ void p0_prologue(const Params& p, LAS unsigned char* lds) {
    int tid_ = threadIdx.x; asm volatile("" : "+v"(tid_));
    const int tid = tid_, lane = tid & 63, wave = __builtin_amdgcn_readfirstlane(tid >> 6), G = gridDim.x;
    unsigned char* ws = p.ws;
    {
        LAS float* sc = (LAS float*)(lds + 69632);
        LAS float* red = (LAS float*)(lds + 69632 + 24576);
        const float* cvec = p.in[6]; const float* cctx = p.in[7];
        for (int i = tid; i < 3 * 2048; i += 512) { const int c = i >> 11, k = i & 2047; const float x = (c == 0) ? cctx[k] : cvec[(c - 1) * 2048 + k]; sc[i] = x / (1.f + __expf(-x)); }
        __syncthreads();
        float* MOD = (float*)(ws + WS_MOD);
        for (int item = blockIdx.x; item < 256; item += G) {
            const int l = item >> 7, cgp = item & 127, ln = lane < 48 ? lane : 47;
            const float* W = p.in[8] + (size_t)l * 2048 * MODW + cgp * 96 + ln * 2;
            float a00 = 0.f, a01 = 0.f, a10 = 0.f, a11 = 0.f, a20 = 0.f, a21 = 0.f;
            const int kb = wave * 256;
#pragma unroll 8
            for (int k = 0; k < 256; ++k) {
                const f32x2 w = *(const f32x2*)(W + (size_t)(kb + k) * MODW);
                const float s0 = sc[kb + k], s1 = sc[2048 + kb + k], s2 = sc[4096 + kb + k];
                a00 += s0 * w.x; a01 += s0 * w.y; a10 += s1 * w.x; a11 += s1 * w.y; a20 += s2 * w.x; a21 += s2 * w.y;
            }
            if (lane < 48) { LAS float* r = red + wave * 288 + lane * 2; r[0] = a00; r[1] = a01; r[96] = a10; r[97] = a11; r[192] = a20; r[193] = a21; }
            __syncthreads();
            if (tid < 288) { const int c = tid / 96, j = tid % 96; float s = 0.f;
#pragma unroll
                for (int w = 0; w < 8; ++w) s += red[w * 288 + tid];
                MOD[(size_t)(l * 3 + c) * MODW + cgp * 96 + j] = s + p.in[9][l * MODW + cgp * 96 + j]; }
            __syncthreads();
        }
    }
    {
        LAS float* scr = (LAS float*)(lds + wave * 8448);
        const int gw = blockIdx.x * 8 + wave, NGW = G * 8;
        constexpr int I_IN = 32 * (ABIN / 32), I_O = 32 * (D / 32), I_QKV = 32 * (NQKV / 32), I_1 = 32 * (FFN / 32), I_2 = (FFN / 64) * (D / 32);
        constexpr int NITEMS = I_IN + 2 * I_O + I_QKV + 2 * I_1 + 2 * I_2;
        for (int it = gw; it < NITEMS; it += NGW) {
            int r = it;
            if (r < I_IN) { p0_transpose_item(p.in[12], D, ABIN, (bf16_t*)(ws + WS_WIN), scr, r, lane); continue; } r -= I_IN;
            if (r < I_O) { p0_transpose_item(p.in[16], D, D, (bf16_t*)(ws + WS_WO0), scr, r, lane); continue; } r -= I_O;
            if (r < I_QKV) { p0_transpose_item(p.in[17], D, NQKV, (bf16_t*)(ws + WS_WQKV), scr, r, lane); continue; } r -= I_QKV;
            if (r < I_O) { p0_transpose_item(p.in[19], D, D, (bf16_t*)(ws + WS_WO1), scr, r, lane); continue; } r -= I_O;
            if (r < 2 * I_1) { const int l = r / I_1; p0_transpose_item(p.in[20] + (size_t)l * D * FFN, D, FFN, (bf16_t*)(ws + WS_W1) + (size_t)l * FFN * D, scr, r - l * I_1, lane); continue; } r -= 2 * I_1;
            { const int l = r / I_2; p0_transpose_item(p.in[21] + (size_t)l * D * FFN, FFN, D, (bf16_t*)(ws + WS_W2) + (size_t)l * FFN * D, scr, r - l * I_2, lane); }
        }
    }
    {
        const int gtid = blockIdx.x * 512 + tid, gth = G * 512;
        cvt_linear(p.in[2], (bf16_t*)(ws + WS_K0) + (size_t)MTOT * 256, 1024 * 256, gtid, gth);
        cvt_linear(p.in[3], (bf16_t*)(ws + WS_V0) + (size_t)MTOT * 256, 1024 * 256, gtid, gth);
        cvt_linear(p.in[4], (bf16_t*)(ws + WS_CNK), 1024 * 2048, gtid, gth);
        cvt_linear(p.in[5], (bf16_t*)(ws + WS_CNV), 1024 * 2048, gtid, gth);
    }
}

template <bool OUT_F32>
__device__ __forceinline__ void norm_phase(const float* src_lo, const float* src_hi, const float* gain, const float* mod, int shift_off, int scale_off, bf16_t* dst_bf, float* dst_f) {
    int tid_ = threadIdx.x; asm volatile("" : "+v"(tid_));
    const int tid = tid_, lane = tid & 63, wave = tid >> 6, G = gridDim.x;
    const int gw = blockIdx.x * 8 + wave, NGW = G * 8, per = (MTOT + NGW - 1) / NGW;
    const int r_beg = gw * per, r_end = (r_beg + per < MTOT) ? r_beg + per : MTOT;
    int cur = -1; f32x4 A[8], B[8];
    for (int row = r_beg; row < r_end; ++row) {
        const int cond = (row < MCTX) ? 0 : 1 + ((row - MCTX) >> 11);
        if (cond != cur) {
            cur = cond;
#pragma unroll
            for (int j = 0; j < 8; ++j) {
                const int col = 4 * lane + 256 * j; const f32x4 g = *(const f32x4*)(gain + col);
                if (mod) { const f32x4 sc = *(const f32x4*)(mod + (size_t)cond * MODW + scale_off + col); A[j] = g * (sc + 1.f); B[j] = *(const f32x4*)(mod + (size_t)cond * MODW + shift_off + col); }
                else { A[j] = g; B[j] = (f32x4){0.f, 0.f, 0.f, 0.f}; }
            }
        }
        const float* xr = ((row < MCTX) ? src_lo : src_hi) + (size_t)row * D + 4 * lane;
        f32x4 v[8]; float s = 0.f;
#pragma unroll
        for (int j = 0; j < 8; ++j) { v[j] = *(const f32x4*)(xr + 256 * j); s += (v[j].x * v[j].x + v[j].y * v[j].y) + (v[j].z * v[j].z + v[j].w * v[j].w); }
        const float rstd = rsqrtf(wave_sum(s) * (1.f / D) + EPS);
#pragma unroll
        for (int j = 0; j < 8; ++j) {
            const f32x4 y = v[j] * rstd * A[j] + B[j];
            if (OUT_F32) *(f32x4*)(dst_f + (size_t)row * D + 4 * lane + 256 * j) = y;
            else { u32x2 o; o.x = cvt_pk_bf16(y[0], y[1]); o.y = cvt_pk_bf16(y[2], y[3]); *(u32x2*)(dst_bf + (size_t)row * D + 4 * lane + 256 * j) = o; }
        }
    }
}

__device__ __forceinline__ void unpack8(const u32x4 r, float (&f)[8]) {
    f[0] = bf2f(r.x & 0xffffu); f[1] = __uint_as_float(r.x & 0xffff0000u); f[2] = bf2f(r.y & 0xffffu); f[3] = __uint_as_float(r.y & 0xffff0000u);
    f[4] = bf2f(r.z & 0xffffu); f[5] = __uint_as_float(r.z & 0xffff0000u); f[6] = bf2f(r.w & 0xffffu); f[7] = __uint_as_float(r.w & 0xffff0000u);
}
__device__ __forceinline__ void ew0_phase(const Params& p) {
    int tid_ = threadIdx.x; asm volatile("" : "+v"(tid_));
    const int tid = tid_, lane = tid & 63, wave = tid >> 6, G = gridDim.x;
    const int gw = blockIdx.x * 8 + wave, NGW = G * 8;
    unsigned char* ws = p.ws;
    const bf16_t* Z = (const bf16_t*)(ws + WS_Z);
    bf16_t* AB = (bf16_t*)(ws + WS_AB); bf16_t* Q0 = (bf16_t*)(ws + WS_Q0); bf16_t* K0 = (bf16_t*)(ws + WS_K0); bf16_t* V0 = (bf16_t*)(ws + WS_V0);
    const float* convw = p.in[13]; const float* qn = p.in[14]; const float* kn = p.in[15];
    const int ri = lane & 31, chunk = lane >> 5, da = chunk * 64 + ri, db = da + 32;
    const float inv = __builtin_amdgcn_exp2f(-(float)ri * (13.287712379549449f / 32.f));
    const float qwa = qn[da], qwb = qn[db], kwa = kn[da], kwb = kn[db];
    for (int tok = gw; tok < MTOT; tok += NGW) {
        const bool lat = tok >= MCTX;
        const int t = lat ? ((tok - MCTX) & 2047) : (tok & 255), slen = lat ? 2048 : 256;
        const bf16_t* zr = Z + (size_t)tok * ABIN;
#pragma unroll
        for (int j = 0; j < 2; ++j) {
            const int ch = j * 512 + lane * 8;
            float gb[8], acc[8];
            unpack8(*(const u32x4*)(zr + ch), gb);
#pragma unroll
            for (int e = 0; e < 8; ++e) acc[e] = 0.f;
#pragma unroll
            for (int dt = -1; dt <= 1; ++dt) {
                if (t + dt >= 0 && t + dt < slen) {
                    float gc[8], xa[8];
                    unpack8(*(const u32x4*)(zr + dt * ABIN + 1024 + ch), gc);
                    unpack8(*(const u32x4*)(zr + dt * ABIN + 2048 + ch), xa);
                    const f32x4 w0 = *(const f32x4*)(convw + (dt + 1) * 1024 + ch), w1 = *(const f32x4*)(convw + (dt + 1) * 1024 + ch + 4);
#pragma unroll
                    for (int e = 0; e < 4; ++e) { acc[e] += w0[e] * (gc[e] * xa[e]); acc[4 + e] += w1[e] * (gc[4 + e] * xa[4 + e]); }
                }
            }
            u32x4 o; o.x = cvt_pk_bf16(gb[0] * acc[0], gb[1] * acc[1]); o.y = cvt_pk_bf16(gb[2] * acc[2], gb[3] * acc[3]);
            o.z = cvt_pk_bf16(gb[4] * acc[4], gb[5] * acc[5]); o.w = cvt_pk_bf16(gb[6] * acc[6], gb[7] * acc[7]);
            *(u32x4*)(AB + (size_t)tok * D + ch) = o;
        }
        float cs = 1.f, sn = 0.f;
        if (lat) { const float pos = (float)(chunk == 0 ? (t >> 6) : (t & 63)); const float ang = pos * inv; cs = __cosf(ang); sn = __sinf(ang); }
#pragma unroll
        for (int hh = 0; hh < 10; ++hh) {
            const bf16_t* hp = zr + 3072 + hh * 128;
            const float va = bf2f(hp[da]), vb = bf2f(hp[db]);
            const float rstd = rsqrtf(wave_sum(va * va + vb * vb) * (1.f / 128.f) + EPS);
            const float na = va * rstd * (hh < 8 ? qwa : kwa), nb = vb * rstd * (hh < 8 ? qwb : kwb);
            const float ra = na * cs - nb * sn, rb = na * sn + nb * cs;
            if (hh < 8) { bf16_t* q = Q0 + (size_t)tok * 1024 + hh * 128; q[da] = (bf16_t)f2bf(ra); q[db] = (bf16_t)f2bf(rb); }
            else {
                const int kvh = hh - 8;
                bf16_t* k = K0 + (size_t)tok * 256 + kvh * 128; k[da] = (bf16_t)f2bf(ra); k[db] = (bf16_t)f2bf(rb);
                if (!lat) { float* ok = p.out + OUT_AK + (size_t)tok * 256 + kvh * 128; ok[da] = na; ok[db] = nb; }
            }
        }
        {
            const u32x2 r = *(const u32x2*)(zr + 4352 + lane * 4);
            *(u32x2*)(V0 + (size_t)tok * 256 + lane * 4) = r;
            if (!lat) { f32x4 o; o[0] = bf2f(r.x & 0xffffu); o[1] = __uint_as_float(r.x & 0xffff0000u); o[2] = bf2f(r.y & 0xffffu); o[3] = __uint_as_float(r.y & 0xffff0000u);
                *(f32x4*)(p.out + OUT_AV + (size_t)tok * 256 + lane * 4) = o; }
        }
    }
}

constexpr int KSTR = 272, VSTR = 288, LDS_KT = 0, LDS_VT = 2 * 64 * KSTR, LDS_BIAS = LDS_VT + 2 * 64 * VSTR;
constexpr float SCL2 = 0.08838834764831845f * 1.4426950408889634f, LOG2E = 1.4426950408889634f;
struct AttnArgs {
    const bf16_t* q; int qstride; int qrow0;
    bf16_t* o; int ostride;
    const bf16_t* kA; const bf16_t* vA; int strideA, ntA;
    const bf16_t* kB; const bf16_t* vB; int strideB, ntB;
    int t0, t1, role; f32x4* xs; unsigned* xf;
    int r0, krlo; const float* bias;
};
__device__ __forceinline__ v4i16_t vtr(const LAS unsigned char* p) { return __builtin_amdgcn_ds_read_tr16_b64_v4i16((LAS v4i16_t*)p); }

template <int NA>
__device__ __forceinline__ void attn_run(LAS unsigned char* lds, const AttnArgs& a) {
    int tid_ = threadIdx.x; asm volatile("" : "+v"(tid_));
    const int tid = tid_, lane = tid & 63, wave = __builtin_amdgcn_readfirstlane(tid >> 6), fr = lane & 15, fq = lane >> 4;
    bf16x8 Qf[2][4];
#pragma unroll
    for (int qb = 0; qb < 2; ++qb)
#pragma unroll
        for (int dc = 0; dc < 4; ++dc) Qf[qb][dc] = *(const bf16x8*)(a.q + (size_t)(a.qrow0 + wave * 32 + qb * 16 + fr) * a.qstride + dc * 32 + fq * 8);
    f32x4 O[2][8];
#pragma unroll
    for (int qb = 0; qb < 2; ++qb)
#pragma unroll
        for (int db = 0; db < 8; ++db) O[qb][db] = (f32x4){0.f, 0.f, 0.f, 0.f};
    float mrun[2] = {-1e30f, -1e30f}, lrun[2] = {0.f, 0.f};
    LAS float* biasL = (LAS float*)(lds + LDS_BIAS);
    if (NA) { for (int i = tid; i < 465; i += 512) biasL[i] = a.bias[i]; }
    const int lrow = tid >> 3, lch = tid & 7;
    u32x4 kr0, kr1, vr0, vr1;
#define ATT_GLOAD(t) do { const bool inA = (t) < a.ntA; const int tt = inA ? (t) : (t) - a.ntA; const int st = inA ? a.strideA : a.strideB; \
        const bf16_t* kp = (inA ? a.kA : a.kB) + (size_t)(tt * 64 + lrow) * st + lch * 8; const bf16_t* vp = (inA ? a.vA : a.vB) + (size_t)(tt * 64 + lrow) * st + lch * 8; \
        kr0 = *(const u32x4*)kp; kr1 = *(const u32x4*)(kp + 64); vr0 = *(const u32x4*)vp; vr1 = *(const u32x4*)(vp + 64); } while (0)
#define ATT_LWRITE(b) do { LAS unsigned char* kd = lds + LDS_KT + (b) * 64 * KSTR + lrow * KSTR + lch * 16; LAS unsigned char* vd = lds + LDS_VT + (b) * 64 * VSTR + lrow * VSTR + lch * 16; \
        *(LAS u32x4*)kd = kr0; *(LAS u32x4*)(kd + 128) = kr1; *(LAS u32x4*)vd = vr0; *(LAS u32x4*)(vd + 128) = vr1; } while (0)
    ATT_GLOAD(a.t0); ATT_LWRITE(a.t0 & 1); __syncthreads();
    const int rw = NA ? a.r0 + (wave >> 1) : 0;
    const int kr_lo_w = NA ? (rw - 4 < 0 ? 0 : (rw - 4 > 24 ? 24 : rw - 4)) : 0;
    for (int t = a.t0; t < a.t1; ++t) {
        if (t + 1 < a.t1) ATT_GLOAD(t + 1);
        bool active = true; int kr = 0; const bool local = NA && t >= a.ntA;
        if (local) { kr = a.krlo + (t - a.ntA); active = (kr >= kr_lo_w) && (kr < kr_lo_w + 8); }
        if (active) {
            const LAS unsigned char* Kt = lds + LDS_KT + (t & 1) * 64 * KSTR;
            const LAS unsigned char* Vt = lds + LDS_VT + (t & 1) * 64 * VSTR;
            f32x4 S[2][4];
#pragma unroll
            for (int qb = 0; qb < 2; ++qb)
#pragma unroll
                for (int kb = 0; kb < 4; ++kb) S[qb][kb] = (f32x4){0.f, 0.f, 0.f, 0.f};
#pragma unroll
            for (int kb = 0; kb < 4; ++kb)
#pragma unroll
                for (int dc = 0; dc < 4; ++dc) {
                    const bf16x8 kf = *(const LAS bf16x8*)(Kt + (kb * 16 + fr) * KSTR + dc * 64 + fq * 16);
                    S[0][kb] = __builtin_amdgcn_mfma_f32_16x16x32_bf16(kf, Qf[0][dc], S[0][kb], 0, 0, 0);
                    S[1][kb] = __builtin_amdgcn_mfma_f32_16x16x32_bf16(kf, Qf[1][dc], S[1][kb], 0, 0, 0);
                }
            bf16x8 Pf[2][2];
#pragma unroll
            for (int qb = 0; qb < 2; ++qb) {
                if (local) {
                    const int c = (wave & 1) * 32 + qb * 16 + fr;
                    const int kc0 = c - 8 < 0 ? 0 : (c - 8 > 48 ? 48 : c - 8);
                    const LAS float* brow = biasL + (kr - rw + 7) * 31 + 15 - c;
#pragma unroll
                    for (int kb = 0; kb < 4; ++kb)
#pragma unroll
                        for (int j = 0; j < 4; ++j) { const int kc = kb * 16 + 4 * fq + j; const bool ok = (kc >= kc0) && (kc < kc0 + 16);
                            const float bv = brow[ok ? kc : c];
                            S[qb][kb][j] = ok ? (S[qb][kb][j] * SCL2 + bv * LOG2E) : -1e30f; }
                } else {
#pragma unroll
                    for (int kb = 0; kb < 4; ++kb) S[qb][kb] = S[qb][kb] * SCL2;
                }
                float mx = -1e30f;
#pragma unroll
                for (int kb = 0; kb < 4; ++kb) mx = fmaxf(mx, fmaxf(fmaxf(S[qb][kb][0], S[qb][kb][1]), fmaxf(S[qb][kb][2], S[qb][kb][3])));
                mx = fmaxf(mx, __shfl_xor(mx, 16)); mx = fmaxf(mx, __shfl_xor(mx, 32));
                const float mn = fmaxf(mrun[qb], mx), alpha = __builtin_amdgcn_exp2f(mrun[qb] - mn);
                mrun[qb] = mn;
                float rs = 0.f;
#pragma unroll
                for (int kb = 0; kb < 4; ++kb)
#pragma unroll
                    for (int j = 0; j < 4; ++j) { const float pv = __builtin_amdgcn_exp2f(S[qb][kb][j] - mn); S[qb][kb][j] = pv; rs += pv; }
                lrun[qb] = lrun[qb] * alpha + rs;
#pragma unroll
                for (int db = 0; db < 8; ++db) O[qb][db] = O[qb][db] * alpha;
#pragma unroll
                for (int c2 = 0; c2 < 2; ++c2) {
                    u32x4 pk; pk.x = cvt_pk_bf16(S[qb][2 * c2][0], S[qb][2 * c2][1]); pk.y = cvt_pk_bf16(S[qb][2 * c2][2], S[qb][2 * c2][3]);
                    pk.z = cvt_pk_bf16(S[qb][2 * c2 + 1][0], S[qb][2 * c2 + 1][1]); pk.w = cvt_pk_bf16(S[qb][2 * c2 + 1][2], S[qb][2 * c2 + 1][3]);
                    Pf[qb][c2] = __builtin_bit_cast(bf16x8, pk);
                }
            }
            const LAS unsigned char* vb = Vt + (4 * fq + (fr >> 2)) * VSTR + (fr & 3) * 8;
#pragma unroll
            for (int c2 = 0; c2 < 2; ++c2)
#pragma unroll
                for (int db = 0; db < 8; ++db) {
                    const v4i16_t lo = vtr(vb + (c2 * 32) * VSTR + db * 32), hi = vtr(vb + (c2 * 32 + 16) * VSTR + db * 32);
                    bf16x8 vf; vf[0] = lo[0]; vf[1] = lo[1]; vf[2] = lo[2]; vf[3] = lo[3]; vf[4] = hi[0]; vf[5] = hi[1]; vf[6] = hi[2]; vf[7] = hi[3];
                    O[0][db] = __builtin_amdgcn_mfma_f32_16x16x32_bf16(vf, Pf[0][c2], O[0][db], 0, 0, 0);
                    O[1][db] = __builtin_amdgcn_mfma_f32_16x16x32_bf16(vf, Pf[1][c2], O[1][db], 0, 0, 0);
                }
        }
        if (t + 1 < a.t1) ATT_LWRITE((t + 1) & 1);
        __syncthreads();
    }
#undef ATT_GLOAD
#undef ATT_LWRITE
    if (a.role == 2) {
        f32x4* sp = a.xs + tid;
#pragma unroll
        for (int qb = 0; qb < 2; ++qb)
#pragma unroll
            for (int db = 0; db < 8; ++db) asm volatile("global_store_dwordx4 %0, %1, off sc1" :: "v"(sp + (qb * 8 + db) * 512), "v"(O[qb][db]) : "memory");
        const f32x4 ml = {mrun[0], mrun[1], lrun[0], lrun[1]};
        asm volatile("global_store_dwordx4 %0, %1, off sc1" :: "v"(sp + 16 * 512), "v"(ml) : "memory");
        asm volatile("s_waitcnt vmcnt(0)" ::: "memory");
        if (lane == 0) __hip_atomic_store(a.xf + wave, 1u, __ATOMIC_RELAXED, __HIP_MEMORY_SCOPE_AGENT);
        return;
    }
    if (a.role == 1) {
        unsigned spins = 0;
        while (__hip_atomic_load(a.xf + wave, __ATOMIC_RELAXED, __HIP_MEMORY_SCOPE_AGENT) == 0u) { __builtin_amdgcn_s_sleep(2); if (++spins > (1u << 22)) break; }
        __builtin_amdgcn_fence(__ATOMIC_ACQUIRE, "agent");
        asm volatile("s_waitcnt vmcnt(0)" ::: "memory");
        const f32x4* sp = a.xs + tid;
        const f32x4 ml = sp[16 * 512];
        float fa[2], fb[2];
#pragma unroll
        for (int qb = 0; qb < 2; ++qb) { const float mo = ml[qb], mn = fmaxf(mrun[qb], mo); fa[qb] = __builtin_amdgcn_exp2f(mrun[qb] - mn); fb[qb] = __builtin_amdgcn_exp2f(mo - mn); lrun[qb] = lrun[qb] * fa[qb] + ml[2 + qb] * fb[qb]; }
#pragma unroll
        for (int qb = 0; qb < 2; ++qb)
#pragma unroll
            for (int db = 0; db < 8; ++db) { const f32x4 o2 = sp[(qb * 8 + db) * 512]; O[qb][db] = O[qb][db] * fa[qb] + o2 * fb[qb]; asm volatile("" ::: "memory"); }
    }
#pragma unroll
    for (int qb = 0; qb < 2; ++qb) {
        float lt = lrun[qb]; lt += __shfl_xor(lt, 16); lt += __shfl_xor(lt, 32);
        const float il = 1.f / lt;
        bf16_t* op = a.o + (size_t)(a.qrow0 + wave * 32 + qb * 16 + fr) * a.ostride + 4 * fq;
#pragma unroll
        for (int db = 0; db < 8; ++db) { const f32x4 v = O[qb][db] * il; u32x2 o; o.x = cvt_pk_bf16(v[0], v[1]); o.y = cvt_pk_bf16(v[2], v[3]); *(u32x2*)(op + db * 16) = o; }
    }
}

__device__ __forceinline__ void attn0_phase(const Params& p, LAS unsigned char* lds) {
    unsigned char* ws = p.ws; const int G = gridDim.x;
    const bf16_t* Q0 = (const bf16_t*)(ws + WS_Q0); const bf16_t* K0 = (const bf16_t*)(ws + WS_K0); const bf16_t* V0 = (const bf16_t*)(ws + WS_V0);
    bf16_t* AB = (bf16_t*)(ws + WS_AB);
    const bool split = (G == 256);
    for (int i = blockIdx.x; i < 512; i += G) {
        AttnArgs a;
        if (i < 256) { const int it = i & 127; const int b = it >> 6, h = (it >> 3) & 7, qblk = it & 7, kvh = h >> 2;
            if (!split && i >= 128) continue;
            a.q = Q0 + h * 128; a.qstride = 1024; a.qrow0 = MCTX + b * 2048 + qblk * 256; a.o = AB + 1024 + h * 128; a.ostride = D;
            a.kA = K0 + (size_t)(MTOT + b * 512) * 256 + kvh * 128; a.vA = V0 + (size_t)(MTOT + b * 512) * 256 + kvh * 128; a.strideA = 256; a.ntA = 8;
            a.kB = K0 + (size_t)(MCTX + b * 2048) * 256 + kvh * 128; a.vB = V0 + (size_t)(MCTX + b * 2048) * 256 + kvh * 128; a.strideB = 256; a.ntB = 32;
            a.t0 = (split && i >= 128) ? 20 : 0; a.t1 = (split && i < 128) ? 20 : 40; a.role = split ? (i < 128 ? 1 : 2) : 0;
            a.xs = (f32x4*)(ws + WS_TS) + (size_t)it * (17 * 512); a.xf = (unsigned*)(ws + WS_FLAGS) + 8 * 1024 + it * 8;
        } else { const int j = i - 256, b = j >> 3, h = j & 7, kvh = h >> 2;
            a.q = Q0 + h * 128; a.qstride = 1024; a.qrow0 = b * 256; a.o = AB + 1024 + h * 128; a.ostride = D;
            a.kA = K0 + (size_t)(b * 256) * 256 + kvh * 128; a.vA = V0 + (size_t)(b * 256) * 256 + kvh * 128; a.strideA = 256; a.ntA = 4;
            a.kB = a.kA; a.vB = a.vA; a.strideB = 256; a.ntB = 0;
            a.t0 = 0; a.t1 = 4; a.role = 0; a.xs = nullptr; a.xf = nullptr;
        }
        a.r0 = 0; a.krlo = 0; a.bias = nullptr;
        attn_run<0>(lds, a);
    }
}
__device__ __forceinline__ void attn1_phase(const Params& p, LAS unsigned char* lds, bf16_t* AO) {
    unsigned char* ws = p.ws; const int G = gridDim.x;
    const bf16_t* Q1 = (const bf16_t*)(ws + WS_Z); const bf16_t* K1 = Q1 + (size_t)MTOT * D; const bf16_t* V1 = K1 + (size_t)MTOT * D;
    const bf16_t* CNK = (const bf16_t*)(ws + WS_CNK); const bf16_t* CNV = (const bf16_t*)(ws + WS_CNV);
    for (int i = blockIdx.x; i < 256; i += G) {
        AttnArgs a;
        const int b = i >> 7, h = (i >> 3) & 15, rg = i & 7, r0 = rg * 4;
        const int lo = r0 - 4 < 0 ? 0 : (r0 - 4 > 24 ? 24 : r0 - 4), hi0 = r0 - 1 < 0 ? 0 : (r0 - 1 > 24 ? 24 : r0 - 1), hi = hi0 + 7;
        a.q = Q1 + h * 128; a.qstride = D; a.qrow0 = MCTX + b * 2048 + r0 * 64; a.o = AO + h * 128; a.ostride = D;
        a.kA = CNK + (size_t)(b * 512) * 2048 + h * 128; a.vA = CNV + (size_t)(b * 512) * 2048 + h * 128; a.strideA = 2048; a.ntA = 8;
        a.kB = K1 + (size_t)(MCTX + b * 2048 + lo * 64) * D + h * 128; a.vB = V1 + (size_t)(MCTX + b * 2048 + lo * 64) * D + h * 128; a.strideB = D; a.ntB = hi - lo + 1;
        a.r0 = r0; a.krlo = lo; a.bias = p.in[18] + h * 465; a.t0 = 0; a.t1 = a.ntA + a.ntB; a.role = 0; a.xs = nullptr; a.xf = nullptr;
        attn_run<1>(lds, a);
    }
    for (int j = blockIdx.x; j < 512; j += G) {
        AttnArgs a;
        const int b = j >> 4, h = j & 15;
        a.q = Q1 + h * 128; a.qstride = D; a.qrow0 = b * 256; a.o = AO + h * 128; a.ostride = D;
        a.kA = K1 + (size_t)(b * 256) * D + h * 128; a.vA = V1 + (size_t)(b * 256) * D + h * 128; a.strideA = D; a.ntA = 4;
        a.kB = a.kA; a.vB = a.vA; a.strideB = D; a.ntB = 0;
        a.r0 = 0; a.krlo = 0; a.bias = nullptr; a.t0 = 0; a.t1 = 4; a.role = 0; a.xs = nullptr; a.xf = nullptr;
        attn_run<0>(lds, a);
    }
}

#define XB_TMO      128
#define XB_XCNT(j)  (256  + 64 * (j))
#define XB_XSUB(j)  (1280 + 64 * (j))
#define XB_XGEN(j)  (2304 + 64 * (j))
#define XB_TOP      3328
#define XB_TOPGEN   3392
#define XCD_BAR_WORDS 3456
#define XB_SPIN_CAP (1u << 18)

__device__ __forceinline__ unsigned xb_ld(unsigned* p)              { return __hip_atomic_load(p, __ATOMIC_RELAXED, __HIP_MEMORY_SCOPE_AGENT); }
__device__ __forceinline__ unsigned xb_add(unsigned* p, unsigned v) { return __hip_atomic_fetch_add(p, v, __ATOMIC_RELAXED, __HIP_MEMORY_SCOPE_AGENT); }
__device__ __forceinline__ unsigned xb_xcc_id() { return (unsigned)__builtin_amdgcn_s_getreg((3 << 11) | 20) & 0xFu; }
#define XB_SPIN(cond, bar) do { unsigned _sp = 0; while (cond) { __builtin_amdgcn_s_sleep(1); \
    if ((++_sp & 255u) == 0u) { if (xb_ld(&(bar)[XB_TMO])) break; if (_sp > XB_SPIN_CAP) { atomicAdd(&(bar)[XB_TMO], 1u); break; } } } } while (0)

struct XcdBarrier {
    unsigned* bar; unsigned x;
    volatile LAS unsigned* st;
};

__device__ __forceinline__ XcdBarrier xcd_barrier_post(unsigned* bar, volatile LAS unsigned* st) {
    XcdBarrier b; b.bar = bar; b.x = xb_xcc_id(); b.st = st;
    if (threadIdx.x == 0) (void)xb_add(&bar[XB_XCNT(b.x)], 1u);
    return b;
}
__device__ __forceinline__ void xcd_barrier_complete(unsigned* bar, unsigned x, unsigned& nloc, unsigned& nx) {
    const unsigned G = gridDim.x * gridDim.y * gridDim.z;
    unsigned sum, cnt, mine, sp = 0u;
    for (;;) {
        sum = 0u; cnt = 0u; mine = 0u;
#pragma unroll
        for (unsigned j = 0; j < 16; ++j) { const unsigned c = xb_ld(&bar[XB_XCNT(j)]); sum += c; cnt += (c > 0u) ? 1u : 0u; mine = (j == x) ? c : mine; }
        if (sum == G) break;
        __builtin_amdgcn_s_sleep(1);
        if ((++sp & 255u) == 0u) { if (xb_ld(&bar[XB_TMO])) break; if (sp > XB_SPIN_CAP) { atomicAdd(&bar[XB_TMO], 1u); break; } }
    }
    nloc = mine > 0u ? mine : 1u; nx = cnt > 0u ? cnt : 1u;
}

__device__ __forceinline__ void xcd_barrier(const XcdBarrier& b) {
    asm volatile("s_waitcnt vmcnt(0)" ::: "memory");
    __syncthreads();
    if (threadIdx.x == 0) {
        unsigned* bar = b.bar;
        __builtin_amdgcn_s_waitcnt(0);
        unsigned nloc = b.st[0], nx = b.st[1];
        if (nloc == 0u) { xcd_barrier_complete(bar, b.x, nloc, nx); b.st[0] = nloc; b.st[1] = nx; }
        const unsigned old = xb_add(&bar[XB_XSUB(b.x)], 1u);
        const unsigned gen = old / nloc;
        if (old + 1u == (gen + 1u) * nloc) {
            __builtin_amdgcn_fence(__ATOMIC_RELEASE, "agent");
            asm volatile("s_waitcnt vmcnt(0)" ::: "memory");
            const unsigned og = xb_add(&bar[XB_TOP], 1u);
            const unsigned tg = og / nx;
            if (og + 1u == (tg + 1u) * nx) xb_add(&bar[XB_TOPGEN], 1u);
            else XB_SPIN(xb_ld(&bar[XB_TOPGEN]) == tg, bar);
            __builtin_amdgcn_fence(__ATOMIC_ACQUIRE, "agent");
            xb_add(&bar[XB_XGEN(b.x)], 1u);
            asm volatile("s_waitcnt vmcnt(0)" ::: "memory");
        } else {
            XB_SPIN(xb_ld(&bar[XB_XGEN(b.x)]) == gen, bar);
            __builtin_amdgcn_fence(__ATOMIC_ACQUIRE, "agent");
            asm volatile("s_waitcnt vmcnt(0)" ::: "memory");
        }
    }
    __syncthreads();
}


constexpr int NPHASE = 18;
__global__ void __launch_bounds__(512, 2) mega_fwd(Params p) {
    extern __shared__ __attribute__((aligned(16))) unsigned char lds_raw[];
    LAS unsigned char* lds = (LAS unsigned char*)lds_raw;
    cg::grid_group grid = cg::this_grid();
    if (threadIdx.x < 64) ((LAS unsigned*)(lds + 131072))[threadIdx.x] = 0u;
    __syncthreads();
    XcdBarrier xbar = xcd_barrier_post((unsigned*)(p.ws + WS_BAR), (volatile LAS unsigned*)(lds + 131072));
    unsigned char* ws = p.ws;
    const int G = gridDim.x;
    float* MOD = (float*)(ws + WS_MOD);
    bf16_t* XN = (bf16_t*)(ws + WS_XN); float* X = (float*)(ws + WS_X);
    bf16_t* Z = (bf16_t*)(ws + WS_Z); bf16_t* AB = (bf16_t*)(ws + WS_AB); bf16_t* H = (bf16_t*)(ws + WS_H);
#define RUN(k) (p.ph_lo <= (k) && (k) < p.ph_hi)
#define GRID_SYNC_CG() do { asm volatile("s_waitcnt vmcnt(0) lgkmcnt(0)" ::: "memory"); grid.sync(); __builtin_amdgcn_fence(__ATOMIC_ACQUIRE, "agent"); asm volatile("s_waitcnt vmcnt(0)" ::: "memory"); } while (0)
#define GRID_SYNC() do { xcd_barrier(xbar); } while (0)
#define REPEAT(n, stmt) do { for (int rep_ = 0; rep_ < (n); ++rep_) { stmt; if (rep_ + 1 < (n)) GRID_SYNC(); } } while (0)
#define SEAM(k) do { if (p.ph_lo <= (k) && (k) + 1 < p.ph_hi) GRID_SYNC(); } while (0)
    if (RUN(0)) REPEAT(REP_P0, p0_prologue(p, lds));
    if (p.ph_lo <= 0 && 1 < p.ph_hi) GRID_SYNC_CG();
    for (int l = 0; l < 2; ++l) {
        const int k0 = 1 + 8 * l;
        const float* modl = MOD + (size_t)l * 3 * MODW;
        const float* xin_lo = (l == 0) ? p.in[0] : X;
        const float* xin_hi = (l == 0) ? p.in[1] - (size_t)MCTX * D : X;
        if (RUN(k0)) REPEAT(REP_NORM, norm_phase<false>(xin_lo, xin_hi, p.in[10] + l * D, modl, 0, D, XN, nullptr));
        SEAM(k0);
        if (RUN(k0 + 1)) for (int repg_ = 0; repg_ < REP_G; ++repg_) {
            if (repg_) GRID_SYNC();
            if (l == 0) { pg8::Gemm g{XN, (const bf16_t*)(ws + WS_WIN), MTOT, ABIN, D}; pg8::StaticOrder S; S.init(MTOT, ABIN, G, (int)blockIdx.x, D, ws, -1);
                EpiBf16<0, false> E{Z, ABIN, nullptr, nullptr, 0, 0}; pg8::gemm_phase(lds, g, S, E); }
            else { pg8::Gemm g{XN, (const bf16_t*)(ws + WS_WQKV), MTOT, NQKV, D}; pg8::StaticOrder S; S.init(MTOT, NQKV, G, (int)blockIdx.x, D, ws, -1);
                EpiBf16<0, true> E{Z, D, p.out + OUT_NK, p.out + OUT_NV, 8, (size_t)MTOT * D}; pg8::gemm_phase(lds, g, S, E); }
        }
        SEAM(k0 + 1);
        if (l == 0) { if (RUN(k0 + 2)) REPEAT(REP_EW, ew0_phase(p)); SEAM(k0 + 2); }
        if (RUN(k0 + 3)) REPEAT(REP_ATT, if (l == 0) attn0_phase(p, lds); else attn1_phase(p, lds, AB));
        SEAM(k0 + 3);
        if (RUN(k0 + 4)) { pg8::Gemm g{AB, (const bf16_t*)(ws + (l == 0 ? WS_WO0 : WS_WO1)), MTOT, D, D}; pg8::StaticOrder S; S.init(MTOT, D, G, (int)blockIdx.x, D, ws, -1);
            EpiResid E{xin_lo, xin_hi, X, modl + 2 * D}; pg8::gemm_phase(lds, g, S, E); }
        SEAM(k0 + 4);
        if (RUN(k0 + 5)) REPEAT(REP_NORM, norm_phase<false>(X, X, p.in[11] + l * D, modl, 3 * D, 4 * D, XN, nullptr));
        SEAM(k0 + 5);
        if (RUN(k0 + 6)) for (int repg_ = 0; repg_ < REP_G; ++repg_) { if (repg_) GRID_SYNC(); pg8::Gemm g{XN, (const bf16_t*)(ws + WS_W1) + (size_t)l * FFN * D, MTOT, FFN, D}; pg8::StaticOrder S; S.init(MTOT, FFN, G, (int)blockIdx.x, D, ws, -1);
            EpiBf16<1, false> E{H, FFN, nullptr, nullptr, 0, 0}; pg8::gemm_phase(lds, g, S, E); }
        SEAM(k0 + 6);
        if (RUN(k0 + 7)) { pg8::Gemm g{H, (const bf16_t*)(ws + WS_W2) + (size_t)l * FFN * D, MTOT, D, FFN}; pg8::StaticOrder S; S.init(MTOT, D, G, (int)blockIdx.x, FFN, ws, (l * 4 + 3) * 1024);
            EpiResid E{X, X, X, modl + 5 * D}; pg8::gemm_phase(lds, g, S, E); }
        SEAM(k0 + 7);
    }
#if PROBE_STOP > 0
    GRID_SYNC();
    {
        const size_t n = (size_t)MTOT * D, gt = (size_t)blockIdx.x * 512 + threadIdx.x, gs = (size_t)G * 512;
        const bf16_t* sb = PROBE_SRC == 1 ? XN : PROBE_SRC == 2 ? AB : PROBE_SRC == 3 ? Z : PROBE_SRC == 5 ? Z + (size_t)4096 * NQKV : (const bf16_t*)(ws + WS_Q0);
#if PROBE_SRC == 6
        attn1_phase(p, lds, XN);
        GRID_SYNC();
        for (size_t i = gt; i < n; i += gs) p.out[i] = bf2f(AB[i]) - bf2f(XN[i]);
#else
        for (size_t i = gt; i < n; i += gs) p.out[i] = (PROBE_SRC == 0) ? X[i] : bf2f(sb[i]);
#endif
#if PROBE_STOP < 4
        for (size_t i = gt; i < (size_t)2 * MCTX * 256; i += gs) p.out[OUT_AK + i] = 0.f;
#endif
        for (size_t i = gt; i < (size_t)2 * MCTX * D; i += gs) p.out[OUT_NK + i] = 0.f;
    }
#else
    if (RUN(17)) REPEAT(REP_NORM, norm_phase<true>(X, X, p.in[22], nullptr, 0, 0, nullptr, p.out));
#endif
#undef RUN
#undef SEAM
#undef REPEAT
#undef GRID_SYNC
#undef GRID_SYNC_CG
}

extern "C" void kernel_launch(void* const* d_in, const int* in_sizes, int n_in, void* d_out, int out_size, void* d_ws, size_t ws_size, hipStream_t stream) {
    static int grid = 0;
    if (grid == 0) {
        if (n_in != 23 || ws_size < WS_END) { fprintf(stderr, "kernel_launch: expected 23 inputs and >= %zu bytes of workspace (got %d, %zu)\n", (size_t)WS_END, n_in, ws_size); grid = -1; return; }
        int dev = 0, cus = 0, per_cu = 0;
        (void)hipGetDevice(&dev);
        (void)hipDeviceGetAttribute(&cus, hipDeviceAttributeMultiprocessorCount, dev);
        if (hipFuncSetAttribute((const void*)mega_fwd, hipFuncAttributeMaxDynamicSharedMemorySize, LDS_BYTES) != hipSuccess) { fprintf(stderr, "kernel_launch: hipFuncSetAttribute failed\n"); grid = -1; return; }
        if (hipOccupancyMaxActiveBlocksPerMultiprocessor(&per_cu, (const void*)mega_fwd, 512, LDS_BYTES) != hipSuccess || per_cu < 1) { fprintf(stderr, "kernel_launch: occupancy query failed (%d)\n", per_cu); grid = -1; return; }
        grid = cus * (per_cu > 1 ? 1 : per_cu);
        fprintf(stderr, "kernel_launch: grid %d (cus %d, per_cu %d)\n", grid, cus, per_cu);
    }
    if (grid < 0) return;
    (void)hipMemsetAsync((char*)d_ws + WS_BAR, 0, 65536, stream);
    Params p{};
    for (int i = 0; i < 23; ++i) p.in[i] = (const float*)d_in[i];
    p.out = (float*)d_out; p.ws = (unsigned char*)d_ws;
#if MK_PER_PHASE
    for (int k = 0; k < NPHASE; ++k) {
        if (k == 11) continue;
        p.ph_lo = k; p.ph_hi = k + 1;
        void* args[] = {&p};
        hipError_t e = hipLaunchCooperativeKernel((const void*)mega_fwd, dim3(grid), dim3(512), args, LDS_BYTES, stream);
        if (e != hipSuccess) { fprintf(stderr, "launch %d failed: %s\n", k, hipGetErrorString(e)); break; }
    }
#else
    p.ph_lo = 0; p.ph_hi = PROBE_STOP > 0 ? PROBE_STOP : NPHASE;
    void* args[] = {&p};
    hipError_t e = hipLaunchCooperativeKernel((const void*)mega_fwd, dim3(grid), dim3(512), args, LDS_BYTES, stream);
    if (e != hipSuccess) fprintf(stderr, "cooperative launch failed: %s (grid %d)\n", hipGetErrorString(e), grid);
#endif
}
```

```cpp
#include <hip/hip_runtime.h>
#include <hip/hip_cooperative_groups.h>
#include <cstdio>
#include <cstdint>
namespace cg = cooperative_groups;

#ifndef MK_PER_PHASE
#define MK_PER_PHASE 0
#endif

#ifndef REP_NG
#define REP_NG 1
#endif
#ifndef REP_P0
#define REP_P0 REP_NG
#endif
#ifndef REP_NORM
#define REP_NORM REP_NG
#endif
#ifndef REP_EW
#define REP_EW REP_NG
#endif
#ifndef REP_ATT
#define REP_ATT REP_NG
#endif
#ifndef REP_G
#define REP_G 1
#endif
#ifndef PROBE_STOP
#define PROBE_STOP 0
#endif
#ifndef PROBE_SRC
#define PROBE_SRC 0
#endif
#define LAS __attribute__((address_space(3)))
#define PG8_LAS __attribute__((address_space(3)))
typedef unsigned short bf16_t;
typedef short bf16x8 __attribute__((ext_vector_type(8)));
typedef short v4i16_t __attribute__((ext_vector_type(4)));
typedef float f32x4 __attribute__((ext_vector_type(4)));
typedef float f32x2 __attribute__((ext_vector_type(2)));
typedef unsigned u32x4 __attribute__((ext_vector_type(4)));
typedef unsigned u32x2 __attribute__((ext_vector_type(2)));

__device__ __forceinline__ float bf2f(unsigned h) { return __uint_as_float(h << 16); }
typedef __bf16 bf16x2_t __attribute__((ext_vector_type(2)));
__device__ __forceinline__ unsigned cvt_pk_bf16(float lo, float hi) { f32x2 v = {lo, hi}; bf16x2_t r = __builtin_convertvector(v, bf16x2_t); return __builtin_bit_cast(unsigned, r); }
__device__ __forceinline__ float wave_sum(float v) {
#pragma unroll
    for (int o = 1; o < 64; o <<= 1) v += __shfl_xor(v, o);
    return v;
}

constexpr size_t WS_TS_OFS = 595591168ull;
constexpr size_t WS_FLAGS_OFS = (512u << 10) + 16384;
namespace pg8 {
constexpr int BM = 256, BK = 64, HALF = 128, HTB = HALF * BK * 2  , STAGE_BYTES = 8 * HTB, NXCD = 8, WGM = 4;

__host__ __device__ __forceinline__ int lds_byte(int r, int c) { const int st = (r >> 4) * 2 + (c >> 5), rr = r & 15, cc = c & 31, ob = rr * 64 + cc * 2; return st * 1024 + (ob ^ (((ob >> 9) & 1) << 5)); }
__host__ __device__ __forceinline__ void stage_rc(int b, int& R, int& C) { const int st = b / 1024, sb = b % 1024, swz = sb ^ (((sb >> 9) & 1) << 5); R = (st >> 1) * 16 + swz / 64; C = (st & 1) * 32 + (swz % 64) / 2; }
__host__ __device__ __forceinline__ int perm32(int rho) { const int n = rho >> 4, i = rho & 15; return 8 * (i >> 2) + 4 * n + (i & 3); }
struct Unit { int pm, pn, code; };
struct Gemm { const bf16_t* A; const bf16_t* Bt; int M, N, K; };
struct StaticOrder {
    int nM, nN, nwg, G, c, ntk, R, tail, fofs, msplit; unsigned char* wsb;
    __device__ __forceinline__ int kt0(const Unit& u) const { return (u.code & 3) == 2 ? (ntk >> 1) : 0; }
    __device__ __forceinline__ int nkt(const Unit& u) const { return ((u.code & 3) == 1 || (u.code & 3) == 2) ? (ntk >> 1) : ntk; }
    __host__ __device__ void init(int M, int N, int G_, int c_, int K, unsigned char* wsb_, int fofs_) {
        nM = M / BM; nN = N / BM; nwg = nM * nN; G = G_; c = c_; ntk = K / BK; wsb = wsb_; fofs = fofs_; msplit = (fofs_ == -2);
        R = nwg / G; tail = nwg - R * G;
        if (fofs_ == -1 || 2 * tail > G || (ntk & 3)) tail = 0;
    }
    __host__ __device__ bool next(int i, Unit& u) const {
        long L;
        if (tail) {
            if (i < R) { L = (long)i * G + c; u.code = 0; }
            else if (i == R && c < 2 * tail) { L = (long)R * G + (c >> 1); u.code = msplit ? (3 | ((c & 1) << 2)) : ((1 + (c & 1)) | ((c >> 1) << 2)); }
            else return false;
        } else { L = (long)i * G + c; if (L >= nwg) return false; u.code = 0; }
        int wgid = (int)L; { const int q = nwg / NXCD, r = nwg % NXCD, xcd = wgid % NXCD, off = wgid / NXCD; wgid = (xcd < r ? xcd * (q + 1) : r * (q + 1) + (xcd - r) * q) + off; }
        const int nig = WGM * nN, gid = wgid / nig, fm = gid * WGM, gsz = (nM - fm) < WGM ? (nM - fm) : WGM;
        u.pm = fm + ((wgid % nig) % gsz); u.pn = (wgid % nig) / gsz; return true;
    }
    __device__ __forceinline__ void a_ready(const Unit&) const {}
    __device__ __forceinline__ void done(const Unit&) const {}
};
template <class Epi, class Sched>
__device__ __forceinline__ void gemm_phase(PG8_LAS unsigned char* lds, const Gemm g, const Sched& S, const Epi& E) {
    int tid_ = threadIdx.x; asm volatile("" : "+v"(tid_));
    const int tid = tid_, wid = __builtin_amdgcn_readfirstlane(tid >> 6), lane = tid & 63, wr = wid >> 2, wc = wid & 3, fr = lane & 15, fq = lane >> 4;
    const int K = g.K;
    unsigned voffA[2], voffB[2];
#pragma unroll
    for (int i = 0; i < 2; ++i) { int R, C; stage_rc(tid * 16 + i * 8192, R, C); const int Rb = Epi::PERM ? ((R & ~31) + perm32(R & 31)) : R;
        voffA[i] = (unsigned)(R * K + C) * 2u; voffB[i] = (unsigned)(Rb * K + C) * 2u; }
    const size_t kstep = (size_t)(BK * 2);
    const size_t hstep = (size_t)HALF * K * 2;
    const size_t tstep = 2 * hstep;
    const unsigned ldsw = (unsigned)wid * 1024u;
    const int aoff = lds_byte(wr * 64 + fr, fq * 8), boff = lds_byte(wc * 32 + fr, fq * 8);
#define PG8_SA(b, h) (((b) * 2 + (h)) * HTB)
#define PG8_SB(b, h) ((4 + (b) * 2 + (h)) * HTB)
#define PG8_STAGE(bufoff, gbase, voff) do { _Pragma("unroll") for (int _i = 0; _i < 2; ++_i) \
        __builtin_amdgcn_global_load_lds((const unsigned*)((const char*)(gbase) + (voff)[_i]), (PG8_LAS unsigned*)(lds + (bufoff) + ldsw + _i * 8192), 16, 0, 0); } while (0)
#define PG8_LDA(dst, b, h) do { _Pragma("unroll") for (int m = 0; m < 4; ++m) _Pragma("unroll") for (int k = 0; k < 2; ++k) dst[m][k] = *(const PG8_LAS bf16x8*)(lds + PG8_SA(b, h) + aoff + m * 2048 + k * 1024); } while (0)
#define PG8_LDB(dst, b, h) do { _Pragma("unroll") for (int n = 0; n < 2; ++n) _Pragma("unroll") for (int k = 0; k < 2; ++k) dst[n][k] = *(const PG8_LAS bf16x8*)(lds + PG8_SB(b, h) + boff + n * 2048 + k * 1024); } while (0)
#define PG8_MMA(ai, bj, At, Bt) do { __builtin_amdgcn_s_setprio(1); _Pragma("unroll") for (int m = 0; m < 4; ++m) _Pragma("unroll") for (int n = 0; n < 2; ++n) _Pragma("unroll") for (int k = 0; k < 2; ++k) \
        acc[ai][bj][m][n] = __builtin_amdgcn_mfma_f32_16x16x32_bf16(Bt[n][k], At[m][k], acc[ai][bj][m][n], 0, 0, 0); __builtin_amdgcn_s_setprio(0); } while (0)
#define PG8_WAIT_V(n) asm volatile("s_waitcnt vmcnt(" #n ")" ::: "memory")
#define PG8_WAIT_L(n) asm volatile("s_waitcnt lgkmcnt(" #n ")" ::: "memory")
#define PG8_BAR __builtin_amdgcn_s_barrier()
#define PG8_SCHED __builtin_amdgcn_sched_barrier(0)
    Unit cur, nxt; int ui = 0;
    if (!S.next(0, cur)) return;
    f32x4 acc[2][2][4][2];
#pragma unroll
    for (int a = 0; a < 2; ++a)
#pragma unroll
        for (int b = 0; b < 2; ++b)
#pragma unroll
            for (int m = 0; m < 4; ++m)
#pragma unroll
                for (int n = 0; n < 2; ++n) acc[a][b][m][n] = (f32x4){0.f, 0.f, 0.f, 0.f};
    bf16x8 At[4][2], B0[2][2], B1[2][2];
    const char* cA = (const char*)g.A + (size_t)cur.pm * tstep + (size_t)S.kt0(cur) * kstep; const char* cB = (const char*)g.Bt + (size_t)cur.pn * tstep + (size_t)S.kt0(cur) * kstep;
    S.a_ready(cur);
    if ((cur.code & 3) == 3) cA += (size_t)(cur.code >> 2) * hstep;
    size_t ahs = (cur.code & 3) == 3 ? 0 : hstep;
    PG8_STAGE(PG8_SB(0, 0), cB, voffB); PG8_STAGE(PG8_SB(0, 1), cB + hstep, voffB); PG8_STAGE(PG8_SA(0, 0), cA, voffA); PG8_STAGE(PG8_SA(0, 1), cA + ahs, voffA);
    if (wr == 1) PG8_BAR;
    PG8_WAIT_V(2); PG8_BAR;
    PG8_STAGE(PG8_SB(1, 0), cB + kstep, voffB); PG8_STAGE(PG8_SA(1, 0), cA + kstep, voffA); PG8_STAGE(PG8_SB(1, 1), cB + hstep + kstep, voffB);
    PG8_WAIT_V(6); PG8_BAR;
    for (;;) {
        const bool has_next = S.next(ui + 1, nxt);
        const char* nA = has_next ? (const char*)g.A + (size_t)nxt.pm * tstep + (size_t)S.kt0(nxt) * kstep : cA; const char* nB = has_next ? (const char*)g.Bt + (size_t)nxt.pn * tstep + (size_t)S.kt0(nxt) * kstep : cB;
        const int nt = S.nkt(cur);
        const bool full = (cur.code & 3) != 3;
        const size_t ahs_n = (has_next && (nxt.code & 3) == 3) ? 0 : (has_next ? hstep : ahs);
        if (has_next && (nxt.code & 3) == 3) nA += (size_t)(nxt.code >> 2) * hstep;
        for (int t = 0; t < nt; t += 2) {
            const bool last = (t == nt - 2);
            const char* a1 = cA + (size_t)(t + 1) * kstep;
            const char* a2 = last ? nA : cA + (size_t)(t + 2) * kstep; const char* b2 = last ? nB : cB + (size_t)(t + 2) * kstep;
            const char* a3 = a2 + kstep; const char* b3 = b2 + kstep;
            if (last && has_next) S.a_ready(nxt);
            PG8_LDB(B0, 0, 0); PG8_LDB(B1, 0, 1); PG8_SCHED; PG8_LDA(At, 0, 0); PG8_STAGE(PG8_SA(1, 1), a1 + ahs, voffA);
            PG8_WAIT_V(8); PG8_WAIT_L(0); PG8_BAR; PG8_MMA(0, 0, At, B0); PG8_MMA(0, 1, At, B1); PG8_BAR; PG8_SCHED;
            PG8_LDA(At, 0, 1); PG8_STAGE(PG8_SB(0, 0), b2, voffB); PG8_STAGE(PG8_SB(0, 1), b2 + hstep, voffB); PG8_STAGE(PG8_SA(0, 0), a2, voffA);
            PG8_WAIT_V(8); PG8_WAIT_L(0); PG8_BAR; if (full) { PG8_MMA(1, 0, At, B0); PG8_MMA(1, 1, At, B1); } PG8_BAR; PG8_SCHED;
            PG8_LDB(B0, 1, 0); PG8_LDB(B1, 1, 1); PG8_SCHED; PG8_LDA(At, 1, 0); PG8_STAGE(PG8_SA(0, 1), a2 + (last ? ahs_n : ahs), voffA);
            PG8_WAIT_V(8); PG8_WAIT_L(0); PG8_BAR; PG8_MMA(0, 0, At, B0); PG8_MMA(0, 1, At, B1); PG8_BAR; PG8_SCHED;
            PG8_LDA(At, 1, 1); PG8_STAGE(PG8_SB(1, 0), b3, voffB); PG8_STAGE(PG8_SB(1, 1), b3 + hstep, voffB); PG8_STAGE(PG8_SA(1, 0), a3, voffA);
            PG8_WAIT_V(8); PG8_WAIT_L(0); PG8_BAR; if (full) { PG8_MMA(1, 0, At, B0); PG8_MMA(1, 1, At, B1); } PG8_BAR; PG8_SCHED;
        }
        if (wr == 0) PG8_BAR;
        const int role = cur.code & 3, slot = cur.code >> 2;
        if (role == 2) {
            f32x4* sp = (f32x4*)(S.wsb + WS_TS_OFS) + (size_t)slot * (32 * 512) + tid;
#pragma unroll
            for (int a = 0; a < 2; ++a)
#pragma unroll
                for (int b = 0; b < 2; ++b)
#pragma unroll
                    for (int m = 0; m < 4; ++m)
#pragma unroll
                        for (int n = 0; n < 2; ++n) asm volatile("global_store_dwordx4 %0, %1, off sc1" :: "v"(sp + (((a * 2 + b) * 4 + m) * 2 + n) * 512), "v"(acc[a][b][m][n]) : "memory");
            asm volatile("s_waitcnt vmcnt(0)" ::: "memory");
            if (lane == 0) __hip_atomic_store((unsigned*)(S.wsb + WS_FLAGS_OFS) + S.fofs + slot * 8 + wid, 1u, __ATOMIC_RELAXED, __HIP_MEMORY_SCOPE_AGENT);
        } else {
            if (role == 1) {
                unsigned spins = 0;
                while (__hip_atomic_load((unsigned*)(S.wsb + WS_FLAGS_OFS) + S.fofs + slot * 8 + wid, __ATOMIC_RELAXED, __HIP_MEMORY_SCOPE_AGENT) == 0u) { __builtin_amdgcn_s_sleep(2); if (++spins > (1u << 22)) break; }
                __builtin_amdgcn_fence(__ATOMIC_ACQUIRE, "agent");
                asm volatile("s_waitcnt vmcnt(0)" ::: "memory");
                const f32x4* sp = (const f32x4*)(S.wsb + WS_TS_OFS) + (size_t)slot * (32 * 512) + tid;
#pragma unroll
                for (int a = 0; a < 2; ++a)
#pragma unroll
                    for (int b = 0; b < 2; ++b)
#pragma unroll
                        for (int m = 0; m < 4; ++m)
#pragma unroll
                            for (int n = 0; n < 2; ++n) { acc[a][b][m][n] += sp[(((a * 2 + b) * 4 + m) * 2 + n) * 512]; asm volatile("" ::: "memory"); }
            }
            E(acc, cur, wr, wc, fr, fq, role == 3 ? slot * 128 : 0, role == 3 ? 1 : 2);
        }
        if (!has_next) break;
#pragma unroll
        for (int a = 0; a < 2; ++a)
#pragma unroll
            for (int b = 0; b < 2; ++b)
#pragma unroll
                for (int m = 0; m < 4; ++m)
#pragma unroll
                    for (int n = 0; n < 2; ++n) acc[a][b][m][n] = (f32x4){0.f, 0.f, 0.f, 0.f};
        cur = nxt; cA = nA; cB = nB; ahs = ahs_n; ++ui;
        if (wr == 1) PG8_BAR;
    }
    PG8_WAIT_V(0);
    PG8_BAR;
    if constexpr (Epi::AFTER_DRAIN) { E.fused(acc, cur, wr, wc, fr, fq, lds, wid, lane); S.done(cur); }
#undef PG8_SA
#undef PG8_SB
#undef PG8_STAGE
#undef PG8_LDA
#undef PG8_LDB
#undef PG8_MMA
#undef PG8_WAIT_V
#undef PG8_WAIT_L
#undef PG8_BAR
#undef PG8_SCHED
}
}

constexpr int D = 2048, MCTX = 8192, MLAT = 4096, MTOT = 12288, FFN = 8192, ABIN = 4608, NQKV = 6144, MODW = 12288;
constexpr float EPS = 1e-6f;
constexpr size_t WS_MOD = 0;
constexpr size_t WS_BAR = 512u << 10;
constexpr size_t WS_WIN = 1u << 20;
constexpr size_t WS_WO0 = WS_WIN + (size_t)ABIN * D * 2;
constexpr size_t WS_WQKV = WS_WO0 + (size_t)D * D * 2;
constexpr size_t WS_WO1 = WS_WQKV + (size_t)NQKV * D * 2;
constexpr size_t WS_W1 = WS_WO1 + (size_t)D * D * 2;
constexpr size_t WS_W2 = WS_W1 + 2 * (size_t)FFN * D * 2;
constexpr size_t WS_XN = WS_W2 + 2 * (size_t)FFN * D * 2;
constexpr size_t WS_H = WS_XN + (size_t)MTOT * D * 2;
constexpr size_t WS_Z = WS_H;
constexpr size_t WS_AB = WS_H + (size_t)MTOT * NQKV * 2;
constexpr size_t WS_Q0 = WS_H + (size_t)MTOT * FFN * 2;
constexpr size_t WS_K0 = WS_Q0 + (size_t)MTOT * 1024 * 2;
constexpr size_t WS_V0 = WS_K0 + (size_t)(MTOT + 1024) * 256 * 2;
constexpr size_t WS_CNK = WS_V0 + (size_t)(MTOT + 1024) * 256 * 2;
constexpr size_t WS_CNV = WS_CNK + (size_t)1024 * 2048 * 2;
constexpr size_t WS_X = WS_CNV + (size_t)1024 * 2048 * 2;
constexpr size_t WS_TS = WS_X + (size_t)MTOT * D * 4;
constexpr size_t WS_END = WS_TS + (size_t)128 * 32 * 512 * 16;
constexpr size_t WS_FLAGS = WS_BAR + 16384;
static_assert(WS_TS == WS_TS_OFS && WS_FLAGS == WS_FLAGS_OFS, "early offsets");
constexpr int LDS_BYTES = 131072 + 256;

constexpr size_t OUT_YP = 0, OUT_YS = (size_t)MCTX * D, OUT_AK = OUT_YS + (size_t)MLAT * D, OUT_AV = OUT_AK + (size_t)MCTX * 256,
                 OUT_NK = OUT_AV + (size_t)MCTX * 256, OUT_NV = OUT_NK + (size_t)MCTX * D;

struct Params {
    const float* in[23];
    float* out;
    unsigned char* ws;
    int ph_lo, ph_hi;
};

template <int ACT, bool SIDE> struct EpiBf16 {
    static constexpr bool PERM = true, AFTER_DRAIN = false;
    bf16_t* O; int ldc; float* kout; float* vout; int split_tiles; size_t split_stride;
    __device__ __forceinline__ void operator()(const f32x4 (&acc)[2][2][4][2], const pg8::Unit& u, int wr, int wc, int fr, int fq, int rowofs, int nai) const {
        const int row0 = u.pm * 256 + rowofs + wr * 64 + fr, col0 = u.pn * 256 + wc * 32 + 8 * fq;
        const int spt = split_tiles ? u.pn / split_tiles : 0; bf16_t* Ob = O + (size_t)spt * split_stride; const int ocol0 = col0 - spt * split_tiles * 256;
        const bool side = SIDE && (u.pm < 32) && (u.pn >= 8);
        float* sbase = nullptr; int scol0 = 0;
        if (SIDE) { sbase = (u.pn < 16) ? kout : vout; scol0 = col0 - ((u.pn < 16) ? 2048 : 4096); }
#pragma unroll
        for (int ai = 0; ai < 2; ++ai) if (ai < nai)
#pragma unroll
            for (int m = 0; m < 4; ++m) {
                const int row = row0 + ai * 128 + m * 16;
                bf16_t* rowp = Ob + (size_t)row * ldc + ocol0;
#pragma unroll
                for (int bj = 0; bj < 2; ++bj) {
                    f32x4 v0 = acc[ai][bj][m][0], v1 = acc[ai][bj][m][1];
                    if (SIDE) { if (side) { float* sp = sbase + (size_t)row * 2048 + scol0 + bj * 128; *(f32x4*)sp = v0; *(f32x4*)(sp + 4) = v1; } }
                    if (ACT == 1) {
#pragma unroll
                        for (int j = 0; j < 4; ++j) { float a = fmaxf(v0[j], 0.f), b = fmaxf(v1[j], 0.f); v0[j] = a * a; v1[j] = b * b; }
                    }
                    u32x4 o; o.x = cvt_pk_bf16(v0[0], v0[1]); o.y = cvt_pk_bf16(v0[2], v0[3]); o.z = cvt_pk_bf16(v1[0], v1[1]); o.w = cvt_pk_bf16(v1[2], v1[3]);
                    *(u32x4*)(rowp + bj * 128) = o;
                }
            }
    }
};
struct EpiResid {
    static constexpr bool PERM = false, AFTER_DRAIN = false;
    const float* src_lo; const float* src_hi;
    float* X; const float* gate;
    __device__ __forceinline__ void operator()(const f32x4 (&acc)[2][2][4][2], const pg8::Unit& u, int wr, int wc, int fr, int fq, int rowofs, int nai) const {
        const int row0 = u.pm * 256 + rowofs + wr * 64 + fr, col0 = u.pn * 256 + wc * 32 + 4 * fq;
        const int cond = (u.pm < 32) ? 0 : 1 + ((u.pm - 32) >> 3);
        const float* gp = gate + (size_t)cond * MODW + col0;
        const float* sb = (u.pm < 32) ? src_lo : src_hi;
        f32x4 gv[2][2];
#pragma unroll
        for (int bj = 0; bj < 2; ++bj)
#pragma unroll
            for (int n = 0; n < 2; ++n) gv[bj][n] = *(const f32x4*)(gp + bj * 128 + n * 16);
#pragma unroll
        for (int ai = 0; ai < 2; ++ai) if (ai < nai)
#pragma unroll
            for (int m = 0; m < 4; ++m) {
                const size_t off = (size_t)(row0 + ai * 128 + m * 16) * D + col0;
#pragma unroll
                for (int bj = 0; bj < 2; ++bj)
#pragma unroll
                    for (int n = 0; n < 2; ++n) {
                        const f32x4 r = *(const f32x4*)(sb + off + bj * 128 + n * 16);
                        *(f32x4*)(X + off + bj * 128 + n * 16) = r + gv[bj][n] * acc[ai][bj][m][n];
                    }
            }
    }
};

__device__ __forceinline__ unsigned f2bf(float f) { unsigned u = __float_as_uint(f); return (u + 0x7fffu + ((u >> 16) & 1u)) >> 16; }
__device__ __forceinline__ unsigned pk2(float lo, float hi) { return f2bf(lo) | (f2bf(hi) << 16); }
__device__ __forceinline__ void p0_transpose_item(const float* W, int K, int N, bf16_t* WT, LAS float* scr, int item, int lane) {
    const int nblk = N / 32, kb = item / nblk, nb = item % nblk, k0 = 64 * kb, n0 = 32 * nb;
#pragma unroll 8
    for (int i = 0; i < 32; ++i) { const int kk = 2 * i + (lane >> 5); scr[kk * 33 + (lane & 31)] = W[(size_t)(k0 + kk) * N + n0 + (lane & 31)]; }
    asm volatile("s_waitcnt lgkmcnt(0)" ::: "memory");
    const int c = lane & 7;
#pragma unroll
    for (int j = 0; j < 4; ++j) { const int n = (lane >> 3) + 8 * j; const LAS float* s = scr + (8 * c) * 33 + n;
        u32x4 o; o.x = pk2(s[0 * 33], s[1 * 33]); o.y = pk2(s[2 * 33], s[3 * 33]); o.z = pk2(s[4 * 33], s[5 * 33]); o.w = pk2(s[6 * 33], s[7 * 33]);
        *(u32x4*)(WT + (size_t)(n0 + n) * K + k0 + 8 * c) = o; }
    asm volatile("s_waitcnt lgkmcnt(0)" ::: "memory");
}
__device__ __forceinline__ void cvt_linear(const float* src, bf16_t* dst, int n, int gtid, int gthreads) {
    for (int i = gtid * 4; i < n; i += gthreads * 4) { const f32x4 v = *(const f32x4*)(src + i); u32x2 o; o.x = cvt_pk_bf16(v[0], v[1]); o.y = cvt_pk_bf16(v[2], v[3]); *(u32x2*)(dst + i) = o; }
}
__device__ __forceinline__ void p0_prologue(const Params& p, LAS unsigned char* lds) {
    int tid_ = threadIdx.x; asm volatile("" : "+v"(tid_));
    const int tid = tid_, lane = tid & 63, wave = __builtin_amdgcn_readfirstlane(tid >> 6), G = gridDim.x;
    unsigned char* ws = p.ws;
    {
        LAS float* sc = (LAS float*)(lds + 69632);
        LAS float* red = (LAS float*)(lds + 69632 + 24576);
        const float* cvec = p.in[6]; const float* cctx = p.in[7];
        for (int i = tid; i < 3 * 2048; i += 512) { const int c = i >> 11, k = i & 2047; const float x = (c == 0) ? cctx[k] : cvec[(c - 1) * 2048 + k]; sc[i] = x / (1.f + __expf(-x)); }
        __syncthreads();
        float* MOD = (float*)(ws + WS_MOD);
        for (int item = blockIdx.x; item < 256; item += G) {
            const int l = item >> 7, cgp = item & 127, ln = lane < 48 ? lane : 47;
            const float* W = p.in[8] + (size_t)l * 2048 * MODW + cgp * 96 + ln * 2;
            float a00 = 0.f, a01 = 0.f, a10 = 0.f, a11 = 0.f, a20 = 0.f, a21 = 0.f;
            const int kb = wave * 256;
#pragma unroll 8
            for (int k = 0; k < 256; ++k) {
                const f32x2 w = *(const f32x2*)(W + (size_t)(kb + k) * MODW);
                const float s0 = sc[kb + k], s1 = sc[2048 + kb + k], s2 = sc[4096 + kb + k];
                a00 += s0 * w.x; a01 += s0 * w.y; a10 += s1 * w.x; a11 += s1 * w.y; a20 += s2 * w.x; a21 += s2 * w.y;
            }
            if (lane < 48) { LAS float* r = red + wave * 288 + lane * 2; r[0] = a00; r[1] = a01; r[96] = a10; r[97] = a11; r[192] = a20; r[193] = a21; }
            __syncthreads();
            if (tid < 288) { const int c = tid / 96, j = tid % 96; float s = 0.f;
#pragma unroll
                for (int w = 0; w < 8; ++w) s += red[w * 288 + tid];
                MOD[(size_t)(l * 3 + c) * MODW + cgp * 96 + j] = s + p.in[9][l * MODW + cgp * 96 + j]; }
            __syncthreads();
        }
    }
    {
        LAS float* scr = (LAS float*)(lds + wave * 8448);
        const int gw = blockIdx.x * 8 + wave, NGW = G * 8;
        constexpr int I_IN = 32 * (ABIN / 32), I_O = 32 * (D / 32), I_QKV = 32 * (NQKV / 32), I_1 = 32 * (FFN / 32), I_2 = (FFN / 64) * (D / 32);
        constexpr int NITEMS = I_IN + 2 * I_O + I_QKV + 2 * I_1 + 2 * I_2;
        for (int it = gw; it < NITEMS; it += NGW) {
            int r = it;
            if (r < I_IN) { p0_transpose_item(p.in[12], D, ABIN, (bf16_t*)(ws + WS_WIN), scr, r, lane); continue; } r -= I_IN;
            if (r < I_O) { p0_transpose_item(p.in[16], D, D, (bf16_t*)(ws + WS_WO0), scr, r, lane); continue; } r -= I_O;
            if (r < I_QKV) { p0_transpose_item(p.in[17], D, NQKV, (bf16_t*)(ws + WS_WQKV), scr, r, lane); continue; } r -= I_QKV;
            if (r < I_O) { p0_transpose_item(p.in[19], D, D, (bf16_t*)(ws + WS_WO1), scr, r, lane); continue; } r -= I_O;
            if (r < 2 * I_1) { const int l = r / I_1; p0_transpose_item(p.in[20] + (size_t)l * D * FFN, D, FFN, (bf16_t*)(ws + WS_W1) + (size_t)l * FFN * D, scr, r - l * I_1, lane); continue; } r -= 2 * I_1;
            { const int l = r / I_2; p0_transpose_item(p.in[21] + (size_t)l * D * FFN, FFN, D, (bf16_t*)(ws + WS_W2) + (size_t)l * FFN * D, scr, r - l * I_2, lane); }
        }
    }
    {
        const int gtid = blockIdx.x * 512 + tid, gth = G * 512;
        cvt_linear(p.in[2], (bf16_t*)(ws + WS_K0) + (size_t)MTOT * 256, 1024 * 256, gtid, gth);
        cvt_linear(p.in[3], (bf16_t*)(ws + WS_V0) + (size_t)MTOT * 256, 1024 * 256, gtid, gth);
        cvt_linear(p.in[4], (bf16_t*)(ws + WS_CNK), 1024 * 2048, gtid, gth);
        cvt_linear(p.in[5], (bf16_t*)(ws + WS_CNV), 1024 * 2048, gtid, gth);
    }
}

template <bool OUT_F32>
__device__ __forceinline__ void norm_phase(const float* src_lo, const float* src_hi, const float* gain, const float* mod, int shift_off, int scale_off, bf16_t* dst_bf, float* dst_f) {
    int tid_ = threadIdx.x; asm volatile("" : "+v"(tid_));
    const int tid = tid_, lane = tid & 63, wave = tid >> 6, G = gridDim.x;
    const int gw = blockIdx.x * 8 + wave, NGW = G * 8, per = (MTOT + NGW - 1) / NGW;
    const int r_beg = gw * per, r_end = (r_beg + per < MTOT) ? r_beg + per : MTOT;
    int cur = -1; f32x4 A[8], B[8];
    for (int row = r_beg; row < r_end; ++row) {
        const int cond = (row < MCTX) ? 0 : 1 + ((row - MCTX) >> 11);
        if (cond != cur) {
            cur = cond;
#pragma unroll
            for (int j = 0; j < 8; ++j) {
                const int col = 4 * lane + 256 * j; const f32x4 g = *(const f32x4*)(gain + col);
                if (mod) { const f32x4 sc = *(const f32x4*)(mod + (size_t)cond * MODW + scale_off + col); A[j] = g * (sc + 1.f); B[j] = *(const f32x4*)(mod + (size_t)cond * MODW + shift_off + col); }
                else { A[j] = g; B[j] = (f32x4){0.f, 0.f, 0.f, 0.f}; }
            }
        }
        const float* xr = ((row < MCTX) ? src_lo : src_hi) + (size_t)row * D + 4 * lane;
        f32x4 v[8]; float s = 0.f;
#pragma unroll
        for (int j = 0; j < 8; ++j) { v[j] = *(const f32x4*)(xr + 256 * j); s += (v[j].x * v[j].x + v[j].y * v[j].y) + (v[j].z * v[j].z + v[j].w * v[j].w); }
        const float rstd = rsqrtf(wave_sum(s) * (1.f / D) + EPS);
#pragma unroll
        for (int j = 0; j < 8; ++j) {
            const f32x4 y = v[j] * rstd * A[j] + B[j];
            if (OUT_F32) *(f32x4*)(dst_f + (size_t)row * D + 4 * lane + 256 * j) = y;
            else { u32x2 o; o.x = cvt_pk_bf16(y[0], y[1]); o.y = cvt_pk_bf16(y[2], y[3]); *(u32x2*)(dst_bf + (size_t)row * D + 4 * lane + 256 * j) = o; }
        }
    }
}

__device__ __forceinline__ void unpack8(const u32x4 r, float (&f)[8]) {
    f[0] = bf2f(r.x & 0xffffu); f[1] = __uint_as_float(r.x & 0xffff0000u); f[2] = bf2f(r.y & 0xffffu); f[3] = __uint_as_float(r.y & 0xffff0000u);
    f[4] = bf2f(r.z & 0xffffu); f[5] = __uint_as_float(r.z & 0xffff0000u); f[6] = bf2f(r.w & 0xffffu); f[7] = __uint_as_float(r.w & 0xffff0000u);
}
__device__ __forceinline__ void ew0_phase(const Params& p) {
    int tid_ = threadIdx.x; asm volatile("" : "+v"(tid_));
    const int tid = tid_, lane = tid & 63, wave = tid >> 6, G = gridDim.x;
    const int gw = blockIdx.x * 8 + wave, NGW = G * 8;
    unsigned char* ws = p.ws;
    const bf16_t* Z = (const bf16_t*)(ws + WS_Z);
    bf16_t* AB = (bf16_t*)(ws + WS_AB); bf16_t* Q0 = (bf16_t*)(ws + WS_Q0); bf16_t* K0 = (bf16_t*)(ws + WS_K0); bf16_t* V0 = (bf16_t*)(ws + WS_V0);
    const float* convw = p.in[13]; const float* qn = p.in[14]; const float* kn = p.in[15];
    const int ri = lane & 31, chunk = lane >> 5, da = chunk * 64 + ri, db = da + 32;
    const float inv = __builtin_amdgcn_exp2f(-(float)ri * (13.287712379549449f / 32.f));
    const float qwa = qn[da], qwb = qn[db], kwa = kn[da], kwb = kn[db];
    for (int tok = gw; tok < MTOT; tok += NGW) {
        const bool lat = tok >= MCTX;
        const int t = lat ? ((tok - MCTX) & 2047) : (tok & 255), slen = lat ? 2048 : 256;
        const bf16_t* zr = Z + (size_t)tok * ABIN;
#pragma unroll
        for (int j = 0; j < 2; ++j) {
            const int ch = j * 512 + lane * 8;
            float gb[8], acc[8];
            unpack8(*(const u32x4*)(zr + ch), gb);
#pragma unroll
            for (int e = 0; e < 8; ++e) acc[e] = 0.f;
#pragma unroll
            for (int dt = -1; dt <= 1; ++dt) {
                if (t + dt >= 0 && t + dt < slen) {
                    float gc[8], xa[8];
                    unpack8(*(const u32x4*)(zr + dt * ABIN + 1024 + ch), gc);
                    unpack8(*(const u32x4*)(zr + dt * ABIN + 2048 + ch), xa);
                    const f32x4 w0 = *(const f32x4*)(convw + (dt + 1) * 1024 + ch), w1 = *(const f32x4*)(convw + (dt + 1) * 1024 + ch + 4);
#pragma unroll
                    for (int e = 0; e < 4; ++e) { acc[e] += w0[e] * (gc[e] * xa[e]); acc[4 + e] += w1[e] * (gc[4 + e] * xa[4 + e]); }
                }
            }
            u32x4 o; o.x = cvt_pk_bf16(gb[0] * acc[0], gb[1] * acc[1]); o.y = cvt_pk_bf16(gb[2] * acc[2], gb[3] * acc[3]);
            o.z = cvt_pk_bf16(gb[4] * acc[4], gb[5] * acc[5]); o.w = cvt_pk_bf16(gb[6] * acc[6], gb[7] * acc[7]);
            *(u32x4*)(AB + (size_t)tok * D + ch) = o;
        }
        float cs = 1.f, sn = 0.f;
        if (lat) { const float pos = (float)(chunk == 0 ? (t >> 6) : (t & 63)); const float ang = pos * inv; cs = __cosf(ang); sn = __sinf(ang); }
#pragma unroll
        for (int hh = 0; hh < 10; ++hh) {
            const bf16_t* hp = zr + 3072 + hh * 128;
            const float va = bf2f(hp[da]), vb = bf2f(hp[db]);
            const float rstd = rsqrtf(wave_sum(va * va + vb * vb) * (1.f / 128.f) + EPS);
            const float na = va * rstd * (hh < 8 ? qwa : kwa), nb = vb * rstd * (hh < 8 ? qwb : kwb);
            const float ra = na * cs - nb * sn, rb = na * sn + nb * cs;
            if (hh < 8) { bf16_t* q = Q0 + (size_t)tok * 1024 + hh * 128; q[da] = (bf16_t)f2bf(ra); q[db] = (bf16_t)f2bf(rb); }
            else {
                const int kvh = hh - 8;
                bf16_t* k = K0 + (size_t)tok * 256 + kvh * 128; k[da] = (bf16_t)f2bf(ra); k[db] = (bf16_t)f2bf(rb);
                if (!lat) { float* ok = p.out + OUT_AK + (size_t)tok * 256 + kvh * 128; ok[da] = na; ok[db] = nb; }
            }
        }
        {
            const u32x2 r = *(const u32x2*)(zr + 4352 + lane * 4);
            *(u32x2*)(V0 + (size_t)tok * 256 + lane * 4) = r;
            if (!lat) { f32x4 o; o[0] = bf2f(r.x & 0xffffu); o[1] = __uint_as_float(r.x & 0xffff0000u); o[2] = bf2f(r.y & 0xffffu); o[3] = __uint_as_float(r.y & 0xffff0000u);
                *(f32x4*)(p.out + OUT_AV + (size_t)tok * 256 + lane * 4) = o; }
        }
    }
}

constexpr int KSTR = 272, VSTR = 288, LDS_KT = 0, LDS_VT = 2 * 64 * KSTR, LDS_BIAS = LDS_VT + 2 * 64 * VSTR;
constexpr float SCL2 = 0.08838834764831845f * 1.4426950408889634f, LOG2E = 1.4426950408889634f;
struct AttnArgs {
    const bf16_t* q; int qstride; int qrow0;
    bf16_t* o; int ostride;
    const bf16_t* kA; const bf16_t* vA; int strideA, ntA;
    const bf16_t* kB; const bf16_t* vB; int strideB, ntB;
    int t0, t1, role; f32x4* xs; unsigned* xf;
    int r0, krlo; const float* bias;
};
__device__ __forceinline__ v4i16_t vtr(const LAS unsigned char* p) { return __builtin_amdgcn_ds_read_tr16_b64_v4i16((LAS v4i16_t*)p); }

template <int NA>
__device__ __forceinline__ void attn_run(LAS unsigned char* lds, const AttnArgs& a) {
    int tid_ = threadIdx.x; asm volatile("" : "+v"(tid_));
    const int tid = tid_, lane = tid & 63, wave = __builtin_amdgcn_readfirstlane(tid >> 6), fr = lane & 15, fq = lane >> 4;
    bf16x8 Qf[2][4];
#pragma unroll
    for (int qb = 0; qb < 2; ++qb)
#pragma unroll
        for (int dc = 0; dc < 4; ++dc) Qf[qb][dc] = *(const bf16x8*)(a.q + (size_t)(a.qrow0 + wave * 32 + qb * 16 + fr) * a.qstride + dc * 32 + fq * 8);
    f32x4 O[2][8];
#pragma unroll
    for (int qb = 0; qb < 2; ++qb)
#pragma unroll
        for (int db = 0; db < 8; ++db) O[qb][db] = (f32x4){0.f, 0.f, 0.f, 0.f};
    float mrun[2] = {-1e30f, -1e30f}, lrun[2] = {0.f, 0.f};
    LAS float* biasL = (LAS float*)(lds + LDS_BIAS);
    if (NA) { for (int i = tid; i < 465; i += 512) biasL[i] = a.bias[i]; }
    const int lrow = tid >> 3, lch = tid & 7;
    u32x4 kr0, kr1, vr0, vr1;
#define ATT_GLOAD(t) do { const bool inA = (t) < a.ntA; const int tt = inA ? (t) : (t) - a.ntA; const int st = inA ? a.strideA : a.strideB; \
        const bf16_t* kp = (inA ? a.kA : a.kB) + (size_t)(tt * 64 + lrow) * st + lch * 8; const bf16_t* vp = (inA ? a.vA : a.vB) + (size_t)(tt * 64 + lrow) * st + lch * 8; \
        kr0 = *(const u32x4*)kp; kr1 = *(const u32x4*)(kp + 64); vr0 = *(const u32x4*)vp; vr1 = *(const u32x4*)(vp + 64); } while (0)
#define ATT_LWRITE(b) do { LAS unsigned char* kd = lds + LDS_KT + (b) * 64 * KSTR + lrow * KSTR + lch * 16; LAS unsigned char* vd = lds + LDS_VT + (b) * 64 * VSTR + lrow * VSTR + lch * 16; \
        *(LAS u32x4*)kd = kr0; *(LAS u32x4*)(kd + 128) = kr1; *(LAS u32x4*)vd = vr0; *(LAS u32x4*)(vd + 128) = vr1; } while (0)
    ATT_GLOAD(a.t0); ATT_LWRITE(a.t0 & 1); __syncthreads();
    const int rw = NA ? a.r0 + (wave >> 1) : 0;
    const int kr_lo_w = NA ? (rw - 4 < 0 ? 0 : (rw - 4 > 24 ? 24 : rw - 4)) : 0;
    for (int t = a.t0; t < a.t1; ++t) {
        if (t + 1 < a.t1) ATT_GLOAD(t + 1);
        bool active = true; int kr = 0; const bool local = NA && t >= a.ntA;
        if (local) { kr = a.krlo + (t - a.ntA); active = (kr >= kr_lo_w) && (kr < kr_lo_w + 8); }
        if (active) {
            const LAS unsigned char* Kt = lds + LDS_KT + (t & 1) * 64 * KSTR;
            const LAS unsigned char* Vt = lds + LDS_VT + (t & 1) * 64 * VSTR;
            f32x4 S[2][4];
#pragma unroll
            for (int qb = 0; qb < 2; ++qb)
#pragma unroll
                for (int kb = 0; kb < 4; ++kb) S[qb][kb] = (f32x4){0.f, 0.f, 0.f, 0.f};
#pragma unroll
            for (int kb = 0; kb < 4; ++kb)
#pragma unroll
                for (int dc = 0; dc < 4; ++dc) {
                    const bf16x8 kf = *(const LAS bf16x8*)(Kt + (kb * 16 + fr) * KSTR + dc * 64 + fq * 16);
                    S[0][kb] = __builtin_amdgcn_mfma_f32_16x16x32_bf16(kf, Qf[0][dc], S[0][kb], 0, 0, 0);
                    S[1][kb] = __builtin_amdgcn_mfma_f32_16x16x32_bf16(kf, Qf[1][dc], S[1][kb], 0, 0, 0);
                }
            bf16x8 Pf[2][2];
#pragma unroll
            for (int qb = 0; qb < 2; ++qb) {
                if (local) {
                    const int c = (wave & 1) * 32 + qb * 16 + fr;
                    const int kc0 = c - 8 < 0 ? 0 : (c - 8 > 48 ? 48 : c - 8);
                    const LAS float* brow = biasL + (kr - rw + 7) * 31 + 15 - c;
#pragma unroll
                    for (int kb = 0; kb < 4; ++kb)
#pragma unroll
                        for (int j = 0; j < 4; ++j) { const int kc = kb * 16 + 4 * fq + j; const bool ok = (kc >= kc0) && (kc < kc0 + 16);
                            const float bv = brow[ok ? kc : c];
                            S[qb][kb][j] = ok ? (S[qb][kb][j] * SCL2 + bv * LOG2E) : -1e30f; }
                } else {
#pragma unroll
                    for (int kb = 0; kb < 4; ++kb) S[qb][kb] = S[qb][kb] * SCL2;
                }
                float mx = -1e30f;
#pragma unroll
                for (int kb = 0; kb < 4; ++kb) mx = fmaxf(mx, fmaxf(fmaxf(S[qb][kb][0], S[qb][kb][1]), fmaxf(S[qb][kb][2], S[qb][kb][3])));
                mx = fmaxf(mx, __shfl_xor(mx, 16)); mx = fmaxf(mx, __shfl_xor(mx, 32));
                const float mn = fmaxf(mrun[qb], mx), alpha = __builtin_amdgcn_exp2f(mrun[qb] - mn);
                mrun[qb] = mn;
                float rs = 0.f;
#pragma unroll
                for (int kb = 0; kb < 4; ++kb)
#pragma unroll
                    for (int j = 0; j < 4; ++j) { const float pv = __builtin_amdgcn_exp2f(S[qb][kb][j] - mn); S[qb][kb][j] = pv; rs += pv; }
                lrun[qb] = lrun[qb] * alpha + rs;
#pragma unroll
                for (int db = 0; db < 8; ++db) O[qb][db] = O[qb][db] * alpha;
#pragma unroll
                for (int c2 = 0; c2 < 2; ++c2) {
                    u32x4 pk; pk.x = cvt_pk_bf16(S[qb][2 * c2][0], S[qb][2 * c2][1]); pk.y = cvt_pk_bf16(S[qb][2 * c2][2], S[qb][2 * c2][3]);
                    pk.z = cvt_pk_bf16(S[qb][2 * c2 + 1][0], S[qb][2 * c2 + 1][1]); pk.w = cvt_pk_bf16(S[qb][2 * c2 + 1][2], S[qb][2 * c2 + 1][3]);
                    Pf[qb][c2] = __builtin_bit_cast(bf16x8, pk);
                }
            }
            const LAS unsigned char* vb = Vt + (4 * fq + (fr >> 2)) * VSTR + (fr & 3) * 8;
#pragma unroll
            for (int c2 = 0; c2 < 2; ++c2)
#pragma unroll
                for (int db = 0; db < 8; ++db) {
                    const v4i16_t lo = vtr(vb + (c2 * 32) * VSTR + db * 32), hi = vtr(vb + (c2 * 32 + 16) * VSTR + db * 32);
                    bf16x8 vf; vf[0] = lo[0]; vf[1] = lo[1]; vf[2] = lo[2]; vf[3] = lo[3]; vf[4] = hi[0]; vf[5] = hi[1]; vf[6] = hi[2]; vf[7] = hi[3];
                    O[0][db] = __builtin_amdgcn_mfma_f32_16x16x32_bf16(vf, Pf[0][c2], O[0][db], 0, 0, 0);
                    O[1][db] = __builtin_amdgcn_mfma_f32_16x16x32_bf16(vf, Pf[1][c2], O[1][db], 0, 0, 0);
                }
        }
        if (t + 1 < a.t1) ATT_LWRITE((t + 1) & 1);
        __syncthreads();
    }
#undef ATT_GLOAD
#undef ATT_LWRITE
    if (a.role == 2) {
        f32x4* sp = a.xs + tid;
#pragma unroll
        for (int qb = 0; qb < 2; ++qb)
#pragma unroll
            for (int db = 0; db < 8; ++db) asm volatile("global_store_dwordx4 %0, %1, off sc1" :: "v"(sp + (qb * 8 + db) * 512), "v"(O[qb][db]) : "memory");
        const f32x4 ml = {mrun[0], mrun[1], lrun[0], lrun[1]};
        asm volatile("global_store_dwordx4 %0, %1, off sc1" :: "v"(sp + 16 * 512), "v"(ml) : "memory");
        asm volatile("s_waitcnt vmcnt(0)" ::: "memory");
        if (lane == 0) __hip_atomic_store(a.xf + wave, 1u, __ATOMIC_RELAXED, __HIP_MEMORY_SCOPE_AGENT);
        return;
    }
    if (a.role == 1) {
        unsigned spins = 0;
        while (__hip_atomic_load(a.xf + wave, __ATOMIC_RELAXED, __HIP_MEMORY_SCOPE_AGENT) == 0u) { __builtin_amdgcn_s_sleep(2); if (++spins > (1u << 22)) break; }
        __builtin_amdgcn_fence(__ATOMIC_ACQUIRE, "agent");
        asm volatile("s_waitcnt vmcnt(0)" ::: "memory");
        const f32x4* sp = a.xs + tid;
        const f32x4 ml = sp[16 * 512];
        float fa[2], fb[2];
#pragma unroll
        for (int qb = 0; qb < 2; ++qb) { const float mo = ml[qb], mn = fmaxf(mrun[qb], mo); fa[qb] = __builtin_amdgcn_exp2f(mrun[qb] - mn); fb[qb] = __builtin_amdgcn_exp2f(mo - mn); lrun[qb] = lrun[qb] * fa[qb] + ml[2 + qb] * fb[qb]; }
#pragma unroll
        for (int qb = 0; qb < 2; ++qb)
#pragma unroll
            for (int db = 0; db < 8; ++db) { const f32x4 o2 = sp[(qb * 8 + db) * 512]; O[qb][db] = O[qb][db] * fa[qb] + o2 * fb[qb]; asm volatile("" ::: "memory"); }
    }
#pragma unroll
    for (int qb = 0; qb < 2; ++qb) {
        float lt = lrun[qb]; lt += __shfl_xor(lt, 16); lt += __shfl_xor(lt, 32);
        const float il = 1.f / lt;
        bf16_t* op = a.o + (size_t)(a.qrow0 + wave * 32 + qb * 16 + fr) * a.ostride + 4 * fq;
#pragma unroll
        for (int db = 0; db < 8; ++db) { const f32x4 v = O[qb][db] * il; u32x2 o; o.x = cvt_pk_bf16(v[0], v[1]); o.y = cvt_pk_bf16(v[2], v[3]); *(u32x2*)(op + db * 16) = o; }
    }
}

__device__ __forceinline__ void attn0_phase(const Params& p, LAS unsigned char* lds) {
    unsigned char* ws = p.ws; const int G = gridDim.x;
    const bf16_t* Q0 = (const bf16_t*)(ws + WS_Q0); const bf16_t* K0 = (const bf16_t*)(ws + WS_K0); const bf16_t* V0 = (const bf16_t*)(ws + WS_V0);
    bf16_t* AB = (bf16_t*)(ws + WS_AB);
    const bool split = (G == 256);
    for (int i = blockIdx.x; i < 512; i += G) {
        AttnArgs a;
        if (i < 256) { const int it = i & 127; const int b = it >> 6, h = (it >> 3) & 7, qblk = it & 7, kvh = h >> 2;
            if (!split && i >= 128) continue;
            a.q = Q0 + h * 128; a.qstride = 1024; a.qrow0 = MCTX + b * 2048 + qblk * 256; a.o = AB + 1024 + h * 128; a.ostride = D;
            a.kA = K0 + (size_t)(MTOT + b * 512) * 256 + kvh * 128; a.vA = V0 + (size_t)(MTOT + b * 512) * 256 + kvh * 128; a.strideA = 256; a.ntA = 8;
            a.kB = K0 + (size_t)(MCTX + b * 2048) * 256 + kvh * 128; a.vB = V0 + (size_t)(MCTX + b * 2048) * 256 + kvh * 128; a.strideB = 256; a.ntB = 32;
            a.t0 = (split && i >= 128) ? 20 : 0; a.t1 = (split && i < 128) ? 20 : 40; a.role = split ? (i < 128 ? 1 : 2) : 0;
            a.xs = (f32x4*)(ws + WS_TS) + (size_t)it * (17 * 512); a.xf = (unsigned*)(ws + WS_FLAGS) + 8 * 1024 + it * 8;
        } else { const int j = i - 256, b = j >> 3, h = j & 7, kvh = h >> 2;
            a.q = Q0 + h * 128; a.qstride = 1024; a.qrow0 = b * 256; a.o = AB + 1024 + h * 128; a.ostride = D;
            a.kA = K0 + (size_t)(b * 256) * 256 + kvh * 128; a.vA = V0 + (size_t)(b * 256) * 256 + kvh * 128; a.strideA = 256; a.ntA = 4;
            a.kB = a.kA; a.vB = a.vA; a.strideB = 256; a.ntB = 0;
            a.t0 = 0; a.t1 = 4; a.role = 0; a.xs = nullptr; a.xf = nullptr;
        }
        a.r0 = 0; a.krlo = 0; a.bias = nullptr;
        attn_run<0>(lds, a);
    }
}
__device__ __forceinline__ void attn1_phase(const Params& p, LAS unsigned char* lds, bf16_t* AO) {
    unsigned char* ws = p.ws; const int G = gridDim.x;
    const bf16_t* Q1 = (const bf16_t*)(ws + WS_Z); const bf16_t* K1 = Q1 + (size_t)MTOT * D; const bf16_t* V1 = K1 + (size_t)MTOT * D;
    const bf16_t* CNK = (const bf16_t*)(ws + WS_CNK); const bf16_t* CNV = (const bf16_t*)(ws + WS_CNV);
    for (int i = blockIdx.x; i < 256; i += G) {
        AttnArgs a;
        const int b = i >> 7, h = (i >> 3) & 15, rg = i & 7, r0 = rg * 4;
        const int lo = r0 - 4 < 0 ? 0 : (r0 - 4 > 24 ? 24 : r0 - 4), hi0 = r0 - 1 < 0 ? 0 : (r0 - 1 > 24 ? 24 : r0 - 1), hi = hi0 + 7;
        a.q = Q1 + h * 128; a.qstride = D; a.qrow0 = MCTX + b * 2048 + r0 * 64; a.o = AO + h * 128; a.ostride = D;
        a.kA = CNK + (size_t)(b * 512) * 2048 + h * 128; a.vA = CNV + (size_t)(b * 512) * 2048 + h * 128; a.strideA = 2048; a.ntA = 8;
        a.kB = K1 + (size_t)(MCTX + b * 2048 + lo * 64) * D + h * 128; a.vB = V1 + (size_t)(MCTX + b * 2048 + lo * 64) * D + h * 128; a.strideB = D; a.ntB = hi - lo + 1;
        a.r0 = r0; a.krlo = lo; a.bias = p.in[18] + h * 465; a.t0 = 0; a.t1 = a.ntA + a.ntB; a.role = 0; a.xs = nullptr; a.xf = nullptr;
        attn_run<1>(lds, a);
    }
    for (int j = blockIdx.x; j < 512; j += G) {
        AttnArgs a;
        const int b = j >> 4, h = j & 15;
        a.q = Q1 + h * 128; a.qstride = D; a.qrow0 = b * 256; a.o = AO + h * 128; a.ostride = D;
        a.kA = K1 + (size_t)(b * 256) * D + h * 128; a.vA = V1 + (size_t)(b * 256) * D + h * 128; a.strideA = D; a.ntA = 4;
        a.kB = a.kA; a.vB = a.vA; a.strideB = D; a.ntB = 0;
        a.r0 = 0; a.krlo = 0; a.bias = nullptr; a.t0 = 0; a.t1 = 4; a.role = 0; a.xs = nullptr; a.xf = nullptr;
        attn_run<0>(lds, a);
    }
}

#define XB_TMO      128
#define XB_XCNT(j)  (256  + 64 * (j))
#define XB_XSUB(j)  (1280 + 64 * (j))
#define XB_XGEN(j)  (2304 + 64 * (j))
#define XB_TOP      3328
#define XB_TOPGEN   3392
#define XCD_BAR_WORDS 3456
#define XB_SPIN_CAP (1u << 18)

__device__ __forceinline__ unsigned xb_ld(unsigned* p)              { return __hip_atomic_load(p, __ATOMIC_RELAXED, __HIP_MEMORY_SCOPE_AGENT); }
__device__ __forceinline__ unsigned xb_add(unsigned* p, unsigned v) { return __hip_atomic_fetch_add(p, v, __ATOMIC_RELAXED, __HIP_MEMORY_SCOPE_AGENT); }
__device__ __forceinline__ unsigned xb_xcc_id() { return (unsigned)__builtin_amdgcn_s_getreg((3 << 11) | 20) & 0xFu; }
#define XB_SPIN(cond, bar) do { unsigned _sp = 0; while (cond) { __builtin_amdgcn_s_sleep(1); \
    if ((++_sp & 255u) == 0u) { if (xb_ld(&(bar)[XB_TMO])) break; if (_sp > XB_SPIN_CAP) { atomicAdd(&(bar)[XB_TMO], 1u); break; } } } } while (0)

struct XcdBarrier {
    unsigned* bar; unsigned x;
    volatile LAS unsigned* st;
};

__device__ __forceinline__ XcdBarrier xcd_barrier_post(unsigned* bar, volatile LAS unsigned* st) {
    XcdBarrier b; b.bar = bar; b.x = xb_xcc_id(); b.st = st;
    if (threadIdx.x == 0) (void)xb_add(&bar[XB_XCNT(b.x)], 1u);
    return b;
}
__device__ __forceinline__ void xcd_barrier_complete(unsigned* bar, unsigned x, unsigned& nloc, unsigned& nx) {
    const unsigned G = gridDim.x * gridDim.y * gridDim.z;
    unsigned sum, cnt, mine, sp = 0u;
    for (;;) {
        sum = 0u; cnt = 0u; mine = 0u;
#pragma unroll
        for (unsigned j = 0; j < 16; ++j) { const unsigned c = xb_ld(&bar[XB_XCNT(j)]); sum += c; cnt += (c > 0u) ? 1u : 0u; mine = (j == x) ? c : mine; }
        if (sum == G) break;
        __builtin_amdgcn_s_sleep(1);
        if ((++sp & 255u) == 0u) { if (xb_ld(&bar[XB_TMO])) break; if (sp > XB_SPIN_CAP) { atomicAdd(&bar[XB_TMO], 1u); break; } }
    }
    nloc = mine > 0u ? mine : 1u; nx = cnt > 0u ? cnt : 1u;
}

__device__ __forceinline__ void xcd_barrier(const XcdBarrier& b) {
    asm volatile("s_waitcnt vmcnt(0)" ::: "memory");
    __syncthreads();
    if (threadIdx.x == 0) {
        unsigned* bar = b.bar;
        __builtin_amdgcn_s_waitcnt(0);
        unsigned nloc = b.st[0], nx = b.st[1];
        if (nloc == 0u) { xcd_barrier_complete(bar, b.x, nloc, nx); b.st[0] = nloc; b.st[1] = nx; }
        const unsigned old = xb_add(&bar[XB_XSUB(b.x)], 1u);
        const unsigned gen = old / nloc;
        if (old + 1u == (gen + 1u) * nloc) {
            __builtin_amdgcn_fence(__ATOMIC_RELEASE, "agent");
            asm volatile("s_waitcnt vmcnt(0)" ::: "memory");
            const unsigned og = xb_add(&bar[XB_TOP], 1u);
            const unsigned tg = og / nx;
            if (og + 1u == (tg + 1u) * nx) xb_add(&bar[XB_TOPGEN], 1u);
            else XB_SPIN(xb_ld(&bar[XB_TOPGEN]) == tg, bar);
            __builtin_amdgcn_fence(__ATOMIC_ACQUIRE, "agent");
            xb_add(&bar[XB_XGEN(b.x)], 1u);
            asm volatile("s_waitcnt vmcnt(0)" ::: "memory");
        } else {
            XB_SPIN(xb_ld(&bar[XB_XGEN(b.x)]) == gen, bar);
            __builtin_amdgcn_fence(__ATOMIC_ACQUIRE, "agent");
            asm volatile("s_waitcnt vmcnt(0)" ::: "memory");
        }
    }
    __syncthreads();
}


constexpr int NPHASE = 18;
__global__ void __launch_bounds__(512, 2) mega_fwd(Params p) {
    extern __shared__ __attribute__((aligned(16))) unsigned char lds_raw[];
    LAS unsigned char* lds = (LAS unsigned char*)lds_raw;
    cg::grid_group grid = cg::this_grid();
    if (threadIdx.x < 64) ((LAS unsigned*)(lds + 131072))[threadIdx.x] = 0u;
    __syncthreads();
    XcdBarrier xbar = xcd_barrier_post((unsigned*)(p.ws + WS_BAR), (volatile LAS unsigned*)(lds + 131072));
    unsigned char* ws = p.ws;
    const int G = gridDim.x;
    float* MOD = (float*)(ws + WS_MOD);
    bf16_t* XN = (bf16_t*)(ws + WS_XN); float* X = (float*)(ws + WS_X);
    bf16_t* Z = (bf16_t*)(ws + WS_Z); bf16_t* AB = (bf16_t*)(ws + WS_AB); bf16_t* H = (bf16_t*)(ws + WS_H);
#define RUN(k) (p.ph_lo <= (k) && (k) < p.ph_hi)
#define GRID_SYNC_CG() do { asm volatile("s_waitcnt vmcnt(0) lgkmcnt(0)" ::: "memory"); grid.sync(); __builtin_amdgcn_fence(__ATOMIC_ACQUIRE, "agent"); asm volatile("s_waitcnt vmcnt(0)" ::: "memory"); } while (0)
#define GRID_SYNC() do { xcd_barrier(xbar); } while (0)
#define REPEAT(n, stmt) do { for (int rep_ = 0; rep_ < (n); ++rep_) { stmt; if (rep_ + 1 < (n)) GRID_SYNC(); } } while (0)
#define SEAM(k) do { if (p.ph_lo <= (k) && (k) + 1 < p.ph_hi) GRID_SYNC(); } while (0)
    if (RUN(0)) REPEAT(REP_P0, p0_prologue(p, lds));
    if (p.ph_lo <= 0 && 1 < p.ph_hi) GRID_SYNC_CG();
    for (int l = 0; l < 2; ++l) {
        const int k0 = 1 + 8 * l;
        const float* modl = MOD + (size_t)l * 3 * MODW;
        const float* xin_lo = (l == 0) ? p.in[0] : X;
        const float* xin_hi = (l == 0) ? p.in[1] - (size_t)MCTX * D : X;
        if (RUN(k0)) REPEAT(REP_NORM, norm_phase<false>(xin_lo, xin_hi, p.in[10] + l * D, modl, 0, D, XN, nullptr));
        SEAM(k0);
        if (RUN(k0 + 1)) for (int repg_ = 0; repg_ < REP_G; ++repg_) {
            if (repg_) GRID_SYNC();
            if (l == 0) { pg8::Gemm g{XN, (const bf16_t*)(ws + WS_WIN), MTOT, ABIN, D}; pg8::StaticOrder S; S.init(MTOT, ABIN, G, (int)blockIdx.x, D, ws, -2);
                EpiBf16<0, false> E{Z, ABIN, nullptr, nullptr, 0, 0}; pg8::gemm_phase(lds, g, S, E); }
            else { pg8::Gemm g{XN, (const bf16_t*)(ws + WS_WQKV), MTOT, NQKV, D}; pg8::StaticOrder S; S.init(MTOT, NQKV, G, (int)blockIdx.x, D, ws, -2);
                EpiBf16<0, true> E{Z, D, p.out + OUT_NK, p.out + OUT_NV, 8, (size_t)MTOT * D}; pg8::gemm_phase(lds, g, S, E); }
        }
        SEAM(k0 + 1);
        if (l == 0) { if (RUN(k0 + 2)) REPEAT(REP_EW, ew0_phase(p)); SEAM(k0 + 2); }
        if (RUN(k0 + 3)) REPEAT(REP_ATT, if (l == 0) attn0_phase(p, lds); else attn1_phase(p, lds, AB));
        SEAM(k0 + 3);
        if (RUN(k0 + 4)) { pg8::Gemm g{AB, (const bf16_t*)(ws + (l == 0 ? WS_WO0 : WS_WO1)), MTOT, D, D}; pg8::StaticOrder S; S.init(MTOT, D, G, (int)blockIdx.x, D, ws, -2);
            EpiResid E{xin_lo, xin_hi, X, modl + 2 * D}; pg8::gemm_phase(lds, g, S, E); }
        SEAM(k0 + 4);
        if (RUN(k0 + 5)) REPEAT(REP_NORM, norm_phase<false>(X, X, p.in[11] + l * D, modl, 3 * D, 4 * D, XN, nullptr));
        SEAM(k0 + 5);
        if (RUN(k0 + 6)) for (int repg_ = 0; repg_ < REP_G; ++repg_) { if (repg_) GRID_SYNC(); pg8::Gemm g{XN, (const bf16_t*)(ws + WS_W1) + (size_t)l * FFN * D, MTOT, FFN, D}; pg8::StaticOrder S; S.init(MTOT, FFN, G, (int)blockIdx.x, D, ws, -1);
            EpiBf16<1, false> E{H, FFN, nullptr, nullptr, 0, 0}; pg8::gemm_phase(lds, g, S, E); }
        SEAM(k0 + 6);
        if (RUN(k0 + 7)) { pg8::Gemm g{H, (const bf16_t*)(ws + WS_W2) + (size_t)l * FFN * D, MTOT, D, FFN}; pg8::StaticOrder S; S.init(MTOT, D, G, (int)blockIdx.x, FFN, ws, (l * 4 + 3) * 1024);
            EpiResid E{X, X, X, modl + 5 * D}; pg8::gemm_phase(lds, g, S, E); }
        SEAM(k0 + 7);
    }
#if PROBE_STOP > 0
    GRID_SYNC();
    {
        const size_t n = (size_t)MTOT * D, gt = (size_t)blockIdx.x * 512 + threadIdx.x, gs = (size_t)G * 512;
        const bf16_t* sb = PROBE_SRC == 1 ? XN : PROBE_SRC == 2 ? AB : PROBE_SRC == 3 ? Z : PROBE_SRC == 5 ? Z + (size_t)4096 * NQKV : (const bf16_t*)(ws + WS_Q0);
#if PROBE_SRC == 6
        attn1_phase(p, lds, XN);
        GRID_SYNC();
        for (size_t i = gt; i < n; i += gs) p.out[i] = bf2f(AB[i]) - bf2f(XN[i]);
#else
        for (size_t i = gt; i < n; i += gs) p.out[i] = (PROBE_SRC == 0) ? X[i] : bf2f(sb[i]);
#endif
#if PROBE_STOP < 4
        for (size_t i = gt; i < (size_t)2 * MCTX * 256; i += gs) p.out[OUT_AK + i] = 0.f;
#endif
        for (size_t i = gt; i < (size_t)2 * MCTX * D; i += gs) p.out[OUT_NK + i] = 0.f;
    }
#else
    if (RUN(17)) REPEAT(REP_NORM, norm_phase<true>(X, X, p.in[22], nullptr, 0, 0, nullptr, p.out));
#endif
#undef RUN
#undef SEAM
#undef REPEAT
#undef GRID_SYNC
#undef GRID_SYNC_CG
}

extern "C" void kernel_launch(void* const* d_in, const int* in_sizes, int n_in, void* d_out, int out_size, void* d_ws, size_t ws_size, hipStream_t stream) {
    static int grid = 0;
    if (grid == 0) {
        if (n_in != 23 || ws_size < WS_END) { fprintf(stderr, "kernel_launch: expected 23 inputs and >= %zu bytes of workspace (got %d, %zu)\n", (size_t)WS_END, n_in, ws_size); grid = -1; return; }
        int dev = 0, cus = 0, per_cu = 0;
        (void)hipGetDevice(&dev);
        (void)hipDeviceGetAttribute(&cus, hipDeviceAttributeMultiprocessorCount, dev);
        if (hipFuncSetAttribute((const void*)mega_fwd, hipFuncAttributeMaxDynamicSharedMemorySize, LDS_BYTES) != hipSuccess) { fprintf(stderr, "kernel_launch: hipFuncSetAttribute failed\n"); grid = -1; return; }
        if (hipOccupancyMaxActiveBlocksPerMultiprocessor(&per_cu, (const void*)mega_fwd, 512, LDS_BYTES) != hipSuccess || per_cu < 1) { fprintf(stderr, "kernel_launch: occupancy query failed (%d)\n", per_cu); grid = -1; return; }
        grid = cus * (per_cu > 1 ? 1 : per_cu);
        fprintf(stderr, "kernel_launch: grid %d (cus %d, per_cu %d)\n", grid, cus, per_cu);
    }
    if (grid < 0) return;
    (void)hipMemsetAsync((char*)d_ws + WS_BAR, 0, 65536, stream);
    Params p{};
    for (int i = 0; i < 23; ++i) p.in[i] = (const float*)d_in[i];
    p.out = (float*)d_out; p.ws = (unsigned char*)d_ws;
#if MK_PER_PHASE
    for (int k = 0; k < NPHASE; ++k) {
        if (k == 11) continue;
        p.ph_lo = k; p.ph_hi = k + 1;
        void* args[] = {&p};
        hipError_t e = hipLaunchCooperativeKernel((const void*)mega_fwd, dim3(grid), dim3(512), args, LDS_BYTES, stream);
        if (e != hipSuccess) { fprintf(stderr, "launch %d failed: %s\n", k, hipGetErrorString(e)); break; }
    }
#else
    p.ph_lo = 0; p.ph_hi = PROBE_STOP > 0 ? PROBE_STOP : NPHASE;
    void* args[] = {&p};
    hipError_t e = hipLaunchCooperativeKernel((const void*)mega_fwd, dim3(grid), dim3(512), args, LDS_BYTES, stream);
    if (e != hipSuccess) fprintf(stderr, "cooperative launch failed: %s (grid %d)\n", hipGetErrorString(e), grid);
#endif
}
```

```cpp
#include <hip/hip_runtime.h>
#include <hip/hip_cooperative_groups.h>
#include <cstdio>
#include <cstdint>
namespace cg = cooperative_groups;

#ifndef MK_PER_PHASE
#define MK_PER_PHASE 0
#endif

#ifndef REP_NG
#define REP_NG 1
#endif
#ifndef REP_P0
#define REP_P0 REP_NG
#endif
#ifndef REP_NORM
#define REP_NORM REP_NG
#endif
#ifndef REP_EW
#define REP_EW REP_NG
#endif
#ifndef REP_ATT
#define REP_ATT REP_NG
#endif
#ifndef REP_G
#define REP_G 1
#endif
#ifndef PROBE_STOP
#define PROBE_STOP 0
#endif
#ifndef PROBE_SRC
#define PROBE_SRC 0
#endif
#define LAS __attribute__((address_space(3)))
#define PG8_LAS __attribute__((address_space(3)))
typedef unsigned short bf16_t;
typedef short bf16x8 __attribute__((ext_vector_type(8)));
typedef short v4i16_t __attribute__((ext_vector_type(4)));
typedef float f32x4 __attribute__((ext_vector_type(4)));
typedef float f32x2 __attribute__((ext_vector_type(2)));
typedef unsigned u32x4 __attribute__((ext_vector_type(4)));
typedef unsigned u32x2 __attribute__((ext_vector_type(2)));

__device__ __forceinline__ float bf2f(unsigned h) { return __uint_as_float(h << 16); }
typedef __bf16 bf16x2_t __attribute__((ext_vector_type(2)));
__device__ __forceinline__ unsigned cvt_pk_bf16(float lo, float hi) { f32x2 v = {lo, hi}; bf16x2_t r = __builtin_convertvector(v, bf16x2_t); return __builtin_bit_cast(unsigned, r); }
__device__ __forceinline__ float wave_sum(float v) {
#pragma unroll
    for (int o = 1; o < 64; o <<= 1) v += __shfl_xor(v, o);
    return v;
}

constexpr size_t WS_TS_OFS = 595591168ull;
constexpr size_t WS_FLAGS_OFS = (512u << 10) + 16384;
namespace pg8 {
constexpr int BM = 256, BK = 64, HALF = 128, HTB = HALF * BK * 2  , STAGE_BYTES = 8 * HTB, NXCD = 8, WGM = 4;

__host__ __device__ __forceinline__ int lds_byte(int r, int c) { const int st = (r >> 4) * 2 + (c >> 5), rr = r & 15, cc = c & 31, ob = rr * 64 + cc * 2; return st * 1024 + (ob ^ (((ob >> 9) & 1) << 5)); }
__host__ __device__ __forceinline__ void stage_rc(int b, int& R, int& C) { const int st = b / 1024, sb = b % 1024, swz = sb ^ (((sb >> 9) & 1) << 5); R = (st >> 1) * 16 + swz / 64; C = (st & 1) * 32 + (swz % 64) / 2; }
__host__ __device__ __forceinline__ int perm32(int rho) { const int n = rho >> 4, i = rho & 15; return 8 * (i >> 2) + 4 * n + (i & 3); }
struct Unit { int pm, pn, code; };
struct Gemm { const bf16_t* A; const bf16_t* Bt; int M, N, K; };
struct StaticOrder {
    int nM, nN, nwg, G, c, ntk, R, tail, fofs, msplit; unsigned char* wsb;
    __device__ __forceinline__ int kt0(const Unit& u) const { return (u.code & 3) == 2 ? (ntk >> 1) : 0; }
    __device__ __forceinline__ int nkt(const Unit& u) const { return ((u.code & 3) == 1 || (u.code & 3) == 2) ? (ntk >> 1) : ntk; }
    __host__ __device__ void init(int M, int N, int G_, int c_, int K, unsigned char* wsb_, int fofs_) {
        nM = M / BM; nN = N / BM; nwg = nM * nN; G = G_; c = c_; ntk = K / BK; wsb = wsb_; fofs = fofs_; msplit = (fofs_ == -2);
        R = nwg / G; tail = nwg - R * G;
        if (fofs_ == -1 || 2 * tail > G || (ntk & 3)) tail = 0;
    }
    __host__ __device__ bool next(int i, Unit& u) const {
        long L;
        if (tail) {
            if (i < R) { L = (long)i * G + c; u.code = 0; }
            else if (i == R && c < 2 * tail) { L = (long)R * G + (c >> 1); u.code = msplit ? (3 | ((c & 1) << 2)) : ((1 + (c & 1)) | ((c >> 1) << 2)); }
            else return false;
        } else { L = (long)i * G + c; if (L >= nwg) return false; u.code = 0; }
        int wgid = (int)L; { const int q = nwg / NXCD, r = nwg % NXCD, xcd = wgid % NXCD, off = wgid / NXCD; wgid = (xcd < r ? xcd * (q + 1) : r * (q + 1) + (xcd - r) * q) + off; }
        const int nig = WGM * nN, gid = wgid / nig, fm = gid * WGM, gsz = (nM - fm) < WGM ? (nM - fm) : WGM;
        u.pm = fm + ((wgid % nig) % gsz); u.pn = (wgid % nig) / gsz; return true;
    }
    __device__ __forceinline__ void a_ready(const Unit&) const {}
    __device__ __forceinline__ void done(const Unit&) const {}
};
template <class Epi, class Sched>
__device__ __forceinline__ void gemm_phase(PG8_LAS unsigned char* lds, const Gemm g, const Sched& S, const Epi& E) {
    int tid_ = threadIdx.x; asm volatile("" : "+v"(tid_));
    const int tid = tid_, wid = __builtin_amdgcn_readfirstlane(tid >> 6), lane = tid & 63, wr = wid >> 2, wc = wid & 3, fr = lane & 15, fq = lane >> 4;
    const int K = g.K;
    unsigned voffA[2], voffB[2];
#pragma unroll
    for (int i = 0; i < 2; ++i) { int R, C; stage_rc(tid * 16 + i * 8192, R, C); const int Rb = Epi::PERM ? ((R & ~31) + perm32(R & 31)) : R;
        voffA[i] = (unsigned)(R * K + C) * 2u; voffB[i] = (unsigned)(Rb * K + C) * 2u; }
    const size_t kstep = (size_t)(BK * 2);
    const size_t hstep = (size_t)HALF * K * 2;
    const size_t tstep = 2 * hstep;
    const unsigned ldsw = (unsigned)wid * 1024u;
    const int aoff = lds_byte(wr * 64 + fr, fq * 8), boff = lds_byte(wc * 32 + fr, fq * 8);
#define PG8_SA(b, h) (((b) * 2 + (h)) * HTB)
#define PG8_SB(b, h) ((4 + (b) * 2 + (h)) * HTB)
#define PG8_STAGE(bufoff, gbase, voff) do { _Pragma("unroll") for (int _i = 0; _i < 2; ++_i) \
        __builtin_amdgcn_global_load_lds((const unsigned*)((const char*)(gbase) + (voff)[_i]), (PG8_LAS unsigned*)(lds + (bufoff) + ldsw + _i * 8192), 16, 0, 0); } while (0)
#define PG8_LDA(dst, b, h) do { _Pragma("unroll") for (int m = 0; m < 4; ++m) _Pragma("unroll") for (int k = 0; k < 2; ++k) dst[m][k] = *(const PG8_LAS bf16x8*)(lds + PG8_SA(b, h) + aoff + m * 2048 + k * 1024); } while (0)
#define PG8_LDB(dst, b, h) do { _Pragma("unroll") for (int n = 0; n < 2; ++n) _Pragma("unroll") for (int k = 0; k < 2; ++k) dst[n][k] = *(const PG8_LAS bf16x8*)(lds + PG8_SB(b, h) + boff + n * 2048 + k * 1024); } while (0)
#define PG8_MMA(ai, bj, At, Bt) do { __builtin_amdgcn_s_setprio(1); _Pragma("unroll") for (int m = 0; m < 4; ++m) _Pragma("unroll") for (int n = 0; n < 2; ++n) _Pragma("unroll") for (int k = 0; k < 2; ++k) \
        acc[ai][bj][m][n] = __builtin_amdgcn_mfma_f32_16x16x32_bf16(Bt[n][k], At[m][k], acc[ai][bj][m][n], 0, 0, 0); __builtin_amdgcn_s_setprio(0); } while (0)
#define PG8_WAIT_V(n) asm volatile("s_waitcnt vmcnt(" #n ")" ::: "memory")
#define PG8_WAIT_L(n) asm volatile("s_waitcnt lgkmcnt(" #n ")" ::: "memory")
#define PG8_BAR __builtin_amdgcn_s_barrier()
#define PG8_SCHED __builtin_amdgcn_sched_barrier(0)
    Unit cur, nxt; int ui = 0;
    if (!S.next(0, cur)) return;
    f32x4 acc[2][2][4][2];
#pragma unroll
    for (int a = 0; a < 2; ++a)
#pragma unroll
        for (int b = 0; b < 2; ++b)
#pragma unroll
            for (int m = 0; m < 4; ++m)
#pragma unroll
                for (int n = 0; n < 2; ++n) acc[a][b][m][n] = (f32x4){0.f, 0.f, 0.f, 0.f};
    bf16x8 At[4][2], B0[2][2], B1[2][2];
    const char* cA = (const char*)g.A + (size_t)cur.pm * tstep + (size_t)S.kt0(cur) * kstep; const char* cB = (const char*)g.Bt + (size_t)cur.pn * tstep + (size_t)S.kt0(cur) * kstep;
    S.a_ready(cur);
    if ((cur.code & 3) == 3) cA += (size_t)(cur.code >> 2) * hstep;
    size_t ahs = (cur.code & 3) == 3 ? 0 : hstep;
    PG8_STAGE(PG8_SB(0, 0), cB, voffB); PG8_STAGE(PG8_SB(0, 1), cB + hstep, voffB); PG8_STAGE(PG8_SA(0, 0), cA, voffA); PG8_STAGE(PG8_SA(0, 1), cA + ahs, voffA);
    if (wr == 1) PG8_BAR;
    PG8_WAIT_V(2); PG8_BAR;
    PG8_STAGE(PG8_SB(1, 0), cB + kstep, voffB); PG8_STAGE(PG8_SA(1, 0), cA + kstep, voffA); PG8_STAGE(PG8_SB(1, 1), cB + hstep + kstep, voffB);
    PG8_WAIT_V(6); PG8_BAR;
    for (;;) {
        const bool has_next = S.next(ui + 1, nxt);
        const char* nA = has_next ? (const char*)g.A + (size_t)nxt.pm * tstep + (size_t)S.kt0(nxt) * kstep : cA; const char* nB = has_next ? (const char*)g.Bt + (size_t)nxt.pn * tstep + (size_t)S.kt0(nxt) * kstep : cB;
        const int nt = S.nkt(cur);
        const bool full = (cur.code & 3) != 3;
        const size_t ahs_n = (has_next && (nxt.code & 3) == 3) ? 0 : (has_next ? hstep : ahs);
        if (has_next && (nxt.code & 3) == 3) nA += (size_t)(nxt.code >> 2) * hstep;
        for (int t = 0; t < nt; t += 2) {
            const bool last = (t == nt - 2);
            const char* a1 = cA + (size_t)(t + 1) * kstep;
            const char* a2 = last ? nA : cA + (size_t)(t + 2) * kstep; const char* b2 = last ? nB : cB + (size_t)(t + 2) * kstep;
            const char* a3 = a2 + kstep; const char* b3 = b2 + kstep;
            if (last && has_next) S.a_ready(nxt);
            PG8_LDB(B0, 0, 0); PG8_LDB(B1, 0, 1); PG8_SCHED; PG8_LDA(At, 0, 0); PG8_STAGE(PG8_SA(1, 1), a1 + ahs, voffA);
            PG8_WAIT_V(8); PG8_WAIT_L(0); PG8_BAR; PG8_MMA(0, 0, At, B0); PG8_MMA(0, 1, At, B1); PG8_BAR; PG8_SCHED;
            PG8_LDA(At, 0, 1); PG8_STAGE(PG8_SB(0, 0), b2, voffB); PG8_STAGE(PG8_SB(0, 1), b2 + hstep, voffB); PG8_STAGE(PG8_SA(0, 0), a2, voffA);
            PG8_WAIT_V(8); PG8_WAIT_L(0); PG8_BAR; if (full) { PG8_MMA(1, 0, At, B0); PG8_MMA(1, 1, At, B1); } PG8_BAR; PG8_SCHED;
            PG8_LDB(B0, 1, 0); PG8_LDB(B1, 1, 1); PG8_SCHED; PG8_LDA(At, 1, 0); PG8_STAGE(PG8_SA(0, 1), a2 + (last ? ahs_n : ahs), voffA);
            PG8_WAIT_V(8); PG8_WAIT_L(0); PG8_BAR; PG8_MMA(0, 0, At, B0); PG8_MMA(0, 1, At, B1); PG8_BAR; PG8_SCHED;
            PG8_LDA(At, 1, 1); PG8_STAGE(PG8_SB(1, 0), b3, voffB); PG8_STAGE(PG8_SB(1, 1), b3 + hstep, voffB); PG8_STAGE(PG8_SA(1, 0), a3, voffA);
            PG8_WAIT_V(8); PG8_WAIT_L(0); PG8_BAR; if (full) { PG8_MMA(1, 0, At, B0); PG8_MMA(1, 1, At, B1); } PG8_BAR; PG8_SCHED;
        }
        if (wr == 0) PG8_BAR;
        const int role = cur.code & 3, slot = cur.code >> 2;
        if (role == 2) {
            f32x4* sp = (f32x4*)(S.wsb + WS_TS_OFS + (size_t)((S.fofs >> 12) + 1) * 33554432u) + (size_t)slot * (32 * 512) + tid;
#pragma unroll
            for (int a = 0; a < 2; ++a)
#pragma unroll
                for (int b = 0; b < 2; ++b)
#pragma unroll
                    for (int m = 0; m < 4; ++m)
#pragma unroll
                        for (int n = 0; n < 2; ++n) asm volatile("global_store_dwordx4 %0, %1, off sc1" :: "v"(sp + (((a * 2 + b) * 4 + m) * 2 + n) * 512), "v"(acc[a][b][m][n]) : "memory");
            asm volatile("s_waitcnt vmcnt(0)" ::: "memory");
            if (lane == 0) __hip_atomic_store((unsigned*)(S.wsb + WS_FLAGS_OFS) + S.fofs + slot * 8 + wid, 1u, __ATOMIC_RELAXED, __HIP_MEMORY_SCOPE_AGENT);
        } else {
            if (role == 1) {
                unsigned spins = 0;
                while (__hip_atomic_load((unsigned*)(S.wsb + WS_FLAGS_OFS) + S.fofs + slot * 8 + wid, __ATOMIC_RELAXED, __HIP_MEMORY_SCOPE_AGENT) == 0u) { __builtin_amdgcn_s_sleep(2); if (++spins > (1u << 22)) break; }
                __builtin_amdgcn_fence(__ATOMIC_ACQUIRE, "agent");
                asm volatile("s_waitcnt vmcnt(0)" ::: "memory");
                const f32x4* sp = (const f32x4*)(S.wsb + WS_TS_OFS + (size_t)((S.fofs >> 12) + 1) * 33554432u) + (size_t)slot * (32 * 512) + tid;
#pragma unroll
                for (int a = 0; a < 2; ++a)
#pragma unroll
                    for (int b = 0; b < 2; ++b)
#pragma unroll
                        for (int m = 0; m < 4; ++m)
#pragma unroll
                            for (int n = 0; n < 2; ++n) { acc[a][b][m][n] += sp[(((a * 2 + b) * 4 + m) * 2 + n) * 512]; asm volatile("" ::: "memory"); }
            }
            E(acc, cur, wr, wc, fr, fq, role == 3 ? slot * 128 : 0, role == 3 ? 1 : 2);
        }
        if (!has_next) break;
#pragma unroll
        for (int a = 0; a < 2; ++a)
#pragma unroll
            for (int b = 0; b < 2; ++b)
#pragma unroll
                for (int m = 0; m < 4; ++m)
#pragma unroll
                    for (int n = 0; n < 2; ++n) acc[a][b][m][n] = (f32x4){0.f, 0.f, 0.f, 0.f};
        cur = nxt; cA = nA; cB = nB; ahs = ahs_n; ++ui;
        if (wr == 1) PG8_BAR;
    }
    PG8_WAIT_V(0);
    PG8_BAR;
    if constexpr (Epi::AFTER_DRAIN) { E.fused(acc, cur, wr, wc, fr, fq, lds, wid, lane); S.done(cur); }
#undef PG8_SA
#undef PG8_SB
#undef PG8_STAGE
#undef PG8_LDA
#undef PG8_LDB
#undef PG8_MMA
#undef PG8_WAIT_V
#undef PG8_WAIT_L
#undef PG8_BAR
#undef PG8_SCHED
}
}

constexpr int D = 2048, MCTX = 8192, MLAT = 4096, MTOT = 12288, FFN = 8192, ABIN = 4608, NQKV = 6144, MODW = 12288;
constexpr float EPS = 1e-6f;
constexpr size_t WS_MOD = 0;
constexpr size_t WS_BAR = 512u << 10;
constexpr size_t WS_WIN = 1u << 20;
constexpr size_t WS_WO0 = WS_WIN + (size_t)ABIN * D * 2;
constexpr size_t WS_WQKV = WS_WO0 + (size_t)D * D * 2;
constexpr size_t WS_WO1 = WS_WQKV + (size_t)NQKV * D * 2;
constexpr size_t WS_W1 = WS_WO1 + (size_t)D * D * 2;
constexpr size_t WS_W2 = WS_W1 + 2 * (size_t)FFN * D * 2;
constexpr size_t WS_XN = WS_W2 + 2 * (size_t)FFN * D * 2;
constexpr size_t WS_H = WS_XN + (size_t)MTOT * D * 2;
constexpr size_t WS_Z = WS_H;
constexpr size_t WS_AB = WS_H + (size_t)MTOT * NQKV * 2;
constexpr size_t WS_Q0 = WS_H + (size_t)MTOT * FFN * 2;
constexpr size_t WS_K0 = WS_Q0 + (size_t)MTOT * 1024 * 2;
constexpr size_t WS_V0 = WS_K0 + (size_t)(MTOT + 1024) * 256 * 2;
constexpr size_t WS_CNK = WS_V0 + (size_t)(MTOT + 1024) * 256 * 2;
constexpr size_t WS_CNV = WS_CNK + (size_t)1024 * 2048 * 2;
constexpr size_t WS_X = WS_CNV + (size_t)1024 * 2048 * 2;
constexpr size_t WS_TS = WS_X + (size_t)MTOT * D * 4;
constexpr size_t WS_END = WS_TS + 3 * (size_t)128 * 32 * 512 * 16;
constexpr size_t WS_FLAGS = WS_BAR + 16384;
static_assert(WS_TS == WS_TS_OFS && WS_FLAGS == WS_FLAGS_OFS, "early offsets");
constexpr int LDS_BYTES = 131072 + 256;

constexpr size_t OUT_YP = 0, OUT_YS = (size_t)MCTX * D, OUT_AK = OUT_YS + (size_t)MLAT * D, OUT_AV = OUT_AK + (size_t)MCTX * 256,
                 OUT_NK = OUT_AV + (size_t)MCTX * 256, OUT_NV = OUT_NK + (size_t)MCTX * D;

struct Params {
    const float* in[23];
    float* out;
    unsigned char* ws;
    int ph_lo, ph_hi;
};

template <int ACT, bool SIDE> struct EpiBf16 {
    static constexpr bool PERM = true, AFTER_DRAIN = false;
    bf16_t* O; int ldc; float* kout; float* vout; int split_tiles; size_t split_stride;
    __device__ __forceinline__ void operator()(const f32x4 (&acc)[2][2][4][2], const pg8::Unit& u, int wr, int wc, int fr, int fq, int rowofs, int nai) const {
        const int row0 = u.pm * 256 + rowofs + wr * 64 + fr, col0 = u.pn * 256 + wc * 32 + 8 * fq;
        const int spt = split_tiles ? u.pn / split_tiles : 0; bf16_t* Ob = O + (size_t)spt * split_stride; const int ocol0 = col0 - spt * split_tiles * 256;
        const bool side = SIDE && (u.pm < 32) && (u.pn >= 8);
        float* sbase = nullptr; int scol0 = 0;
        if (SIDE) { sbase = (u.pn < 16) ? kout : vout; scol0 = col0 - ((u.pn < 16) ? 2048 : 4096); }
#pragma unroll
        for (int ai = 0; ai < 2; ++ai) if (ai < nai)
#pragma unroll
            for (int m = 0; m < 4; ++m) {
                const int row = row0 + ai * 128 + m * 16;
                bf16_t* rowp = Ob + (size_t)row * ldc + ocol0;
#pragma unroll
                for (int bj = 0; bj < 2; ++bj) {
                    f32x4 v0 = acc[ai][bj][m][0], v1 = acc[ai][bj][m][1];
                    if (SIDE) { if (side) { float* sp = sbase + (size_t)row * 2048 + scol0 + bj * 128; *(f32x4*)sp = v0; *(f32x4*)(sp + 4) = v1; } }
                    if (ACT == 1) {
#pragma unroll
                        for (int j = 0; j < 4; ++j) { float a = fmaxf(v0[j], 0.f), b = fmaxf(v1[j], 0.f); v0[j] = a * a; v1[j] = b * b; }
                    }
                    u32x4 o; o.x = cvt_pk_bf16(v0[0], v0[1]); o.y = cvt_pk_bf16(v0[2], v0[3]); o.z = cvt_pk_bf16(v1[0], v1[1]); o.w = cvt_pk_bf16(v1[2], v1[3]);
                    *(u32x4*)(rowp + bj * 128) = o;
                }
            }
    }
};
struct EpiResid {
    static constexpr bool PERM = false, AFTER_DRAIN = false;
    const float* src_lo; const float* src_hi;
    float* X; const float* gate;
    __device__ __forceinline__ void operator()(const f32x4 (&acc)[2][2][4][2], const pg8::Unit& u, int wr, int wc, int fr, int fq, int rowofs, int nai) const {
        const int row0 = u.pm * 256 + rowofs + wr * 64 + fr, col0 = u.pn * 256 + wc * 32 + 4 * fq;
        const int cond = (u.pm < 32) ? 0 : 1 + ((u.pm - 32) >> 3);
        const float* gp = gate + (size_t)cond * MODW + col0;
        const float* sb = (u.pm < 32) ? src_lo : src_hi;
        f32x4 gv[2][2];
#pragma unroll
        for (int bj = 0; bj < 2; ++bj)
#pragma unroll
            for (int n = 0; n < 2; ++n) gv[bj][n] = *(const f32x4*)(gp + bj * 128 + n * 16);
#pragma unroll
        for (int ai = 0; ai < 2; ++ai) if (ai < nai)
#pragma unroll
            for (int m = 0; m < 4; ++m) {
                const size_t off = (size_t)(row0 + ai * 128 + m * 16) * D + col0;
#pragma unroll
                for (int bj = 0; bj < 2; ++bj)
#pragma unroll
                    for (int n = 0; n < 2; ++n) {
                        const f32x4 r = *(const f32x4*)(sb + off + bj * 128 + n * 16);
                        *(f32x4*)(X + off + bj * 128 + n * 16) = r + gv[bj][n] * acc[ai][bj][m][n];
                    }
            }
    }
};

__device__ __forceinline__ unsigned f2bf(float f) { unsigned u = __float_as_uint(f); return (u + 0x7fffu + ((u >> 16) & 1u)) >> 16; }
__device__ __forceinline__ unsigned pk2(float lo, float hi) { return f2bf(lo) | (f2bf(hi) << 16); }
__device__ __forceinline__ void p0_transpose_item(const float* W, int K, int N, bf16_t* WT, LAS float* scr, int item, int lane) {
    const int nblk = N / 32, kb = item / nblk, nb = item % nblk, k0 = 64 * kb, n0 = 32 * nb;
#pragma unroll 8
    for (int i = 0; i < 32; ++i) { const int kk = 2 * i + (lane >> 5); scr[kk * 33 + (lane & 31)] = W[(size_t)(k0 + kk) * N + n0 + (lane & 31)]; }
    asm volatile("s_waitcnt lgkmcnt(0)" ::: "memory");
    const int c = lane & 7;
#pragma unroll
    for (int j = 0; j < 4; ++j) { const int n = (lane >> 3) + 8 * j; const LAS float* s = scr + (8 * c) * 33 + n;
        u32x4 o; o.x = pk2(s[0 * 33], s[1 * 33]); o.y = pk2(s[2 * 33], s[3 * 33]); o.z = pk2(s[4 * 33], s[5 * 33]); o.w = pk2(s[6 * 33], s[7 * 33]);
        *(u32x4*)(WT + (size_t)(n0 + n) * K + k0 + 8 * c) = o; }
    asm volatile("s_waitcnt lgkmcnt(0)" ::: "memory");
}
__device__ __forceinline__ void cvt_linear(const float* src, bf16_t* dst, int n, int gtid, int gthreads) {
    for (int i = gtid * 4; i < n; i += gthreads * 4) { const f32x4 v = *(const f32x4*)(src + i); u32x2 o; o.x = cvt_pk_bf16(v[0], v[1]); o.y = cvt_pk_bf16(v[2], v[3]); *(u32x2*)(dst + i) = o; }
}
__device__ __forceinline__ void p0_prologue(const Params& p, LAS unsigned char* lds) {
    int tid_ = threadIdx.x; asm volatile("" : "+v"(tid_));
    const int tid = tid_, lane = tid & 63, wave = __builtin_amdgcn_readfirstlane(tid >> 6), G = gridDim.x;
    unsigned char* ws = p.ws;
    {
        LAS float* sc = (LAS float*)(lds + 69632);
        LAS float* red = (LAS float*)(lds + 69632 + 24576);
        const float* cvec = p.in[6]; const float* cctx = p.in[7];
        for (int i = tid; i < 3 * 2048; i += 512) { const int c = i >> 11, k = i & 2047; const float x = (c == 0) ? cctx[k] : cvec[(c - 1) * 2048 + k]; sc[i] = x / (1.f + __expf(-x)); }
        __syncthreads();
        float* MOD = (float*)(ws + WS_MOD);
        for (int item = blockIdx.x; item < 256; item += G) {
            const int l = item >> 7, cgp = item & 127, ln = lane < 48 ? lane : 47;
            const float* W = p.in[8] + (size_t)l * 2048 * MODW + cgp * 96 + ln * 2;
            float a00 = 0.f, a01 = 0.f, a10 = 0.f, a11 = 0.f, a20 = 0.f, a21 = 0.f;
            const int kb = wave * 256;
#pragma unroll 8
            for (int k = 0; k < 256; ++k) {
                const f32x2 w = *(const f32x2*)(W + (size_t)(kb + k) * MODW);
                const float s0 = sc[kb + k], s1 = sc[2048 + kb + k], s2 = sc[4096 + kb + k];
                a00 += s0 * w.x; a01 += s0 * w.y; a10 += s1 * w.x; a11 += s1 * w.y; a20 += s2 * w.x; a21 += s2 * w.y;
            }
            if (lane < 48) { LAS float* r = red + wave * 288 + lane * 2; r[0] = a00; r[1] = a01; r[96] = a10; r[97] = a11; r[192] = a20; r[193] = a21; }
            __syncthreads();
            if (tid < 288) { const int c = tid / 96, j = tid % 96; float s = 0.f;
#pragma unroll
                for (int w = 0; w < 8; ++w) s += red[w * 288 + tid];
                MOD[(size_t)(l * 3 + c) * MODW + cgp * 96 + j] = s + p.in[9][l * MODW + cgp * 96 + j]; }
            __syncthreads();
        }
    }
    {
        LAS float* scr = (LAS float*)(lds + wave * 8448);
        const int gw = blockIdx.x * 8 + wave, NGW = G * 8;
        constexpr int I_IN = 32 * (ABIN / 32), I_O = 32 * (D / 32), I_QKV = 32 * (NQKV / 32), I_1 = 32 * (FFN / 32), I_2 = (FFN / 64) * (D / 32);
        constexpr int NITEMS = I_IN + 2 * I_O + I_QKV + 2 * I_1 + 2 * I_2;
        for (int it = gw; it < NITEMS; it += NGW) {
            int r = it;
            if (r < I_IN) { p0_transpose_item(p.in[12], D, ABIN, (bf16_t*)(ws + WS_WIN), scr, r, lane); continue; } r -= I_IN;
            if (r < I_O) { p0_transpose_item(p.in[16], D, D, (bf16_t*)(ws + WS_WO0), scr, r, lane); continue; } r -= I_O;
            if (r < I_QKV) { p0_transpose_item(p.in[17], D, NQKV, (bf16_t*)(ws + WS_WQKV), scr, r, lane); continue; } r -= I_QKV;
            if (r < I_O) { p0_transpose_item(p.in[19], D, D, (bf16_t*)(ws + WS_WO1), scr, r, lane); continue; } r -= I_O;
            if (r < 2 * I_1) { const int l = r / I_1; p0_transpose_item(p.in[20] + (size_t)l * D * FFN, D, FFN, (bf16_t*)(ws + WS_W1) + (size_t)l * FFN * D, scr, r - l * I_1, lane); continue; } r -= 2 * I_1;
            { const int l = r / I_2; p0_transpose_item(p.in[21] + (size_t)l * D * FFN, FFN, D, (bf16_t*)(ws + WS_W2) + (size_t)l * FFN * D, scr, r - l * I_2, lane); }
        }
    }
    {
        const int gtid = blockIdx.x * 512 + tid, gth = G * 512;
        cvt_linear(p.in[2], (bf16_t*)(ws + WS_K0) + (size_t)MTOT * 256, 1024 * 256, gtid, gth);
        cvt_linear(p.in[3], (bf16_t*)(ws + WS_V0) + (size_t)MTOT * 256, 1024 * 256, gtid, gth);
        cvt_linear(p.in[4], (bf16_t*)(ws + WS_CNK), 1024 * 2048, gtid, gth);
        cvt_linear(p.in[5], (bf16_t*)(ws + WS_CNV), 1024 * 2048, gtid, gth);
    }
}

template <bool OUT_F32>
__device__ __forceinline__ void norm_phase(const float* src_lo, const float* src_hi, const float* gain, const float* mod, int shift_off, int scale_off, bf16_t* dst_bf, float* dst_f) {
    int tid_ = threadIdx.x; asm volatile("" : "+v"(tid_));
    const int tid = tid_, lane = tid & 63, wave = tid >> 6, G = gridDim.x;
    const int gw = blockIdx.x * 8 + wave, NGW = G * 8, per = (MTOT + NGW - 1) / NGW;
    const int r_beg = gw * per, r_end = (r_beg + per < MTOT) ? r_beg + per : MTOT;
    int cur = -1; f32x4 A[8], B[8];
    for (int row = r_beg; row < r_end; ++row) {
        const int cond = (row < MCTX) ? 0 : 1 + ((row - MCTX) >> 11);
        if (cond != cur) {
            cur = cond;
#pragma unroll
            for (int j = 0; j < 8; ++j) {
                const int col = 4 * lane + 256 * j; const f32x4 g = *(const f32x4*)(gain + col);
                if (mod) { const f32x4 sc = *(const f32x4*)(mod + (size_t)cond * MODW + scale_off + col); A[j] = g * (sc + 1.f); B[j] = *(const f32x4*)(mod + (size_t)cond * MODW + shift_off + col); }
                else { A[j] = g; B[j] = (f32x4){0.f, 0.f, 0.f, 0.f}; }
            }
        }
        const float* xr = ((row < MCTX) ? src_lo : src_hi) + (size_t)row * D + 4 * lane;
        f32x4 v[8]; float s = 0.f;
#pragma unroll
        for (int j = 0; j < 8; ++j) { v[j] = *(const f32x4*)(xr + 256 * j); s += (v[j].x * v[j].x + v[j].y * v[j].y) + (v[j].z * v[j].z + v[j].w * v[j].w); }
        const float rstd = rsqrtf(wave_sum(s) * (1.f / D) + EPS);
#pragma unroll
        for (int j = 0; j < 8; ++j) {
            const f32x4 y = v[j] * rstd * A[j] + B[j];
            if (OUT_F32) *(f32x4*)(dst_f + (size_t)row * D + 4 * lane + 256 * j) = y;
            else { u32x2 o; o.x = cvt_pk_bf16(y[0], y[1]); o.y = cvt_pk_bf16(y[2], y[3]); *(u32x2*)(dst_bf + (size_t)row * D + 4 * lane + 256 * j) = o; }
        }
    }
}

__device__ __forceinline__ void unpack8(const u32x4 r, float (&f)[8]) {
    f[0] = bf2f(r.x & 0xffffu); f[1] = __uint_as_float(r.x & 0xffff0000u); f[2] = bf2f(r.y & 0xffffu); f[3] = __uint_as_float(r.y & 0xffff0000u);
    f[4] = bf2f(r.z & 0xffffu); f[5] = __uint_as_float(r.z & 0xffff0000u); f[6] = bf2f(r.w & 0xffffu); f[7] = __uint_as_float(r.w & 0xffff0000u);
}
__device__ __forceinline__ void ew0_phase(const Params& p) {
    int tid_ = threadIdx.x; asm volatile("" : "+v"(tid_));
    const int tid = tid_, lane = tid & 63, wave = tid >> 6, G = gridDim.x;
    const int gw = blockIdx.x * 8 + wave, NGW = G * 8;
    unsigned char* ws = p.ws;
    const bf16_t* Z = (const bf16_t*)(ws + WS_Z);
    bf16_t* AB = (bf16_t*)(ws + WS_AB); bf16_t* Q0 = (bf16_t*)(ws + WS_Q0); bf16_t* K0 = (bf16_t*)(ws + WS_K0); bf16_t* V0 = (bf16_t*)(ws + WS_V0);
    const float* convw = p.in[13]; const float* qn = p.in[14]; const float* kn = p.in[15];
    const int ri = lane & 31, chunk = lane >> 5, da = chunk * 64 + ri, db = da + 32;
    const float inv = __builtin_amdgcn_exp2f(-(float)ri * (13.287712379549449f / 32.f));
    const float qwa = qn[da], qwb = qn[db], kwa = kn[da], kwb = kn[db];
    for (int tok = gw; tok < MTOT; tok += NGW) {
        const bool lat = tok >= MCTX;
        const int t = lat ? ((tok - MCTX) & 2047) : (tok & 255), slen = lat ? 2048 : 256;
        const bf16_t* zr = Z + (size_t)tok * ABIN;
#pragma unroll
        for (int j = 0; j < 2; ++j) {
            const int ch = j * 512 + lane * 8;
            float gb[8], acc[8];
            unpack8(*(const u32x4*)(zr + ch), gb);
#pragma unroll
            for (int e = 0; e < 8; ++e) acc[e] = 0.f;
#pragma unroll
            for (int dt = -1; dt <= 1; ++dt) {
                if (t + dt >= 0 && t + dt < slen) {
                    float gc[8], xa[8];
                    unpack8(*(const u32x4*)(zr + dt * ABIN + 1024 + ch), gc);
                    unpack8(*(const u32x4*)(zr + dt * ABIN + 2048 + ch), xa);
                    const f32x4 w0 = *(const f32x4*)(convw + (dt + 1) * 1024 + ch), w1 = *(const f32x4*)(convw + (dt + 1) * 1024 + ch + 4);
#pragma unroll
                    for (int e = 0; e < 4; ++e) { acc[e] += w0[e] * (gc[e] * xa[e]); acc[4 + e] += w1[e] * (gc[4 + e] * xa[4 + e]); }
                }
            }
            u32x4 o; o.x = cvt_pk_bf16(gb[0] * acc[0], gb[1] * acc[1]); o.y = cvt_pk_bf16(gb[2] * acc[2], gb[3] * acc[3]);
            o.z = cvt_pk_bf16(gb[4] * acc[4], gb[5] * acc[5]); o.w = cvt_pk_bf16(gb[6] * acc[6], gb[7] * acc[7]);
            *(u32x4*)(AB + (size_t)tok * D + ch) = o;
        }
        float cs = 1.f, sn = 0.f;
        if (lat) { const float pos = (float)(chunk == 0 ? (t >> 6) : (t & 63)); const float ang = pos * inv; cs = __cosf(ang); sn = __sinf(ang); }
#pragma unroll
        for (int hh = 0; hh < 10; ++hh) {
            const bf16_t* hp = zr + 3072 + hh * 128;
            const float va = bf2f(hp[da]), vb = bf2f(hp[db]);
            const float rstd = rsqrtf(wave_sum(va * va + vb * vb) * (1.f / 128.f) + EPS);
            const float na = va * rstd * (hh < 8 ? qwa : kwa), nb = vb * rstd * (hh < 8 ? qwb : kwb);
            const float ra = na * cs - nb * sn, rb = na * sn + nb * cs;
            if (hh < 8) { bf16_t* q = Q0 + (size_t)tok * 1024 + hh * 128; q[da] = (bf16_t)f2bf(ra); q[db] = (bf16_t)f2bf(rb); }
            else {
                const int kvh = hh - 8;
                bf16_t* k = K0 + (size_t)tok * 256 + kvh * 128; k[da] = (bf16_t)f2bf(ra); k[db] = (bf16_t)f2bf(rb);
                if (!lat) { float* ok = p.out + OUT_AK + (size_t)tok * 256 + kvh * 128; ok[da] = na; ok[db] = nb; }
            }
        }
        {
            const u32x2 r = *(const u32x2*)(zr + 4352 + lane * 4);
            *(u32x2*)(V0 + (size_t)tok * 256 + lane * 4) = r;
            if (!lat) { f32x4 o; o[0] = bf2f(r.x & 0xffffu); o[1] = __uint_as_float(r.x & 0xffff0000u); o[2] = bf2f(r.y & 0xffffu); o[3] = __uint_as_float(r.y & 0xffff0000u);
                *(f32x4*)(p.out + OUT_AV + (size_t)tok * 256 + lane * 4) = o; }
        }
    }
}

constexpr int KSTR = 272, VSTR = 288, LDS_KT = 0, LDS_VT = 2 * 64 * KSTR, LDS_BIAS = LDS_VT + 2 * 64 * VSTR;
constexpr float SCL2 = 0.08838834764831845f * 1.4426950408889634f, LOG2E = 1.4426950408889634f;
struct AttnArgs {
    const bf16_t* q; int qstride; int qrow0;
    bf16_t* o; int ostride;
    const bf16_t* kA; const bf16_t* vA; int strideA, ntA;
    const bf16_t* kB; const bf16_t* vB; int strideB, ntB;
    int t0, t1, role; f32x4* xs; unsigned* xf;
    int r0, krlo; const float* bias;
};
__device__ __forceinline__ v4i16_t vtr(const LAS unsigned char* p) { return __builtin_amdgcn_ds_read_tr16_b64_v4i16((LAS v4i16_t*)p); }

template <int NA>
__device__ __forceinline__ void attn_run(LAS unsigned char* lds, const AttnArgs& a) {
    int tid_ = threadIdx.x; asm volatile("" : "+v"(tid_));
    const int tid = tid_, lane = tid & 63, wave = __builtin_amdgcn_readfirstlane(tid >> 6), fr = lane & 15, fq = lane >> 4;
    bf16x8 Qf[2][4];
#pragma unroll
    for (int qb = 0; qb < 2; ++qb)
#pragma unroll
        for (int dc = 0; dc < 4; ++dc) Qf[qb][dc] = *(const bf16x8*)(a.q + (size_t)(a.qrow0 + wave * 32 + qb * 16 + fr) * a.qstride + dc * 32 + fq * 8);
    f32x4 O[2][8];
#pragma unroll
    for (int qb = 0; qb < 2; ++qb)
#pragma unroll
        for (int db = 0; db < 8; ++db) O[qb][db] = (f32x4){0.f, 0.f, 0.f, 0.f};
    float mrun[2] = {-1e30f, -1e30f}, lrun[2] = {0.f, 0.f};
    LAS float* biasL = (LAS float*)(lds + LDS_BIAS);
    if (NA) { for (int i = tid; i < 465; i += 512) biasL[i] = a.bias[i]; }
    const int lrow = tid >> 3, lch = tid & 7;
    u32x4 kr0, kr1, vr0, vr1;
#define ATT_GLOAD(t) do { const bool inA = (t) < a.ntA; const int tt = inA ? (t) : (t) - a.ntA; const int st = inA ? a.strideA : a.strideB; \
        const bf16_t* kp = (inA ? a.kA : a.kB) + (size_t)(tt * 64 + lrow) * st + lch * 8; const bf16_t* vp = (inA ? a.vA : a.vB) + (size_t)(tt * 64 + lrow) * st + lch * 8; \
        kr0 = *(const u32x4*)kp; kr1 = *(const u32x4*)(kp + 64); vr0 = *(const u32x4*)vp; vr1 = *(const u32x4*)(vp + 64); } while (0)
#define ATT_LWRITE(b) do { LAS unsigned char* kd = lds + LDS_KT + (b) * 64 * KSTR + lrow * KSTR + lch * 16; LAS unsigned char* vd = lds + LDS_VT + (b) * 64 * VSTR + lrow * VSTR + lch * 16; \
        *(LAS u32x4*)kd = kr0; *(LAS u32x4*)(kd + 128) = kr1; *(LAS u32x4*)vd = vr0; *(LAS u32x4*)(vd + 128) = vr1; } while (0)
    ATT_GLOAD(a.t0); ATT_LWRITE(a.t0 & 1); __syncthreads();
    const int rw = NA ? a.r0 + (wave >> 1) : 0;
    const int kr_lo_w = NA ? (rw - 4 < 0 ? 0 : (rw - 4 > 24 ? 24 : rw - 4)) : 0;
    for (int t = a.t0; t < a.t1; ++t) {
        if (t + 1 < a.t1) ATT_GLOAD(t + 1);
        bool active = true; int kr = 0; const bool local = NA && t >= a.ntA;
        if (local) { kr = a.krlo + (t - a.ntA); active = (kr >= kr_lo_w) && (kr < kr_lo_w + 8); }
        if (active) {
            const LAS unsigned char* Kt = lds + LDS_KT + (t & 1) * 64 * KSTR;
            const LAS unsigned char* Vt = lds + LDS_VT + (t & 1) * 64 * VSTR;
            f32x4 S[2][4];
#pragma unroll
            for (int qb = 0; qb < 2; ++qb)
#pragma unroll
                for (int kb = 0; kb < 4; ++kb) S[qb][kb] = (f32x4){0.f, 0.f, 0.f, 0.f};
#pragma unroll
            for (int kb = 0; kb < 4; ++kb)
#pragma unroll
                for (int dc = 0; dc < 4; ++dc) {
                    const bf16x8 kf = *(const LAS bf16x8*)(Kt + (kb * 16 + fr) * KSTR + dc * 64 + fq * 16);
                    S[0][kb] = __builtin_amdgcn_mfma_f32_16x16x32_bf16(kf, Qf[0][dc], S[0][kb], 0, 0, 0);
                    S[1][kb] = __builtin_amdgcn_mfma_f32_16x16x32_bf16(kf, Qf[1][dc], S[1][kb], 0, 0, 0);
                }
            bf16x8 Pf[2][2];
#pragma unroll
            for (int qb = 0; qb < 2; ++qb) {
                if (local) {
                    const int c = (wave & 1) * 32 + qb * 16 + fr;
                    const int kc0 = c - 8 < 0 ? 0 : (c - 8 > 48 ? 48 : c - 8);
                    const LAS float* brow = biasL + (kr - rw + 7) * 31 + 15 - c;
#pragma unroll
                    for (int kb = 0; kb < 4; ++kb)
#pragma unroll
                        for (int j = 0; j < 4; ++j) { const int kc = kb * 16 + 4 * fq + j; const bool ok = (kc >= kc0) && (kc < kc0 + 16);
                            const float bv = brow[ok ? kc : c];
                            S[qb][kb][j] = ok ? (S[qb][kb][j] * SCL2 + bv * LOG2E) : -1e30f; }
                } else {
#pragma unroll
                    for (int kb = 0; kb < 4; ++kb) S[qb][kb] = S[qb][kb] * SCL2;
                }
                float mx = -1e30f;
#pragma unroll
                for (int kb = 0; kb < 4; ++kb) mx = fmaxf(mx, fmaxf(fmaxf(S[qb][kb][0], S[qb][kb][1]), fmaxf(S[qb][kb][2], S[qb][kb][3])));
                mx = fmaxf(mx, __shfl_xor(mx, 16)); mx = fmaxf(mx, __shfl_xor(mx, 32));
                const float mn = fmaxf(mrun[qb], mx), alpha = __builtin_amdgcn_exp2f(mrun[qb] - mn);
                mrun[qb] = mn;
                float rs = 0.f;
#pragma unroll
                for (int kb = 0; kb < 4; ++kb)
#pragma unroll
                    for (int j = 0; j < 4; ++j) { const float pv = __builtin_amdgcn_exp2f(S[qb][kb][j] - mn); S[qb][kb][j] = pv; rs += pv; }
                lrun[qb] = lrun[qb] * alpha + rs;
#pragma unroll
                for (int db = 0; db < 8; ++db) O[qb][db] = O[qb][db] * alpha;
#pragma unroll
                for (int c2 = 0; c2 < 2; ++c2) {
                    u32x4 pk; pk.x = cvt_pk_bf16(S[qb][2 * c2][0], S[qb][2 * c2][1]); pk.y = cvt_pk_bf16(S[qb][2 * c2][2], S[qb][2 * c2][3]);
                    pk.z = cvt_pk_bf16(S[qb][2 * c2 + 1][0], S[qb][2 * c2 + 1][1]); pk.w = cvt_pk_bf16(S[qb][2 * c2 + 1][2], S[qb][2 * c2 + 1][3]);
                    Pf[qb][c2] = __builtin_bit_cast(bf16x8, pk);
                }
            }
            const LAS unsigned char* vb = Vt + (4 * fq + (fr >> 2)) * VSTR + (fr & 3) * 8;
#pragma unroll
            for (int c2 = 0; c2 < 2; ++c2)
#pragma unroll
                for (int db = 0; db < 8; ++db) {
                    const v4i16_t lo = vtr(vb + (c2 * 32) * VSTR + db * 32), hi = vtr(vb + (c2 * 32 + 16) * VSTR + db * 32);
                    bf16x8 vf; vf[0] = lo[0]; vf[1] = lo[1]; vf[2] = lo[2]; vf[3] = lo[3]; vf[4] = hi[0]; vf[5] = hi[1]; vf[6] = hi[2]; vf[7] = hi[3];
                    O[0][db] = __builtin_amdgcn_mfma_f32_16x16x32_bf16(vf, Pf[0][c2], O[0][db], 0, 0, 0);
                    O[1][db] = __builtin_amdgcn_mfma_f32_16x16x32_bf16(vf, Pf[1][c2], O[1][db], 0, 0, 0);
                }
        }
        if (t + 1 < a.t1) ATT_LWRITE((t + 1) & 1);
        __syncthreads();
    }
#undef ATT_GLOAD
#undef ATT_LWRITE
    if (a.role == 2) {
        f32x4* sp = a.xs + tid;
#pragma unroll
        for (int qb = 0; qb < 2; ++qb)
#pragma unroll
            for (int db = 0; db < 8; ++db) asm volatile("global_store_dwordx4 %0, %1, off sc1" :: "v"(sp + (qb * 8 + db) * 512), "v"(O[qb][db]) : "memory");
        const f32x4 ml = {mrun[0], mrun[1], lrun[0], lrun[1]};
        asm volatile("global_store_dwordx4 %0, %1, off sc1" :: "v"(sp + 16 * 512), "v"(ml) : "memory");
        asm volatile("s_waitcnt vmcnt(0)" ::: "memory");
        if (lane == 0) __hip_atomic_store(a.xf + wave, 1u, __ATOMIC_RELAXED, __HIP_MEMORY_SCOPE_AGENT);
        return;
    }
    if (a.role == 1) {
        unsigned spins = 0;
        while (__hip_atomic_load(a.xf + wave, __ATOMIC_RELAXED, __HIP_MEMORY_SCOPE_AGENT) == 0u) { __builtin_amdgcn_s_sleep(2); if (++spins > (1u << 22)) break; }
        __builtin_amdgcn_fence(__ATOMIC_ACQUIRE, "agent");
        asm volatile("s_waitcnt vmcnt(0)" ::: "memory");
        const f32x4* sp = a.xs + tid;
        const f32x4 ml = sp[16 * 512];
        float fa[2], fb[2];
#pragma unroll
        for (int qb = 0; qb < 2; ++qb) { const float mo = ml[qb], mn = fmaxf(mrun[qb], mo); fa[qb] = __builtin_amdgcn_exp2f(mrun[qb] - mn); fb[qb] = __builtin_amdgcn_exp2f(mo - mn); lrun[qb] = lrun[qb] * fa[qb] + ml[2 + qb] * fb[qb]; }
#pragma unroll
        for (int qb = 0; qb < 2; ++qb)
#pragma unroll
            for (int db = 0; db < 8; ++db) { const f32x4 o2 = sp[(qb * 8 + db) * 512]; O[qb][db] = O[qb][db] * fa[qb] + o2 * fb[qb]; asm volatile("" ::: "memory"); }
    }
#pragma unroll
    for (int qb = 0; qb < 2; ++qb) {
        float lt = lrun[qb]; lt += __shfl_xor(lt, 16); lt += __shfl_xor(lt, 32);
        const float il = 1.f / lt;
        bf16_t* op = a.o + (size_t)(a.qrow0 + wave * 32 + qb * 16 + fr) * a.ostride + 4 * fq;
#pragma unroll
        for (int db = 0; db < 8; ++db) { const f32x4 v = O[qb][db] * il; u32x2 o; o.x = cvt_pk_bf16(v[0], v[1]); o.y = cvt_pk_bf16(v[2], v[3]); *(u32x2*)(op + db * 16) = o; }
    }
}

__device__ __forceinline__ void attn0_phase(const Params& p, LAS unsigned char* lds) {
    unsigned char* ws = p.ws; const int G = gridDim.x;
    const bf16_t* Q0 = (const bf16_t*)(ws + WS_Q0); const bf16_t* K0 = (const bf16_t*)(ws + WS_K0); const bf16_t* V0 = (const bf16_t*)(ws + WS_V0);
    bf16_t* AB = (bf16_t*)(ws + WS_AB);
    const bool split = (G == 256);
    for (int i = blockIdx.x; i < 512; i += G) {
        AttnArgs a;
        if (i < 256) { const int it = i & 127; const int b = it >> 6, h = (it >> 3) & 7, qblk = it & 7, kvh = h >> 2;
            if (!split && i >= 128) continue;
            a.q = Q0 + h * 128; a.qstride = 1024; a.qrow0 = MCTX + b * 2048 + qblk * 256; a.o = AB + 1024 + h * 128; a.ostride = D;
            a.kA = K0 + (size_t)(MTOT + b * 512) * 256 + kvh * 128; a.vA = V0 + (size_t)(MTOT + b * 512) * 256 + kvh * 128; a.strideA = 256; a.ntA = 8;
            a.kB = K0 + (size_t)(MCTX + b * 2048) * 256 + kvh * 128; a.vB = V0 + (size_t)(MCTX + b * 2048) * 256 + kvh * 128; a.strideB = 256; a.ntB = 32;
            a.t0 = (split && i >= 128) ? 20 : 0; a.t1 = (split && i < 128) ? 20 : 40; a.role = split ? (i < 128 ? 1 : 2) : 0;
            a.xs = (f32x4*)(ws + WS_TS) + (size_t)it * (17 * 512); a.xf = (unsigned*)(ws + WS_FLAGS) + 8 * 1024 + it * 8;
        } else { const int j = i - 256, b = j >> 3, h = j & 7, kvh = h >> 2;
            a.q = Q0 + h * 128; a.qstride = 1024; a.qrow0 = b * 256; a.o = AB + 1024 + h * 128; a.ostride = D;
            a.kA = K0 + (size_t)(b * 256) * 256 + kvh * 128; a.vA = V0 + (size_t)(b * 256) * 256 + kvh * 128; a.strideA = 256; a.ntA = 4;
            a.kB = a.kA; a.vB = a.vA; a.strideB = 256; a.ntB = 0;
            a.t0 = 0; a.t1 = 4; a.role = 0; a.xs = nullptr; a.xf = nullptr;
        }
        a.r0 = 0; a.krlo = 0; a.bias = nullptr;
        attn_run<0>(lds, a);
    }
}
__device__ __forceinline__ void attn1_phase(const Params& p, LAS unsigned char* lds, bf16_t* AO) {
    unsigned char* ws = p.ws; const int G = gridDim.x;
    const bf16_t* Q1 = (const bf16_t*)(ws + WS_Z); const bf16_t* K1 = Q1 + (size_t)MTOT * D; const bf16_t* V1 = K1 + (size_t)MTOT * D;
    const bf16_t* CNK = (const bf16_t*)(ws + WS_CNK); const bf16_t* CNV = (const bf16_t*)(ws + WS_CNV);
    for (int i = blockIdx.x; i < 256; i += G) {
        AttnArgs a;
        const int b = i >> 7, h = (i >> 3) & 15, rg = i & 7, r0 = rg * 4;
        const int lo = r0 - 4 < 0 ? 0 : (r0 - 4 > 24 ? 24 : r0 - 4), hi0 = r0 - 1 < 0 ? 0 : (r0 - 1 > 24 ? 24 : r0 - 1), hi = hi0 + 7;
        a.q = Q1 + h * 128; a.qstride = D; a.qrow0 = MCTX + b * 2048 + r0 * 64; a.o = AO + h * 128; a.ostride = D;
        a.kA = CNK + (size_t)(b * 512) * 2048 + h * 128; a.vA = CNV + (size_t)(b * 512) * 2048 + h * 128; a.strideA = 2048; a.ntA = 8;
        a.kB = K1 + (size_t)(MCTX + b * 2048 + lo * 64) * D + h * 128; a.vB = V1 + (size_t)(MCTX + b * 2048 + lo * 64) * D + h * 128; a.strideB = D; a.ntB = hi - lo + 1;
        a.r0 = r0; a.krlo = lo; a.bias = p.in[18] + h * 465; a.t0 = 0; a.t1 = a.ntA + a.ntB; a.role = 0; a.xs = nullptr; a.xf = nullptr;
        attn_run<1>(lds, a);
    }
    for (int j = blockIdx.x; j < 512; j += G) {
        AttnArgs a;
        const int b = j >> 4, h = j & 15;
        a.q = Q1 + h * 128; a.qstride = D; a.qrow0 = b * 256; a.o = AO + h * 128; a.ostride = D;
        a.kA = K1 + (size_t)(b * 256) * D + h * 128; a.vA = V1 + (size_t)(b * 256) * D + h * 128; a.strideA = D; a.ntA = 4;
        a.kB = a.kA; a.vB = a.vA; a.strideB = D; a.ntB = 0;
        a.r0 = 0; a.krlo = 0; a.bias = nullptr; a.t0 = 0; a.t1 = 4; a.role = 0; a.xs = nullptr; a.xf = nullptr;
        attn_run<0>(lds, a);
    }
}

#define XB_TMO      128
#define XB_XCNT(j)  (256  + 64 * (j))
#define XB_XSUB(j)  (1280 + 64 * (j))
#define XB_XGEN(j)  (2304 + 64 * (j))
#define XB_TOP      3328
#define XB_TOPGEN   3392
#define XCD_BAR_WORDS 3456
#define XB_SPIN_CAP (1u << 18)

__device__ __forceinline__ unsigned xb_ld(unsigned* p)              { return __hip_atomic_load(p, __ATOMIC_RELAXED, __HIP_MEMORY_SCOPE_AGENT); }
__device__ __forceinline__ unsigned xb_add(unsigned* p, unsigned v) { return __hip_atomic_fetch_add(p, v, __ATOMIC_RELAXED, __HIP_MEMORY_SCOPE_AGENT); }
__device__ __forceinline__ unsigned xb_xcc_id() { return (unsigned)__builtin_amdgcn_s_getreg((3 << 11) | 20) & 0xFu; }
#define XB_SPIN(cond, bar) do { unsigned _sp = 0; while (cond) { __builtin_amdgcn_s_sleep(1); \
    if ((++_sp & 255u) == 0u) { if (xb_ld(&(bar)[XB_TMO])) break; if (_sp > XB_SPIN_CAP) { atomicAdd(&(bar)[XB_TMO], 1u); break; } } } } while (0)

struct XcdBarrier {
    unsigned* bar; unsigned x;
    volatile LAS unsigned* st;
};

__device__ __forceinline__ XcdBarrier xcd_barrier_post(unsigned* bar, volatile LAS unsigned* st) {
    XcdBarrier b; b.bar = bar; b.x = xb_xcc_id(); b.st = st;
    if (threadIdx.x == 0) (void)xb_add(&bar[XB_XCNT(b.x)], 1u);
    return b;
}
__device__ __forceinline__ void xcd_barrier_complete(unsigned* bar, unsigned x, unsigned& nloc, unsigned& nx) {
    const unsigned G = gridDim.x * gridDim.y * gridDim.z;
    unsigned sum, cnt, mine, sp = 0u;
    for (;;) {
        sum = 0u; cnt = 0u; mine = 0u;
#pragma unroll
        for (unsigned j = 0; j < 16; ++j) { const unsigned c = xb_ld(&bar[XB_XCNT(j)]); sum += c; cnt += (c > 0u) ? 1u : 0u; mine = (j == x) ? c : mine; }
        if (sum == G) break;
        __builtin_amdgcn_s_sleep(1);
        if ((++sp & 255u) == 0u) { if (xb_ld(&bar[XB_TMO])) break; if (sp > XB_SPIN_CAP) { atomicAdd(&bar[XB_TMO], 1u); break; } }
    }
    nloc = mine > 0u ? mine : 1u; nx = cnt > 0u ? cnt : 1u;
}

__device__ __forceinline__ void xcd_barrier(const XcdBarrier& b) {
    asm volatile("s_waitcnt vmcnt(0)" ::: "memory");
    __syncthreads();
    if (threadIdx.x == 0) {
        unsigned* bar = b.bar;
        __builtin_amdgcn_s_waitcnt(0);
        unsigned nloc = b.st[0], nx = b.st[1];
        if (nloc == 0u) { xcd_barrier_complete(bar, b.x, nloc, nx); b.st[0] = nloc; b.st[1] = nx; }
        const unsigned old = xb_add(&bar[XB_XSUB(b.x)], 1u);
        const unsigned gen = old / nloc;
        if (old + 1u == (gen + 1u) * nloc) {
            __builtin_amdgcn_fence(__ATOMIC_RELEASE, "agent");
            asm volatile("s_waitcnt vmcnt(0)" ::: "memory");
            const unsigned og = xb_add(&bar[XB_TOP], 1u);
            const unsigned tg = og / nx;
            if (og + 1u == (tg + 1u) * nx) xb_add(&bar[XB_TOPGEN], 1u);
            else XB_SPIN(xb_ld(&bar[XB_TOPGEN]) == tg, bar);
            __builtin_amdgcn_fence(__ATOMIC_ACQUIRE, "agent");
            xb_add(&bar[XB_XGEN(b.x)], 1u);
            asm volatile("s_waitcnt vmcnt(0)" ::: "memory");
        } else {
            XB_SPIN(xb_ld(&bar[XB_XGEN(b.x)]) == gen, bar);
            __builtin_amdgcn_fence(__ATOMIC_ACQUIRE, "agent");
            asm volatile("s_waitcnt vmcnt(0)" ::: "memory");
        }
    }
    __syncthreads();
}


constexpr int NPHASE = 18;
__global__ void __launch_bounds__(512, 2) mega_fwd(Params p) {
    extern __shared__ __attribute__((aligned(16))) unsigned char lds_raw[];
    LAS unsigned char* lds = (LAS unsigned char*)lds_raw;
    cg::grid_group grid = cg::this_grid();
    if (threadIdx.x < 64) ((LAS unsigned*)(lds + 131072))[threadIdx.x] = 0u;
    __syncthreads();
    XcdBarrier xbar = xcd_barrier_post((unsigned*)(p.ws + WS_BAR), (volatile LAS unsigned*)(lds + 131072));
    unsigned char* ws = p.ws;
    const int G = gridDim.x;
    float* MOD = (float*)(ws + WS_MOD);
    bf16_t* XN = (bf16_t*)(ws + WS_XN); float* X = (float*)(ws + WS_X);
    bf16_t* Z = (bf16_t*)(ws + WS_Z); bf16_t* AB = (bf16_t*)(ws + WS_AB); bf16_t* H = (bf16_t*)(ws + WS_H);
#define RUN(k) (p.ph_lo <= (k) && (k) < p.ph_hi)
#define GRID_SYNC_CG() do { asm volatile("s_waitcnt vmcnt(0) lgkmcnt(0)" ::: "memory"); grid.sync(); __builtin_amdgcn_fence(__ATOMIC_ACQUIRE, "agent"); asm volatile("s_waitcnt vmcnt(0)" ::: "memory"); } while (0)
#define GRID_SYNC() do { xcd_barrier(xbar); } while (0)
#define REPEAT(n, stmt) do { for (int rep_ = 0; rep_ < (n); ++rep_) { stmt; if (rep_ + 1 < (n)) GRID_SYNC(); } } while (0)
#define SEAM(k) do { if (p.ph_lo <= (k) && (k) + 1 < p.ph_hi) GRID_SYNC(); } while (0)
    if (RUN(0)) REPEAT(REP_P0, p0_prologue(p, lds));
    if (p.ph_lo <= 0 && 1 < p.ph_hi) GRID_SYNC_CG();
    for (int l = 0; l < 2; ++l) {
        const int k0 = 1 + 8 * l;
        const float* modl = MOD + (size_t)l * 3 * MODW;
        const float* xin_lo = (l == 0) ? p.in[0] : X;
        const float* xin_hi = (l == 0) ? p.in[1] - (size_t)MCTX * D : X;
        if (RUN(k0)) REPEAT(REP_NORM, norm_phase<false>(xin_lo, xin_hi, p.in[10] + l * D, modl, 0, D, XN, nullptr));
        SEAM(k0);
        if (RUN(k0 + 1)) for (int repg_ = 0; repg_ < REP_G; ++repg_) {
            if (repg_) GRID_SYNC();
            if (l == 0) { pg8::Gemm g{XN, (const bf16_t*)(ws + WS_WIN), MTOT, ABIN, D}; pg8::StaticOrder S; S.init(MTOT, ABIN, G, (int)blockIdx.x, D, ws, -2);
                EpiBf16<0, false> E{Z, ABIN, nullptr, nullptr, 0, 0}; pg8::gemm_phase(lds, g, S, E); }
            else { pg8::Gemm g{XN, (const bf16_t*)(ws + WS_WQKV), MTOT, NQKV, D}; pg8::StaticOrder S; S.init(MTOT, NQKV, G, (int)blockIdx.x, D, ws, -2);
                EpiBf16<0, true> E{Z, D, p.out + OUT_NK, p.out + OUT_NV, 8, (size_t)MTOT * D}; pg8::gemm_phase(lds, g, S, E); }
        }
        SEAM(k0 + 1);
        if (l == 0) { if (RUN(k0 + 2)) REPEAT(REP_EW, ew0_phase(p)); SEAM(k0 + 2); }
        if (RUN(k0 + 3)) REPEAT(REP_ATT, if (l == 0) attn0_phase(p, lds); else attn1_phase(p, lds, AB));
        SEAM(k0 + 3);
        if (RUN(k0 + 4)) { pg8::Gemm g{AB, (const bf16_t*)(ws + (l == 0 ? WS_WO0 : WS_WO1)), MTOT, D, D}; pg8::StaticOrder S; S.init(MTOT, D, G, (int)blockIdx.x, D, ws, -2);
            EpiResid E{xin_lo, xin_hi, X, modl + 2 * D}; pg8::gemm_phase(lds, g, S, E); }
        SEAM(k0 + 4);
        if (RUN(k0 + 5)) REPEAT(REP_NORM, norm_phase<false>(X, X, p.in[11] + l * D, modl, 3 * D, 4 * D, XN, nullptr));
        SEAM(k0 + 5);
        if (RUN(k0 + 6)) for (int repg_ = 0; repg_ < REP_G; ++repg_) { if (repg_) GRID_SYNC(); pg8::Gemm g{XN, (const bf16_t*)(ws + WS_W1) + (size_t)l * FFN * D, MTOT, FFN, D}; pg8::StaticOrder S; S.init(MTOT, FFN, G, (int)blockIdx.x, D, ws, -1);
            EpiBf16<1, false> E{H, FFN, nullptr, nullptr, 0, 0}; pg8::gemm_phase(lds, g, S, E); }
        SEAM(k0 + 6);
        if (RUN(k0 + 7)) { pg8::Gemm g{H, (const bf16_t*)(ws + WS_W2) + (size_t)l * FFN * D, MTOT, D, FFN}; pg8::StaticOrder S; S.init(MTOT, D, G, (int)blockIdx.x, FFN, ws, (l * 4 + 3) * 1024);
            EpiResid E{X, X, X, modl + 5 * D}; pg8::gemm_phase(lds, g, S, E); }
        SEAM(k0 + 7);
    }
#if PROBE_STOP > 0
    GRID_SYNC();
    {
        const size_t n = (size_t)MTOT * D, gt = (size_t)blockIdx.x * 512 + threadIdx.x, gs = (size_t)G * 512;
        const bf16_t* sb = PROBE_SRC == 1 ? XN : PROBE_SRC == 2 ? AB : PROBE_SRC == 3 ? Z : PROBE_SRC == 5 ? Z + (size_t)4096 * NQKV : (const bf16_t*)(ws + WS_Q0);
#if PROBE_SRC == 6
        attn1_phase(p, lds, XN);
        GRID_SYNC();
        for (size_t i = gt; i < n; i += gs) p.out[i] = bf2f(AB[i]) - bf2f(XN[i]);
#else
        for (size_t i = gt; i < n; i += gs) p.out[i] = (PROBE_SRC == 0) ? X[i] : bf2f(sb[i]);
#endif
#if PROBE_STOP < 4
        for (size_t i = gt; i < (size_t)2 * MCTX * 256; i += gs) p.out[OUT_AK + i] = 0.f;
#endif
        for (size_t i = gt; i < (size_t)2 * MCTX * D; i += gs) p.out[OUT_NK + i] = 0.f;
    }
#else
    if (RUN(17)) REPEAT(REP_NORM, norm_phase<true>(X, X, p.in[22], nullptr, 0, 0, nullptr, p.out));
#endif
#undef RUN
#undef SEAM
#undef REPEAT
#undef GRID_SYNC
#undef GRID_SYNC_CG
}

extern "C" void kernel_launch(void* const* d_in, const int* in_sizes, int n_in, void* d_out, int out_size, void* d_ws, size_t ws_size, hipStream_t stream) {
    static int grid = 0;
    if (grid == 0) {
        if (n_in != 23 || ws_size < WS_END) { fprintf(stderr, "kernel_launch: expected 23 inputs and >= %zu bytes of workspace (got %d, %zu)\n", (size_t)WS_END, n_in, ws_size); grid = -1; return; }
        int dev = 0, cus = 0, per_cu = 0;
        (void)hipGetDevice(&dev);
        (void)hipDeviceGetAttribute(&cus, hipDeviceAttributeMultiprocessorCount, dev);
        if (hipFuncSetAttribute((const void*)mega_fwd, hipFuncAttributeMaxDynamicSharedMemorySize, LDS_BYTES) != hipSuccess) { fprintf(stderr, "kernel_launch: hipFuncSetAttribute failed\n"); grid = -1; return; }
        if (hipOccupancyMaxActiveBlocksPerMultiprocessor(&per_cu, (const void*)mega_fwd, 512, LDS_BYTES) != hipSuccess || per_cu < 1) { fprintf(stderr, "kernel_launch: occupancy query failed (%d)\n", per_cu); grid = -1; return; }
        grid = cus * (per_cu > 1 ? 1 : per_cu);
        fprintf(stderr, "kernel_launch: grid %d (cus %d, per_cu %d)\n", grid, cus, per_cu);
    }
    if (grid < 0) return;
    (void)hipMemsetAsync((char*)d_ws + WS_BAR, 0, 65536, stream);
    Params p{};
    for (int i = 0; i < 23; ++i) p.in[i] = (const float*)d_in[i];
    p.out = (float*)d_out; p.ws = (unsigned char*)d_ws;
#if MK_PER_PHASE
    for (int k = 0; k < NPHASE; ++k) {
        if (k == 11) continue;
        p.ph_lo = k; p.ph_hi = k + 1;
        void* args[] = {&p};
        hipError_t e = hipLaunchCooperativeKernel((const void*)mega_fwd, dim3(grid), dim3(512), args, LDS_BYTES, stream);
        if (e != hipSuccess) { fprintf(stderr, "launch %d failed: %s\n", k, hipGetErrorString(e)); break; }
    }
#else
    p.ph_lo = 0; p.ph_hi = PROBE_STOP > 0 ? PROBE_STOP : NPHASE;
    void* args[] = {&p};
    hipError_t e = hipLaunchCooperativeKernel((const void*)mega_fwd, dim3(grid), dim3(512), args, LDS_BYTES, stream);
    if (e != hipSuccess) fprintf(stderr, "cooperative launch failed: %s (grid %d)\n", hipGetErrorString(e), grid);
#endif
}
```

```cpp
#include <hip/hip_runtime.h>
#include <hip/hip_cooperative_groups.h>
#include <cstdio>
#include <cstdint>
namespace cg = cooperative_groups;

#ifndef MK_PER_PHASE
#define MK_PER_PHASE 0
#endif

#ifndef REP_NG
#define REP_NG 1
#endif
#ifndef REP_P0
#define REP_P0 REP_NG
#endif
#ifndef REP_NORM
#define REP_NORM REP_NG
#endif
#ifndef REP_EW
#define REP_EW REP_NG
#endif
#ifndef REP_ATT
#define REP_ATT REP_NG
#endif
#ifndef REP_G
#define REP_G 1
#endif
#ifndef PROBE_STOP
#define PROBE_STOP 0
#endif
#ifndef PROBE_SRC
#define PROBE_SRC 0
#endif
#define LAS __attribute__((address_space(3)))
#define PG8_LAS __attribute__((address_space(3)))
typedef unsigned short bf16_t;
typedef short bf16x8 __attribute__((ext_vector_type(8)));
typedef short v4i16_t __attribute__((ext_vector_type(4)));
typedef float f32x4 __attribute__((ext_vector_type(4)));
typedef float f32x2 __attribute__((ext_vector_type(2)));
typedef unsigned u32x4 __attribute__((ext_vector_type(4)));
typedef unsigned u32x2 __attribute__((ext_vector_type(2)));

__device__ __forceinline__ float bf2f(unsigned h) { return __uint_as_float(h << 16); }
typedef __bf16 bf16x2_t __attribute__((ext_vector_type(2)));
__device__ __forceinline__ unsigned cvt_pk_bf16(float lo, float hi) { f32x2 v = {lo, hi}; bf16x2_t r = __builtin_convertvector(v, bf16x2_t); return __builtin_bit_cast(unsigned, r); }
__device__ __forceinline__ float wave_sum(float v) {
#pragma unroll
    for (int o = 1; o < 64; o <<= 1) v += __shfl_xor(v, o);
    return v;
}

constexpr size_t WS_TS_OFS = 595591168ull;
constexpr size_t WS_FLAGS_OFS = (512u << 10) + 16384;
namespace pg8 {
constexpr int BM = 256, BK = 64, HALF = 128, HTB = HALF * BK * 2  , STAGE_BYTES = 8 * HTB, NXCD = 8, WGM = 4;

__host__ __device__ __forceinline__ int lds_byte(int r, int c) { const int st = (r >> 4) * 2 + (c >> 5), rr = r & 15, cc = c & 31, ob = rr * 64 + cc * 2; return st * 1024 + (ob ^ (((ob >> 9) & 1) << 5)); }
__host__ __device__ __forceinline__ void stage_rc(int b, int& R, int& C) { const int st = b / 1024, sb = b % 1024, swz = sb ^ (((sb >> 9) & 1) << 5); R = (st >> 1) * 16 + swz / 64; C = (st & 1) * 32 + (swz % 64) / 2; }
__host__ __device__ __forceinline__ int perm32(int rho) { const int n = rho >> 4, i = rho & 15; return 8 * (i >> 2) + 4 * n + (i & 3); }
struct Unit { int pm, pn, code; };
struct Gemm { const bf16_t* A; const bf16_t* Bt; int M, N, K; };
struct StaticOrder {
    int nM, nN, nwg, G, c, ntk, R, tail, fofs, msplit; unsigned char* wsb;
    __device__ __forceinline__ int kt0(const Unit& u) const { return (u.code & 3) == 2 ? (ntk >> 1) : 0; }
    __device__ __forceinline__ int nkt(const Unit& u) const { return ((u.code & 3) == 1 || (u.code & 3) == 2) ? (ntk >> 1) : ntk; }
    __host__ __device__ void init(int M, int N, int G_, int c_, int K, unsigned char* wsb_, int fofs_) {
        nM = M / BM; nN = N / BM; nwg = nM * nN; G = G_; c = c_; ntk = K / BK; wsb = wsb_; fofs = fofs_; msplit = (fofs_ == -2);
        R = nwg / G; tail = nwg - R * G;
        if (fofs_ == -1 || 2 * tail > G || (ntk & 3)) tail = 0;
    }
    __host__ __device__ bool next(int i, Unit& u) const {
        long L;
        if (tail) {
            if (i < R) { L = (long)i * G + c; u.code = 0; }
            else if (i == R && c < 2 * tail) { L = (long)R * G + (c >> 1); u.code = msplit ? (3 | ((c & 1) << 2)) : ((1 + (c & 1)) | ((c >> 1) << 2)); }
            else return false;
        } else { L = (long)i * G + c; if (L >= nwg) return false; u.code = 0; }
        int wgid = (int)L; { const int q = nwg / NXCD, r = nwg % NXCD, xcd = wgid % NXCD, off = wgid / NXCD; wgid = (xcd < r ? xcd * (q + 1) : r * (q + 1) + (xcd - r) * q) + off; }
        const int nig = WGM * nN, gid = wgid / nig, fm = gid * WGM, gsz = (nM - fm) < WGM ? (nM - fm) : WGM;
        u.pm = fm + ((wgid % nig) % gsz); u.pn = (wgid % nig) / gsz; return true;
    }
    __device__ __forceinline__ void a_ready(const Unit&) const {}
    __device__ __forceinline__ void done(const Unit&) const {}
};
template <class Epi, class Sched>
__device__ __forceinline__ void gemm_phase(PG8_LAS unsigned char* lds, const Gemm g, const Sched& S, const Epi& E) {
    int tid_ = threadIdx.x; asm volatile("" : "+v"(tid_));
    const int tid = tid_, wid = __builtin_amdgcn_readfirstlane(tid >> 6), lane = tid & 63, wr = wid >> 2, wc = wid & 3, fr = lane & 15, fq = lane >> 4;
    const int K = g.K;
    unsigned voffA[2], voffB[2];
#pragma unroll
    for (int i = 0; i < 2; ++i) { int R, C; stage_rc(tid * 16 + i * 8192, R, C); const int Rb = Epi::PERM ? ((R & ~31) + perm32(R & 31)) : R;
        voffA[i] = (unsigned)(R * K + C) * 2u; voffB[i] = (unsigned)(Rb * K + C) * 2u; }
    const size_t kstep = (size_t)(BK * 2);
    const size_t hstep = (size_t)HALF * K * 2;
    const size_t tstep = 2 * hstep;
    const unsigned ldsw = (unsigned)wid * 1024u;
    const int aoff = lds_byte(wr * 64 + fr, fq * 8), boff = lds_byte(wc * 32 + fr, fq * 8);
#define PG8_SA(b, h) (((b) * 2 + (h)) * HTB)
#define PG8_SB(b, h) ((4 + (b) * 2 + (h)) * HTB)
#define PG8_STAGE(bufoff, gbase, voff) do { _Pragma("unroll") for (int _i = 0; _i < 2; ++_i) \
        __builtin_amdgcn_global_load_lds((const unsigned*)((const char*)(gbase) + (voff)[_i]), (PG8_LAS unsigned*)(lds + (bufoff) + ldsw + _i * 8192), 16, 0, 0); } while (0)
#define PG8_LDA(dst, b, h) do { _Pragma("unroll") for (int m = 0; m < 4; ++m) _Pragma("unroll") for (int k = 0; k < 2; ++k) dst[m][k] = *(const PG8_LAS bf16x8*)(lds + PG8_SA(b, h) + aoff + m * 2048 + k * 1024); } while (0)
#define PG8_LDB(dst, b, h) do { _Pragma("unroll") for (int n = 0; n < 2; ++n) _Pragma("unroll") for (int k = 0; k < 2; ++k) dst[n][k] = *(const PG8_LAS bf16x8*)(lds + PG8_SB(b, h) + boff + n * 2048 + k * 1024); } while (0)
#define PG8_MMA(ai, bj, At, Bt) do { __builtin_amdgcn_s_setprio(1); _Pragma("unroll") for (int m = 0; m < 4; ++m) _Pragma("unroll") for (int n = 0; n < 2; ++n) _Pragma("unroll") for (int k = 0; k < 2; ++k) \
        acc[ai][bj][m][n] = __builtin_amdgcn_mfma_f32_16x16x32_bf16(Bt[n][k], At[m][k], acc[ai][bj][m][n], 0, 0, 0); __builtin_amdgcn_s_setprio(0); } while (0)
#define PG8_WAIT_V(n) asm volatile("s_waitcnt vmcnt(" #n ")" ::: "memory")
#define PG8_WAIT_L(n) asm volatile("s_waitcnt lgkmcnt(" #n ")" ::: "memory")
#define PG8_BAR __builtin_amdgcn_s_barrier()
#define PG8_SCHED __builtin_amdgcn_sched_barrier(0)
    Unit cur, nxt; int ui = 0;
    if (!S.next(0, cur)) return;
    f32x4 acc[2][2][4][2];
#pragma unroll
    for (int a = 0; a < 2; ++a)
#pragma unroll
        for (int b = 0; b < 2; ++b)
#pragma unroll
            for (int m = 0; m < 4; ++m)
#pragma unroll
                for (int n = 0; n < 2; ++n) acc[a][b][m][n] = (f32x4){0.f, 0.f, 0.f, 0.f};
    bf16x8 At[4][2], B0[2][2], B1[2][2];
    const char* cA = (const char*)g.A + (size_t)cur.pm * tstep + (size_t)S.kt0(cur) * kstep; const char* cB = (const char*)g.Bt + (size_t)cur.pn * tstep + (size_t)S.kt0(cur) * kstep;
    S.a_ready(cur);
    if ((cur.code & 3) == 3) cA += (size_t)(cur.code >> 2) * hstep;
    size_t ahs = (cur.code & 3) == 3 ? 0 : hstep;
    PG8_STAGE(PG8_SB(0, 0), cB, voffB); PG8_STAGE(PG8_SB(0, 1), cB + hstep, voffB); PG8_STAGE(PG8_SA(0, 0), cA, voffA); PG8_STAGE(PG8_SA(0, 1), cA + ahs, voffA);
    if (wr == 1) PG8_BAR;
    PG8_WAIT_V(2); PG8_BAR;
    PG8_STAGE(PG8_SB(1, 0), cB + kstep, voffB); PG8_STAGE(PG8_SA(1, 0), cA + kstep, voffA); PG8_STAGE(PG8_SB(1, 1), cB + hstep + kstep, voffB);
    PG8_WAIT_V(6); PG8_BAR;
    for (;;) {
        const bool has_next = S.next(ui + 1, nxt);
        const char* nA = has_next ? (const char*)g.A + (size_t)nxt.pm * tstep + (size_t)S.kt0(nxt) * kstep : cA; const char* nB = has_next ? (const char*)g.Bt + (size_t)nxt.pn * tstep + (size_t)S.kt0(nxt) * kstep : cB;
        const int nt = S.nkt(cur);
        const bool full = (cur.code & 3) != 3;
        const size_t ahs_n = (has_next && (nxt.code & 3) == 3) ? 0 : (has_next ? hstep : ahs);
        if (has_next && (nxt.code & 3) == 3) nA += (size_t)(nxt.code >> 2) * hstep;
        for (int t = 0; t < nt; t += 2) {
            const bool last = (t == nt - 2);
            const char* a1 = cA + (size_t)(t + 1) * kstep;
            const char* a2 = last ? nA : cA + (size_t)(t + 2) * kstep; const char* b2 = last ? nB : cB + (size_t)(t + 2) * kstep;
            const char* a3 = a2 + kstep; const char* b3 = b2 + kstep;
            if (last && has_next) S.a_ready(nxt);
            PG8_LDB(B0, 0, 0); PG8_LDB(B1, 0, 1); PG8_SCHED; PG8_LDA(At, 0, 0); PG8_STAGE(PG8_SA(1, 1), a1 + ahs, voffA);
            PG8_WAIT_V(8); PG8_WAIT_L(0); PG8_BAR; PG8_MMA(0, 0, At, B0); PG8_MMA(0, 1, At, B1); PG8_BAR; PG8_SCHED;
            PG8_LDA(At, 0, 1); PG8_STAGE(PG8_SB(0, 0), b2, voffB); PG8_STAGE(PG8_SB(0, 1), b2 + hstep, voffB); PG8_STAGE(PG8_SA(0, 0), a2, voffA);
            PG8_WAIT_V(8); PG8_WAIT_L(0); PG8_BAR; if (full) { PG8_MMA(1, 0, At, B0); PG8_MMA(1, 1, At, B1); } PG8_BAR; PG8_SCHED;
            PG8_LDB(B0, 1, 0); PG8_LDB(B1, 1, 1); PG8_SCHED; PG8_LDA(At, 1, 0); PG8_STAGE(PG8_SA(0, 1), a2 + (last ? ahs_n : ahs), voffA);
            PG8_WAIT_V(8); PG8_WAIT_L(0); PG8_BAR; PG8_MMA(0, 0, At, B0); PG8_MMA(0, 1, At, B1); PG8_BAR; PG8_SCHED;
            PG8_LDA(At, 1, 1); PG8_STAGE(PG8_SB(1, 0), b3, voffB); PG8_STAGE(PG8_SB(1, 1), b3 + hstep, voffB); PG8_STAGE(PG8_SA(1, 0), a3, voffA);
            PG8_WAIT_V(8); PG8_WAIT_L(0); PG8_BAR; if (full) { PG8_MMA(1, 0, At, B0); PG8_MMA(1, 1, At, B1); } PG8_BAR; PG8_SCHED;
        }
        if (wr == 0) PG8_BAR;
        const int role = cur.code & 3, slot = cur.code >> 2;
        if (role == 2) {
            f32x4* sp = (f32x4*)(S.wsb + WS_TS_OFS + (size_t)((S.fofs >> 12) + 1) * 33554432u) + (size_t)slot * (32 * 512) + tid;
#pragma unroll
            for (int a = 0; a < 2; ++a)
#pragma unroll
                for (int b = 0; b < 2; ++b)
#pragma unroll
                    for (int m = 0; m < 4; ++m)
#pragma unroll
                        for (int n = 0; n < 2; ++n) asm volatile("global_store_dwordx4 %0, %1, off sc1" :: "v"(sp + (((a * 2 + b) * 4 + m) * 2 + n) * 512), "v"(acc[a][b][m][n]) : "memory");
            asm volatile("s_waitcnt vmcnt(0)" ::: "memory");
            if (lane == 0) __hip_atomic_store((unsigned*)(S.wsb + WS_FLAGS_OFS) + S.fofs + slot * 8 + wid, 1u, __ATOMIC_RELAXED, __HIP_MEMORY_SCOPE_AGENT);
        } else {
            if (role == 1) {
                unsigned spins = 0;
                while (__hip_atomic_load((unsigned*)(S.wsb + WS_FLAGS_OFS) + S.fofs + slot * 8 + wid, __ATOMIC_RELAXED, __HIP_MEMORY_SCOPE_AGENT) == 0u) { __builtin_amdgcn_s_sleep(2); if (++spins > (1u << 22)) break; }
                __builtin_amdgcn_fence(__ATOMIC_ACQUIRE, "agent");
                asm volatile("s_waitcnt vmcnt(0)" ::: "memory");
                const f32x4* sp = (const f32x4*)(S.wsb + WS_TS_OFS + (size_t)((S.fofs >> 12) + 1) * 33554432u) + (size_t)slot * (32 * 512) + tid;
#pragma unroll
                for (int a = 0; a < 2; ++a)
#pragma unroll
                    for (int b = 0; b < 2; ++b)
#pragma unroll
                        for (int m = 0; m < 4; ++m)
#pragma unroll
                            for (int n = 0; n < 2; ++n) { acc[a][b][m][n] += sp[(((a * 2 + b) * 4 + m) * 2 + n) * 512]; asm volatile("" ::: "memory"); }
            }
            E(acc, cur, wr, wc, fr, fq, role == 3 ? slot * 128 : 0, role == 3 ? 1 : 2);
        }
        if (!has_next) break;
#pragma unroll
        for (int a = 0; a < 2; ++a)
#pragma unroll
            for (int b = 0; b < 2; ++b)
#pragma unroll
                for (int m = 0; m < 4; ++m)
#pragma unroll
                    for (int n = 0; n < 2; ++n) acc[a][b][m][n] = (f32x4){0.f, 0.f, 0.f, 0.f};
        cur = nxt; cA = nA; cB = nB; ahs = ahs_n; ++ui;
        if (wr == 1) PG8_BAR;
    }
    PG8_WAIT_V(0);
    PG8_BAR;
    if constexpr (Epi::AFTER_DRAIN) { E.fused(acc, cur, wr, wc, fr, fq, lds, wid, lane); S.done(cur); }
#undef PG8_SA
#undef PG8_SB
#undef PG8_STAGE
#undef PG8_LDA
#undef PG8_LDB
#undef PG8_MMA
#undef PG8_WAIT_V
#undef PG8_WAIT_L
#undef PG8_BAR
#undef PG8_SCHED
}
}

constexpr int D = 2048, MCTX = 8192, MLAT = 4096, MTOT = 12288, FFN = 8192, ABIN = 4608, NQKV = 6144, MODW = 12288;
constexpr float EPS = 1e-6f;
constexpr size_t WS_MOD = 0;
constexpr size_t WS_BAR = 512u << 10;
constexpr size_t WS_WIN = 1u << 20;
constexpr size_t WS_WO0 = WS_WIN + (size_t)ABIN * D * 2;
constexpr size_t WS_WQKV = WS_WO0 + (size_t)D * D * 2;
constexpr size_t WS_WO1 = WS_WQKV + (size_t)NQKV * D * 2;
constexpr size_t WS_W1 = WS_WO1 + (size_t)D * D * 2;
constexpr size_t WS_W2 = WS_W1 + 2 * (size_t)FFN * D * 2;
constexpr size_t WS_XN = WS_W2 + 2 * (size_t)FFN * D * 2;
constexpr size_t WS_H = WS_XN + (size_t)MTOT * D * 2;
constexpr size_t WS_Z = WS_H;
constexpr size_t WS_AB = WS_H + (size_t)MTOT * NQKV * 2;
constexpr size_t WS_Q0 = WS_H + (size_t)MTOT * FFN * 2;
constexpr size_t WS_K0 = WS_Q0 + (size_t)MTOT * 1024 * 2;
constexpr size_t WS_V0 = WS_K0 + (size_t)(MTOT + 1024) * 256 * 2;
constexpr size_t WS_CNK = WS_V0 + (size_t)(MTOT + 1024) * 256 * 2;
constexpr size_t WS_CNV = WS_CNK + (size_t)1024 * 2048 * 2;
constexpr size_t WS_X = WS_CNV + (size_t)1024 * 2048 * 2;
constexpr size_t WS_TS = WS_X + (size_t)MTOT * D * 4;
constexpr size_t WS_END = WS_TS + 3 * (size_t)128 * 32 * 512 * 16;
constexpr size_t WS_FLAGS = WS_BAR + 16384;
static_assert(WS_TS == WS_TS_OFS && WS_FLAGS == WS_FLAGS_OFS, "early offsets");
constexpr int LDS_BYTES = 131072 + 256;

constexpr size_t OUT_YP = 0, OUT_YS = (size_t)MCTX * D, OUT_AK = OUT_YS + (size_t)MLAT * D, OUT_AV = OUT_AK + (size_t)MCTX * 256,
                 OUT_NK = OUT_AV + (size_t)MCTX * 256, OUT_NV = OUT_NK + (size_t)MCTX * D;

struct Params {
    const float* in[23];
    float* out;
    unsigned char* ws;
    int ph_lo, ph_hi;
};

template <int ACT, bool SIDE> struct EpiBf16 {
    static constexpr bool PERM = true, AFTER_DRAIN = false;
    bf16_t* O; int ldc; float* kout; float* vout; int split_tiles; size_t split_stride;
    __device__ __forceinline__ void operator()(const f32x4 (&acc)[2][2][4][2], const pg8::Unit& u, int wr, int wc, int fr, int fq, int rowofs, int nai) const {
        const int row0 = u.pm * 256 + rowofs + wr * 64 + fr, col0 = u.pn * 256 + wc * 32 + 8 * fq;
        const int spt = split_tiles ? u.pn / split_tiles : 0; bf16_t* Ob = O + (size_t)spt * split_stride; const int ocol0 = col0 - spt * split_tiles * 256;
        const bool side = SIDE && (u.pm < 32) && (u.pn >= 8);
        float* sbase = nullptr; int scol0 = 0;
        if (SIDE) { sbase = (u.pn < 16) ? kout : vout; scol0 = col0 - ((u.pn < 16) ? 2048 : 4096); }
#pragma unroll
        for (int ai = 0; ai < 2; ++ai) if (ai < nai)
#pragma unroll
            for (int m = 0; m < 4; ++m) {
                const int row = row0 + ai * 128 + m * 16;
                bf16_t* rowp = Ob + (size_t)row * ldc + ocol0;
#pragma unroll
                for (int bj = 0; bj < 2; ++bj) {
                    f32x4 v0 = acc[ai][bj][m][0], v1 = acc[ai][bj][m][1];
                    if (SIDE) { if (side) { float* sp = sbase + (size_t)row * 2048 + scol0 + bj * 128; *(f32x4*)sp = v0; *(f32x4*)(sp + 4) = v1; } }
                    if (ACT == 1) {
#pragma unroll
                        for (int j = 0; j < 4; ++j) { float a = fmaxf(v0[j], 0.f), b = fmaxf(v1[j], 0.f); v0[j] = a * a; v1[j] = b * b; }
                    }
                    u32x4 o; o.x = cvt_pk_bf16(v0[0], v0[1]); o.y = cvt_pk_bf16(v0[2], v0[3]); o.z = cvt_pk_bf16(v1[0], v1[1]); o.w = cvt_pk_bf16(v1[2], v1[3]);
                    *(u32x4*)(rowp + bj * 128) = o;
                }
            }
    }
};
struct EpiResid {
    static constexpr bool PERM = false, AFTER_DRAIN = false;
    const float* src_lo; const float* src_hi;
    const bf16_t* xsrc; bf16_t* X; const float* gate;
    __device__ __forceinline__ void operator()(const f32x4 (&acc)[2][2][4][2], const pg8::Unit& u, int wr, int wc, int fr, int fq, int rowofs, int nai) const {
        const int row0 = u.pm * 256 + rowofs + wr * 64 + fr, col0 = u.pn * 256 + wc * 32 + 4 * fq;
        const int cond = (u.pm < 32) ? 0 : 1 + ((u.pm - 32) >> 3);
        const float* gp = gate + (size_t)cond * MODW + col0;
        const float* sb = (u.pm < 32) ? src_lo : src_hi;
        f32x4 gv[2][2];
#pragma unroll
        for (int bj = 0; bj < 2; ++bj)
#pragma unroll
            for (int n = 0; n < 2; ++n) gv[bj][n] = *(const f32x4*)(gp + bj * 128 + n * 16);
#pragma unroll
        for (int ai = 0; ai < 2; ++ai) if (ai < nai)
#pragma unroll
            for (int m = 0; m < 4; ++m) {
                const size_t off = (size_t)(row0 + ai * 128 + m * 16) * D + col0;
#pragma unroll
                for (int bj = 0; bj < 2; ++bj)
#pragma unroll
                    for (int n = 0; n < 2; ++n) {
                        f32x4 r;
                        if (xsrc) { const u32x2 rb = *(const u32x2*)(xsrc + off + bj * 128 + n * 16); r[0] = bf2f(rb.x & 0xffffu); r[1] = __uint_as_float(rb.x & 0xffff0000u); r[2] = bf2f(rb.y & 0xffffu); r[3] = __uint_as_float(rb.y & 0xffff0000u); }
                        else r = *(const f32x4*)(sb + off + bj * 128 + n * 16);
                        const f32x4 xn = r + gv[bj][n] * acc[ai][bj][m][n];
                        u32x2 o; o.x = cvt_pk_bf16(xn[0], xn[1]); o.y = cvt_pk_bf16(xn[2], xn[3]);
                        *(u32x2*)(X + off + bj * 128 + n * 16) = o;
                    }
            }
    }
};

__device__ __forceinline__ unsigned f2bf(float f) { unsigned u = __float_as_uint(f); return (u + 0x7fffu + ((u >> 16) & 1u)) >> 16; }
__device__ __forceinline__ unsigned pk2(float lo, float hi) { return f2bf(lo) | (f2bf(hi) << 16); }
__device__ __forceinline__ void p0_transpose_item(const float* W, int K, int N, bf16_t* WT, LAS float* scr, int item, int lane) {
    const int nblk = N / 32, kb = item / nblk, nb = item % nblk, k0 = 64 * kb, n0 = 32 * nb;
#pragma unroll 8
    for (int i = 0; i < 32; ++i) { const int kk = 2 * i + (lane >> 5); scr[kk * 33 + (lane & 31)] = W[(size_t)(k0 + kk) * N + n0 + (lane & 31)]; }
    asm volatile("s_waitcnt lgkmcnt(0)" ::: "memory");
    const int c = lane & 7;
#pragma unroll
    for (int j = 0; j < 4; ++j) { const int n = (lane >> 3) + 8 * j; const LAS float* s = scr + (8 * c) * 33 + n;
        u32x4 o; o.x = pk2(s[0 * 33], s[1 * 33]); o.y = pk2(s[2 * 33], s[3 * 33]); o.z = pk2(s[4 * 33], s[5 * 33]); o.w = pk2(s[6 * 33], s[7 * 33]);
        *(u32x4*)(WT + (size_t)(n0 + n) * K + k0 + 8 * c) = o; }
    asm volatile("s_waitcnt lgkmcnt(0)" ::: "memory");
}
__device__ __forceinline__ void cvt_linear(const float* src, bf16_t* dst, int n, int gtid, int gthreads) {
    for (int i = gtid * 4; i < n; i += gthreads * 4) { const f32x4 v = *(const f32x4*)(src + i); u32x2 o; o.x = cvt_pk_bf16(v[0], v[1]); o.y = cvt_pk_bf16(v[2], v[3]); *(u32x2*)(dst + i) = o; }
}
__device__ __forceinline__ void p0_prologue(const Params& p, LAS unsigned char* lds) {
    int tid_ = threadIdx.x; asm volatile("" : "+v"(tid_));
    const int tid = tid_, lane = tid & 63, wave = __builtin_amdgcn_readfirstlane(tid >> 6), G = gridDim.x;
    unsigned char* ws = p.ws;
    {
        LAS float* sc = (LAS float*)(lds + 69632);
        LAS float* red = (LAS float*)(lds + 69632 + 24576);
        const float* cvec = p.in[6]; const float* cctx = p.in[7];
        for (int i = tid; i < 3 * 2048; i += 512) { const int c = i >> 11, k = i & 2047; const float x = (c == 0) ? cctx[k] : cvec[(c - 1) * 2048 + k]; sc[i] = x / (1.f + __expf(-x)); }
        __syncthreads();
        float* MOD = (float*)(ws + WS_MOD);
        for (int item = blockIdx.x; item < 256; item += G) {
            const int l = item >> 7, cgp = item & 127, ln = lane < 48 ? lane : 47;
            const float* W = p.in[8] + (size_t)l * 2048 * MODW + cgp * 96 + ln * 2;
            float a00 = 0.f, a01 = 0.f, a10 = 0.f, a11 = 0.f, a20 = 0.f, a21 = 0.f;
            const int kb = wave * 256;
#pragma unroll 8
            for (int k = 0; k < 256; ++k) {
                const f32x2 w = *(const f32x2*)(W + (size_t)(kb + k) * MODW);
                const float s0 = sc[kb + k], s1 = sc[2048 + kb + k], s2 = sc[4096 + kb + k];
                a00 += s0 * w.x; a01 += s0 * w.y; a10 += s1 * w.x; a11 += s1 * w.y; a20 += s2 * w.x; a21 += s2 * w.y;
            }
            if (lane < 48) { LAS float* r = red + wave * 288 + lane * 2; r[0] = a00; r[1] = a01; r[96] = a10; r[97] = a11; r[192] = a20; r[193] = a21; }
            __syncthreads();
            if (tid < 288) { const int c = tid / 96, j = tid % 96; float s = 0.f;
#pragma unroll
                for (int w = 0; w < 8; ++w) s += red[w * 288 + tid];
                MOD[(size_t)(l * 3 + c) * MODW + cgp * 96 + j] = s + p.in[9][l * MODW + cgp * 96 + j]; }
            __syncthreads();
        }
    }
    {
        LAS float* scr = (LAS float*)(lds + wave * 8448);
        const int gw = blockIdx.x * 8 + wave, NGW = G * 8;
        constexpr int I_IN = 32 * (ABIN / 32), I_O = 32 * (D / 32), I_QKV = 32 * (NQKV / 32), I_1 = 32 * (FFN / 32), I_2 = (FFN / 64) * (D / 32);
        constexpr int NITEMS = I_IN + 2 * I_O + I_QKV + 2 * I_1 + 2 * I_2;
        for (int it = gw; it < NITEMS; it += NGW) {
            int r = it;
            if (r < I_IN) { p0_transpose_item(p.in[12], D, ABIN, (bf16_t*)(ws + WS_WIN), scr, r, lane); continue; } r -= I_IN;
            if (r < I_O) { p0_transpose_item(p.in[16], D, D, (bf16_t*)(ws + WS_WO0), scr, r, lane); continue; } r -= I_O;
            if (r < I_QKV) { p0_transpose_item(p.in[17], D, NQKV, (bf16_t*)(ws + WS_WQKV), scr, r, lane); continue; } r -= I_QKV;
            if (r < I_O) { p0_transpose_item(p.in[19], D, D, (bf16_t*)(ws + WS_WO1), scr, r, lane); continue; } r -= I_O;
            if (r < 2 * I_1) { const int l = r / I_1; p0_transpose_item(p.in[20] + (size_t)l * D * FFN, D, FFN, (bf16_t*)(ws + WS_W1) + (size_t)l * FFN * D, scr, r - l * I_1, lane); continue; } r -= 2 * I_1;
            { const int l = r / I_2; p0_transpose_item(p.in[21] + (size_t)l * D * FFN, FFN, D, (bf16_t*)(ws + WS_W2) + (size_t)l * FFN * D, scr, r - l * I_2, lane); }
        }
    }
    {
        const int gtid = blockIdx.x * 512 + tid, gth = G * 512;
        cvt_linear(p.in[2], (bf16_t*)(ws + WS_K0) + (size_t)MTOT * 256, 1024 * 256, gtid, gth);
        cvt_linear(p.in[3], (bf16_t*)(ws + WS_V0) + (size_t)MTOT * 256, 1024 * 256, gtid, gth);
        cvt_linear(p.in[4], (bf16_t*)(ws + WS_CNK), 1024 * 2048, gtid, gth);
        cvt_linear(p.in[5], (bf16_t*)(ws + WS_CNV), 1024 * 2048, gtid, gth);
    }
}

template <bool OUT_F32>
__device__ __forceinline__ void norm_phase(const float* src_lo, const float* src_hi, const bf16_t* xb, const float* gain, const float* mod, int shift_off, int scale_off, bf16_t* dst_bf, float* dst_f) {
    int tid_ = threadIdx.x; asm volatile("" : "+v"(tid_));
    const int tid = tid_, lane = tid & 63, wave = tid >> 6, G = gridDim.x;
    const int gw = blockIdx.x * 8 + wave, NGW = G * 8, per = (MTOT + NGW - 1) / NGW;
    const int r_beg = gw * per, r_end = (r_beg + per < MTOT) ? r_beg + per : MTOT;
    int cur = -1; f32x4 A[8], B[8];
    for (int row = r_beg; row < r_end; ++row) {
        const int cond = (row < MCTX) ? 0 : 1 + ((row - MCTX) >> 11);
        if (cond != cur) {
            cur = cond;
#pragma unroll
            for (int j = 0; j < 8; ++j) {
                const int col = 4 * lane + 256 * j; const f32x4 g = *(const f32x4*)(gain + col);
                if (mod) { const f32x4 sc = *(const f32x4*)(mod + (size_t)cond * MODW + scale_off + col); A[j] = g * (sc + 1.f); B[j] = *(const f32x4*)(mod + (size_t)cond * MODW + shift_off + col); }
                else { A[j] = g; B[j] = (f32x4){0.f, 0.f, 0.f, 0.f}; }
            }
        }
        f32x4 v[8]; float s = 0.f;
        if (xb) {
            const bf16_t* xr = xb + (size_t)row * D + 4 * lane;
#pragma unroll
            for (int j = 0; j < 8; ++j) { const u32x2 rb = *(const u32x2*)(xr + 256 * j); v[j][0] = bf2f(rb.x & 0xffffu); v[j][1] = __uint_as_float(rb.x & 0xffff0000u); v[j][2] = bf2f(rb.y & 0xffffu); v[j][3] = __uint_as_float(rb.y & 0xffff0000u); }
        } else {
            const float* xr = ((row < MCTX) ? src_lo : src_hi) + (size_t)row * D + 4 * lane;
#pragma unroll
            for (int j = 0; j < 8; ++j) v[j] = *(const f32x4*)(xr + 256 * j);
        }
#pragma unroll
        for (int j = 0; j < 8; ++j) s += (v[j].x * v[j].x + v[j].y * v[j].y) + (v[j].z * v[j].z + v[j].w * v[j].w);
        const float rstd = rsqrtf(wave_sum(s) * (1.f / D) + EPS);
#pragma unroll
        for (int j = 0; j < 8; ++j) {
            const f32x4 y = v[j] * rstd * A[j] + B[j];
            if (OUT_F32) *(f32x4*)(dst_f + (size_t)row * D + 4 * lane + 256 * j) = y;
            else { u32x2 o; o.x = cvt_pk_bf16(y[0], y[1]); o.y = cvt_pk_bf16(y[2], y[3]); *(u32x2*)(dst_bf + (size_t)row * D + 4 * lane + 256 * j) = o; }
        }
    }
}

__device__ __forceinline__ void unpack8(const u32x4 r, float (&f)[8]) {
    f[0] = bf2f(r.x & 0xffffu); f[1] = __uint_as_float(r.x & 0xffff0000u); f[2] = bf2f(r.y & 0xffffu); f[3] = __uint_as_float(r.y & 0xffff0000u);
    f[4] = bf2f(r.z & 0xffffu); f[5] = __uint_as_float(r.z & 0xffff0000u); f[6] = bf2f(r.w & 0xffffu); f[7] = __uint_as_float(r.w & 0xffff0000u);
}
__device__ __forceinline__ void ew0_phase(const Params& p) {
    int tid_ = threadIdx.x; asm volatile("" : "+v"(tid_));
    const int tid = tid_, lane = tid & 63, wave = tid >> 6, G = gridDim.x;
    const int gw = blockIdx.x * 8 + wave, NGW = G * 8;
    unsigned char* ws = p.ws;
    const bf16_t* Z = (const bf16_t*)(ws + WS_Z);
    bf16_t* AB = (bf16_t*)(ws + WS_AB); bf16_t* Q0 = (bf16_t*)(ws + WS_Q0); bf16_t* K0 = (bf16_t*)(ws + WS_K0); bf16_t* V0 = (bf16_t*)(ws + WS_V0);
    const float* convw = p.in[13]; const float* qn = p.in[14]; const float* kn = p.in[15];
    const int ri = lane & 31, chunk = lane >> 5, da = chunk * 64 + ri, db = da + 32;
    const float inv = __builtin_amdgcn_exp2f(-(float)ri * (13.287712379549449f / 32.f));
    const float qwa = qn[da], qwb = qn[db], kwa = kn[da], kwb = kn[db];
    for (int tok = gw; tok < MTOT; tok += NGW) {
        const bool lat = tok >= MCTX;
        const int t = lat ? ((tok - MCTX) & 2047) : (tok & 255), slen = lat ? 2048 : 256;
        const bf16_t* zr = Z + (size_t)tok * ABIN;
#pragma unroll
        for (int j = 0; j < 2; ++j) {
            const int ch = j * 512 + lane * 8;
            float gb[8], acc[8];
            unpack8(*(const u32x4*)(zr + ch), gb);
#pragma unroll
            for (int e = 0; e < 8; ++e) acc[e] = 0.f;
#pragma unroll
            for (int dt = -1; dt <= 1; ++dt) {
                if (t + dt >= 0 && t + dt < slen) {
                    float gc[8], xa[8];
                    unpack8(*(const u32x4*)(zr + dt * ABIN + 1024 + ch), gc);
                    unpack8(*(const u32x4*)(zr + dt * ABIN + 2048 + ch), xa);
                    const f32x4 w0 = *(const f32x4*)(convw + (dt + 1) * 1024 + ch), w1 = *(const f32x4*)(convw + (dt + 1) * 1024 + ch + 4);
#pragma unroll
                    for (int e = 0; e < 4; ++e) { acc[e] += w0[e] * (gc[e] * xa[e]); acc[4 + e] += w1[e] * (gc[4 + e] * xa[4 + e]); }
                }
            }
            u32x4 o; o.x = cvt_pk_bf16(gb[0] * acc[0], gb[1] * acc[1]); o.y = cvt_pk_bf16(gb[2] * acc[2], gb[3] * acc[3]);
            o.z = cvt_pk_bf16(gb[4] * acc[4], gb[5] * acc[5]); o.w = cvt_pk_bf16(gb[6] * acc[6], gb[7] * acc[7]);
            *(u32x4*)(AB + (size_t)tok * D + ch) = o;
        }
        float cs = 1.f, sn = 0.f;
        if (lat) { const float pos = (float)(chunk == 0 ? (t >> 6) : (t & 63)); const float ang = pos * inv; cs = __cosf(ang); sn = __sinf(ang); }
#pragma unroll
        for (int hh = 0; hh < 10; ++hh) {
            const bf16_t* hp = zr + 3072 + hh * 128;
            const float va = bf2f(hp[da]), vb = bf2f(hp[db]);
            const float rstd = rsqrtf(wave_sum(va * va + vb * vb) * (1.f / 128.f) + EPS);
            const float na = va * rstd * (hh < 8 ? qwa : kwa), nb = vb * rstd * (hh < 8 ? qwb : kwb);
            const float ra = na * cs - nb * sn, rb = na * sn + nb * cs;
            if (hh < 8) { bf16_t* q = Q0 + (size_t)tok * 1024 + hh * 128; q[da] = (bf16_t)f2bf(ra); q[db] = (bf16_t)f2bf(rb); }
            else {
                const int kvh = hh - 8;
                bf16_t* k = K0 + (size_t)tok * 256 + kvh * 128; k[da] = (bf16_t)f2bf(ra); k[db] = (bf16_t)f2bf(rb);
                if (!lat) { float* ok = p.out + OUT_AK + (size_t)tok * 256 + kvh * 128; ok[da] = na; ok[db] = nb; }
            }
        }
        {
            const u32x2 r = *(const u32x2*)(zr + 4352 + lane * 4);
            *(u32x2*)(V0 + (size_t)tok * 256 + lane * 4) = r;
            if (!lat) { f32x4 o; o[0] = bf2f(r.x & 0xffffu); o[1] = __uint_as_float(r.x & 0xffff0000u); o[2] = bf2f(r.y & 0xffffu); o[3] = __uint_as_float(r.y & 0xffff0000u);
                *(f32x4*)(p.out + OUT_AV + (size_t)tok * 256 + lane * 4) = o; }
        }
    }
}

constexpr int KSTR = 272, VSTR = 288, LDS_KT = 0, LDS_VT = 2 * 64 * KSTR, LDS_BIAS = LDS_VT + 2 * 64 * VSTR;
constexpr float SCL2 = 0.08838834764831845f * 1.4426950408889634f, LOG2E = 1.4426950408889634f;
struct AttnArgs {
    const bf16_t* q; int qstride; int qrow0;
    bf16_t* o; int ostride;
    const bf16_t* kA; const bf16_t* vA; int strideA, ntA;
    const bf16_t* kB; const bf16_t* vB; int strideB, ntB;
    int t0, t1, role; f32x4* xs; unsigned* xf;
    int r0, krlo; const float* bias;
};
__device__ __forceinline__ v4i16_t vtr(const LAS unsigned char* p) { return __builtin_amdgcn_ds_read_tr16_b64_v4i16((LAS v4i16_t*)p); }

template <int NA>
__device__ __forceinline__ void attn_run(LAS unsigned char* lds, const AttnArgs& a) {
    int tid_ = threadIdx.x; asm volatile("" : "+v"(tid_));
    const int tid = tid_, lane = tid & 63, wave = __builtin_amdgcn_readfirstlane(tid >> 6), fr = lane & 15, fq = lane >> 4;
    bf16x8 Qf[2][4];
#pragma unroll
    for (int qb = 0; qb < 2; ++qb)
#pragma unroll
        for (int dc = 0; dc < 4; ++dc) Qf[qb][dc] = *(const bf16x8*)(a.q + (size_t)(a.qrow0 + wave * 32 + qb * 16 + fr) * a.qstride + dc * 32 + fq * 8);
    f32x4 O[2][8];
#pragma unroll
    for (int qb = 0; qb < 2; ++qb)
#pragma unroll
        for (int db = 0; db < 8; ++db) O[qb][db] = (f32x4){0.f, 0.f, 0.f, 0.f};
    float mrun[2] = {-1e30f, -1e30f}, lrun[2] = {0.f, 0.f};
    LAS float* biasL = (LAS float*)(lds + LDS_BIAS);
    if (NA) { for (int i = tid; i < 465; i += 512) biasL[i] = a.bias[i]; }
    const int lrow = tid >> 3, lch = tid & 7;
    u32x4 kr0, kr1, vr0, vr1;
#define ATT_GLOAD(t) do { const bool inA = (t) < a.ntA; const int tt = inA ? (t) : (t) - a.ntA; const int st = inA ? a.strideA : a.strideB; \
        const bf16_t* kp = (inA ? a.kA : a.kB) + (size_t)(tt * 64 + lrow) * st + lch * 8; const bf16_t* vp = (inA ? a.vA : a.vB) + (size_t)(tt * 64 + lrow) * st + lch * 8; \
        kr0 = *(const u32x4*)kp; kr1 = *(const u32x4*)(kp + 64); vr0 = *(const u32x4*)vp; vr1 = *(const u32x4*)(vp + 64); } while (0)
#define ATT_LWRITE(b) do { LAS unsigned char* kd = lds + LDS_KT + (b) * 64 * KSTR + lrow * KSTR + lch * 16; LAS unsigned char* vd = lds + LDS_VT + (b) * 64 * VSTR + lrow * VSTR + lch * 16; \
        *(LAS u32x4*)kd = kr0; *(LAS u32x4*)(kd + 128) = kr1; *(LAS u32x4*)vd = vr0; *(LAS u32x4*)(vd + 128) = vr1; } while (0)
    ATT_GLOAD(a.t0); ATT_LWRITE(a.t0 & 1); __syncthreads();
    const int rw = NA ? a.r0 + (wave >> 1) : 0;
    const int kr_lo_w = NA ? (rw - 4 < 0 ? 0 : (rw - 4 > 24 ? 24 : rw - 4)) : 0;
    for (int t = a.t0; t < a.t1; ++t) {
        if (t + 1 < a.t1) ATT_GLOAD(t + 1);
        bool active = true; int kr = 0; const bool local = NA && t >= a.ntA;
        if (local) { kr = a.krlo + (t - a.ntA); active = (kr >= kr_lo_w) && (kr < kr_lo_w + 8); }
        if (active) {
            const LAS unsigned char* Kt = lds + LDS_KT + (t & 1) * 64 * KSTR;
            const LAS unsigned char* Vt = lds + LDS_VT + (t & 1) * 64 * VSTR;
            f32x4 S[2][4];
#pragma unroll
            for (int qb = 0; qb < 2; ++qb)
#pragma unroll
                for (int kb = 0; kb < 4; ++kb) S[qb][kb] = (f32x4){0.f, 0.f, 0.f, 0.f};
#pragma unroll
            for (int kb = 0; kb < 4; ++kb)
#pragma unroll
                for (int dc = 0; dc < 4; ++dc) {
                    const bf16x8 kf = *(const LAS bf16x8*)(Kt + (kb * 16 + fr) * KSTR + dc * 64 + fq * 16);
                    S[0][kb] = __builtin_amdgcn_mfma_f32_16x16x32_bf16(kf, Qf[0][dc], S[0][kb], 0, 0, 0);
                    S[1][kb] = __builtin_amdgcn_mfma_f32_16x16x32_bf16(kf, Qf[1][dc], S[1][kb], 0, 0, 0);
                }
            bf16x8 Pf[2][2];
#pragma unroll
            for (int qb = 0; qb < 2; ++qb) {
                if (local) {
                    const int c = (wave & 1) * 32 + qb * 16 + fr;
                    const int kc0 = c - 8 < 0 ? 0 : (c - 8 > 48 ? 48 : c - 8);
                    const LAS float* brow = biasL + (kr - rw + 7) * 31 + 15 - c;
#pragma unroll
                    for (int kb = 0; kb < 4; ++kb)
#pragma unroll
                        for (int j = 0; j < 4; ++j) { const int kc = kb * 16 + 4 * fq + j; const bool ok = (kc >= kc0) && (kc < kc0 + 16);
                            const float bv = brow[ok ? kc : c];
                            S[qb][kb][j] = ok ? (S[qb][kb][j] * SCL2 + bv * LOG2E) : -1e30f; }
                } else {
#pragma unroll
                    for (int kb = 0; kb < 4; ++kb) S[qb][kb] = S[qb][kb] * SCL2;
                }
                float mx = -1e30f;
#pragma unroll
                for (int kb = 0; kb < 4; ++kb) mx = fmaxf(mx, fmaxf(fmaxf(S[qb][kb][0], S[qb][kb][1]), fmaxf(S[qb][kb][2], S[qb][kb][3])));
                mx = fmaxf(mx, __shfl_xor(mx, 16)); mx = fmaxf(mx, __shfl_xor(mx, 32));
                const float mn = fmaxf(mrun[qb], mx), alpha = __builtin_amdgcn_exp2f(mrun[qb] - mn);
                mrun[qb] = mn;
                float rs = 0.f;
#pragma unroll
                for (int kb = 0; kb < 4; ++kb)
#pragma unroll
                    for (int j = 0; j < 4; ++j) { const float pv = __builtin_amdgcn_exp2f(S[qb][kb][j] - mn); S[qb][kb][j] = pv; rs += pv; }
                lrun[qb] = lrun[qb] * alpha + rs;
#pragma unroll
                for (int db = 0; db < 8; ++db) O[qb][db] = O[qb][db] * alpha;
#pragma unroll
                for (int c2 = 0; c2 < 2; ++c2) {
                    u32x4 pk; pk.x = cvt_pk_bf16(S[qb][2 * c2][0], S[qb][2 * c2][1]); pk.y = cvt_pk_bf16(S[qb][2 * c2][2], S[qb][2 * c2][3]);
                    pk.z = cvt_pk_bf16(S[qb][2 * c2 + 1][0], S[qb][2 * c2 + 1][1]); pk.w = cvt_pk_bf16(S[qb][2 * c2 + 1][2], S[qb][2 * c2 + 1][3]);
                    Pf[qb][c2] = __builtin_bit_cast(bf16x8, pk);
                }
            }
            const LAS unsigned char* vb = Vt + (4 * fq + (fr >> 2)) * VSTR + (fr & 3) * 8;
#pragma unroll
            for (int c2 = 0; c2 < 2; ++c2)
#pragma unroll
                for (int db = 0; db < 8; ++db) {
                    const v4i16_t lo = vtr(vb + (c2 * 32) * VSTR + db * 32), hi = vtr(vb + (c2 * 32 + 16) * VSTR + db * 32);
                    bf16x8 vf; vf[0] = lo[0]; vf[1] = lo[1]; vf[2] = lo[2]; vf[3] = lo[3]; vf[4] = hi[0]; vf[5] = hi[1]; vf[6] = hi[2]; vf[7] = hi[3];
                    O[0][db] = __builtin_amdgcn_mfma_f32_16x16x32_bf16(vf, Pf[0][c2], O[0][db], 0, 0, 0);
                    O[1][db] = __builtin_amdgcn_mfma_f32_16x16x32_bf16(vf, Pf[1][c2], O[1][db], 0, 0, 0);
                }
        }
        if (t + 1 < a.t1) ATT_LWRITE((t + 1) & 1);
        __syncthreads();
    }
#undef ATT_GLOAD
#undef ATT_LWRITE
    if (a.role == 2) {
        f32x4* sp = a.xs + tid;
#pragma unroll
        for (int qb = 0; qb < 2; ++qb)
#pragma unroll
            for (int db = 0; db < 8; ++db) asm volatile("global_store_dwordx4 %0, %1, off sc1" :: "v"(sp + (qb * 8 + db) * 512), "v"(O[qb][db]) : "memory");
        const f32x4 ml = {mrun[0], mrun[1], lrun[0], lrun[1]};
        asm volatile("global_store_dwordx4 %0, %1, off sc1" :: "v"(sp + 16 * 512), "v"(ml) : "memory");
        asm volatile("s_waitcnt vmcnt(0)" ::: "memory");
        if (lane == 0) __hip_atomic_store(a.xf + wave, 1u, __ATOMIC_RELAXED, __HIP_MEMORY_SCOPE_AGENT);
        return;
    }
    if (a.role == 1) {
        unsigned spins = 0;
        while (__hip_atomic_load(a.xf + wave, __ATOMIC_RELAXED, __HIP_MEMORY_SCOPE_AGENT) == 0u) { __builtin_amdgcn_s_sleep(2); if (++spins > (1u << 22)) break; }
        __builtin_amdgcn_fence(__ATOMIC_ACQUIRE, "agent");
        asm volatile("s_waitcnt vmcnt(0)" ::: "memory");
        const f32x4* sp = a.xs + tid;
        const f32x4 ml = sp[16 * 512];
        float fa[2], fb[2];
#pragma unroll
        for (int qb = 0; qb < 2; ++qb) { const float mo = ml[qb], mn = fmaxf(mrun[qb], mo); fa[qb] = __builtin_amdgcn_exp2f(mrun[qb] - mn); fb[qb] = __builtin_amdgcn_exp2f(mo - mn); lrun[qb] = lrun[qb] * fa[qb] + ml[2 + qb] * fb[qb]; }
#pragma unroll
        for (int qb = 0; qb < 2; ++qb)
#pragma unroll
            for (int db = 0; db < 8; ++db) { const f32x4 o2 = sp[(qb * 8 + db) * 512]; O[qb][db] = O[qb][db] * fa[qb] + o2 * fb[qb]; asm volatile("" ::: "memory"); }
    }
#pragma unroll
    for (int qb = 0; qb < 2; ++qb) {
        float lt = lrun[qb]; lt += __shfl_xor(lt, 16); lt += __shfl_xor(lt, 32);
        const float il = 1.f / lt;
        bf16_t* op = a.o + (size_t)(a.qrow0 + wave * 32 + qb * 16 + fr) * a.ostride + 4 * fq;
#pragma unroll
        for (int db = 0; db < 8; ++db) { const f32x4 v = O[qb][db] * il; u32x2 o; o.x = cvt_pk_bf16(v[0], v[1]); o.y = cvt_pk_bf16(v[2], v[3]); *(u32x2*)(op + db * 16) = o; }
    }
}

__device__ __forceinline__ void attn0_phase(const Params& p, LAS unsigned char* lds) {
    unsigned char* ws = p.ws; const int G = gridDim.x;
    const bf16_t* Q0 = (const bf16_t*)(ws + WS_Q0); const bf16_t* K0 = (const bf16_t*)(ws + WS_K0); const bf16_t* V0 = (const bf16_t*)(ws + WS_V0);
    bf16_t* AB = (bf16_t*)(ws + WS_AB);
    const bool split = (G == 256);
    for (int i = blockIdx.x; i < 512; i += G) {
        AttnArgs a;
        if (i < 256) { const int it = i & 127; const int b = it >> 6, h = (it >> 3) & 7, qblk = it & 7, kvh = h >> 2;
            if (!split && i >= 128) continue;
            a.q = Q0 + h * 128; a.qstride = 1024; a.qrow0 = MCTX + b * 2048 + qblk * 256; a.o = AB + 1024 + h * 128; a.ostride = D;
            a.kA = K0 + (size_t)(MTOT + b * 512) * 256 + kvh * 128; a.vA = V0 + (size_t)(MTOT + b * 512) * 256 + kvh * 128; a.strideA = 256; a.ntA = 8;
            a.kB = K0 + (size_t)(MCTX + b * 2048) * 256 + kvh * 128; a.vB = V0 + (size_t)(MCTX + b * 2048) * 256 + kvh * 128; a.strideB = 256; a.ntB = 32;
            a.t0 = (split && i >= 128) ? 20 : 0; a.t1 = (split && i < 128) ? 20 : 40; a.role = split ? (i < 128 ? 1 : 2) : 0;
            a.xs = (f32x4*)(ws + WS_TS) + (size_t)it * (17 * 512); a.xf = (unsigned*)(ws + WS_FLAGS) + 8 * 1024 + it * 8;
        } else { const int j = i - 256, b = j >> 3, h = j & 7, kvh = h >> 2;
            a.q = Q0 + h * 128; a.qstride = 1024; a.qrow0 = b * 256; a.o = AB + 1024 + h * 128; a.ostride = D;
            a.kA = K0 + (size_t)(b * 256) * 256 + kvh * 128; a.vA = V0 + (size_t)(b * 256) * 256 + kvh * 128; a.strideA = 256; a.ntA = 4;
            a.kB = a.kA; a.vB = a.vA; a.strideB = 256; a.ntB = 0;
            a.t0 = 0; a.t1 = 4; a.role = 0; a.xs = nullptr; a.xf = nullptr;
        }
        a.r0 = 0; a.krlo = 0; a.bias = nullptr;
        attn_run<0>(lds, a);
    }
}
__device__ __forceinline__ void attn1_phase(const Params& p, LAS unsigned char* lds, bf16_t* AO) {
    unsigned char* ws = p.ws; const int G = gridDim.x;
    const bf16_t* Q1 = (const bf16_t*)(ws + WS_Z); const bf16_t* K1 = Q1 + (size_t)MTOT * D; const bf16_t* V1 = K1 + (size_t)MTOT * D;
    const bf16_t* CNK = (const bf16_t*)(ws + WS_CNK); const bf16_t* CNV = (const bf16_t*)(ws + WS_CNV);
    for (int i = blockIdx.x; i < 256; i += G) {
        AttnArgs a;
        const int b = i >> 7, h = (i >> 3) & 15, rg = i & 7, r0 = rg * 4;
        const int lo = r0 - 4 < 0 ? 0 : (r0 - 4 > 24 ? 24 : r0 - 4), hi0 = r0 - 1 < 0 ? 0 : (r0 - 1 > 24 ? 24 : r0 - 1), hi = hi0 + 7;
        a.q = Q1 + h * 128; a.qstride = D; a.qrow0 = MCTX + b * 2048 + r0 * 64; a.o = AO + h * 128; a.ostride = D;
        a.kA = CNK + (size_t)(b * 512) * 2048 + h * 128; a.vA = CNV + (size_t)(b * 512) * 2048 + h * 128; a.strideA = 2048; a.ntA = 8;
        a.kB = K1 + (size_t)(MCTX + b * 2048 + lo * 64) * D + h * 128; a.vB = V1 + (size_t)(MCTX + b * 2048 + lo * 64) * D + h * 128; a.strideB = D; a.ntB = hi - lo + 1;
        a.r0 = r0; a.krlo = lo; a.bias = p.in[18] + h * 465; a.t0 = 0; a.t1 = a.ntA + a.ntB; a.role = 0; a.xs = nullptr; a.xf = nullptr;
        attn_run<1>(lds, a);
    }
    for (int j = blockIdx.x; j < 512; j += G) {
        AttnArgs a;
        const int b = j >> 4, h = j & 15;
        a.q = Q1 + h * 128; a.qstride = D; a.qrow0 = b * 256; a.o = AO + h * 128; a.ostride = D;
        a.kA = K1 + (size_t)(b * 256) * D + h * 128; a.vA = V1 + (size_t)(b * 256) * D + h * 128; a.strideA = D; a.ntA = 4;
        a.kB = a.kA; a.vB = a.vA; a.strideB = D; a.ntB = 0;
        a.r0 = 0; a.krlo = 0; a.bias = nullptr; a.t0 = 0; a.t1 = 4; a.role = 0; a.xs = nullptr; a.xf = nullptr;
        attn_run<0>(lds, a);
    }
}

#define XB_TMO      128
#define XB_XCNT(j)  (256  + 64 * (j))
#define XB_XSUB(j)  (1280 + 64 * (j))
#define XB_XGEN(j)  (2304 + 64 * (j))
#define XB_TOP      3328
#define XB_TOPGEN   3392
#define XCD_BAR_WORDS 3456
#define XB_SPIN_CAP (1u << 18)

__device__ __forceinline__ unsigned xb_ld(unsigned* p)              { return __hip_atomic_load(p, __ATOMIC_RELAXED, __HIP_MEMORY_SCOPE_AGENT); }
__device__ __forceinline__ unsigned xb_add(unsigned* p, unsigned v) { return __hip_atomic_fetch_add(p, v, __ATOMIC_RELAXED, __HIP_MEMORY_SCOPE_AGENT); }
__device__ __forceinline__ unsigned xb_xcc_id() { return (unsigned)__builtin_amdgcn_s_getreg((3 << 11) | 20) & 0xFu; }
#define XB_SPIN(cond, bar) do { unsigned _sp = 0; while (cond) { __builtin_amdgcn_s_sleep(1); \
    if ((++_sp & 255u) == 0u) { if (xb_ld(&(bar)[XB_TMO])) break; if (_sp > XB_SPIN_CAP) { atomicAdd(&(bar)[XB_TMO], 1u); break; } } } } while (0)

struct XcdBarrier {
    unsigned* bar; unsigned x;
    volatile LAS unsigned* st;
};

__device__ __forceinline__ XcdBarrier xcd_barrier_post(unsigned* bar, volatile LAS unsigned* st) {
    XcdBarrier b; b.bar = bar; b.x = xb_xcc_id(); b.st = st;
    if (threadIdx.x == 0) (void)xb_add(&bar[XB_XCNT(b.x)], 1u);
    return b;
}
__device__ __forceinline__ void xcd_barrier_complete(unsigned* bar, unsigned x, unsigned& nloc, unsigned& nx) {
    const unsigned G = gridDim.x * gridDim.y * gridDim.z;
    unsigned sum, cnt, mine, sp = 0u;
    for (;;) {
        sum = 0u; cnt = 0u; mine = 0u;
#pragma unroll
        for (unsigned j = 0; j < 16; ++j) { const unsigned c = xb_ld(&bar[XB_XCNT(j)]); sum += c; cnt += (c > 0u) ? 1u : 0u; mine = (j == x) ? c : mine; }
        if (sum == G) break;
        __builtin_amdgcn_s_sleep(1);
        if ((++sp & 255u) == 0u) { if (xb_ld(&bar[XB_TMO])) break; if (sp > XB_SPIN_CAP) { atomicAdd(&bar[XB_TMO], 1u); break; } }
    }
    nloc = mine > 0u ? mine : 1u; nx = cnt > 0u ? cnt : 1u;
}

__device__ __forceinline__ void xcd_barrier(const XcdBarrier& b) {
    asm volatile("s_waitcnt vmcnt(0)" ::: "memory");
    __syncthreads();
    if (threadIdx.x == 0) {
        unsigned* bar = b.bar;
        __builtin_amdgcn_s_waitcnt(0);
        unsigned nloc = b.st[0], nx = b.st[1];
        if (nloc == 0u) { xcd_barrier_complete(bar, b.x, nloc, nx); b.st[0] = nloc; b.st[1] = nx; }
        const unsigned old = xb_add(&bar[XB_XSUB(b.x)], 1u);
        const unsigned gen = old / nloc;
        if (old + 1u == (gen + 1u) * nloc) {
            __builtin_amdgcn_fence(__ATOMIC_RELEASE, "agent");
            asm volatile("s_waitcnt vmcnt(0)" ::: "memory");
            const unsigned og = xb_add(&bar[XB_TOP], 1u);
            const unsigned tg = og / nx;
            if (og + 1u == (tg + 1u) * nx) xb_add(&bar[XB_TOPGEN], 1u);
            else XB_SPIN(xb_ld(&bar[XB_TOPGEN]) == tg, bar);
            __builtin_amdgcn_fence(__ATOMIC_ACQUIRE, "agent");
            xb_add(&bar[XB_XGEN(b.x)], 1u);
            asm volatile("s_waitcnt vmcnt(0)" ::: "memory");
        } else {
            XB_SPIN(xb_ld(&bar[XB_XGEN(b.x)]) == gen, bar);
            __builtin_amdgcn_fence(__ATOMIC_ACQUIRE, "agent");
            asm volatile("s_waitcnt vmcnt(0)" ::: "memory");
        }
    }
    __syncthreads();
}


constexpr int NPHASE = 18;
__global__ void __launch_bounds__(512, 2) mega_fwd(Params p) {
    extern __shared__ __attribute__((aligned(16))) unsigned char lds_raw[];
    LAS unsigned char* lds = (LAS unsigned char*)lds_raw;
    cg::grid_group grid = cg::this_grid();
    if (threadIdx.x < 64) ((LAS unsigned*)(lds + 131072))[threadIdx.x] = 0u;
    __syncthreads();
    XcdBarrier xbar = xcd_barrier_post((unsigned*)(p.ws + WS_BAR), (volatile LAS unsigned*)(lds + 131072));
    unsigned char* ws = p.ws;
    const int G = gridDim.x;
    float* MOD = (float*)(ws + WS_MOD);
    bf16_t* XN = (bf16_t*)(ws + WS_XN); bf16_t* X = (bf16_t*)(ws + WS_X);
    bf16_t* Z = (bf16_t*)(ws + WS_Z); bf16_t* AB = (bf16_t*)(ws + WS_AB); bf16_t* H = (bf16_t*)(ws + WS_H);
#define RUN(k) (p.ph_lo <= (k) && (k) < p.ph_hi)
#define GRID_SYNC_CG() do { asm volatile("s_waitcnt vmcnt(0) lgkmcnt(0)" ::: "memory"); grid.sync(); __builtin_amdgcn_fence(__ATOMIC_ACQUIRE, "agent"); asm volatile("s_waitcnt vmcnt(0)" ::: "memory"); } while (0)
#define GRID_SYNC() do { xcd_barrier(xbar); } while (0)
#define REPEAT(n, stmt) do { for (int rep_ = 0; rep_ < (n); ++rep_) { stmt; if (rep_ + 1 < (n)) GRID_SYNC(); } } while (0)
#define SEAM(k) do { if (p.ph_lo <= (k) && (k) + 1 < p.ph_hi) GRID_SYNC(); } while (0)
    if (RUN(0)) REPEAT(REP_P0, p0_prologue(p, lds));
    if (p.ph_lo <= 0 && 1 < p.ph_hi) GRID_SYNC_CG();
    for (int l = 0; l < 2; ++l) {
        const int k0 = 1 + 8 * l;
        const float* modl = MOD + (size_t)l * 3 * MODW;
        const float* xin_lo = p.in[0];
        const float* xin_hi = p.in[1] - (size_t)MCTX * D;
        const bf16_t* xres = (l == 0) ? nullptr : X;
        if (RUN(k0)) REPEAT(REP_NORM, norm_phase<false>(xin_lo, xin_hi, xres, p.in[10] + l * D, modl, 0, D, XN, nullptr));
        SEAM(k0);
        if (RUN(k0 + 1)) for (int repg_ = 0; repg_ < REP_G; ++repg_) {
            if (repg_) GRID_SYNC();
            if (l == 0) { pg8::Gemm g{XN, (const bf16_t*)(ws + WS_WIN), MTOT, ABIN, D}; pg8::StaticOrder S; S.init(MTOT, ABIN, G, (int)blockIdx.x, D, ws, -2);
                EpiBf16<0, false> E{Z, ABIN, nullptr, nullptr, 0, 0}; pg8::gemm_phase(lds, g, S, E); }
            else { pg8::Gemm g{XN, (const bf16_t*)(ws + WS_WQKV), MTOT, NQKV, D}; pg8::StaticOrder S; S.init(MTOT, NQKV, G, (int)blockIdx.x, D, ws, -2);
                EpiBf16<0, true> E{Z, D, p.out + OUT_NK, p.out + OUT_NV, 8, (size_t)MTOT * D}; pg8::gemm_phase(lds, g, S, E); }
        }
        SEAM(k0 + 1);
        if (l == 0) { if (RUN(k0 + 2)) REPEAT(REP_EW, ew0_phase(p)); SEAM(k0 + 2); }
        if (RUN(k0 + 3)) REPEAT(REP_ATT, if (l == 0) attn0_phase(p, lds); else attn1_phase(p, lds, AB));
        SEAM(k0 + 3);
        if (RUN(k0 + 4)) { pg8::Gemm g{AB, (const bf16_t*)(ws + (l == 0 ? WS_WO0 : WS_WO1)), MTOT, D, D}; pg8::StaticOrder S; S.init(MTOT, D, G, (int)blockIdx.x, D, ws, -2);
            EpiResid E{xin_lo, xin_hi, xres, X, modl + 2 * D}; pg8::gemm_phase(lds, g, S, E); }
        SEAM(k0 + 4);
        if (RUN(k0 + 5)) REPEAT(REP_NORM, norm_phase<false>(nullptr, nullptr, X, p.in[11] + l * D, modl, 3 * D, 4 * D, XN, nullptr));
        SEAM(k0 + 5);
        if (RUN(k0 + 6)) for (int repg_ = 0; repg_ < REP_G; ++repg_) { if (repg_) GRID_SYNC(); pg8::Gemm g{XN, (const bf16_t*)(ws + WS_W1) + (size_t)l * FFN * D, MTOT, FFN, D}; pg8::StaticOrder S; S.init(MTOT, FFN, G, (int)blockIdx.x, D, ws, -1);
            EpiBf16<1, false> E{H, FFN, nullptr, nullptr, 0, 0}; pg8::gemm_phase(lds, g, S, E); }
        SEAM(k0 + 6);
        if (RUN(k0 + 7)) { pg8::Gemm g{H, (const bf16_t*)(ws + WS_W2) + (size_t)l * FFN * D, MTOT, D, FFN}; pg8::StaticOrder S; S.init(MTOT, D, G, (int)blockIdx.x, FFN, ws, (l * 4 + 3) * 1024);
            EpiResid E{nullptr, nullptr, X, X, modl + 5 * D}; pg8::gemm_phase(lds, g, S, E); }
        SEAM(k0 + 7);
    }
#if PROBE_STOP > 0
    GRID_SYNC();
    {
        const size_t n = (size_t)MTOT * D, gt = (size_t)blockIdx.x * 512 + threadIdx.x, gs = (size_t)G * 512;
        const bf16_t* sb = PROBE_SRC == 1 ? XN : PROBE_SRC == 2 ? AB : PROBE_SRC == 3 ? Z : PROBE_SRC == 5 ? Z + (size_t)4096 * NQKV : (const bf16_t*)(ws + WS_Q0);
#if PROBE_SRC == 6
        attn1_phase(p, lds, XN);
        GRID_SYNC();
        for (size_t i = gt; i < n; i += gs) p.out[i] = bf2f(AB[i]) - bf2f(XN[i]);
#else
        for (size_t i = gt; i < n; i += gs) p.out[i] = (PROBE_SRC == 0) ? bf2f(X[i]) : bf2f(sb[i]);
#endif
#if PROBE_STOP < 4
        for (size_t i = gt; i < (size_t)2 * MCTX * 256; i += gs) p.out[OUT_AK + i] = 0.f;
#endif
        for (size_t i = gt; i < (size_t)2 * MCTX * D; i += gs) p.out[OUT_NK + i] = 0.f;
    }
#else
    if (RUN(17)) REPEAT(REP_NORM, norm_phase<true>(nullptr, nullptr, X, p.in[22], nullptr, 0, 0, nullptr, p.out));
#endif
#undef RUN
#undef SEAM
#undef REPEAT
#undef GRID_SYNC
#undef GRID_SYNC_CG
}

extern "C" void kernel_launch(void* const* d_in, const int* in_sizes, int n_in, void* d_out, int out_size, void* d_ws, size_t ws_size, hipStream_t stream) {
    static int grid = 0;
    if (grid == 0) {
        if (n_in != 23 || ws_size < WS_END) { fprintf(stderr, "kernel_launch: expected 23 inputs and >= %zu bytes of workspace (got %d, %zu)\n", (size_t)WS_END, n_in, ws_size); grid = -1; return; }
        int dev = 0, cus = 0, per_cu = 0;
        (void)hipGetDevice(&dev);
        (void)hipDeviceGetAttribute(&cus, hipDeviceAttributeMultiprocessorCount, dev);
        if (hipFuncSetAttribute((const void*)mega_fwd, hipFuncAttributeMaxDynamicSharedMemorySize, LDS_BYTES) != hipSuccess) { fprintf(stderr, "kernel_launch: hipFuncSetAttribute failed\n"); grid = -1; return; }
        if (hipOccupancyMaxActiveBlocksPerMultiprocessor(&per_cu, (const void*)mega_fwd, 512, LDS_BYTES) != hipSuccess || per_cu < 1) { fprintf(stderr, "kernel_launch: occupancy query failed (%d)\n", per_cu); grid = -1; return; }
        grid = cus * (per_cu > 1 ? 1 : per_cu);
        fprintf(stderr, "kernel_launch: grid %d (cus %d, per_cu %d)\n", grid, cus, per_cu);
    }
    if (grid < 0) return;
    (void)hipMemsetAsync((char*)d_ws + WS_BAR, 0, 65536, stream);
    Params p{};
    for (int i = 0; i < 23; ++i) p.in[i] = (const float*)d_in[i];
    p.out = (float*)d_out; p.ws = (unsigned char*)d_ws;
#if MK_PER_PHASE
    for (int k = 0; k < NPHASE; ++k) {
        if (k == 11) continue;
        p.ph_lo = k; p.ph_hi = k + 1;
        void* args[] = {&p};
        hipError_t e = hipLaunchCooperativeKernel((const void*)mega_fwd, dim3(grid), dim3(512), args, LDS_BYTES, stream);
        if (e != hipSuccess) { fprintf(stderr, "launch %d failed: %s\n", k, hipGetErrorString(e)); break; }
    }
#else
    p.ph_lo = 0; p.ph_hi = PROBE_STOP > 0 ? PROBE_STOP : NPHASE;
    void* args[] = {&p};
    hipError_t e = hipLaunchCooperativeKernel((const void*)mega_fwd, dim3(grid), dim3(512), args, LDS_BYTES, stream);
    if (e != hipSuccess) fprintf(stderr, "cooperative launch failed: %s (grid %d)\n", hipGetErrorString(e), grid);
#endif
}
```

```cpp
#include <hip/hip_runtime.h>
#include <hip/hip_cooperative_groups.h>
#include <cstdio>
#include <cstdint>
namespace cg = cooperative_groups;

#ifndef MK_PER_PHASE
#define MK_PER_PHASE 0
#endif

#ifndef REP_NG
#define REP_NG 1
#endif
#ifndef REP_P0
#define REP_P0 REP_NG
#endif
#ifndef REP_NORM
#define REP_NORM REP_NG
#endif
#ifndef REP_EW
#define REP_EW REP_NG
#endif
#ifndef REP_ATT
#define REP_ATT REP_NG
#endif
#ifndef REP_G
#define REP_G 1
#endif
#ifndef PROBE_STOP
#define PROBE_STOP 0
#endif
#ifndef PROBE_SRC
#define PROBE_SRC 0
#endif
#define LAS __attribute__((address_space(3)))
#define PG8_LAS __attribute__((address_space(3)))
typedef unsigned short bf16_t;
typedef short bf16x8 __attribute__((ext_vector_type(8)));
typedef short v4i16_t __attribute__((ext_vector_type(4)));
typedef float f32x4 __attribute__((ext_vector_type(4)));
typedef float f32x2 __attribute__((ext_vector_type(2)));
typedef unsigned u32x4 __attribute__((ext_vector_type(4)));
typedef unsigned u32x2 __attribute__((ext_vector_type(2)));

__device__ __forceinline__ float bf2f(unsigned h) { return __uint_as_float(h << 16); }
typedef __bf16 bf16x2_t __attribute__((ext_vector_type(2)));
__device__ __forceinline__ unsigned cvt_pk_bf16(float lo, float hi) { f32x2 v = {lo, hi}; bf16x2_t r = __builtin_convertvector(v, bf16x2_t); return __builtin_bit_cast(unsigned, r); }
__device__ __forceinline__ float wave_sum(float v) {
#pragma unroll
    for (int o = 1; o < 64; o <<= 1) v += __shfl_xor(v, o);
    return v;
}

constexpr size_t WS_TS_OFS = 595591168ull;
constexpr size_t WS_FLAGS_OFS = (512u << 10) + 16384;
namespace pg8 {
constexpr int BM = 256, BK = 64, HALF = 128, HTB = HALF * BK * 2  , STAGE_BYTES = 8 * HTB, NXCD = 8, WGM = 4;

__host__ __device__ __forceinline__ int lds_byte(int r, int c) { const int st = (r >> 4) * 2 + (c >> 5), rr = r & 15, cc = c & 31, ob = rr * 64 + cc * 2; return st * 1024 + (ob ^ (((ob >> 9) & 1) << 5)); }
__host__ __device__ __forceinline__ void stage_rc(int b, int& R, int& C) { const int st = b / 1024, sb = b % 1024, swz = sb ^ (((sb >> 9) & 1) << 5); R = (st >> 1) * 16 + swz / 64; C = (st & 1) * 32 + (swz % 64) / 2; }
__host__ __device__ __forceinline__ int perm32(int rho) { const int n = rho >> 4, i = rho & 15; return 8 * (i >> 2) + 4 * n + (i & 3); }
struct Unit { int pm, pn, code; };
struct Gemm { const bf16_t* A; const bf16_t* Bt; int M, N, K; };
struct StaticOrder {
    int nM, nN, nwg, G, c, ntk, R, tail, fofs, msplit; unsigned char* wsb;
    __device__ __forceinline__ int kt0(const Unit& u) const { return (u.code & 3) == 2 ? (ntk >> 1) : 0; }
    __device__ __forceinline__ int nkt(const Unit& u) const { return ((u.code & 3) == 1 || (u.code & 3) == 2) ? (ntk >> 1) : ntk; }
    __host__ __device__ void init(int M, int N, int G_, int c_, int K, unsigned char* wsb_, int fofs_) {
        nM = M / BM; nN = N / BM; nwg = nM * nN; G = G_; c = c_; ntk = K / BK; wsb = wsb_; fofs = fofs_; msplit = (fofs_ == -2);
        R = nwg / G; tail = nwg - R * G;
        if (fofs_ == -1 || 2 * tail > G || (ntk & 3)) tail = 0;
    }
    __host__ __device__ bool next(int i, Unit& u) const {
        long L;
        if (tail) {
            if (i < R) { L = (long)i * G + c; u.code = 0; }
            else if (i == R && c < 2 * tail) { L = (long)R * G + (c >> 1); u.code = msplit ? (3 | ((c & 1) << 2)) : ((1 + (c & 1)) | ((c >> 1) << 2)); }
            else return false;
        } else { L = (long)i * G + c; if (L >= nwg) return false; u.code = 0; }
        int wgid = (int)L; { const int q = nwg / NXCD, r = nwg % NXCD, xcd = wgid % NXCD, off = wgid / NXCD; wgid = (xcd < r ? xcd * (q + 1) : r * (q + 1) + (xcd - r) * q) + off; }
        const int nig = WGM * nN, gid = wgid / nig, fm = gid * WGM, gsz = (nM - fm) < WGM ? (nM - fm) : WGM;
        u.pm = fm + ((wgid % nig) % gsz); u.pn = (wgid % nig) / gsz; return true;
    }
    __device__ __forceinline__ void a_ready(const Unit&) const {}
    __device__ __forceinline__ void done(const Unit&) const {}
};
template <class Epi, class Sched>
__device__ __forceinline__ void gemm_phase(PG8_LAS unsigned char* lds, const Gemm g, const Sched& S, const Epi& E) {
    int tid_ = threadIdx.x; asm volatile("" : "+v"(tid_));
    const int tid = tid_, wid = __builtin_amdgcn_readfirstlane(tid >> 6), lane = tid & 63, wr = wid >> 2, wc = wid & 3, fr = lane & 15, fq = lane >> 4;
    const int K = g.K;
    unsigned voffA[2], voffB[2];
#pragma unroll
    for (int i = 0; i < 2; ++i) { int R, C; stage_rc(tid * 16 + i * 8192, R, C); const int Rb = Epi::PERM ? ((R & ~31) + perm32(R & 31)) : R;
        voffA[i] = (unsigned)(R * K + C) * 2u; voffB[i] = (unsigned)(Rb * K + C) * 2u; }
    const size_t kstep = (size_t)(BK * 2);
    const size_t hstep = (size_t)HALF * K * 2;
    const size_t tstep = 2 * hstep;
    const unsigned ldsw = (unsigned)wid * 1024u;
    const int aoff = lds_byte(wr * 64 + fr, fq * 8), boff = lds_byte(wc * 32 + fr, fq * 8);
#define PG8_SA(b, h) (((b) * 2 + (h)) * HTB)
#define PG8_SB(b, h) ((4 + (b) * 2 + (h)) * HTB)
#define PG8_STAGE(bufoff, gbase, voff) do { _Pragma("unroll") for (int _i = 0; _i < 2; ++_i) \
        __builtin_amdgcn_global_load_lds((const unsigned*)((const char*)(gbase) + (voff)[_i]), (PG8_LAS unsigned*)(lds + (bufoff) + ldsw + _i * 8192), 16, 0, 0); } while (0)
#define PG8_LDA(dst, b, h) do { _Pragma("unroll") for (int m = 0; m < 4; ++m) _Pragma("unroll") for (int k = 0; k < 2; ++k) dst[m][k] = *(const PG8_LAS bf16x8*)(lds + PG8_SA(b, h) + aoff + m * 2048 + k * 1024); } while (0)
#define PG8_LDB(dst, b, h) do { _Pragma("unroll") for (int n = 0; n < 2; ++n) _Pragma("unroll") for (int k = 0; k < 2; ++k) dst[n][k] = *(const PG8_LAS bf16x8*)(lds + PG8_SB(b, h) + boff + n * 2048 + k * 1024); } while (0)
#define PG8_MMA(ai, bj, At, Bt) do { __builtin_amdgcn_s_setprio(1); _Pragma("unroll") for (int m = 0; m < 4; ++m) _Pragma("unroll") for (int n = 0; n < 2; ++n) _Pragma("unroll") for (int k = 0; k < 2; ++k) \
        acc[ai][bj][m][n] = __builtin_amdgcn_mfma_f32_16x16x32_bf16(Bt[n][k], At[m][k], acc[ai][bj][m][n], 0, 0, 0); __builtin_amdgcn_s_setprio(0); } while (0)
#define PG8_WAIT_V(n) asm volatile("s_waitcnt vmcnt(" #n ")" ::: "memory")
#define PG8_WAIT_L(n) asm volatile("s_waitcnt lgkmcnt(" #n ")" ::: "memory")
#define PG8_BAR __builtin_amdgcn_s_barrier()
#define PG8_SCHED __builtin_amdgcn_sched_barrier(0)
    Unit cur, nxt; int ui = 0;
    if (!S.next(0, cur)) return;
    f32x4 acc[2][2][4][2];
#pragma unroll
    for (int a = 0; a < 2; ++a)
#pragma unroll
        for (int b = 0; b < 2; ++b)
#pragma unroll
            for (int m = 0; m < 4; ++m)
#pragma unroll
                for (int n = 0; n < 2; ++n) acc[a][b][m][n] = (f32x4){0.f, 0.f, 0.f, 0.f};
    bf16x8 At[4][2], B0[2][2], B1[2][2];
    const char* cA = (const char*)g.A + (size_t)cur.pm * tstep + (size_t)S.kt0(cur) * kstep; const char* cB = (const char*)g.Bt + (size_t)cur.pn * tstep + (size_t)S.kt0(cur) * kstep;
    S.a_ready(cur);
    if ((cur.code & 3) == 3) cA += (size_t)(cur.code >> 2) * hstep;
    size_t ahs = (cur.code & 3) == 3 ? 0 : hstep;
    PG8_STAGE(PG8_SB(0, 0), cB, voffB); PG8_STAGE(PG8_SB(0, 1), cB + hstep, voffB); PG8_STAGE(PG8_SA(0, 0), cA, voffA); PG8_STAGE(PG8_SA(0, 1), cA + ahs, voffA);
    if (wr == 1) PG8_BAR;
    PG8_WAIT_V(2); PG8_BAR;
    PG8_STAGE(PG8_SB(1, 0), cB + kstep, voffB); PG8_STAGE(PG8_SA(1, 0), cA + kstep, voffA); PG8_STAGE(PG8_SB(1, 1), cB + hstep + kstep, voffB);
    PG8_WAIT_V(6); PG8_BAR;
    for (;;) {
        const bool has_next = S.next(ui + 1, nxt);
        const char* nA = has_next ? (const char*)g.A + (size_t)nxt.pm * tstep + (size_t)S.kt0(nxt) * kstep : cA; const char* nB = has_next ? (const char*)g.Bt + (size_t)nxt.pn * tstep + (size_t)S.kt0(nxt) * kstep : cB;
        const int nt = S.nkt(cur);
        const bool full = (cur.code & 3) != 3;
        const size_t ahs_n = (has_next && (nxt.code & 3) == 3) ? 0 : (has_next ? hstep : ahs);
        if (has_next && (nxt.code & 3) == 3) nA += (size_t)(nxt.code >> 2) * hstep;
        for (int t = 0; t < nt; t += 2) {
            const bool last = (t == nt - 2);
            const char* a1 = cA + (size_t)(t + 1) * kstep;
            const char* a2 = last ? nA : cA + (size_t)(t + 2) * kstep; const char* b2 = last ? nB : cB + (size_t)(t + 2) * kstep;
            const char* a3 = a2 + kstep; const char* b3 = b2 + kstep;
            if (last && has_next) S.a_ready(nxt);
            PG8_LDB(B0, 0, 0); PG8_LDB(B1, 0, 1); PG8_SCHED; PG8_LDA(At, 0, 0); PG8_STAGE(PG8_SA(1, 1), a1 + ahs, voffA);
            PG8_WAIT_V(8); PG8_WAIT_L(0); PG8_BAR; PG8_MMA(0, 0, At, B0); PG8_MMA(0, 1, At, B1); PG8_BAR; PG8_SCHED;
            PG8_LDA(At, 0, 1); PG8_STAGE(PG8_SB(0, 0), b2, voffB); PG8_STAGE(PG8_SB(0, 1), b2 + hstep, voffB); PG8_STAGE(PG8_SA(0, 0), a2, voffA);
            PG8_WAIT_V(8); PG8_WAIT_L(0); PG8_BAR; if (full) { PG8_MMA(1, 0, At, B0); PG8_MMA(1, 1, At, B1); } PG8_BAR; PG8_SCHED;
            PG8_LDB(B0, 1, 0); PG8_LDB(B1, 1, 1); PG8_SCHED; PG8_LDA(At, 1, 0); PG8_STAGE(PG8_SA(0, 1), a2 + (last ? ahs_n : ahs), voffA);
            PG8_WAIT_V(8); PG8_WAIT_L(0); PG8_BAR; PG8_MMA(0, 0, At, B0); PG8_MMA(0, 1, At, B1); PG8_BAR; PG8_SCHED;
            PG8_LDA(At, 1, 1); PG8_STAGE(PG8_SB(1, 0), b3, voffB); PG8_STAGE(PG8_SB(1, 1), b3 + hstep, voffB); PG8_STAGE(PG8_SA(1, 0), a3, voffA);
            PG8_WAIT_V(8); PG8_WAIT_L(0); PG8_BAR; if (full) { PG8_MMA(1, 0, At, B0); PG8_MMA(1, 1, At, B1); } PG8_BAR; PG8_SCHED;
        }
        if (wr == 0) PG8_BAR;
        const int role = cur.code & 3, slot = cur.code >> 2;
        if (role == 2) {
            f32x4* sp = (f32x4*)(S.wsb + WS_TS_OFS + (size_t)((S.fofs >> 12) + 1) * 33554432u) + (size_t)slot * (32 * 512) + tid;
#pragma unroll
            for (int a = 0; a < 2; ++a)
#pragma unroll
                for (int b = 0; b < 2; ++b)
#pragma unroll
                    for (int m = 0; m < 4; ++m)
#pragma unroll
                        for (int n = 0; n < 2; ++n) asm volatile("global_store_dwordx4 %0, %1, off sc1" :: "v"(sp + (((a * 2 + b) * 4 + m) * 2 + n) * 512), "v"(acc[a][b][m][n]) : "memory");
            asm volatile("s_waitcnt vmcnt(0)" ::: "memory");
            if (lane == 0) __hip_atomic_store((unsigned*)(S.wsb + WS_FLAGS_OFS) + S.fofs + slot * 8 + wid, 1u, __ATOMIC_RELAXED, __HIP_MEMORY_SCOPE_AGENT);
        } else {
            if (role == 1) {
                unsigned spins = 0;
                while (__hip_atomic_load((unsigned*)(S.wsb + WS_FLAGS_OFS) + S.fofs + slot * 8 + wid, __ATOMIC_RELAXED, __HIP_MEMORY_SCOPE_AGENT) == 0u) { __builtin_amdgcn_s_sleep(2); if (++spins > (1u << 22)) break; }
                __builtin_amdgcn_fence(__ATOMIC_ACQUIRE, "agent");
                asm volatile("s_waitcnt vmcnt(0)" ::: "memory");
                const f32x4* sp = (const f32x4*)(S.wsb + WS_TS_OFS + (size_t)((S.fofs >> 12) + 1) * 33554432u) + (size_t)slot * (32 * 512) + tid;
#pragma unroll
                for (int a = 0; a < 2; ++a)
#pragma unroll
                    for (int b = 0; b < 2; ++b)
#pragma unroll
                        for (int m = 0; m < 4; ++m)
#pragma unroll
                            for (int n = 0; n < 2; ++n) { acc[a][b][m][n] += sp[(((a * 2 + b) * 4 + m) * 2 + n) * 512]; asm volatile("" ::: "memory"); }
            }
            E(acc, cur, wr, wc, fr, fq, role == 3 ? slot * 128 : 0, role == 3 ? 1 : 2);
        }
        if (!has_next) break;
#pragma unroll
        for (int a = 0; a < 2; ++a)
#pragma unroll
            for (int b = 0; b < 2; ++b)
#pragma unroll
                for (int m = 0; m < 4; ++m)
#pragma unroll
                    for (int n = 0; n < 2; ++n) acc[a][b][m][n] = (f32x4){0.f, 0.f, 0.f, 0.f};
        cur = nxt; cA = nA; cB = nB; ahs = ahs_n; ++ui;
        if (wr == 1) PG8_BAR;
    }
    PG8_WAIT_V(0);
    PG8_BAR;
    if constexpr (Epi::AFTER_DRAIN) { E.fused(acc, cur, wr, wc, fr, fq, lds, wid, lane); S.done(cur); }
#undef PG8_SA
#undef PG8_SB
#undef PG8_STAGE
#undef PG8_LDA
#undef PG8_LDB
#undef PG8_MMA
#undef PG8_WAIT_V
#undef PG8_WAIT_L
#undef PG8_BAR
#undef PG8_SCHED
}
}

constexpr int D = 2048, MCTX = 8192, MLAT = 4096, MTOT = 12288, FFN = 8192, ABIN = 4608, NQKV = 6144, MODW = 12288;
constexpr float EPS = 1e-6f;
constexpr size_t WS_MOD = 0;
constexpr size_t WS_BAR = 512u << 10;
constexpr size_t WS_WIN = 1u << 20;
constexpr size_t WS_WO0 = WS_WIN + (size_t)ABIN * D * 2;
constexpr size_t WS_WQKV = WS_WO0 + (size_t)D * D * 2;
constexpr size_t WS_WO1 = WS_WQKV + (size_t)NQKV * D * 2;
constexpr size_t WS_W1 = WS_WO1 + (size_t)D * D * 2;
constexpr size_t WS_W2 = WS_W1 + 2 * (size_t)FFN * D * 2;
constexpr size_t WS_XN = WS_W2 + 2 * (size_t)FFN * D * 2;
constexpr size_t WS_H = WS_XN + (size_t)MTOT * D * 2;
constexpr size_t WS_Z = WS_H;
constexpr size_t WS_AB = WS_H + (size_t)MTOT * NQKV * 2;
constexpr size_t WS_Q0 = WS_H + (size_t)MTOT * FFN * 2;
constexpr size_t WS_K0 = WS_Q0 + (size_t)MTOT * 1024 * 2;
constexpr size_t WS_V0 = WS_K0 + (size_t)(MTOT + 1024) * 256 * 2;
constexpr size_t WS_CNK = WS_V0 + (size_t)(MTOT + 1024) * 256 * 2;
constexpr size_t WS_CNV = WS_CNK + (size_t)1024 * 2048 * 2;
constexpr size_t WS_X = WS_CNV + (size_t)1024 * 2048 * 2;
constexpr size_t WS_TS = WS_X + (size_t)MTOT * D * 4;
constexpr size_t WS_END = WS_TS + 3 * (size_t)128 * 32 * 512 * 16;
constexpr size_t WS_FLAGS = WS_BAR + 16384;
static_assert(WS_TS == WS_TS_OFS && WS_FLAGS == WS_FLAGS_OFS, "early offsets");
constexpr int LDS_BYTES = 131072 + 256;

constexpr size_t OUT_YP = 0, OUT_YS = (size_t)MCTX * D, OUT_AK = OUT_YS + (size_t)MLAT * D, OUT_AV = OUT_AK + (size_t)MCTX * 256,
                 OUT_NK = OUT_AV + (size_t)MCTX * 256, OUT_NV = OUT_NK + (size_t)MCTX * D;

struct Params {
    const float* in[23];
    float* out;
    unsigned char* ws;
    int ph_lo, ph_hi;
};

template <int ACT, bool SIDE> struct EpiBf16 {
    static constexpr bool PERM = true, AFTER_DRAIN = false;
    bf16_t* O; int ldc; float* kout; float* vout; int split_tiles; size_t split_stride;
    __device__ __forceinline__ void operator()(const f32x4 (&acc)[2][2][4][2], const pg8::Unit& u, int wr, int wc, int fr, int fq, int rowofs, int nai) const {
        const int row0 = u.pm * 256 + rowofs + wr * 64 + fr, col0 = u.pn * 256 + wc * 32 + 8 * fq;
        const int spt = split_tiles ? u.pn / split_tiles : 0; bf16_t* Ob = O + (size_t)spt * split_stride; const int ocol0 = col0 - spt * split_tiles * 256;
        const bool side = SIDE && (u.pm < 32) && (u.pn >= 8);
        float* sbase = nullptr; int scol0 = 0;
        if (SIDE) { sbase = (u.pn < 16) ? kout : vout; scol0 = col0 - ((u.pn < 16) ? 2048 : 4096); }
#pragma unroll
        for (int ai = 0; ai < 2; ++ai) if (ai < nai)
#pragma unroll
            for (int m = 0; m < 4; ++m) {
                const int row = row0 + ai * 128 + m * 16;
                bf16_t* rowp = Ob + (size_t)row * ldc + ocol0;
#pragma unroll
                for (int bj = 0; bj < 2; ++bj) {
                    f32x4 v0 = acc[ai][bj][m][0], v1 = acc[ai][bj][m][1];
                    if (SIDE) { if (side) { float* sp = sbase + (size_t)row * 2048 + scol0 + bj * 128; *(f32x4*)sp = v0; *(f32x4*)(sp + 4) = v1; } }
                    if (ACT == 1) {
#pragma unroll
                        for (int j = 0; j < 4; ++j) { float a = fmaxf(v0[j], 0.f), b = fmaxf(v1[j], 0.f); v0[j] = a * a; v1[j] = b * b; }
                    }
                    u32x4 o; o.x = cvt_pk_bf16(v0[0], v0[1]); o.y = cvt_pk_bf16(v0[2], v0[3]); o.z = cvt_pk_bf16(v1[0], v1[1]); o.w = cvt_pk_bf16(v1[2], v1[3]);
                    *(u32x4*)(rowp + bj * 128) = o;
                }
            }
    }
};
struct EpiResid {
    static constexpr bool PERM = true, AFTER_DRAIN = false;
    const float* src_lo; const float* src_hi;
    const bf16_t* xsrc; bf16_t* X; const float* gate;
    __device__ __forceinline__ void operator()(const f32x4 (&acc)[2][2][4][2], const pg8::Unit& u, int wr, int wc, int fr, int fq, int rowofs, int nai) const {
        const int row0 = u.pm * 256 + rowofs + wr * 64 + fr, col0 = u.pn * 256 + wc * 32 + 8 * fq;
        const int cond = (u.pm < 32) ? 0 : 1 + ((u.pm - 32) >> 3);
        const float* gp = gate + (size_t)cond * MODW + col0;
        const float* sb = (u.pm < 32) ? src_lo : src_hi;
        f32x4 gv[2][2];
#pragma unroll
        for (int bj = 0; bj < 2; ++bj)
#pragma unroll
            for (int n = 0; n < 2; ++n) gv[bj][n] = *(const f32x4*)(gp + bj * 128 + n * 4);
#pragma unroll
        for (int ai = 0; ai < 2; ++ai) if (ai < nai)
#pragma unroll
            for (int m = 0; m < 4; ++m) {
                const size_t off = (size_t)(row0 + ai * 128 + m * 16) * D + col0;
#pragma unroll
                for (int bj = 0; bj < 2; ++bj) {
                    f32x4 r0, r1;
                    if (xsrc) { const u32x4 rb = *(const u32x4*)(xsrc + off + bj * 128);
                        r0[0] = bf2f(rb.x & 0xffffu); r0[1] = __uint_as_float(rb.x & 0xffff0000u); r0[2] = bf2f(rb.y & 0xffffu); r0[3] = __uint_as_float(rb.y & 0xffff0000u);
                        r1[0] = bf2f(rb.z & 0xffffu); r1[1] = __uint_as_float(rb.z & 0xffff0000u); r1[2] = bf2f(rb.w & 0xffffu); r1[3] = __uint_as_float(rb.w & 0xffff0000u); }
                    else { r0 = *(const f32x4*)(sb + off + bj * 128); r1 = *(const f32x4*)(sb + off + bj * 128 + 4); }
                    const f32x4 x0 = r0 + gv[bj][0] * acc[ai][bj][m][0], x1 = r1 + gv[bj][1] * acc[ai][bj][m][1];
                    u32x4 o; o.x = cvt_pk_bf16(x0[0], x0[1]); o.y = cvt_pk_bf16(x0[2], x0[3]); o.z = cvt_pk_bf16(x1[0], x1[1]); o.w = cvt_pk_bf16(x1[2], x1[3]);
                    *(u32x4*)(X + off + bj * 128) = o;
                }
            }
    }
};

__device__ __forceinline__ unsigned f2bf(float f) { unsigned u = __float_as_uint(f); return (u + 0x7fffu + ((u >> 16) & 1u)) >> 16; }
__device__ __forceinline__ unsigned pk2(float lo, float hi) { return f2bf(lo) | (f2bf(hi) << 16); }
__device__ __forceinline__ void p0_transpose_item(const float* W, int K, int N, bf16_t* WT, LAS float* scr, int item, int lane) {
    const int nblk = N / 32, kb = item / nblk, nb = item % nblk, k0 = 64 * kb, n0 = 32 * nb;
#pragma unroll 8
    for (int i = 0; i < 32; ++i) { const int kk = 2 * i + (lane >> 5); scr[kk * 33 + (lane & 31)] = W[(size_t)(k0 + kk) * N + n0 + (lane & 31)]; }
    asm volatile("s_waitcnt lgkmcnt(0)" ::: "memory");
    const int c = lane & 7;
#pragma unroll
    for (int j = 0; j < 4; ++j) { const int n = (lane >> 3) + 8 * j; const LAS float* s = scr + (8 * c) * 33 + n;
        u32x4 o; o.x = pk2(s[0 * 33], s[1 * 33]); o.y = pk2(s[2 * 33], s[3 * 33]); o.z = pk2(s[4 * 33], s[5 * 33]); o.w = pk2(s[6 * 33], s[7 * 33]);
        *(u32x4*)(WT + (size_t)(n0 + n) * K + k0 + 8 * c) = o; }
    asm volatile("s_waitcnt lgkmcnt(0)" ::: "memory");
}
__device__ __forceinline__ void cvt_linear(const float* src, bf16_t* dst, int n, int gtid, int gthreads) {
    for (int i = gtid * 4; i < n; i += gthreads * 4) { const f32x4 v = *(const f32x4*)(src + i); u32x2 o; o.x = cvt_pk_bf16(v[0], v[1]); o.y = cvt_pk_bf16(v[2], v[3]); *(u32x2*)(dst + i) = o; }
}
__device__ __forceinline__ void p0_prologue(const Params& p, LAS unsigned char* lds) {
    int tid_ = threadIdx.x; asm volatile("" : "+v"(tid_));
    const int tid = tid_, lane = tid & 63, wave = __builtin_amdgcn_readfirstlane(tid >> 6), G = gridDim.x;
    unsigned char* ws = p.ws;
    {
        LAS float* sc = (LAS float*)(lds + 69632);
        LAS float* red = (LAS float*)(lds + 69632 + 24576);
        const float* cvec = p.in[6]; const float* cctx = p.in[7];
        for (int i = tid; i < 3 * 2048; i += 512) { const int c = i >> 11, k = i & 2047; const float x = (c == 0) ? cctx[k] : cvec[(c - 1) * 2048 + k]; sc[i] = x / (1.f + __expf(-x)); }
        __syncthreads();
        float* MOD = (float*)(ws + WS_MOD);
        for (int item = blockIdx.x; item < 256; item += G) {
            const int l = item >> 7, cgp = item & 127, ln = lane < 48 ? lane : 47;
            const float* W = p.in[8] + (size_t)l * 2048 * MODW + cgp * 96 + ln * 2;
            float a00 = 0.f, a01 = 0.f, a10 = 0.f, a11 = 0.f, a20 = 0.f, a21 = 0.f;
            const int kb = wave * 256;
#pragma unroll 8
            for (int k = 0; k < 256; ++k) {
                const f32x2 w = *(const f32x2*)(W + (size_t)(kb + k) * MODW);
                const float s0 = sc[kb + k], s1 = sc[2048 + kb + k], s2 = sc[4096 + kb + k];
                a00 += s0 * w.x; a01 += s0 * w.y; a10 += s1 * w.x; a11 += s1 * w.y; a20 += s2 * w.x; a21 += s2 * w.y;
            }
            if (lane < 48) { LAS float* r = red + wave * 288 + lane * 2; r[0] = a00; r[1] = a01; r[96] = a10; r[97] = a11; r[192] = a20; r[193] = a21; }
            __syncthreads();
            if (tid < 288) { const int c = tid / 96, j = tid % 96; float s = 0.f;
#pragma unroll
                for (int w = 0; w < 8; ++w) s += red[w * 288 + tid];
                MOD[(size_t)(l * 3 + c) * MODW + cgp * 96 + j] = s + p.in[9][l * MODW + cgp * 96 + j]; }
            __syncthreads();
        }
    }
    {
        LAS float* scr = (LAS float*)(lds + wave * 8448);
        const int gw = blockIdx.x * 8 + wave, NGW = G * 8;
        constexpr int I_IN = 32 * (ABIN / 32), I_O = 32 * (D / 32), I_QKV = 32 * (NQKV / 32), I_1 = 32 * (FFN / 32), I_2 = (FFN / 64) * (D / 32);
        constexpr int NITEMS = I_IN + 2 * I_O + I_QKV + 2 * I_1 + 2 * I_2;
        for (int it = gw; it < NITEMS; it += NGW) {
            int r = it;
            if (r < I_IN) { p0_transpose_item(p.in[12], D, ABIN, (bf16_t*)(ws + WS_WIN), scr, r, lane); continue; } r -= I_IN;
            if (r < I_O) { p0_transpose_item(p.in[16], D, D, (bf16_t*)(ws + WS_WO0), scr, r, lane); continue; } r -= I_O;
            if (r < I_QKV) { p0_transpose_item(p.in[17], D, NQKV, (bf16_t*)(ws + WS_WQKV), scr, r, lane); continue; } r -= I_QKV;
            if (r < I_O) { p0_transpose_item(p.in[19], D, D, (bf16_t*)(ws + WS_WO1), scr, r, lane); continue; } r -= I_O;
            if (r < 2 * I_1) { const int l = r / I_1; p0_transpose_item(p.in[20] + (size_t)l * D * FFN, D, FFN, (bf16_t*)(ws + WS_W1) + (size_t)l * FFN * D, scr, r - l * I_1, lane); continue; } r -= 2 * I_1;
            { const int l = r / I_2; p0_transpose_item(p.in[21] + (size_t)l * D * FFN, FFN, D, (bf16_t*)(ws + WS_W2) + (size_t)l * FFN * D, scr, r - l * I_2, lane); }
        }
    }
    {
        const int gtid = blockIdx.x * 512 + tid, gth = G * 512;
        cvt_linear(p.in[2], (bf16_t*)(ws + WS_K0) + (size_t)MTOT * 256, 1024 * 256, gtid, gth);
        cvt_linear(p.in[3], (bf16_t*)(ws + WS_V0) + (size_t)MTOT * 256, 1024 * 256, gtid, gth);
        cvt_linear(p.in[4], (bf16_t*)(ws + WS_CNK), 1024 * 2048, gtid, gth);
        cvt_linear(p.in[5], (bf16_t*)(ws + WS_CNV), 1024 * 2048, gtid, gth);
    }
}

template <bool OUT_F32>
__device__ __forceinline__ void norm_phase(const float* src_lo, const float* src_hi, const bf16_t* xb, const float* gain, const float* mod, int shift_off, int scale_off, bf16_t* dst_bf, float* dst_f) {
    int tid_ = threadIdx.x; asm volatile("" : "+v"(tid_));
    const int tid = tid_, lane = tid & 63, wave = tid >> 6, G = gridDim.x;
    const int gw = blockIdx.x * 8 + wave, NGW = G * 8, per = (MTOT + NGW - 1) / NGW;
    const int r_beg = gw * per, r_end = (r_beg + per < MTOT) ? r_beg + per : MTOT;
    int cur = -1; f32x4 A[8], B[8];
    for (int row = r_beg; row < r_end; ++row) {
        const int cond = (row < MCTX) ? 0 : 1 + ((row - MCTX) >> 11);
        if (cond != cur) {
            cur = cond;
#pragma unroll
            for (int j = 0; j < 8; ++j) {
                const int col = 4 * lane + 256 * j; const f32x4 g = *(const f32x4*)(gain + col);
                if (mod) { const f32x4 sc = *(const f32x4*)(mod + (size_t)cond * MODW + scale_off + col); A[j] = g * (sc + 1.f); B[j] = *(const f32x4*)(mod + (size_t)cond * MODW + shift_off + col); }
                else { A[j] = g; B[j] = (f32x4){0.f, 0.f, 0.f, 0.f}; }
            }
        }
        f32x4 v[8]; float s = 0.f;
        if (xb) {
            const bf16_t* xr = xb + (size_t)row * D + 4 * lane;
#pragma unroll
            for (int j = 0; j < 8; ++j) { const u32x2 rb = *(const u32x2*)(xr + 256 * j); v[j][0] = bf2f(rb.x & 0xffffu); v[j][1] = __uint_as_float(rb.x & 0xffff0000u); v[j][2] = bf2f(rb.y & 0xffffu); v[j][3] = __uint_as_float(rb.y & 0xffff0000u); }
        } else {
            const float* xr = ((row < MCTX) ? src_lo : src_hi) + (size_t)row * D + 4 * lane;
#pragma unroll
            for (int j = 0; j < 8; ++j) v[j] = *(const f32x4*)(xr + 256 * j);
        }
#pragma unroll
        for (int j = 0; j < 8; ++j) s += (v[j].x * v[j].x + v[j].y * v[j].y) + (v[j].z * v[j].z + v[j].w * v[j].w);
        const float rstd = rsqrtf(wave_sum(s) * (1.f / D) + EPS);
#pragma unroll
        for (int j = 0; j < 8; ++j) {
            const f32x4 y = v[j] * rstd * A[j] + B[j];
            if (OUT_F32) *(f32x4*)(dst_f + (size_t)row * D + 4 * lane + 256 * j) = y;
            else { u32x2 o; o.x = cvt_pk_bf16(y[0], y[1]); o.y = cvt_pk_bf16(y[2], y[3]); *(u32x2*)(dst_bf + (size_t)row * D + 4 * lane + 256 * j) = o; }
        }
    }
}

__device__ __forceinline__ void unpack8(const u32x4 r, float (&f)[8]) {
    f[0] = bf2f(r.x & 0xffffu); f[1] = __uint_as_float(r.x & 0xffff0000u); f[2] = bf2f(r.y & 0xffffu); f[3] = __uint_as_float(r.y & 0xffff0000u);
    f[4] = bf2f(r.z & 0xffffu); f[5] = __uint_as_float(r.z & 0xffff0000u); f[6] = bf2f(r.w & 0xffffu); f[7] = __uint_as_float(r.w & 0xffff0000u);
}
__device__ __forceinline__ void ew0_phase(const Params& p) {
    int tid_ = threadIdx.x; asm volatile("" : "+v"(tid_));
    const int tid = tid_, lane = tid & 63, wave = tid >> 6, G = gridDim.x;
    const int gw = blockIdx.x * 8 + wave, NGW = G * 8;
    unsigned char* ws = p.ws;
    const bf16_t* Z = (const bf16_t*)(ws + WS_Z);
    bf16_t* AB = (bf16_t*)(ws + WS_AB); bf16_t* Q0 = (bf16_t*)(ws + WS_Q0); bf16_t* K0 = (bf16_t*)(ws + WS_K0); bf16_t* V0 = (bf16_t*)(ws + WS_V0);
    const float* convw = p.in[13]; const float* qn = p.in[14]; const float* kn = p.in[15];
    const int ri = lane & 31, chunk = lane >> 5, da = chunk * 64 + ri, db = da + 32;
    const float inv = __builtin_amdgcn_exp2f(-(float)ri * (13.287712379549449f / 32.f));
    const float qwa = qn[da], qwb = qn[db], kwa = kn[da], kwb = kn[db];
    for (int tok = gw; tok < MTOT; tok += NGW) {
        const bool lat = tok >= MCTX;
        const int t = lat ? ((tok - MCTX) & 2047) : (tok & 255), slen = lat ? 2048 : 256;
        const bf16_t* zr = Z + (size_t)tok * ABIN;
#pragma unroll
        for (int j = 0; j < 2; ++j) {
            const int ch = j * 512 + lane * 8;
            float gb[8], acc[8];
            unpack8(*(const u32x4*)(zr + ch), gb);
#pragma unroll
            for (int e = 0; e < 8; ++e) acc[e] = 0.f;
#pragma unroll
            for (int dt = -1; dt <= 1; ++dt) {
                if (t + dt >= 0 && t + dt < slen) {
                    float gc[8], xa[8];
                    unpack8(*(const u32x4*)(zr + dt * ABIN + 1024 + ch), gc);
                    unpack8(*(const u32x4*)(zr + dt * ABIN + 2048 + ch), xa);
                    const f32x4 w0 = *(const f32x4*)(convw + (dt + 1) * 1024 + ch), w1 = *(const f32x4*)(convw + (dt + 1) * 1024 + ch + 4);
#pragma unroll
                    for (int e = 0; e < 4; ++e) { acc[e] += w0[e] * (gc[e] * xa[e]); acc[4 + e] += w1[e] * (gc[4 + e] * xa[4 + e]); }
                }
            }
            u32x4 o; o.x = cvt_pk_bf16(gb[0] * acc[0], gb[1] * acc[1]); o.y = cvt_pk_bf16(gb[2] * acc[2], gb[3] * acc[3]);
            o.z = cvt_pk_bf16(gb[4] * acc[4], gb[5] * acc[5]); o.w = cvt_pk_bf16(gb[6] * acc[6], gb[7] * acc[7]);
            *(u32x4*)(AB + (size_t)tok * D + ch) = o;
        }
        float cs = 1.f, sn = 0.f;
        if (lat) { const float pos = (float)(chunk == 0 ? (t >> 6) : (t & 63)); const float ang = pos * inv; cs = __cosf(ang); sn = __sinf(ang); }
#pragma unroll
        for (int hh = 0; hh < 10; ++hh) {
            const bf16_t* hp = zr + 3072 + hh * 128;
            const float va = bf2f(hp[da]), vb = bf2f(hp[db]);
            const float rstd = rsqrtf(wave_sum(va * va + vb * vb) * (1.f / 128.f) + EPS);
            const float na = va * rstd * (hh < 8 ? qwa : kwa), nb = vb * rstd * (hh < 8 ? qwb : kwb);
            const float ra = na * cs - nb * sn, rb = na * sn + nb * cs;
            if (hh < 8) { bf16_t* q = Q0 + (size_t)tok * 1024 + hh * 128; q[da] = (bf16_t)f2bf(ra); q[db] = (bf16_t)f2bf(rb); }
            else {
                const int kvh = hh - 8;
                bf16_t* k = K0 + (size_t)tok * 256 + kvh * 128; k[da] = (bf16_t)f2bf(ra); k[db] = (bf16_t)f2bf(rb);
                if (!lat) { float* ok = p.out + OUT_AK + (size_t)tok * 256 + kvh * 128; ok[da] = na; ok[db] = nb; }
            }
        }
        {
            const u32x2 r = *(const u32x2*)(zr + 4352 + lane * 4);
            *(u32x2*)(V0 + (size_t)tok * 256 + lane * 4) = r;
            if (!lat) { f32x4 o; o[0] = bf2f(r.x & 0xffffu); o[1] = __uint_as_float(r.x & 0xffff0000u); o[2] = bf2f(r.y & 0xffffu); o[3] = __uint_as_float(r.y & 0xffff0000u);
                *(f32x4*)(p.out + OUT_AV + (size_t)tok * 256 + lane * 4) = o; }
        }
    }
}

constexpr int KSTR = 272, VSTR = 288, LDS_KT = 0, LDS_VT = 2 * 64 * KSTR, LDS_BIAS = LDS_VT + 2 * 64 * VSTR;
constexpr float SCL2 = 0.08838834764831845f * 1.4426950408889634f, LOG2E = 1.4426950408889634f;
struct AttnArgs {
    const bf16_t* q; int qstride; int qrow0;
    bf16_t* o; int ostride;
    const bf16_t* kA; const bf16_t* vA; int strideA, ntA;
    const bf16_t* kB; const bf16_t* vB; int strideB, ntB;
    int t0, t1, role; f32x4* xs; unsigned* xf;
    int r0, krlo; const float* bias;
};
__device__ __forceinline__ v4i16_t vtr(const LAS unsigned char* p) { return __builtin_amdgcn_ds_read_tr16_b64_v4i16((LAS v4i16_t*)p); }

template <int NA>
__device__ __forceinline__ void attn_run(LAS unsigned char* lds, const AttnArgs& a) {
    int tid_ = threadIdx.x; asm volatile("" : "+v"(tid_));
    const int tid = tid_, lane = tid & 63, wave = __builtin_amdgcn_readfirstlane(tid >> 6), fr = lane & 15, fq = lane >> 4;
    bf16x8 Qf[2][4];
#pragma unroll
    for (int qb = 0; qb < 2; ++qb)
#pragma unroll
        for (int dc = 0; dc < 4; ++dc) Qf[qb][dc] = *(const bf16x8*)(a.q + (size_t)(a.qrow0 + wave * 32 + qb * 16 + fr) * a.qstride + dc * 32 + fq * 8);
    f32x4 O[2][8];
#pragma unroll
    for (int qb = 0; qb < 2; ++qb)
#pragma unroll
        for (int db = 0; db < 8; ++db) O[qb][db] = (f32x4){0.f, 0.f, 0.f, 0.f};
    float mrun[2] = {-1e30f, -1e30f}, lrun[2] = {0.f, 0.f};
    LAS float* biasL = (LAS float*)(lds + LDS_BIAS);
    if (NA) { for (int i = tid; i < 465; i += 512) biasL[i] = a.bias[i]; }
    const int lrow = tid >> 3, lch = tid & 7;
    u32x4 kr0, kr1, vr0, vr1;
#define ATT_GLOAD(t) do { const bool inA = (t) < a.ntA; const int tt = inA ? (t) : (t) - a.ntA; const int st = inA ? a.strideA : a.strideB; \
        const bf16_t* kp = (inA ? a.kA : a.kB) + (size_t)(tt * 64 + lrow) * st + lch * 8; const bf16_t* vp = (inA ? a.vA : a.vB) + (size_t)(tt * 64 + lrow) * st + lch * 8; \
        kr0 = *(const u32x4*)kp; kr1 = *(const u32x4*)(kp + 64); vr0 = *(const u32x4*)vp; vr1 = *(const u32x4*)(vp + 64); } while (0)
#define ATT_LWRITE(b) do { LAS unsigned char* kd = lds + LDS_KT + (b) * 64 * KSTR + lrow * KSTR + lch * 16; LAS unsigned char* vd = lds + LDS_VT + (b) * 64 * VSTR + lrow * VSTR + lch * 16; \
        *(LAS u32x4*)kd = kr0; *(LAS u32x4*)(kd + 128) = kr1; *(LAS u32x4*)vd = vr0; *(LAS u32x4*)(vd + 128) = vr1; } while (0)
    ATT_GLOAD(a.t0); ATT_LWRITE(a.t0 & 1); __syncthreads();
    const int rw = NA ? a.r0 + (wave >> 1) : 0;
    const int kr_lo_w = NA ? (rw - 4 < 0 ? 0 : (rw - 4 > 24 ? 24 : rw - 4)) : 0;
    for (int t = a.t0; t < a.t1; ++t) {
        if (t + 1 < a.t1) ATT_GLOAD(t + 1);
        bool active = true; int kr = 0; const bool local = NA && t >= a.ntA;
        if (local) { kr = a.krlo + (t - a.ntA); active = (kr >= kr_lo_w) && (kr < kr_lo_w + 8); }
        if (active) {
            const LAS unsigned char* Kt = lds + LDS_KT + (t & 1) * 64 * KSTR;
            const LAS unsigned char* Vt = lds + LDS_VT + (t & 1) * 64 * VSTR;
            f32x4 S[2][4];
#pragma unroll
            for (int qb = 0; qb < 2; ++qb)
#pragma unroll
                for (int kb = 0; kb < 4; ++kb) S[qb][kb] = (f32x4){0.f, 0.f, 0.f, 0.f};
#pragma unroll
            for (int kb = 0; kb < 4; ++kb)
#pragma unroll
                for (int dc = 0; dc < 4; ++dc) {
                    const bf16x8 kf = *(const LAS bf16x8*)(Kt + (kb * 16 + fr) * KSTR + dc * 64 + fq * 16);
                    S[0][kb] = __builtin_amdgcn_mfma_f32_16x16x32_bf16(kf, Qf[0][dc], S[0][kb], 0, 0, 0);
                    S[1][kb] = __builtin_amdgcn_mfma_f32_16x16x32_bf16(kf, Qf[1][dc], S[1][kb], 0, 0, 0);
                }
            bf16x8 Pf[2][2];
#pragma unroll
            for (int qb = 0; qb < 2; ++qb) {
                if (local) {
                    const int c = (wave & 1) * 32 + qb * 16 + fr;
                    const int kc0 = c - 8 < 0 ? 0 : (c - 8 > 48 ? 48 : c - 8);
                    const LAS float* brow = biasL + (kr - rw + 7) * 31 + 15 - c;
#pragma unroll
                    for (int kb = 0; kb < 4; ++kb)
#pragma unroll
                        for (int j = 0; j < 4; ++j) { const int kc = kb * 16 + 4 * fq + j; const bool ok = (kc >= kc0) && (kc < kc0 + 16);
                            const float bv = brow[ok ? kc : c];
                            S[qb][kb][j] = ok ? (S[qb][kb][j] * SCL2 + bv * LOG2E) : -1e30f; }
                } else {
#pragma unroll
                    for (int kb = 0; kb < 4; ++kb) S[qb][kb] = S[qb][kb] * SCL2;
                }
                float mx = -1e30f;
#pragma unroll
                for (int kb = 0; kb < 4; ++kb) mx = fmaxf(mx, fmaxf(fmaxf(S[qb][kb][0], S[qb][kb][1]), fmaxf(S[qb][kb][2], S[qb][kb][3])));
                mx = fmaxf(mx, __shfl_xor(mx, 16)); mx = fmaxf(mx, __shfl_xor(mx, 32));
                const float mn = fmaxf(mrun[qb], mx), alpha = __builtin_amdgcn_exp2f(mrun[qb] - mn);
                mrun[qb] = mn;
                float rs = 0.f;
#pragma unroll
                for (int kb = 0; kb < 4; ++kb)
#pragma unroll
                    for (int j = 0; j < 4; ++j) { const float pv = __builtin_amdgcn_exp2f(S[qb][kb][j] - mn); S[qb][kb][j] = pv; rs += pv; }
                lrun[qb] = lrun[qb] * alpha + rs;
#pragma unroll
                for (int db = 0; db < 8; ++db) O[qb][db] = O[qb][db] * alpha;
#pragma unroll
                for (int c2 = 0; c2 < 2; ++c2) {
                    u32x4 pk; pk.x = cvt_pk_bf16(S[qb][2 * c2][0], S[qb][2 * c2][1]); pk.y = cvt_pk_bf16(S[qb][2 * c2][2], S[qb][2 * c2][3]);
                    pk.z = cvt_pk_bf16(S[qb][2 * c2 + 1][0], S[qb][2 * c2 + 1][1]); pk.w = cvt_pk_bf16(S[qb][2 * c2 + 1][2], S[qb][2 * c2 + 1][3]);
                    Pf[qb][c2] = __builtin_bit_cast(bf16x8, pk);
                }
            }
            const LAS unsigned char* vb = Vt + (4 * fq + (fr >> 2)) * VSTR + (fr & 3) * 8;
#pragma unroll
            for (int c2 = 0; c2 < 2; ++c2)
#pragma unroll
                for (int db = 0; db < 8; ++db) {
                    const v4i16_t lo = vtr(vb + (c2 * 32) * VSTR + db * 32), hi = vtr(vb + (c2 * 32 + 16) * VSTR + db * 32);
                    bf16x8 vf; vf[0] = lo[0]; vf[1] = lo[1]; vf[2] = lo[2]; vf[3] = lo[3]; vf[4] = hi[0]; vf[5] = hi[1]; vf[6] = hi[2]; vf[7] = hi[3];
                    O[0][db] = __builtin_amdgcn_mfma_f32_16x16x32_bf16(vf, Pf[0][c2], O[0][db], 0, 0, 0);
                    O[1][db] = __builtin_amdgcn_mfma_f32_16x16x32_bf16(vf, Pf[1][c2], O[1][db], 0, 0, 0);
                }
        }
        if (t + 1 < a.t1) ATT_LWRITE((t + 1) & 1);
        __syncthreads();
    }
#undef ATT_GLOAD
#undef ATT_LWRITE
    if (a.role == 2) {
        f32x4* sp = a.xs + tid;
#pragma unroll
        for (int qb = 0; qb < 2; ++qb)
#pragma unroll
            for (int db = 0; db < 8; ++db) asm volatile("global_store_dwordx4 %0, %1, off sc1" :: "v"(sp + (qb * 8 + db) * 512), "v"(O[qb][db]) : "memory");
        const f32x4 ml = {mrun[0], mrun[1], lrun[0], lrun[1]};
        asm volatile("global_store_dwordx4 %0, %1, off sc1" :: "v"(sp + 16 * 512), "v"(ml) : "memory");
        asm volatile("s_waitcnt vmcnt(0)" ::: "memory");
        if (lane == 0) __hip_atomic_store(a.xf + wave, 1u, __ATOMIC_RELAXED, __HIP_MEMORY_SCOPE_AGENT);
        return;
    }
    if (a.role == 1) {
        unsigned spins = 0;
        while (__hip_atomic_load(a.xf + wave, __ATOMIC_RELAXED, __HIP_MEMORY_SCOPE_AGENT) == 0u) { __builtin_amdgcn_s_sleep(2); if (++spins > (1u << 22)) break; }
        __builtin_amdgcn_fence(__ATOMIC_ACQUIRE, "agent");
        asm volatile("s_waitcnt vmcnt(0)" ::: "memory");
        const f32x4* sp = a.xs + tid;
        const f32x4 ml = sp[16 * 512];
        float fa[2], fb[2];
#pragma unroll
        for (int qb = 0; qb < 2; ++qb) { const float mo = ml[qb], mn = fmaxf(mrun[qb], mo); fa[qb] = __builtin_amdgcn_exp2f(mrun[qb] - mn); fb[qb] = __builtin_amdgcn_exp2f(mo - mn); lrun[qb] = lrun[qb] * fa[qb] + ml[2 + qb] * fb[qb]; }
#pragma unroll
        for (int qb = 0; qb < 2; ++qb)
#pragma unroll
            for (int db = 0; db < 8; ++db) { const f32x4 o2 = sp[(qb * 8 + db) * 512]; O[qb][db] = O[qb][db] * fa[qb] + o2 * fb[qb]; asm volatile("" ::: "memory"); }
    }
#pragma unroll
    for (int qb = 0; qb < 2; ++qb) {
        float lt = lrun[qb]; lt += __shfl_xor(lt, 16); lt += __shfl_xor(lt, 32);
        const float il = 1.f / lt;
        bf16_t* op = a.o + (size_t)(a.qrow0 + wave * 32 + qb * 16 + fr) * a.ostride + 4 * fq;
#pragma unroll
        for (int db = 0; db < 8; ++db) { const f32x4 v = O[qb][db] * il; u32x2 o; o.x = cvt_pk_bf16(v[0], v[1]); o.y = cvt_pk_bf16(v[2], v[3]); *(u32x2*)(op + db * 16) = o; }
    }
}

__device__ __forceinline__ void attn0_phase(const Params& p, LAS unsigned char* lds) {
    unsigned char* ws = p.ws; const int G = gridDim.x;
    const bf16_t* Q0 = (const bf16_t*)(ws + WS_Q0); const bf16_t* K0 = (const bf16_t*)(ws + WS_K0); const bf16_t* V0 = (const bf16_t*)(ws + WS_V0);
    bf16_t* AB = (bf16_t*)(ws + WS_AB);
    const bool split = (G == 256);
    for (int i = blockIdx.x; i < 512; i += G) {
        AttnArgs a;
        if (i < 256) { const int it = i & 127; const int b = it >> 6, h = (it >> 3) & 7, qblk = it & 7, kvh = h >> 2;
            if (!split && i >= 128) continue;
            a.q = Q0 + h * 128; a.qstride = 1024; a.qrow0 = MCTX + b * 2048 + qblk * 256; a.o = AB + 1024 + h * 128; a.ostride = D;
            a.kA = K0 + (size_t)(MTOT + b * 512) * 256 + kvh * 128; a.vA = V0 + (size_t)(MTOT + b * 512) * 256 + kvh * 128; a.strideA = 256; a.ntA = 8;
            a.kB = K0 + (size_t)(MCTX + b * 2048) * 256 + kvh * 128; a.vB = V0 + (size_t)(MCTX + b * 2048) * 256 + kvh * 128; a.strideB = 256; a.ntB = 32;
            a.t0 = (split && i >= 128) ? 20 : 0; a.t1 = (split && i < 128) ? 20 : 40; a.role = split ? (i < 128 ? 1 : 2) : 0;
            a.xs = (f32x4*)(ws + WS_TS) + (size_t)it * (17 * 512); a.xf = (unsigned*)(ws + WS_FLAGS) + 8 * 1024 + it * 8;
        } else { const int j = i - 256, b = j >> 3, h = j & 7, kvh = h >> 2;
            a.q = Q0 + h * 128; a.qstride = 1024; a.qrow0 = b * 256; a.o = AB + 1024 + h * 128; a.ostride = D;
            a.kA = K0 + (size_t)(b * 256) * 256 + kvh * 128; a.vA = V0 + (size_t)(b * 256) * 256 + kvh * 128; a.strideA = 256; a.ntA = 4;
            a.kB = a.kA; a.vB = a.vA; a.strideB = 256; a.ntB = 0;
            a.t0 = 0; a.t1 = 4; a.role = 0; a.xs = nullptr; a.xf = nullptr;
        }
        a.r0 = 0; a.krlo = 0; a.bias = nullptr;
        attn_run<0>(lds, a);
    }
}
__device__ __forceinline__ void attn1_phase(const Params& p, LAS unsigned char* lds, bf16_t* AO) {
    unsigned char* ws = p.ws; const int G = gridDim.x;
    const bf16_t* Q1 = (const bf16_t*)(ws + WS_Z); const bf16_t* K1 = Q1 + (size_t)MTOT * D; const bf16_t* V1 = K1 + (size_t)MTOT * D;
    const bf16_t* CNK = (const bf16_t*)(ws + WS_CNK); const bf16_t* CNV = (const bf16_t*)(ws + WS_CNV);
    for (int i = blockIdx.x; i < 256; i += G) {
        AttnArgs a;
        const int b = i >> 7, h = (i >> 3) & 15, rg = i & 7, r0 = rg * 4;
        const int lo = r0 - 4 < 0 ? 0 : (r0 - 4 > 24 ? 24 : r0 - 4), hi0 = r0 - 1 < 0 ? 0 : (r0 - 1 > 24 ? 24 : r0 - 1), hi = hi0 + 7;
        a.q = Q1 + h * 128; a.qstride = D; a.qrow0 = MCTX + b * 2048 + r0 * 64; a.o = AO + h * 128; a.ostride = D;
        a.kA = CNK + (size_t)(b * 512) * 2048 + h * 128; a.vA = CNV + (size_t)(b * 512) * 2048 + h * 128; a.strideA = 2048; a.ntA = 8;
        a.kB = K1 + (size_t)(MCTX + b * 2048 + lo * 64) * D + h * 128; a.vB = V1 + (size_t)(MCTX + b * 2048 + lo * 64) * D + h * 128; a.strideB = D; a.ntB = hi - lo + 1;
        a.r0 = r0; a.krlo = lo; a.bias = p.in[18] + h * 465; a.t0 = 0; a.t1 = a.ntA + a.ntB; a.role = 0; a.xs = nullptr; a.xf = nullptr;
        attn_run<1>(lds, a);
    }
    for (int j = blockIdx.x; j < 512; j += G) {
        AttnArgs a;
        const int b = j >> 4, h = j & 15;
        a.q = Q1 + h * 128; a.qstride = D; a.qrow0 = b * 256; a.o = AO + h * 128; a.ostride = D;
        a.kA = K1 + (size_t)(b * 256) * D + h * 128; a.vA = V1 + (size_t)(b * 256) * D + h * 128; a.strideA = D; a.ntA = 4;
        a.kB = a.kA; a.vB = a.vA; a.strideB = D; a.ntB = 0;
        a.r0 = 0; a.krlo = 0; a.bias = nullptr; a.t0 = 0; a.t1 = 4; a.role = 0; a.xs = nullptr; a.xf = nullptr;
        attn_run<0>(lds, a);
    }
}

#define XB_TMO      128
#define XB_XCNT(j)  (256  + 64 * (j))
#define XB_XSUB(j)  (1280 + 64 * (j))
#define XB_XGEN(j)  (2304 + 64 * (j))
#define XB_TOP      3328
#define XB_TOPGEN   3392
#define XCD_BAR_WORDS 3456
#define XB_SPIN_CAP (1u << 18)

__device__ __forceinline__ unsigned xb_ld(unsigned* p)              { return __hip_atomic_load(p, __ATOMIC_RELAXED, __HIP_MEMORY_SCOPE_AGENT); }
__device__ __forceinline__ unsigned xb_add(unsigned* p, unsigned v) { return __hip_atomic_fetch_add(p, v, __ATOMIC_RELAXED, __HIP_MEMORY_SCOPE_AGENT); }
__device__ __forceinline__ unsigned xb_xcc_id() { return (unsigned)__builtin_amdgcn_s_getreg((3 << 11) | 20) & 0xFu; }
#define XB_SPIN(cond, bar) do { unsigned _sp = 0; while (cond) { __builtin_amdgcn_s_sleep(1); \
    if ((++_sp & 255u) == 0u) { if (xb_ld(&(bar)[XB_TMO])) break; if (_sp > XB_SPIN_CAP) { atomicAdd(&(bar)[XB_TMO], 1u); break; } } } } while (0)

struct XcdBarrier {
    unsigned* bar; unsigned x;
    volatile LAS unsigned* st;
};

__device__ __forceinline__ XcdBarrier xcd_barrier_post(unsigned* bar, volatile LAS unsigned* st) {
    XcdBarrier b; b.bar = bar; b.x = xb_xcc_id(); b.st = st;
    if (threadIdx.x == 0) (void)xb_add(&bar[XB_XCNT(b.x)], 1u);
    return b;
}
__device__ __forceinline__ void xcd_barrier_complete(unsigned* bar, unsigned x, unsigned& nloc, unsigned& nx) {
    const unsigned G = gridDim.x * gridDim.y * gridDim.z;
    unsigned sum, cnt, mine, sp = 0u;
    for (;;) {
        sum = 0u; cnt = 0u; mine = 0u;
#pragma unroll
        for (unsigned j = 0; j < 16; ++j) { const unsigned c = xb_ld(&bar[XB_XCNT(j)]); sum += c; cnt += (c > 0u) ? 1u : 0u; mine = (j == x) ? c : mine; }
        if (sum == G) break;
        __builtin_amdgcn_s_sleep(1);
        if ((++sp & 255u) == 0u) { if (xb_ld(&bar[XB_TMO])) break; if (sp > XB_SPIN_CAP) { atomicAdd(&bar[XB_TMO], 1u); break; } }
    }
    nloc = mine > 0u ? mine : 1u; nx = cnt > 0u ? cnt : 1u;
}

__device__ __forceinline__ void xcd_barrier(const XcdBarrier& b) {
    asm volatile("s_waitcnt vmcnt(0)" ::: "memory");
    __syncthreads();
    if (threadIdx.x == 0) {
        unsigned* bar = b.bar;
        __builtin_amdgcn_s_waitcnt(0);
        unsigned nloc = b.st[0], nx = b.st[1];
        if (nloc == 0u) { xcd_barrier_complete(bar, b.x, nloc, nx); b.st[0] = nloc; b.st[1] = nx; }
        const unsigned old = xb_add(&bar[XB_XSUB(b.x)], 1u);
        const unsigned gen = old / nloc;
        if (old + 1u == (gen + 1u) * nloc) {
            __builtin_amdgcn_fence(__ATOMIC_RELEASE, "agent");
            asm volatile("s_waitcnt vmcnt(0)" ::: "memory");
            const unsigned og = xb_add(&bar[XB_TOP], 1u);
            const unsigned tg = og / nx;
            if (og + 1u == (tg + 1u) * nx) xb_add(&bar[XB_TOPGEN], 1u);
            else XB_SPIN(xb_ld(&bar[XB_TOPGEN]) == tg, bar);
            __builtin_amdgcn_fence(__ATOMIC_ACQUIRE, "agent");
            xb_add(&bar[XB_XGEN(b.x)], 1u);
            asm volatile("s_waitcnt vmcnt(0)" ::: "memory");
        } else {
            XB_SPIN(xb_ld(&bar[XB_XGEN(b.x)]) == gen, bar);
            __builtin_amdgcn_fence(__ATOMIC_ACQUIRE, "agent");
            asm volatile("s_waitcnt vmcnt(0)" ::: "memory");
        }
    }
    __syncthreads();
}


constexpr int NPHASE = 18;
__global__ void __launch_bounds__(512, 2) mega_fwd(Params p) {
    extern __shared__ __attribute__((aligned(16))) unsigned char lds_raw[];
    LAS unsigned char* lds = (LAS unsigned char*)lds_raw;
    cg::grid_group grid = cg::this_grid();
    if (threadIdx.x < 64) ((LAS unsigned*)(lds + 131072))[threadIdx.x] = 0u;
    __syncthreads();
    XcdBarrier xbar = xcd_barrier_post((unsigned*)(p.ws + WS_BAR), (volatile LAS unsigned*)(lds + 131072));
    unsigned char* ws = p.ws;
    const int G = gridDim.x;
    float* MOD = (float*)(ws + WS_MOD);
    bf16_t* XN = (bf16_t*)(ws + WS_XN); bf16_t* X = (bf16_t*)(ws + WS_X);
    bf16_t* Z = (bf16_t*)(ws + WS_Z); bf16_t* AB = (bf16_t*)(ws + WS_AB); bf16_t* H = (bf16_t*)(ws + WS_H);
#define RUN(k) (p.ph_lo <= (k) && (k) < p.ph_hi)
#define GRID_SYNC_CG() do { asm volatile("s_waitcnt vmcnt(0) lgkmcnt(0)" ::: "memory"); grid.sync(); __builtin_amdgcn_fence(__ATOMIC_ACQUIRE, "agent"); asm volatile("s_waitcnt vmcnt(0)" ::: "memory"); } while (0)
#define GRID_SYNC() do { xcd_barrier(xbar); } while (0)
#define REPEAT(n, stmt) do { for (int rep_ = 0; rep_ < (n); ++rep_) { stmt; if (rep_ + 1 < (n)) GRID_SYNC(); } } while (0)
#define SEAM(k) do { if (p.ph_lo <= (k) && (k) + 1 < p.ph_hi) GRID_SYNC(); } while (0)
    if (RUN(0)) REPEAT(REP_P0, p0_prologue(p, lds));
    if (p.ph_lo <= 0 && 1 < p.ph_hi) GRID_SYNC_CG();
    for (int l = 0; l < 2; ++l) {
        const int k0 = 1 + 8 * l;
        const float* modl = MOD + (size_t)l * 3 * MODW;
        const float* xin_lo = p.in[0];
        const float* xin_hi = p.in[1] - (size_t)MCTX * D;
        const bf16_t* xres = (l == 0) ? nullptr : X;
        if (RUN(k0)) REPEAT(REP_NORM, norm_phase<false>(xin_lo, xin_hi, xres, p.in[10] + l * D, modl, 0, D, XN, nullptr));
        SEAM(k0);
        if (RUN(k0 + 1)) for (int repg_ = 0; repg_ < REP_G; ++repg_) {
            if (repg_) GRID_SYNC();
            if (l == 0) { pg8::Gemm g{XN, (const bf16_t*)(ws + WS_WIN), MTOT, ABIN, D}; pg8::StaticOrder S; S.init(MTOT, ABIN, G, (int)blockIdx.x, D, ws, -2);
                EpiBf16<0, false> E{Z, ABIN, nullptr, nullptr, 0, 0}; pg8::gemm_phase(lds, g, S, E); }
            else { pg8::Gemm g{XN, (const bf16_t*)(ws + WS_WQKV), MTOT, NQKV, D}; pg8::StaticOrder S; S.init(MTOT, NQKV, G, (int)blockIdx.x, D, ws, -2);
                EpiBf16<0, true> E{Z, D, p.out + OUT_NK, p.out + OUT_NV, 8, (size_t)MTOT * D}; pg8::gemm_phase(lds, g, S, E); }
        }
        SEAM(k0 + 1);
        if (l == 0) { if (RUN(k0 + 2)) REPEAT(REP_EW, ew0_phase(p)); SEAM(k0 + 2); }
        if (RUN(k0 + 3)) REPEAT(REP_ATT, if (l == 0) attn0_phase(p, lds); else attn1_phase(p, lds, AB));
        SEAM(k0 + 3);
        if (RUN(k0 + 4)) { pg8::Gemm g{AB, (const bf16_t*)(ws + (l == 0 ? WS_WO0 : WS_WO1)), MTOT, D, D}; pg8::StaticOrder S; S.init(MTOT, D, G, (int)blockIdx.x, D, ws, -2);
            EpiResid E{xin_lo, xin_hi, xres, X, modl + 2 * D}; pg8::gemm_phase(lds, g, S, E); }
        SEAM(k0 + 4);
        if (RUN(k0 + 5)) REPEAT(REP_NORM, norm_phase<false>(nullptr, nullptr, X, p.in[11] + l * D, modl, 3 * D, 4 * D, XN, nullptr));
        SEAM(k0 + 5);
        if (RUN(k0 + 6)) for (int repg_ = 0; repg_ < REP_G; ++repg_) { if (repg_) GRID_SYNC(); pg8::Gemm g{XN, (const bf16_t*)(ws + WS_W1) + (size_t)l * FFN * D, MTOT, FFN, D}; pg8::StaticOrder S; S.init(MTOT, FFN, G, (int)blockIdx.x, D, ws, -1);
            EpiBf16<1, false> E{H, FFN, nullptr, nullptr, 0, 0}; pg8::gemm_phase(lds, g, S, E); }
        SEAM(k0 + 6);
        if (RUN(k0 + 7)) { pg8::Gemm g{H, (const bf16_t*)(ws + WS_W2) + (size_t)l * FFN * D, MTOT, D, FFN}; pg8::StaticOrder S; S.init(MTOT, D, G, (int)blockIdx.x, FFN, ws, (l * 4 + 3) * 1024);
            EpiResid E{nullptr, nullptr, X, X, modl + 5 * D}; pg8::gemm_phase(lds, g, S, E); }
        SEAM(k0 + 7);
    }
#if PROBE_STOP > 0
    GRID_SYNC();
    {
        const size_t n = (size_t)MTOT * D, gt = (size_t)blockIdx.x * 512 + threadIdx.x, gs = (size_t)G * 512;
        const bf16_t* sb = PROBE_SRC == 1 ? XN : PROBE_SRC == 2 ? AB : PROBE_SRC == 3 ? Z : PROBE_SRC == 5 ? Z + (size_t)4096 * NQKV : (const bf16_t*)(ws + WS_Q0);
#if PROBE_SRC == 6
        attn1_phase(p, lds, XN);
        GRID_SYNC();
        for (size_t i = gt; i < n; i += gs) p.out[i] = bf2f(AB[i]) - bf2f(XN[i]);
#else
        for (size_t i = gt; i < n; i += gs) p.out[i] = (PROBE_SRC == 0) ? bf2f(X[i]) : bf2f(sb[i]);
#endif
#if PROBE_STOP < 4
        for (size_t i = gt; i < (size_t)2 * MCTX * 256; i += gs) p.out[OUT_AK + i] = 0.f;
#endif
        for (size_t i = gt; i < (size_t)2 * MCTX * D; i += gs) p.out[OUT_NK + i] = 0.f;
    }
#else
    if (RUN(17)) REPEAT(REP_NORM, norm_phase<true>(nullptr, nullptr, X, p.in[22], nullptr, 0, 0, nullptr, p.out));
#endif
#undef RUN
#undef SEAM
#undef REPEAT
#undef GRID_SYNC
#undef GRID_SYNC_CG
}

extern "C" void kernel_launch(void* const* d_in, const int* in_sizes, int n_in, void* d_out, int out_size, void* d_ws, size_t ws_size, hipStream_t stream) {
    static int grid = 0;
    if (grid == 0) {
        if (n_in != 23 || ws_size < WS_END) { fprintf(stderr, "kernel_launch: expected 23 inputs and >= %zu bytes of workspace (got %d, %zu)\n", (size_t)WS_END, n_in, ws_size); grid = -1; return; }
        int dev = 0, cus = 0, per_cu = 0;
        (void)hipGetDevice(&dev);
        (void)hipDeviceGetAttribute(&cus, hipDeviceAttributeMultiprocessorCount, dev);
        if (hipFuncSetAttribute((const void*)mega_fwd, hipFuncAttributeMaxDynamicSharedMemorySize, LDS_BYTES) != hipSuccess) { fprintf(stderr, "kernel_launch: hipFuncSetAttribute failed\n"); grid = -1; return; }
        if (hipOccupancyMaxActiveBlocksPerMultiprocessor(&per_cu, (const void*)mega_fwd, 512, LDS_BYTES) != hipSuccess || per_cu < 1) { fprintf(stderr, "kernel_launch: occupancy query failed (%d)\n", per_cu); grid = -1; return; }
        grid = cus * (per_cu > 1 ? 1 : per_cu);
        fprintf(stderr, "kernel_launch: grid %d (cus %d, per_cu %d)\n", grid, cus, per_cu);
    }
    if (grid < 0) return;
    (void)hipMemsetAsync((char*)d_ws + WS_BAR, 0, 65536, stream);
    Params p{};
    for (int i = 0; i < 23; ++i) p.in[i] = (const float*)d_in[i];
    p.out = (float*)d_out; p.ws = (unsigned char*)d_ws;
#if MK_PER_PHASE
    for (int k = 0; k < NPHASE; ++k) {
        if (k == 11) continue;
        p.ph_lo = k; p.ph_hi = k + 1;
        void* args[] = {&p};
        hipError_t e = hipLaunchCooperativeKernel((const void*)mega_fwd, dim3(grid), dim3(512), args, LDS_BYTES, stream);
        if (e != hipSuccess) { fprintf(stderr, "launch %d failed: %s\n", k, hipGetErrorString(e)); break; }
    }
#else
    p.ph_lo = 0; p.ph_hi = PROBE_STOP > 0 ? PROBE_STOP : NPHASE;
    void* args[] = {&p};
    hipError_t e = hipLaunchCooperativeKernel((const void*)mega_fwd, dim3(grid), dim3(512), args, LDS_BYTES, stream);
    if (e != hipSuccess) fprintf(stderr, "cooperative launch failed: %s (grid %d)\n", hipGetErrorString(e), grid);
#endif
}
```

```cpp
#include <hip/hip_runtime.h>
#include <hip/hip_cooperative_groups.h>
#include <cstdio>
#include <cstdint>
namespace cg = cooperative_groups;

#ifndef MK_PER_PHASE
#define MK_PER_PHASE 0
#endif

#ifndef REP_NG
#define REP_NG 1
#endif
#ifndef REP_P0
#define REP_P0 REP_NG
#endif
#ifndef REP_NORM
#define REP_NORM REP_NG
#endif
#ifndef REP_EW
#define REP_EW REP_NG
#endif
#ifndef REP_ATT
#define REP_ATT REP_NG
#endif
#ifndef REP_G
#define REP_G 1
#endif
#ifndef PROBE_STOP
#define PROBE_STOP 0
#endif
#ifndef PROBE_SRC
#define PROBE_SRC 0
#endif
#define LAS __attribute__((address_space(3)))
#define PG8_LAS __attribute__((address_space(3)))
typedef unsigned short bf16_t;
typedef short bf16x8 __attribute__((ext_vector_type(8)));
typedef short v4i16_t __attribute__((ext_vector_type(4)));
typedef float f32x4 __attribute__((ext_vector_type(4)));
typedef float f32x2 __attribute__((ext_vector_type(2)));
typedef unsigned u32x4 __attribute__((ext_vector_type(4)));
typedef unsigned u32x2 __attribute__((ext_vector_type(2)));

__device__ __forceinline__ float bf2f(unsigned h) { return __uint_as_float(h << 16); }
typedef __bf16 bf16x2_t __attribute__((ext_vector_type(2)));
__device__ __forceinline__ unsigned cvt_pk_bf16(float lo, float hi) { f32x2 v = {lo, hi}; bf16x2_t r = __builtin_convertvector(v, bf16x2_t); return __builtin_bit_cast(unsigned, r); }
__device__ __forceinline__ float wave_sum(float v) {
#pragma unroll
    for (int o = 1; o < 64; o <<= 1) v += __shfl_xor(v, o);
    return v;
}

constexpr size_t WS_TS_OFS = 595591168ull;
constexpr size_t WS_FLAGS_OFS = (512u << 10) + 16384;
namespace pg8 {
constexpr int BM = 256, BK = 64, HALF = 128, HTB = HALF * BK * 2  , STAGE_BYTES = 8 * HTB, NXCD = 8, WGM = 4;

__host__ __device__ __forceinline__ int lds_byte(int r, int c) { const int st = (r >> 4) * 2 + (c >> 5), rr = r & 15, cc = c & 31, ob = rr * 64 + cc * 2; return st * 1024 + (ob ^ (((ob >> 9) & 1) << 5)); }
__host__ __device__ __forceinline__ void stage_rc(int b, int& R, int& C) { const int st = b / 1024, sb = b % 1024, swz = sb ^ (((sb >> 9) & 1) << 5); R = (st >> 1) * 16 + swz / 64; C = (st & 1) * 32 + (swz % 64) / 2; }
__host__ __device__ __forceinline__ int perm32(int rho) { const int n = rho >> 4, i = rho & 15; return 8 * (i >> 2) + 4 * n + (i & 3); }
struct Unit { int pm, pn, code; };
struct Gemm { const bf16_t* A; const bf16_t* Bt; int M, N, K; };
struct StaticOrder {
    int nM, nN, nwg, G, c, ntk, R, tail, fofs, msplit; unsigned char* wsb;
    __device__ __forceinline__ int kt0(const Unit& u) const { return (u.code & 3) == 2 ? (ntk >> 1) : 0; }
    __device__ __forceinline__ int nkt(const Unit& u) const { return ((u.code & 3) == 1 || (u.code & 3) == 2) ? (ntk >> 1) : ntk; }
    __host__ __device__ void init(int M, int N, int G_, int c_, int K, unsigned char* wsb_, int fofs_) {
        nM = M / BM; nN = N / BM; nwg = nM * nN; G = G_; c = c_; ntk = K / BK; wsb = wsb_; fofs = fofs_; msplit = (fofs_ == -2);
        R = nwg / G; tail = nwg - R * G;
        if (fofs_ == -1 || 2 * tail > G || (ntk & 3)) tail = 0;
    }
    __host__ __device__ bool next(int i, Unit& u) const {
        long L;
        if (tail) {
            if (i < R) { L = (long)i * G + c; u.code = 0; }
            else if (i == R && c < 2 * tail) { L = (long)R * G + (c >> 1); u.code = msplit ? (3 | ((c & 1) << 2)) : ((1 + (c & 1)) | ((c >> 1) << 2)); }
            else return false;
        } else { L = (long)i * G + c; if (L >= nwg) return false; u.code = 0; }
        int wgid = (int)L; { const int q = nwg / NXCD, r = nwg % NXCD, xcd = wgid % NXCD, off = wgid / NXCD; wgid = (xcd < r ? xcd * (q + 1) : r * (q + 1) + (xcd - r) * q) + off; }
        const int nig = WGM * nN, gid = wgid / nig, fm = gid * WGM, gsz = (nM - fm) < WGM ? (nM - fm) : WGM;
        u.pm = fm + ((wgid % nig) % gsz); u.pn = (wgid % nig) / gsz; return true;
    }
    __device__ __forceinline__ void a_ready(const Unit&) const {}
    __device__ __forceinline__ void done(const Unit&) const {}
};
template <class Epi, class Sched>
__device__ __forceinline__ void gemm_phase(PG8_LAS unsigned char* lds, const Gemm g, const Sched& S, const Epi& E) {
    int tid_ = threadIdx.x; asm volatile("" : "+v"(tid_));
    const int tid = tid_, wid = __builtin_amdgcn_readfirstlane(tid >> 6), lane = tid & 63, wr = wid >> 2, wc = wid & 3, fr = lane & 15, fq = lane >> 4;
    const int K = g.K;
    unsigned voffA[2], voffB[2];
#pragma unroll
    for (int i = 0; i < 2; ++i) { int R, C; stage_rc(tid * 16 + i * 8192, R, C); const int Rb = Epi::PERM ? ((R & ~31) + perm32(R & 31)) : R;
        voffA[i] = (unsigned)(R * K + C) * 2u; voffB[i] = (unsigned)(Rb * K + C) * 2u; }
    const size_t kstep = (size_t)(BK * 2);
    const size_t hstep = (size_t)HALF * K * 2;
    const size_t tstep = 2 * hstep;
    const unsigned ldsw = (unsigned)wid * 1024u;
    const int aoff = lds_byte(wr * 64 + fr, fq * 8), boff = lds_byte(wc * 32 + fr, fq * 8);
#define PG8_SA(b, h) (((b) * 2 + (h)) * HTB)
#define PG8_SB(b, h) ((4 + (b) * 2 + (h)) * HTB)
#define PG8_STAGE(bufoff, gbase, voff) do { _Pragma("unroll") for (int _i = 0; _i < 2; ++_i) \
        __builtin_amdgcn_global_load_lds((const unsigned*)((const char*)(gbase) + (voff)[_i]), (PG8_LAS unsigned*)(lds + (bufoff) + ldsw + _i * 8192), 16, 0, 0); } while (0)
#define PG8_LDA(dst, b, h) do { _Pragma("unroll") for (int m = 0; m < 4; ++m) _Pragma("unroll") for (int k = 0; k < 2; ++k) dst[m][k] = *(const PG8_LAS bf16x8*)(lds + PG8_SA(b, h) + aoff + m * 2048 + k * 1024); } while (0)
#define PG8_LDB(dst, b, h) do { _Pragma("unroll") for (int n = 0; n < 2; ++n) _Pragma("unroll") for (int k = 0; k < 2; ++k) dst[n][k] = *(const PG8_LAS bf16x8*)(lds + PG8_SB(b, h) + boff + n * 2048 + k * 1024); } while (0)
#define PG8_MMA(ai, bj, At, Bt) do { __builtin_amdgcn_s_setprio(1); _Pragma("unroll") for (int m = 0; m < 4; ++m) _Pragma("unroll") for (int n = 0; n < 2; ++n) _Pragma("unroll") for (int k = 0; k < 2; ++k) \
        acc[ai][bj][m][n] = __builtin_amdgcn_mfma_f32_16x16x32_bf16(Bt[n][k], At[m][k], acc[ai][bj][m][n], 0, 0, 0); __builtin_amdgcn_s_setprio(0); } while (0)
#define PG8_WAIT_V(n) asm volatile("s_waitcnt vmcnt(" #n ")" ::: "memory")
#define PG8_WAIT_L(n) asm volatile("s_waitcnt lgkmcnt(" #n ")" ::: "memory")
#define PG8_BAR __builtin_amdgcn_s_barrier()
#define PG8_SCHED __builtin_amdgcn_sched_barrier(0)
    Unit cur, nxt; int ui = 0;
    if (!S.next(0, cur)) return;
    f32x4 acc[2][2][4][2];
#pragma unroll
    for (int a = 0; a < 2; ++a)
#pragma unroll
        for (int b = 0; b < 2; ++b)
#pragma unroll
            for (int m = 0; m < 4; ++m)
#pragma unroll
                for (int n = 0; n < 2; ++n) acc[a][b][m][n] = (f32x4){0.f, 0.f, 0.f, 0.f};
    bf16x8 At[4][2], B0[2][2], B1[2][2];
    const char* cA = (const char*)g.A + (size_t)cur.pm * tstep + (size_t)S.kt0(cur) * kstep; const char* cB = (const char*)g.Bt + (size_t)cur.pn * tstep + (size_t)S.kt0(cur) * kstep;
    S.a_ready(cur);
    if ((cur.code & 3) == 3) cA += (size_t)(cur.code >> 2) * hstep;
    size_t ahs = (cur.code & 3) == 3 ? 0 : hstep;
    PG8_STAGE(PG8_SB(0, 0), cB, voffB); PG8_STAGE(PG8_SB(0, 1), cB + hstep, voffB); PG8_STAGE(PG8_SA(0, 0), cA, voffA); PG8_STAGE(PG8_SA(0, 1), cA + ahs, voffA);
    if (wr == 1) PG8_BAR;
    PG8_WAIT_V(2); PG8_BAR;
    PG8_STAGE(PG8_SB(1, 0), cB + kstep, voffB); PG8_STAGE(PG8_SA(1, 0), cA + kstep, voffA); PG8_STAGE(PG8_SB(1, 1), cB + hstep + kstep, voffB);
    PG8_WAIT_V(6); PG8_BAR;
    for (;;) {
        const bool has_next = S.next(ui + 1, nxt);
        const char* nA = has_next ? (const char*)g.A + (size_t)nxt.pm * tstep + (size_t)S.kt0(nxt) * kstep : cA; const char* nB = has_next ? (const char*)g.Bt + (size_t)nxt.pn * tstep + (size_t)S.kt0(nxt) * kstep : cB;
        const int nt = S.nkt(cur);
        const bool full = (cur.code & 3) != 3;
        const size_t ahs_n = (has_next && (nxt.code & 3) == 3) ? 0 : (has_next ? hstep : ahs);
        if (has_next && (nxt.code & 3) == 3) nA += (size_t)(nxt.code >> 2) * hstep;
        for (int t = 0; t < nt; t += 2) {
            const bool last = (t == nt - 2);
            const char* a1 = cA + (size_t)(t + 1) * kstep;
            const char* a2 = last ? nA : cA + (size_t)(t + 2) * kstep; const char* b2 = last ? nB : cB + (size_t)(t + 2) * kstep;
            const char* a3 = a2 + kstep; const char* b3 = b2 + kstep;
            if (last && has_next) S.a_ready(nxt);
            PG8_LDB(B0, 0, 0); PG8_LDB(B1, 0, 1); PG8_SCHED; PG8_LDA(At, 0, 0); PG8_STAGE(PG8_SA(1, 1), a1 + ahs, voffA);
            PG8_WAIT_V(8); PG8_WAIT_L(0); PG8_BAR; PG8_MMA(0, 0, At, B0); PG8_MMA(0, 1, At, B1); PG8_BAR; PG8_SCHED;
            PG8_LDA(At, 0, 1); PG8_STAGE(PG8_SB(0, 0), b2, voffB); PG8_STAGE(PG8_SB(0, 1), b2 + hstep, voffB); PG8_STAGE(PG8_SA(0, 0), a2, voffA);
            PG8_WAIT_V(8); PG8_WAIT_L(0); PG8_BAR; if (full) { PG8_MMA(1, 0, At, B0); PG8_MMA(1, 1, At, B1); } PG8_BAR; PG8_SCHED;
            PG8_LDB(B0, 1, 0); PG8_LDB(B1, 1, 1); PG8_SCHED; PG8_LDA(At, 1, 0); PG8_STAGE(PG8_SA(0, 1), a2 + (last ? ahs_n : ahs), voffA);
            PG8_WAIT_V(8); PG8_WAIT_L(0); PG8_BAR; PG8_MMA(0, 0, At, B0); PG8_MMA(0, 1, At, B1); PG8_BAR; PG8_SCHED;
            PG8_LDA(At, 1, 1); PG8_STAGE(PG8_SB(1, 0), b3, voffB); PG8_STAGE(PG8_SB(1, 1), b3 + hstep, voffB); PG8_STAGE(PG8_SA(1, 0), a3, voffA);
            PG8_WAIT_V(8); PG8_WAIT_L(0); PG8_BAR; if (full) { PG8_MMA(1, 0, At, B0); PG8_MMA(1, 1, At, B1); } PG8_BAR; PG8_SCHED;
        }
        if (wr == 0) PG8_BAR;
        const int role = cur.code & 3, slot = cur.code >> 2;
        if (role == 2) {
            f32x4* sp = (f32x4*)(S.wsb + WS_TS_OFS + (size_t)((S.fofs >> 12) + 1) * 33554432u) + (size_t)slot * (32 * 512) + tid;
#pragma unroll
            for (int a = 0; a < 2; ++a)
#pragma unroll
                for (int b = 0; b < 2; ++b)
#pragma unroll
                    for (int m = 0; m < 4; ++m)
#pragma unroll
                        for (int n = 0; n < 2; ++n) asm volatile("global_store_dwordx4 %0, %1, off sc1" :: "v"(sp + (((a * 2 + b) * 4 + m) * 2 + n) * 512), "v"(acc[a][b][m][n]) : "memory");
            asm volatile("s_waitcnt vmcnt(0)" ::: "memory");
            if (lane == 0) __hip_atomic_store((unsigned*)(S.wsb + WS_FLAGS_OFS) + S.fofs + slot * 8 + wid, 1u, __ATOMIC_RELAXED, __HIP_MEMORY_SCOPE_AGENT);
        } else {
            if (role == 1) {
                unsigned spins = 0;
                while (__hip_atomic_load((unsigned*)(S.wsb + WS_FLAGS_OFS) + S.fofs + slot * 8 + wid, __ATOMIC_RELAXED, __HIP_MEMORY_SCOPE_AGENT) == 0u) { __builtin_amdgcn_s_sleep(2); if (++spins > (1u << 22)) break; }
                __builtin_amdgcn_fence(__ATOMIC_ACQUIRE, "agent");
                asm volatile("s_waitcnt vmcnt(0)" ::: "memory");
                const f32x4* sp = (const f32x4*)(S.wsb + WS_TS_OFS + (size_t)((S.fofs >> 12) + 1) * 33554432u) + (size_t)slot * (32 * 512) + tid;
#pragma unroll
                for (int a = 0; a < 2; ++a)
#pragma unroll
                    for (int b = 0; b < 2; ++b)
#pragma unroll
                        for (int m = 0; m < 4; ++m)
#pragma unroll
                            for (int n = 0; n < 2; ++n) { acc[a][b][m][n] += sp[(((a * 2 + b) * 4 + m) * 2 + n) * 512]; asm volatile("" ::: "memory"); }
            }
            E(acc, cur, wr, wc, fr, fq, role == 3 ? slot * 128 : 0, role == 3 ? 1 : 2);
        }
        if (!has_next) break;
#pragma unroll
        for (int a = 0; a < 2; ++a)
#pragma unroll
            for (int b = 0; b < 2; ++b)
#pragma unroll
                for (int m = 0; m < 4; ++m)
#pragma unroll
                    for (int n = 0; n < 2; ++n) acc[a][b][m][n] = (f32x4){0.f, 0.f, 0.f, 0.f};
        cur = nxt; cA = nA; cB = nB; ahs = ahs_n; ++ui;
        if (wr == 1) PG8_BAR;
    }
    PG8_WAIT_V(0);
    PG8_BAR;
    if constexpr (Epi::AFTER_DRAIN) { E.fused(acc, cur, wr, wc, fr, fq, lds, wid, lane); S.done(cur); }
#undef PG8_SA
#undef PG8_SB
#undef PG8_STAGE
#undef PG8_LDA
#undef PG8_LDB
#undef PG8_MMA
#undef PG8_WAIT_V
#undef PG8_WAIT_L
#undef PG8_BAR
#undef PG8_SCHED
}
}

constexpr int D = 2048, MCTX = 8192, MLAT = 4096, MTOT = 12288, FFN = 8192, ABIN = 4608, NQKV = 6144, MODW = 12288;
constexpr float EPS = 1e-6f;
constexpr size_t WS_MOD = 0;
constexpr size_t WS_BAR = 512u << 10;
constexpr size_t WS_WIN = 1u << 20;
constexpr size_t WS_WO0 = WS_WIN + (size_t)ABIN * D * 2;
constexpr size_t WS_WQKV = WS_WO0 + (size_t)D * D * 2;
constexpr size_t WS_WO1 = WS_WQKV + (size_t)NQKV * D * 2;
constexpr size_t WS_W1 = WS_WO1 + (size_t)D * D * 2;
constexpr size_t WS_W2 = WS_W1 + 2 * (size_t)FFN * D * 2;
constexpr size_t WS_XN = WS_W2 + 2 * (size_t)FFN * D * 2;
constexpr size_t WS_H = WS_XN + (size_t)MTOT * D * 2;
constexpr size_t WS_Z = WS_H;
constexpr size_t WS_AB = WS_H + (size_t)MTOT * NQKV * 2;
constexpr size_t WS_Q0 = WS_H + (size_t)MTOT * FFN * 2;
constexpr size_t WS_K0 = WS_Q0 + (size_t)MTOT * 1024 * 2;
constexpr size_t WS_V0 = WS_K0 + (size_t)(MTOT + 1024) * 256 * 2;
constexpr size_t WS_CNK = WS_V0 + (size_t)(MTOT + 1024) * 256 * 2;
constexpr size_t WS_CNV = WS_CNK + (size_t)1024 * 2048 * 2;
constexpr size_t WS_X = WS_CNV + (size_t)1024 * 2048 * 2;
constexpr size_t WS_TS = WS_X + (size_t)MTOT * D * 4;
constexpr size_t WS_END = WS_TS + 3 * (size_t)128 * 32 * 512 * 16;
constexpr size_t WS_FLAGS = WS_BAR + 16384;
static_assert(WS_TS == WS_TS_OFS && WS_FLAGS == WS_FLAGS_OFS, "early offsets");
constexpr int LDS_BYTES = 131072 + 256;

constexpr size_t OUT_YP = 0, OUT_YS = (size_t)MCTX * D, OUT_AK = OUT_YS + (size_t)MLAT * D, OUT_AV = OUT_AK + (size_t)MCTX * 256,
                 OUT_NK = OUT_AV + (size_t)MCTX * 256, OUT_NV = OUT_NK + (size_t)MCTX * D;

struct Params {
    const float* in[23];
    float* out;
    unsigned char* ws;
    int ph_lo, ph_hi;
};

template <int ACT, bool SIDE> struct EpiBf16 {
    static constexpr bool PERM = true, AFTER_DRAIN = false;
    bf16_t* O; int ldc; float* kout; float* vout; int split_tiles; size_t split_stride;
    __device__ __forceinline__ void operator()(const f32x4 (&acc)[2][2][4][2], const pg8::Unit& u, int wr, int wc, int fr, int fq, int rowofs, int nai) const {
        const int row0 = u.pm * 256 + rowofs + wr * 64 + fr, col0 = u.pn * 256 + wc * 32 + 8 * fq;
        const int spt = split_tiles ? u.pn / split_tiles : 0; bf16_t* Ob = O + (size_t)spt * split_stride; const int ocol0 = col0 - spt * split_tiles * 256;
        const bool side = SIDE && (u.pm < 32) && (u.pn >= 8);
        float* sbase = nullptr; int scol0 = 0;
        if (SIDE) { sbase = (u.pn < 16) ? kout : vout; scol0 = col0 - ((u.pn < 16) ? 2048 : 4096); }
#pragma unroll
        for (int ai = 0; ai < 2; ++ai) if (ai < nai)
#pragma unroll
            for (int m = 0; m < 4; ++m) {
                const int row = row0 + ai * 128 + m * 16;
                bf16_t* rowp = Ob + (size_t)row * ldc + ocol0;
#pragma unroll
                for (int bj = 0; bj < 2; ++bj) {
                    f32x4 v0 = acc[ai][bj][m][0], v1 = acc[ai][bj][m][1];
                    if (SIDE) { if (side) { float* sp = sbase + (size_t)row * 2048 + scol0 + bj * 128; *(f32x4*)sp = v0; *(f32x4*)(sp + 4) = v1; } }
                    if (ACT == 1) {
#pragma unroll
                        for (int j = 0; j < 4; ++j) { float a = fmaxf(v0[j], 0.f), b = fmaxf(v1[j], 0.f); v0[j] = a * a; v1[j] = b * b; }
                    }
                    u32x4 o; o.x = cvt_pk_bf16(v0[0], v0[1]); o.y = cvt_pk_bf16(v0[2], v0[3]); o.z = cvt_pk_bf16(v1[0], v1[1]); o.w = cvt_pk_bf16(v1[2], v1[3]);
                    *(u32x4*)(rowp + bj * 128) = o;
                }
            }
    }
};
struct EpiResid {
    static constexpr bool PERM = true, AFTER_DRAIN = false;
    const float* src_lo; const float* src_hi;
    const bf16_t* xsrc; bf16_t* X; const float* gate;
    __device__ __forceinline__ void operator()(const f32x4 (&acc)[2][2][4][2], const pg8::Unit& u, int wr, int wc, int fr, int fq, int rowofs, int nai) const {
        const int row0 = u.pm * 256 + rowofs + wr * 64 + fr, col0 = u.pn * 256 + wc * 32 + 8 * fq;
        const int cond = (u.pm < 32) ? 0 : 1 + ((u.pm - 32) >> 3);
        const float* gp = gate + (size_t)cond * MODW + col0;
        const float* sb = (u.pm < 32) ? src_lo : src_hi;
        f32x4 gv[2][2];
#pragma unroll
        for (int bj = 0; bj < 2; ++bj)
#pragma unroll
            for (int n = 0; n < 2; ++n) gv[bj][n] = *(const f32x4*)(gp + bj * 128 + n * 4);
#pragma unroll
        for (int ai = 0; ai < 2; ++ai) if (ai < nai)
#pragma unroll
            for (int m = 0; m < 4; ++m) {
                const size_t off = (size_t)(row0 + ai * 128 + m * 16) * D + col0;
#pragma unroll
                for (int bj = 0; bj < 2; ++bj) {
                    f32x4 r0, r1;
                    if (xsrc) { const u32x4 rb = *(const u32x4*)(xsrc + off + bj * 128);
                        r0[0] = bf2f(rb.x & 0xffffu); r0[1] = __uint_as_float(rb.x & 0xffff0000u); r0[2] = bf2f(rb.y & 0xffffu); r0[3] = __uint_as_float(rb.y & 0xffff0000u);
                        r1[0] = bf2f(rb.z & 0xffffu); r1[1] = __uint_as_float(rb.z & 0xffff0000u); r1[2] = bf2f(rb.w & 0xffffu); r1[3] = __uint_as_float(rb.w & 0xffff0000u); }
                    else { r0 = *(const f32x4*)(sb + off + bj * 128); r1 = *(const f32x4*)(sb + off + bj * 128 + 4); }
                    const f32x4 x0 = r0 + gv[bj][0] * acc[ai][bj][m][0], x1 = r1 + gv[bj][1] * acc[ai][bj][m][1];
                    u32x4 o; o.x = cvt_pk_bf16(x0[0], x0[1]); o.y = cvt_pk_bf16(x0[2], x0[3]); o.z = cvt_pk_bf16(x1[0], x1[1]); o.w = cvt_pk_bf16(x1[2], x1[3]);
                    *(u32x4*)(X + off + bj * 128) = o;
                }
            }
    }
};

__device__ __forceinline__ unsigned f2bf(float f) { unsigned u = __float_as_uint(f); return (u + 0x7fffu + ((u >> 16) & 1u)) >> 16; }
__device__ __forceinline__ unsigned pk2(float lo, float hi) { return f2bf(lo) | (f2bf(hi) << 16); }
__device__ __forceinline__ void p0_transpose_item(const float* W, int K, int N, bf16_t* WT, LAS float* scr, int item, int lane) {
    (void)scr;
    const int nblk = N / 32, kblk = item / nblk, nb = item % nblk, kb = lane & 7, ng = lane >> 3;
    const int k0 = 64 * kblk + 8 * kb, n0 = 32 * nb + 4 * ng;
    const float* wp = W + (size_t)k0 * N + n0;
    f32x4 r[8];
#pragma unroll
    for (int i = 0; i < 8; ++i) r[i] = *(const f32x4*)(wp + (size_t)i * N);
#pragma unroll
    for (int i = 0; i < 4; ++i) {
        u32x4 o; o.x = cvt_pk_bf16(r[0][i], r[1][i]); o.y = cvt_pk_bf16(r[2][i], r[3][i]); o.z = cvt_pk_bf16(r[4][i], r[5][i]); o.w = cvt_pk_bf16(r[6][i], r[7][i]);
        *(u32x4*)(WT + (size_t)(n0 + i) * K + k0) = o;
    }
}
__device__ __forceinline__ void cvt_linear(const float* src, bf16_t* dst, int n, int gtid, int gthreads) {
    for (int i = gtid * 4; i < n; i += gthreads * 4) { const f32x4 v = *(const f32x4*)(src + i); u32x2 o; o.x = cvt_pk_bf16(v[0], v[1]); o.y = cvt_pk_bf16(v[2], v[3]); *(u32x2*)(dst + i) = o; }
}
__device__ __forceinline__ void p0_prologue(const Params& p, LAS unsigned char* lds) {
    int tid_ = threadIdx.x; asm volatile("" : "+v"(tid_));
    const int tid = tid_, lane = tid & 63, wave = __builtin_amdgcn_readfirstlane(tid >> 6), G = gridDim.x;
    unsigned char* ws = p.ws;
    {
        LAS float* sc = (LAS float*)(lds + 69632);
        LAS float* red = (LAS float*)(lds + 69632 + 24576);
        const float* cvec = p.in[6]; const float* cctx = p.in[7];
        for (int i = tid; i < 3 * 2048; i += 512) { const int c = i >> 11, k = i & 2047; const float x = (c == 0) ? cctx[k] : cvec[(c - 1) * 2048 + k]; sc[i] = x / (1.f + __expf(-x)); }
        __syncthreads();
        float* MOD = (float*)(ws + WS_MOD);
        for (int item = blockIdx.x; item < 256; item += G) {
            const int l = item >> 7, cgp = item & 127, ln = lane < 48 ? lane : 47;
            const float* W = p.in[8] + (size_t)l * 2048 * MODW + cgp * 96 + ln * 2;
            float a00 = 0.f, a01 = 0.f, a10 = 0.f, a11 = 0.f, a20 = 0.f, a21 = 0.f;
            const int kb = wave * 256;
#pragma unroll 8
            for (int k = 0; k < 256; ++k) {
                const f32x2 w = *(const f32x2*)(W + (size_t)(kb + k) * MODW);
                const float s0 = sc[kb + k], s1 = sc[2048 + kb + k], s2 = sc[4096 + kb + k];
                a00 += s0 * w.x; a01 += s0 * w.y; a10 += s1 * w.x; a11 += s1 * w.y; a20 += s2 * w.x; a21 += s2 * w.y;
            }
            if (lane < 48) { LAS float* r = red + wave * 288 + lane * 2; r[0] = a00; r[1] = a01; r[96] = a10; r[97] = a11; r[192] = a20; r[193] = a21; }
            __syncthreads();
            if (tid < 288) { const int c = tid / 96, j = tid % 96; float s = 0.f;
#pragma unroll
                for (int w = 0; w < 8; ++w) s += red[w * 288 + tid];
                MOD[(size_t)(l * 3 + c) * MODW + cgp * 96 + j] = s + p.in[9][l * MODW + cgp * 96 + j]; }
            __syncthreads();
        }
    }
    {
        LAS float* scr = (LAS float*)(lds + wave * 8448);
        const int gw = blockIdx.x * 8 + wave, NGW = G * 8;
        constexpr int I_IN = 32 * (ABIN / 32), I_O = 32 * (D / 32), I_QKV = 32 * (NQKV / 32), I_1 = 32 * (FFN / 32), I_2 = (FFN / 64) * (D / 32);
        constexpr int NITEMS = I_IN + 2 * I_O + I_QKV + 2 * I_1 + 2 * I_2;
        for (int it = gw; it < NITEMS; it += NGW) {
            int r = it;
            if (r < I_IN) { p0_transpose_item(p.in[12], D, ABIN, (bf16_t*)(ws + WS_WIN), scr, r, lane); continue; } r -= I_IN;
            if (r < I_O) { p0_transpose_item(p.in[16], D, D, (bf16_t*)(ws + WS_WO0), scr, r, lane); continue; } r -= I_O;
            if (r < I_QKV) { p0_transpose_item(p.in[17], D, NQKV, (bf16_t*)(ws + WS_WQKV), scr, r, lane); continue; } r -= I_QKV;
            if (r < I_O) { p0_transpose_item(p.in[19], D, D, (bf16_t*)(ws + WS_WO1), scr, r, lane); continue; } r -= I_O;
            if (r < 2 * I_1) { const int l = r / I_1; p0_transpose_item(p.in[20] + (size_t)l * D * FFN, D, FFN, (bf16_t*)(ws + WS_W1) + (size_t)l * FFN * D, scr, r - l * I_1, lane); continue; } r -= 2 * I_1;
            { const int l = r / I_2; p0_transpose_item(p.in[21] + (size_t)l * D * FFN, FFN, D, (bf16_t*)(ws + WS_W2) + (size_t)l * FFN * D, scr, r - l * I_2, lane); }
        }
    }
    {
        const int gtid = blockIdx.x * 512 + tid, gth = G * 512;
        cvt_linear(p.in[2], (bf16_t*)(ws + WS_K0) + (size_t)MTOT * 256, 1024 * 256, gtid, gth);
        cvt_linear(p.in[3], (bf16_t*)(ws + WS_V0) + (size_t)MTOT * 256, 1024 * 256, gtid, gth);
        cvt_linear(p.in[4], (bf16_t*)(ws + WS_CNK), 1024 * 2048, gtid, gth);
        cvt_linear(p.in[5], (bf16_t*)(ws + WS_CNV), 1024 * 2048, gtid, gth);
    }
}

template <bool OUT_F32>
__device__ __forceinline__ void norm_phase(const float* src_lo, const float* src_hi, const bf16_t* xb, const float* gain, const float* mod, int shift_off, int scale_off, bf16_t* dst_bf, float* dst_f) {
    int tid_ = threadIdx.x; asm volatile("" : "+v"(tid_));
    const int tid = tid_, lane = tid & 63, wave = tid >> 6, G = gridDim.x;
    const int gw = blockIdx.x * 8 + wave, NGW = G * 8, per = (MTOT + NGW - 1) / NGW;
    const int r_beg = gw * per, r_end = (r_beg + per < MTOT) ? r_beg + per : MTOT;
    int cur = -1; f32x4 A[8], B[8];
    for (int row = r_beg; row < r_end; ++row) {
        const int cond = (row < MCTX) ? 0 : 1 + ((row - MCTX) >> 11);
        if (cond != cur) {
            cur = cond;
#pragma unroll
            for (int j = 0; j < 8; ++j) {
                const int col = 4 * lane + 256 * j; const f32x4 g = *(const f32x4*)(gain + col);
                if (mod) { const f32x4 sc = *(const f32x4*)(mod + (size_t)cond * MODW + scale_off + col); A[j] = g * (sc + 1.f); B[j] = *(const f32x4*)(mod + (size_t)cond * MODW + shift_off + col); }
                else { A[j] = g; B[j] = (f32x4){0.f, 0.f, 0.f, 0.f}; }
            }
        }
        f32x4 v[8]; float s = 0.f;
        if (xb) {
            const bf16_t* xr = xb + (size_t)row * D + 4 * lane;
#pragma unroll
            for (int j = 0; j < 8; ++j) { const u32x2 rb = *(const u32x2*)(xr + 256 * j); v[j][0] = bf2f(rb.x & 0xffffu); v[j][1] = __uint_as_float(rb.x & 0xffff0000u); v[j][2] = bf2f(rb.y & 0xffffu); v[j][3] = __uint_as_float(rb.y & 0xffff0000u); }
        } else {
            const float* xr = ((row < MCTX) ? src_lo : src_hi) + (size_t)row * D + 4 * lane;
#pragma unroll
            for (int j = 0; j < 8; ++j) v[j] = *(const f32x4*)(xr + 256 * j);
        }
#pragma unroll
        for (int j = 0; j < 8; ++j) s += (v[j].x * v[j].x + v[j].y * v[j].y) + (v[j].z * v[j].z + v[j].w * v[j].w);
        const float rstd = rsqrtf(wave_sum(s) * (1.f / D) + EPS);
#pragma unroll
        for (int j = 0; j < 8; ++j) {
            const f32x4 y = v[j] * rstd * A[j] + B[j];
            if (OUT_F32) *(f32x4*)(dst_f + (size_t)row * D + 4 * lane + 256 * j) = y;
            else { u32x2 o; o.x = cvt_pk_bf16(y[0], y[1]); o.y = cvt_pk_bf16(y[2], y[3]); *(u32x2*)(dst_bf + (size_t)row * D + 4 * lane + 256 * j) = o; }
        }
    }
}

__device__ __forceinline__ void unpack8(const u32x4 r, float (&f)[8]) {
    f[0] = bf2f(r.x & 0xffffu); f[1] = __uint_as_float(r.x & 0xffff0000u); f[2] = bf2f(r.y & 0xffffu); f[3] = __uint_as_float(r.y & 0xffff0000u);
    f[4] = bf2f(r.z & 0xffffu); f[5] = __uint_as_float(r.z & 0xffff0000u); f[6] = bf2f(r.w & 0xffffu); f[7] = __uint_as_float(r.w & 0xffff0000u);
}
__device__ __forceinline__ void ew0_phase(const Params& p) {
    int tid_ = threadIdx.x; asm volatile("" : "+v"(tid_));
    const int tid = tid_, lane = tid & 63, wave = tid >> 6, G = gridDim.x;
    const int gw = blockIdx.x * 8 + wave, NGW = G * 8;
    unsigned char* ws = p.ws;
    const bf16_t* Z = (const bf16_t*)(ws + WS_Z);
    bf16_t* AB = (bf16_t*)(ws + WS_AB); bf16_t* Q0 = (bf16_t*)(ws + WS_Q0); bf16_t* K0 = (bf16_t*)(ws + WS_K0); bf16_t* V0 = (bf16_t*)(ws + WS_V0);
    const float* convw = p.in[13]; const float* qn = p.in[14]; const float* kn = p.in[15];
    const int ri = lane & 31, chunk = lane >> 5, da = chunk * 64 + ri, db = da + 32;
    const float inv = __builtin_amdgcn_exp2f(-(float)ri * (13.287712379549449f / 32.f));
    const float qwa = qn[da], qwb = qn[db], kwa = kn[da], kwb = kn[db];
    for (int tok = gw; tok < MTOT; tok += NGW) {
        const bool lat = tok >= MCTX;
        const int t = lat ? ((tok - MCTX) & 2047) : (tok & 255), slen = lat ? 2048 : 256;
        const bf16_t* zr = Z + (size_t)tok * ABIN;
#pragma unroll
        for (int j = 0; j < 2; ++j) {
            const int ch = j * 512 + lane * 8;
            float gb[8], acc[8];
            unpack8(*(const u32x4*)(zr + ch), gb);
#pragma unroll
            for (int e = 0; e < 8; ++e) acc[e] = 0.f;
#pragma unroll
            for (int dt = -1; dt <= 1; ++dt) {
                if (t + dt >= 0 && t + dt < slen) {
                    float gc[8], xa[8];
                    unpack8(*(const u32x4*)(zr + dt * ABIN + 1024 + ch), gc);
                    unpack8(*(const u32x4*)(zr + dt * ABIN + 2048 + ch), xa);
                    const f32x4 w0 = *(const f32x4*)(convw + (dt + 1) * 1024 + ch), w1 = *(const f32x4*)(convw + (dt + 1) * 1024 + ch + 4);
#pragma unroll
                    for (int e = 0; e < 4; ++e) { acc[e] += w0[e] * (gc[e] * xa[e]); acc[4 + e] += w1[e] * (gc[4 + e] * xa[4 + e]); }
                }
            }
            u32x4 o; o.x = cvt_pk_bf16(gb[0] * acc[0], gb[1] * acc[1]); o.y = cvt_pk_bf16(gb[2] * acc[2], gb[3] * acc[3]);
            o.z = cvt_pk_bf16(gb[4] * acc[4], gb[5] * acc[5]); o.w = cvt_pk_bf16(gb[6] * acc[6], gb[7] * acc[7]);
            *(u32x4*)(AB + (size_t)tok * D + ch) = o;
        }
        float cs = 1.f, sn = 0.f;
        if (lat) { const float pos = (float)(chunk == 0 ? (t >> 6) : (t & 63)); const float ang = pos * inv; cs = __cosf(ang); sn = __sinf(ang); }
#pragma unroll
        for (int hh = 0; hh < 10; ++hh) {
            const bf16_t* hp = zr + 3072 + hh * 128;
            const float va = bf2f(hp[da]), vb = bf2f(hp[db]);
            const float rstd = rsqrtf(wave_sum(va * va + vb * vb) * (1.f / 128.f) + EPS);
            const float na = va * rstd * (hh < 8 ? qwa : kwa), nb = vb * rstd * (hh < 8 ? qwb : kwb);
            const float ra = na * cs - nb * sn, rb = na * sn + nb * cs;
            if (hh < 8) { bf16_t* q = Q0 + (size_t)tok * 1024 + hh * 128; q[da] = (bf16_t)f2bf(ra); q[db] = (bf16_t)f2bf(rb); }
            else {
                const int kvh = hh - 8;
                bf16_t* k = K0 + (size_t)tok * 256 + kvh * 128; k[da] = (bf16_t)f2bf(ra); k[db] = (bf16_t)f2bf(rb);
                if (!lat) { float* ok = p.out + OUT_AK + (size_t)tok * 256 + kvh * 128; ok[da] = na; ok[db] = nb; }
            }
        }
        {
            const u32x2 r = *(const u32x2*)(zr + 4352 + lane * 4);
            *(u32x2*)(V0 + (size_t)tok * 256 + lane * 4) = r;
            if (!lat) { f32x4 o; o[0] = bf2f(r.x & 0xffffu); o[1] = __uint_as_float(r.x & 0xffff0000u); o[2] = bf2f(r.y & 0xffffu); o[3] = __uint_as_float(r.y & 0xffff0000u);
                *(f32x4*)(p.out + OUT_AV + (size_t)tok * 256 + lane * 4) = o; }
        }
    }
}

constexpr int KSTR = 272, VSTR = 288, LDS_KT = 0, LDS_VT = 2 * 64 * KSTR, LDS_BIAS = LDS_VT + 2 * 64 * VSTR;
constexpr float SCL2 = 0.08838834764831845f * 1.4426950408889634f, LOG2E = 1.4426950408889634f;
struct AttnArgs {
    const bf16_t* q; int qstride; int qrow0;
    bf16_t* o; int ostride;
    const bf16_t* kA; const bf16_t* vA; int strideA, ntA;
    const bf16_t* kB; const bf16_t* vB; int strideB, ntB;
    float* kout; float* vout;
    int t0, t1, role; f32x4* xs; unsigned* xf;
    int r0, krlo; const float* bias;
};
__device__ __forceinline__ v4i16_t vtr(const LAS unsigned char* p) { return __builtin_amdgcn_ds_read_tr16_b64_v4i16((LAS v4i16_t*)p); }

__device__ __forceinline__ void store8_f32(float* dst, const u32x4 r) {
    f32x4 a, b; a[0] = bf2f(r.x & 0xffffu); a[1] = __uint_as_float(r.x & 0xffff0000u); a[2] = bf2f(r.y & 0xffffu); a[3] = __uint_as_float(r.y & 0xffff0000u);
    b[0] = bf2f(r.z & 0xffffu); b[1] = __uint_as_float(r.z & 0xffff0000u); b[2] = bf2f(r.w & 0xffffu); b[3] = __uint_as_float(r.w & 0xffff0000u);
    *(f32x4*)dst = a; *(f32x4*)(dst + 4) = b;
}
template <int NA>
__device__ __forceinline__ void attn_run(LAS unsigned char* lds, const AttnArgs& a) {
    int tid_ = threadIdx.x; asm volatile("" : "+v"(tid_));
    const int tid = tid_, lane = tid & 63, wave = __builtin_amdgcn_readfirstlane(tid >> 6), fr = lane & 15, fq = lane >> 4;
    bf16x8 Qf[2][4];
#pragma unroll
    for (int qb = 0; qb < 2; ++qb)
#pragma unroll
        for (int dc = 0; dc < 4; ++dc) Qf[qb][dc] = *(const bf16x8*)(a.q + (size_t)(a.qrow0 + wave * 32 + qb * 16 + fr) * a.qstride + dc * 32 + fq * 8);
    f32x4 O[2][8];
#pragma unroll
    for (int qb = 0; qb < 2; ++qb)
#pragma unroll
        for (int db = 0; db < 8; ++db) O[qb][db] = (f32x4){0.f, 0.f, 0.f, 0.f};
    float mrun[2] = {-1e30f, -1e30f}, lrun[2] = {0.f, 0.f};
    LAS float* biasL = (LAS float*)(lds + LDS_BIAS);
    if (NA) { for (int i = tid; i < 465; i += 512) biasL[i] = a.bias[i]; }
    const int lrow = tid >> 3, lch = tid & 7;
    u32x4 kr0, kr1, vr0, vr1;
#define ATT_GLOAD(t) do { const bool inA = (t) < a.ntA; const int tt = inA ? (t) : (t) - a.ntA; const int st = inA ? a.strideA : a.strideB; \
        const bf16_t* kp = (inA ? a.kA : a.kB) + (size_t)(tt * 64 + lrow) * st + lch * 8; const bf16_t* vp = (inA ? a.vA : a.vB) + (size_t)(tt * 64 + lrow) * st + lch * 8; \
        kr0 = *(const u32x4*)kp; kr1 = *(const u32x4*)(kp + 64); vr0 = *(const u32x4*)vp; vr1 = *(const u32x4*)(vp + 64); } while (0)
#define ATT_LWRITE(b, tt_) do { LAS unsigned char* kd = lds + LDS_KT + (b) * 64 * KSTR + lrow * KSTR + lch * 16; LAS unsigned char* vd = lds + LDS_VT + (b) * 64 * VSTR + lrow * VSTR + lch * 16; \
        *(LAS u32x4*)kd = kr0; *(LAS u32x4*)(kd + 128) = kr1; *(LAS u32x4*)vd = vr0; *(LAS u32x4*)(vd + 128) = vr1; \
        if (a.kout) { float* ko = a.kout + (size_t)((tt_) * 64 + lrow) * 2048 + lch * 8; float* vo = a.vout + (size_t)((tt_) * 64 + lrow) * 2048 + lch * 8; \
            store8_f32(ko, kr0); store8_f32(ko + 64, kr1); store8_f32(vo, vr0); store8_f32(vo + 64, vr1); } } while (0)
    ATT_GLOAD(a.t0); ATT_LWRITE(a.t0 & 1, a.t0); __syncthreads();
    const int rw = NA ? a.r0 + (wave >> 1) : 0;
    const int kr_lo_w = NA ? (rw - 4 < 0 ? 0 : (rw - 4 > 24 ? 24 : rw - 4)) : 0;
    for (int t = a.t0; t < a.t1; ++t) {
        if (t + 1 < a.t1) ATT_GLOAD(t + 1);
        bool active = true; int kr = 0; const bool local = NA && t >= a.ntA;
        if (local) { kr = a.krlo + (t - a.ntA); active = (kr >= kr_lo_w) && (kr < kr_lo_w + 8); }
        if (active) {
            const LAS unsigned char* Kt = lds + LDS_KT + (t & 1) * 64 * KSTR;
            const LAS unsigned char* Vt = lds + LDS_VT + (t & 1) * 64 * VSTR;
            f32x4 S[2][4];
#pragma unroll
            for (int qb = 0; qb < 2; ++qb)
#pragma unroll
                for (int kb = 0; kb < 4; ++kb) S[qb][kb] = (f32x4){0.f, 0.f, 0.f, 0.f};
#pragma unroll
            for (int kb = 0; kb < 4; ++kb)
#pragma unroll
                for (int dc = 0; dc < 4; ++dc) {
                    const bf16x8 kf = *(const LAS bf16x8*)(Kt + (kb * 16 + fr) * KSTR + dc * 64 + fq * 16);
                    S[0][kb] = __builtin_amdgcn_mfma_f32_16x16x32_bf16(kf, Qf[0][dc], S[0][kb], 0, 0, 0);
                    S[1][kb] = __builtin_amdgcn_mfma_f32_16x16x32_bf16(kf, Qf[1][dc], S[1][kb], 0, 0, 0);
                }
            bf16x8 Pf[2][2];
#pragma unroll
            for (int qb = 0; qb < 2; ++qb) {
                if (local) {
                    const int c = (wave & 1) * 32 + qb * 16 + fr;
                    const int kc0 = c - 8 < 0 ? 0 : (c - 8 > 48 ? 48 : c - 8);
                    const LAS float* brow = biasL + (kr - rw + 7) * 31 + 15 - c;
#pragma unroll
                    for (int kb = 0; kb < 4; ++kb)
#pragma unroll
                        for (int j = 0; j < 4; ++j) { const int kc = kb * 16 + 4 * fq + j; const bool ok = (kc >= kc0) && (kc < kc0 + 16);
                            const float bv = brow[ok ? kc : c];
                            S[qb][kb][j] = ok ? (S[qb][kb][j] * SCL2 + bv * LOG2E) : -1e30f; }
                } else {
#pragma unroll
                    for (int kb = 0; kb < 4; ++kb) S[qb][kb] = S[qb][kb] * SCL2;
                }
                float mx = -1e30f;
#pragma unroll
                for (int kb = 0; kb < 4; ++kb) mx = fmaxf(mx, fmaxf(fmaxf(S[qb][kb][0], S[qb][kb][1]), fmaxf(S[qb][kb][2], S[qb][kb][3])));
                mx = fmaxf(mx, __shfl_xor(mx, 16)); mx = fmaxf(mx, __shfl_xor(mx, 32));
                const float mn = fmaxf(mrun[qb], mx), alpha = __builtin_amdgcn_exp2f(mrun[qb] - mn);
                mrun[qb] = mn;
                float rs = 0.f;
#pragma unroll
                for (int kb = 0; kb < 4; ++kb)
#pragma unroll
                    for (int j = 0; j < 4; ++j) { const float pv = __builtin_amdgcn_exp2f(S[qb][kb][j] - mn); S[qb][kb][j] = pv; rs += pv; }
                lrun[qb] = lrun[qb] * alpha + rs;
#pragma unroll
                for (int db = 0; db < 8; ++db) O[qb][db] = O[qb][db] * alpha;
#pragma unroll
                for (int c2 = 0; c2 < 2; ++c2) {
                    u32x4 pk; pk.x = cvt_pk_bf16(S[qb][2 * c2][0], S[qb][2 * c2][1]); pk.y = cvt_pk_bf16(S[qb][2 * c2][2], S[qb][2 * c2][3]);
                    pk.z = cvt_pk_bf16(S[qb][2 * c2 + 1][0], S[qb][2 * c2 + 1][1]); pk.w = cvt_pk_bf16(S[qb][2 * c2 + 1][2], S[qb][2 * c2 + 1][3]);
                    Pf[qb][c2] = __builtin_bit_cast(bf16x8, pk);
                }
            }
            const LAS unsigned char* vb = Vt + (4 * fq + (fr >> 2)) * VSTR + (fr & 3) * 8;
#pragma unroll
            for (int c2 = 0; c2 < 2; ++c2)
#pragma unroll
                for (int db = 0; db < 8; ++db) {
                    const v4i16_t lo = vtr(vb + (c2 * 32) * VSTR + db * 32), hi = vtr(vb + (c2 * 32 + 16) * VSTR + db * 32);
                    bf16x8 vf; vf[0] = lo[0]; vf[1] = lo[1]; vf[2] = lo[2]; vf[3] = lo[3]; vf[4] = hi[0]; vf[5] = hi[1]; vf[6] = hi[2]; vf[7] = hi[3];
                    O[0][db] = __builtin_amdgcn_mfma_f32_16x16x32_bf16(vf, Pf[0][c2], O[0][db], 0, 0, 0);
                    O[1][db] = __builtin_amdgcn_mfma_f32_16x16x32_bf16(vf, Pf[1][c2], O[1][db], 0, 0, 0);
                }
        }
        if (t + 1 < a.t1) ATT_LWRITE((t + 1) & 1, t + 1);
        __syncthreads();
    }
#undef ATT_GLOAD
#undef ATT_LWRITE
    if (a.role == 2) {
        f32x4* sp = a.xs + tid;
#pragma unroll
        for (int qb = 0; qb < 2; ++qb)
#pragma unroll
            for (int db = 0; db < 8; ++db) asm volatile("global_store_dwordx4 %0, %1, off sc1" :: "v"(sp + (qb * 8 + db) * 512), "v"(O[qb][db]) : "memory");
        const f32x4 ml = {mrun[0], mrun[1], lrun[0], lrun[1]};
        asm volatile("global_store_dwordx4 %0, %1, off sc1" :: "v"(sp + 16 * 512), "v"(ml) : "memory");
        asm volatile("s_waitcnt vmcnt(0)" ::: "memory");
        if (lane == 0) __hip_atomic_store(a.xf + wave, 1u, __ATOMIC_RELAXED, __HIP_MEMORY_SCOPE_AGENT);
        return;
    }
    if (a.role == 1) {
        unsigned spins = 0;
        while (__hip_atomic_load(a.xf + wave, __ATOMIC_RELAXED, __HIP_MEMORY_SCOPE_AGENT) == 0u) { __builtin_amdgcn_s_sleep(2); if (++spins > (1u << 22)) break; }
        __builtin_amdgcn_fence(__ATOMIC_ACQUIRE, "agent");
        asm volatile("s_waitcnt vmcnt(0)" ::: "memory");
        const f32x4* sp = a.xs + tid;
        const f32x4 ml = sp[16 * 512];
        float fa[2], fb[2];
#pragma unroll
        for (int qb = 0; qb < 2; ++qb) { const float mo = ml[qb], mn = fmaxf(mrun[qb], mo); fa[qb] = __builtin_amdgcn_exp2f(mrun[qb] - mn); fb[qb] = __builtin_amdgcn_exp2f(mo - mn); lrun[qb] = lrun[qb] * fa[qb] + ml[2 + qb] * fb[qb]; }
#pragma unroll
        for (int qb = 0; qb < 2; ++qb)
#pragma unroll
            for (int db = 0; db < 8; ++db) { const f32x4 o2 = sp[(qb * 8 + db) * 512]; O[qb][db] = O[qb][db] * fa[qb] + o2 * fb[qb]; asm volatile("" ::: "memory"); }
    }
#pragma unroll
    for (int qb = 0; qb < 2; ++qb) {
        float lt = lrun[qb]; lt += __shfl_xor(lt, 16); lt += __shfl_xor(lt, 32);
        const float il = 1.f / lt;
        bf16_t* op = a.o + (size_t)(a.qrow0 + wave * 32 + qb * 16 + fr) * a.ostride + 4 * fq;
#pragma unroll
        for (int db = 0; db < 8; ++db) { const f32x4 v = O[qb][db] * il; u32x2 o; o.x = cvt_pk_bf16(v[0], v[1]); o.y = cvt_pk_bf16(v[2], v[3]); *(u32x2*)(op + db * 16) = o; }
    }
}

__device__ __forceinline__ void attn0_phase(const Params& p, LAS unsigned char* lds) {
    unsigned char* ws = p.ws; const int G = gridDim.x;
    const bf16_t* Q0 = (const bf16_t*)(ws + WS_Q0); const bf16_t* K0 = (const bf16_t*)(ws + WS_K0); const bf16_t* V0 = (const bf16_t*)(ws + WS_V0);
    bf16_t* AB = (bf16_t*)(ws + WS_AB);
    const bool split = (G == 256);
    for (int i = blockIdx.x; i < 512; i += G) {
        AttnArgs a;
        if (i < 256) { const int it = i & 127; const int b = it >> 6, h = (it >> 3) & 7, qblk = it & 7, kvh = h >> 2;
            if (!split && i >= 128) continue;
            a.q = Q0 + h * 128; a.qstride = 1024; a.qrow0 = MCTX + b * 2048 + qblk * 256; a.o = AB + 1024 + h * 128; a.ostride = D;
            a.kA = K0 + (size_t)(MTOT + b * 512) * 256 + kvh * 128; a.vA = V0 + (size_t)(MTOT + b * 512) * 256 + kvh * 128; a.strideA = 256; a.ntA = 8;
            a.kB = K0 + (size_t)(MCTX + b * 2048) * 256 + kvh * 128; a.vB = V0 + (size_t)(MCTX + b * 2048) * 256 + kvh * 128; a.strideB = 256; a.ntB = 32;
            a.t0 = (split && i >= 128) ? 20 : 0; a.t1 = (split && i < 128) ? 20 : 40; a.role = split ? (i < 128 ? 1 : 2) : 0;
            a.xs = (f32x4*)(ws + WS_TS) + (size_t)it * (17 * 512); a.xf = (unsigned*)(ws + WS_FLAGS) + 8 * 1024 + it * 8; a.kout = nullptr; a.vout = nullptr;
        } else { const int j = i - 256, b = j >> 3, h = j & 7, kvh = h >> 2;
            a.q = Q0 + h * 128; a.qstride = 1024; a.qrow0 = b * 256; a.o = AB + 1024 + h * 128; a.ostride = D;
            a.kA = K0 + (size_t)(b * 256) * 256 + kvh * 128; a.vA = V0 + (size_t)(b * 256) * 256 + kvh * 128; a.strideA = 256; a.ntA = 4;
            a.kB = a.kA; a.vB = a.vA; a.strideB = 256; a.ntB = 0;
            a.t0 = 0; a.t1 = 4; a.role = 0; a.xs = nullptr; a.xf = nullptr; a.kout = nullptr; a.vout = nullptr;
        }
        a.r0 = 0; a.krlo = 0; a.bias = nullptr;
        attn_run<0>(lds, a);
    }
}
__device__ __forceinline__ void attn1_phase(const Params& p, LAS unsigned char* lds, bf16_t* AO) {
    unsigned char* ws = p.ws; const int G = gridDim.x;
    const bf16_t* Q1 = (const bf16_t*)(ws + WS_Z); const bf16_t* K1 = Q1 + (size_t)MTOT * D; const bf16_t* V1 = K1 + (size_t)MTOT * D;
    const bf16_t* CNK = (const bf16_t*)(ws + WS_CNK); const bf16_t* CNV = (const bf16_t*)(ws + WS_CNV);
    for (int i = blockIdx.x; i < 256; i += G) {
        AttnArgs a;
        const int b = i >> 7, h = (i >> 3) & 15, rg = i & 7, r0 = rg * 4;
        const int lo = r0 - 4 < 0 ? 0 : (r0 - 4 > 24 ? 24 : r0 - 4), hi0 = r0 - 1 < 0 ? 0 : (r0 - 1 > 24 ? 24 : r0 - 1), hi = hi0 + 7;
        a.q = Q1 + h * 128; a.qstride = D; a.qrow0 = MCTX + b * 2048 + r0 * 64; a.o = AO + h * 128; a.ostride = D;
        a.kA = CNK + (size_t)(b * 512) * 2048 + h * 128; a.vA = CNV + (size_t)(b * 512) * 2048 + h * 128; a.strideA = 2048; a.ntA = 8;
        a.kB = K1 + (size_t)(MCTX + b * 2048 + lo * 64) * D + h * 128; a.vB = V1 + (size_t)(MCTX + b * 2048 + lo * 64) * D + h * 128; a.strideB = D; a.ntB = hi - lo + 1;
        a.r0 = r0; a.krlo = lo; a.bias = p.in[18] + h * 465; a.t0 = 0; a.t1 = a.ntA + a.ntB; a.role = 0; a.xs = nullptr; a.xf = nullptr; a.kout = nullptr; a.vout = nullptr;
        attn_run<1>(lds, a);
    }
    for (int j = blockIdx.x; j < 512; j += G) {
        AttnArgs a;
        const int b = j >> 4, h = j & 15;
        a.q = Q1 + h * 128; a.qstride = D; a.qrow0 = b * 256; a.o = AO + h * 128; a.ostride = D;
        a.kA = K1 + (size_t)(b * 256) * D + h * 128; a.vA = V1 + (size_t)(b * 256) * D + h * 128; a.strideA = D; a.ntA = 4;
        a.kB = a.kA; a.vB = a.vA; a.strideB = D; a.ntB = 0;
        a.r0 = 0; a.krlo = 0; a.bias = nullptr; a.t0 = 0; a.t1 = 4; a.role = 0; a.xs = nullptr; a.xf = nullptr;
        a.kout = p.out + OUT_NK + (size_t)(b * 256) * 2048 + h * 128; a.vout = p.out + OUT_NV + (size_t)(b * 256) * 2048 + h * 128;
        attn_run<0>(lds, a);
    }
}

#define XB_TMO      128
#define XB_XCNT(j)  (256  + 64 * (j))
#define XB_XSUB(j)  (1280 + 64 * (j))
#define XB_XGEN(j)  (2304 + 64 * (j))
#define XB_TOP      3328
#define XB_TOPGEN   3392
#define XCD_BAR_WORDS 3456
#define XB_SPIN_CAP (1u << 18)

__device__ __forceinline__ unsigned xb_ld(unsigned* p)              { return __hip_atomic_load(p, __ATOMIC_RELAXED, __HIP_MEMORY_SCOPE_AGENT); }
__device__ __forceinline__ unsigned xb_add(unsigned* p, unsigned v) { return __hip_atomic_fetch_add(p, v, __ATOMIC_RELAXED, __HIP_MEMORY_SCOPE_AGENT); }
__device__ __forceinline__ unsigned xb_xcc_id() { return (unsigned)__builtin_amdgcn_s_getreg((3 << 11) | 20) & 0xFu; }
#define XB_SPIN(cond, bar) do { unsigned _sp = 0; while (cond) { __builtin_amdgcn_s_sleep(1); \
    if ((++_sp & 255u) == 0u) { if (xb_ld(&(bar)[XB_TMO])) break; if (_sp > XB_SPIN_CAP) { atomicAdd(&(bar)[XB_TMO], 1u); break; } } } } while (0)

struct XcdBarrier {
    unsigned* bar; unsigned x;
    volatile LAS unsigned* st;
};

__device__ __forceinline__ XcdBarrier xcd_barrier_post(unsigned* bar, volatile LAS unsigned* st) {
    XcdBarrier b; b.bar = bar; b.x = xb_xcc_id(); b.st = st;
    if (threadIdx.x == 0) (void)xb_add(&bar[XB_XCNT(b.x)], 1u);
    return b;
}
__device__ __forceinline__ void xcd_barrier_complete(unsigned* bar, unsigned x, unsigned& nloc, unsigned& nx) {
    const unsigned G = gridDim.x * gridDim.y * gridDim.z;
    unsigned sum, cnt, mine, sp = 0u;
    for (;;) {
        sum = 0u; cnt = 0u; mine = 0u;
#pragma unroll
        for (unsigned j = 0; j < 16; ++j) { const unsigned c = xb_ld(&bar[XB_XCNT(j)]); sum += c; cnt += (c > 0u) ? 1u : 0u; mine = (j == x) ? c : mine; }
        if (sum == G) break;
        __builtin_amdgcn_s_sleep(1);
        if ((++sp & 255u) == 0u) { if (xb_ld(&bar[XB_TMO])) break; if (sp > XB_SPIN_CAP) { atomicAdd(&bar[XB_TMO], 1u); break; } }
    }
    nloc = mine > 0u ? mine : 1u; nx = cnt > 0u ? cnt : 1u;
}

__device__ __forceinline__ void xcd_barrier(const XcdBarrier& b) {
    asm volatile("s_waitcnt vmcnt(0)" ::: "memory");
    __syncthreads();
    if (threadIdx.x == 0) {
        unsigned* bar = b.bar;
        __builtin_amdgcn_s_waitcnt(0);
        unsigned nloc = b.st[0], nx = b.st[1];
        if (nloc == 0u) { xcd_barrier_complete(bar, b.x, nloc, nx); b.st[0] = nloc; b.st[1] = nx; }
        const unsigned old = xb_add(&bar[XB_XSUB(b.x)], 1u);
        const unsigned gen = old / nloc;
        if (old + 1u == (gen + 1u) * nloc) {
            __builtin_amdgcn_fence(__ATOMIC_RELEASE, "agent");
            asm volatile("s_waitcnt vmcnt(0)" ::: "memory");
            const unsigned og = xb_add(&bar[XB_TOP], 1u);
            const unsigned tg = og / nx;
            if (og + 1u == (tg + 1u) * nx) xb_add(&bar[XB_TOPGEN], 1u);
            else XB_SPIN(xb_ld(&bar[XB_TOPGEN]) == tg, bar);
            __builtin_amdgcn_fence(__ATOMIC_ACQUIRE, "agent");
            xb_add(&bar[XB_XGEN(b.x)], 1u);
            asm volatile("s_waitcnt vmcnt(0)" ::: "memory");
        } else {
            XB_SPIN(xb_ld(&bar[XB_XGEN(b.x)]) == gen, bar);
            __builtin_amdgcn_fence(__ATOMIC_ACQUIRE, "agent");
            asm volatile("s_waitcnt vmcnt(0)" ::: "memory");
        }
    }
    __syncthreads();
}


constexpr int NPHASE = 18;
__global__ void __launch_bounds__(512, 2) mega_fwd(Params p) {
    extern __shared__ __attribute__((aligned(16))) unsigned char lds_raw[];
    LAS unsigned char* lds = (LAS unsigned char*)lds_raw;
    cg::grid_group grid = cg::this_grid();
    if (threadIdx.x < 64) ((LAS unsigned*)(lds + 131072))[threadIdx.x] = 0u;
    __syncthreads();
    XcdBarrier xbar = xcd_barrier_post((unsigned*)(p.ws + WS_BAR), (volatile LAS unsigned*)(lds + 131072));
    unsigned char* ws = p.ws;
    const int G = gridDim.x;
    float* MOD = (float*)(ws + WS_MOD);
    bf16_t* XN = (bf16_t*)(ws + WS_XN); bf16_t* X = (bf16_t*)(ws + WS_X);
    bf16_t* Z = (bf16_t*)(ws + WS_Z); bf16_t* AB = (bf16_t*)(ws + WS_AB); bf16_t* H = (bf16_t*)(ws + WS_H);
#define RUN(k) (p.ph_lo <= (k) && (k) < p.ph_hi)
#define GRID_SYNC_CG() do { asm volatile("s_waitcnt vmcnt(0) lgkmcnt(0)" ::: "memory"); grid.sync(); __builtin_amdgcn_fence(__ATOMIC_ACQUIRE, "agent"); asm volatile("s_waitcnt vmcnt(0)" ::: "memory"); } while (0)
#define GRID_SYNC() do { xcd_barrier(xbar); } while (0)
#define REPEAT(n, stmt) do { for (int rep_ = 0; rep_ < (n); ++rep_) { stmt; if (rep_ + 1 < (n)) GRID_SYNC(); } } while (0)
#define SEAM(k) do { if (p.ph_lo <= (k) && (k) + 1 < p.ph_hi) GRID_SYNC(); } while (0)
    if (RUN(0)) REPEAT(REP_P0, p0_prologue(p, lds));
    if (p.ph_lo <= 0 && 1 < p.ph_hi) GRID_SYNC_CG();
    for (int l = 0; l < 2; ++l) {
        const int k0 = 1 + 8 * l;
        const float* modl = MOD + (size_t)l * 3 * MODW;
        const float* xin_lo = p.in[0];
        const float* xin_hi = p.in[1] - (size_t)MCTX * D;
        const bf16_t* xres = (l == 0) ? nullptr : X;
        if (RUN(k0)) REPEAT(REP_NORM, norm_phase<false>(xin_lo, xin_hi, xres, p.in[10] + l * D, modl, 0, D, XN, nullptr));
        SEAM(k0);
        if (RUN(k0 + 1)) for (int repg_ = 0; repg_ < REP_G; ++repg_) {
            if (repg_) GRID_SYNC();
            if (l == 0) { pg8::Gemm g{XN, (const bf16_t*)(ws + WS_WIN), MTOT, ABIN, D}; pg8::StaticOrder S; S.init(MTOT, ABIN, G, (int)blockIdx.x, D, ws, -2);
                EpiBf16<0, false> E{Z, ABIN, nullptr, nullptr, 0, 0}; pg8::gemm_phase(lds, g, S, E); }
            else { pg8::Gemm g{XN, (const bf16_t*)(ws + WS_WQKV), MTOT, NQKV, D}; pg8::StaticOrder S; S.init(MTOT, NQKV, G, (int)blockIdx.x, D, ws, -2);
                EpiBf16<0, false> E{Z, D, nullptr, nullptr, 8, (size_t)MTOT * D}; pg8::gemm_phase(lds, g, S, E); }
        }
        SEAM(k0 + 1);
        if (l == 0) { if (RUN(k0 + 2)) REPEAT(REP_EW, ew0_phase(p)); SEAM(k0 + 2); }
        if (RUN(k0 + 3)) REPEAT(REP_ATT, if (l == 0) attn0_phase(p, lds); else attn1_phase(p, lds, AB));
        SEAM(k0 + 3);
        if (RUN(k0 + 4)) { pg8::Gemm g{AB, (const bf16_t*)(ws + (l == 0 ? WS_WO0 : WS_WO1)), MTOT, D, D}; pg8::StaticOrder S; S.init(MTOT, D, G, (int)blockIdx.x, D, ws, -2);
            EpiResid E{xin_lo, xin_hi, xres, X, modl + 2 * D}; pg8::gemm_phase(lds, g, S, E); }
        SEAM(k0 + 4);
        if (RUN(k0 + 5)) REPEAT(REP_NORM, norm_phase<false>(nullptr, nullptr, X, p.in[11] + l * D, modl, 3 * D, 4 * D, XN, nullptr));
        SEAM(k0 + 5);
        if (RUN(k0 + 6)) for (int repg_ = 0; repg_ < REP_G; ++repg_) { if (repg_) GRID_SYNC(); pg8::Gemm g{XN, (const bf16_t*)(ws + WS_W1) + (size_t)l * FFN * D, MTOT, FFN, D}; pg8::StaticOrder S; S.init(MTOT, FFN, G, (int)blockIdx.x, D, ws, -1);
            EpiBf16<1, false> E{H, FFN, nullptr, nullptr, 0, 0}; pg8::gemm_phase(lds, g, S, E); }
        SEAM(k0 + 6);
        if (RUN(k0 + 7)) { pg8::Gemm g{H, (const bf16_t*)(ws + WS_W2) + (size_t)l * FFN * D, MTOT, D, FFN}; pg8::StaticOrder S; S.init(MTOT, D, G, (int)blockIdx.x, FFN, ws, (l * 4 + 3) * 1024);
            EpiResid E{nullptr, nullptr, X, X, modl + 5 * D}; pg8::gemm_phase(lds, g, S, E); }
        SEAM(k0 + 7);
    }
#if PROBE_STOP > 0
    GRID_SYNC();
    {
        const size_t n = (size_t)MTOT * D, gt = (size_t)blockIdx.x * 512 + threadIdx.x, gs = (size_t)G * 512;
        const bf16_t* sb = PROBE_SRC == 1 ? XN : PROBE_SRC == 2 ? AB : PROBE_SRC == 3 ? Z : PROBE_SRC == 5 ? Z + (size_t)4096 * NQKV : (const bf16_t*)(ws + WS_Q0);
#if PROBE_SRC == 6
        attn1_phase(p, lds, XN);
        GRID_SYNC();
        for (size_t i = gt; i < n; i += gs) p.out[i] = bf2f(AB[i]) - bf2f(XN[i]);
#else
        for (size_t i = gt; i < n; i += gs) p.out[i] = (PROBE_SRC == 0) ? bf2f(X[i]) : bf2f(sb[i]);
#endif
#if PROBE_STOP < 4
        for (size_t i = gt; i < (size_t)2 * MCTX * 256; i += gs) p.out[OUT_AK + i] = 0.f;
#endif
        for (size_t i = gt; i < (size_t)2 * MCTX * D; i += gs) p.out[OUT_NK + i] = 0.f;
    }
#else
    if (RUN(17)) REPEAT(REP_NORM, norm_phase<true>(nullptr, nullptr, X, p.in[22], nullptr, 0, 0, nullptr, p.out));
#endif
#undef RUN
#undef SEAM
#undef REPEAT
#undef GRID_SYNC
#undef GRID_SYNC_CG
}

extern "C" void kernel_launch(void* const* d_in, const int* in_sizes, int n_in, void* d_out, int out_size, void* d_ws, size_t ws_size, hipStream_t stream) {
    static int grid = 0;
    if (grid == 0) {
        if (n_in != 23 || ws_size < WS_END) { fprintf(stderr, "kernel_launch: expected 23 inputs and >= %zu bytes of workspace (got %d, %zu)\n", (size_t)WS_END, n_in, ws_size); grid = -1; return; }
        int dev = 0, cus = 0, per_cu = 0;
        (void)hipGetDevice(&dev);
        (void)hipDeviceGetAttribute(&cus, hipDeviceAttributeMultiprocessorCount, dev);
        if (hipFuncSetAttribute((const void*)mega_fwd, hipFuncAttributeMaxDynamicSharedMemorySize, LDS_BYTES) != hipSuccess) { fprintf(stderr, "kernel_launch: hipFuncSetAttribute failed\n"); grid = -1; return; }
        if (hipOccupancyMaxActiveBlocksPerMultiprocessor(&per_cu, (const void*)mega_fwd, 512, LDS_BYTES) != hipSuccess || per_cu < 1) { fprintf(stderr, "kernel_launch: occupancy query failed (%d)\n", per_cu); grid = -1; return; }
        grid = cus * (per_cu > 1 ? 1 : per_cu);
        fprintf(stderr, "kernel_launch: grid %d (cus %d, per_cu %d)\n", grid, cus, per_cu);
    }
    if (grid < 0) return;
    (void)hipMemsetAsync((char*)d_ws + WS_BAR, 0, 65536, stream);
    Params p{};
    for (int i = 0; i < 23; ++i) p.in[i] = (const float*)d_in[i];
    p.out = (float*)d_out; p.ws = (unsigned char*)d_ws;
#if MK_PER_PHASE
    for (int k = 0; k < NPHASE; ++k) {
        if (k == 11) continue;
        p.ph_lo = k; p.ph_hi = k + 1;
        void* args[] = {&p};
        hipError_t e = hipLaunchCooperativeKernel((const void*)mega_fwd, dim3(grid), dim3(512), args, LDS_BYTES, stream);
        if (e != hipSuccess) { fprintf(stderr, "launch %d failed: %s\n", k, hipGetErrorString(e)); break; }
    }
#else
    p.ph_lo = 0; p.ph_hi = PROBE_STOP > 0 ? PROBE_STOP : NPHASE;
    void* args[] = {&p};
    hipError_t e = hipLaunchCooperativeKernel((const void*)mega_fwd, dim3(grid), dim3(512), args, LDS_BYTES, stream);
    if (e != hipSuccess) fprintf(stderr, "cooperative launch failed: %s (grid %d)\n", hipGetErrorString(e), grid);
#endif
}
```

```cpp
#include <hip/hip_runtime.h>
#include <hip/hip_cooperative_groups.h>
#include <cstdio>
#include <cstdint>
namespace cg = cooperative_groups;

#ifndef MK_PER_PHASE
#define MK_PER_PHASE 0
#endif

#ifndef REP_NG
#define REP_NG 1
#endif
#ifndef REP_P0
#define REP_P0 REP_NG
#endif
#ifndef REP_NORM
#define REP_NORM REP_NG
#endif
#ifndef REP_EW
#define REP_EW REP_NG
#endif
#ifndef REP_ATT
#define REP_ATT REP_NG
#endif
#ifndef REP_G
#define REP_G 1
#endif
#ifndef PROBE_STOP
#define PROBE_STOP 0
#endif
#ifndef PROBE_SRC
#define PROBE_SRC 0
#endif
#define LAS __attribute__((address_space(3)))
#define PG8_LAS __attribute__((address_space(3)))
typedef unsigned short bf16_t;
typedef short bf16x8 __attribute__((ext_vector_type(8)));
typedef short v4i16_t __attribute__((ext_vector_type(4)));
typedef float f32x4 __attribute__((ext_vector_type(4)));
typedef float f32x2 __attribute__((ext_vector_type(2)));
typedef unsigned u32x4 __attribute__((ext_vector_type(4)));
typedef unsigned u32x2 __attribute__((ext_vector_type(2)));

__device__ __forceinline__ float bf2f(unsigned h) { return __uint_as_float(h << 16); }
typedef __bf16 bf16x2_t __attribute__((ext_vector_type(2)));
__device__ __forceinline__ unsigned cvt_pk_bf16(float lo, float hi) { f32x2 v = {lo, hi}; bf16x2_t r = __builtin_convertvector(v, bf16x2_t); return __builtin_bit_cast(unsigned, r); }
__device__ __forceinline__ float wave_sum(float v) {
#pragma unroll
    for (int o = 1; o < 64; o <<= 1) v += __shfl_xor(v, o);
    return v;
}

constexpr size_t WS_TS_OFS = 595591168ull;
constexpr size_t WS_FLAGS_OFS = (512u << 10) + 16384;
namespace pg8 {
constexpr int BM = 256, BK = 64, HALF = 128, HTB = HALF * BK * 2  , STAGE_BYTES = 8 * HTB, NXCD = 8, WGM = 4;

__host__ __device__ __forceinline__ int lds_byte(int r, int c) { const int st = (r >> 4) * 2 + (c >> 5), rr = r & 15, cc = c & 31, ob = rr * 64 + cc * 2; return st * 1024 + (ob ^ (((ob >> 9) & 1) << 5)); }
__host__ __device__ __forceinline__ void stage_rc(int b, int& R, int& C) { const int st = b / 1024, sb = b % 1024, swz = sb ^ (((sb >> 9) & 1) << 5); R = (st >> 1) * 16 + swz / 64; C = (st & 1) * 32 + (swz % 64) / 2; }
__host__ __device__ __forceinline__ int perm32(int rho) { const int n = rho >> 4, i = rho & 15; return 8 * (i >> 2) + 4 * n + (i & 3); }
struct Unit { int pm, pn, code; };
struct Gemm { const bf16_t* A; const bf16_t* Bt; int M, N, K; };
struct StaticOrder {
    int nM, nN, nwg, G, c, ntk, R, tail, fofs, msplit; unsigned char* wsb;
    __device__ __forceinline__ int kt0(const Unit& u) const { return (u.code & 3) == 2 ? (ntk >> 1) : 0; }
    __device__ __forceinline__ int nkt(const Unit& u) const { return ((u.code & 3) == 1 || (u.code & 3) == 2) ? (ntk >> 1) : ntk; }
    __host__ __device__ void init(int M, int N, int G_, int c_, int K, unsigned char* wsb_, int fofs_) {
        nM = M / BM; nN = N / BM; nwg = nM * nN; G = G_; c = c_; ntk = K / BK; wsb = wsb_; fofs = fofs_; msplit = (fofs_ == -2);
        R = nwg / G; tail = nwg - R * G;
        if (fofs_ == -1 || 2 * tail > G || (ntk & 3)) tail = 0;
    }
    __host__ __device__ bool next(int i, Unit& u) const {
        long L;
        if (tail) {
            if (i < R) { L = (long)i * G + c; u.code = 0; }
            else if (i == R && c < 2 * tail) { L = (long)R * G + (c >> 1); u.code = msplit ? (3 | ((c & 1) << 2)) : ((1 + (c & 1)) | ((c >> 1) << 2)); }
            else return false;
        } else { L = (long)i * G + c; if (L >= nwg) return false; u.code = 0; }
        int wgid = (int)L; { const int q = nwg / NXCD, r = nwg % NXCD, xcd = wgid % NXCD, off = wgid / NXCD; wgid = (xcd < r ? xcd * (q + 1) : r * (q + 1) + (xcd - r) * q) + off; }
        const int nig = WGM * nN, gid = wgid / nig, fm = gid * WGM, gsz = (nM - fm) < WGM ? (nM - fm) : WGM;
        u.pm = fm + ((wgid % nig) % gsz); u.pn = (wgid % nig) / gsz; return true;
    }
    __device__ __forceinline__ void a_ready(const Unit&) const {}
    __device__ __forceinline__ void done(const Unit&) const {}
};
template <class Epi, class Sched>
__device__ __forceinline__ void gemm_phase(PG8_LAS unsigned char* lds, const Gemm g, const Sched& S, const Epi& E) {
    int tid_ = threadIdx.x; asm volatile("" : "+v"(tid_));
    const int tid = tid_, wid = __builtin_amdgcn_readfirstlane(tid >> 6), lane = tid & 63, wr = wid >> 2, wc = wid & 3, fr = lane & 15, fq = lane >> 4;
    const int K = g.K;
    unsigned voffA[2], voffB[2];
#pragma unroll
    for (int i = 0; i < 2; ++i) { int R, C; stage_rc(tid * 16 + i * 8192, R, C); const int Rb = Epi::PERM ? ((R & ~31) + perm32(R & 31)) : R;
        voffA[i] = (unsigned)(R * K + C) * 2u; voffB[i] = (unsigned)(Rb * K + C) * 2u; }
    const size_t kstep = (size_t)(BK * 2);
    const size_t hstep = (size_t)HALF * K * 2;
    const size_t tstep = 2 * hstep;
    const unsigned ldsw = (unsigned)wid * 1024u;
    const int aoff = lds_byte(wr * 64 + fr, fq * 8), boff = lds_byte(wc * 32 + fr, fq * 8);
#define PG8_SA(b, h) (((b) * 2 + (h)) * HTB)
#define PG8_SB(b, h) ((4 + (b) * 2 + (h)) * HTB)
#define PG8_STAGE(bufoff, gbase, voff) do { _Pragma("unroll") for (int _i = 0; _i < 2; ++_i) \
        __builtin_amdgcn_global_load_lds((const unsigned*)((const char*)(gbase) + (voff)[_i]), (PG8_LAS unsigned*)(lds + (bufoff) + ldsw + _i * 8192), 16, 0, 0); } while (0)
#define PG8_LDA(dst, b, h) do { _Pragma("unroll") for (int m = 0; m < 4; ++m) _Pragma("unroll") for (int k = 0; k < 2; ++k) dst[m][k] = *(const PG8_LAS bf16x8*)(lds + PG8_SA(b, h) + aoff + m * 2048 + k * 1024); } while (0)
#define PG8_LDB(dst, b, h) do { _Pragma("unroll") for (int n = 0; n < 2; ++n) _Pragma("unroll") for (int k = 0; k < 2; ++k) dst[n][k] = *(const PG8_LAS bf16x8*)(lds + PG8_SB(b, h) + boff + n * 2048 + k * 1024); } while (0)
#define PG8_MMA(ai, bj, At, Bt) do { __builtin_amdgcn_s_setprio(0); _Pragma("unroll") for (int m = 0; m < 4; ++m) _Pragma("unroll") for (int n = 0; n < 2; ++n) _Pragma("unroll") for (int k = 0; k < 2; ++k) \
        acc[ai][bj][m][n] = __builtin_amdgcn_mfma_f32_16x16x32_bf16(Bt[n][k], At[m][k], acc[ai][bj][m][n], 0, 0, 0); __builtin_amdgcn_s_setprio(1); } while (0)
#define PG8_WAIT_V(n) asm volatile("s_waitcnt vmcnt(" #n ")" ::: "memory")
#define PG8_WAIT_L(n) asm volatile("s_waitcnt lgkmcnt(" #n ")" ::: "memory")
#define PG8_BAR __builtin_amdgcn_s_barrier()
#define PG8_SCHED __builtin_amdgcn_sched_barrier(0)
    Unit cur, nxt; int ui = 0;
    if (!S.next(0, cur)) return;
    f32x4 acc[2][2][4][2];
#pragma unroll
    for (int a = 0; a < 2; ++a)
#pragma unroll
        for (int b = 0; b < 2; ++b)
#pragma unroll
            for (int m = 0; m < 4; ++m)
#pragma unroll
                for (int n = 0; n < 2; ++n) acc[a][b][m][n] = (f32x4){0.f, 0.f, 0.f, 0.f};
    bf16x8 At[4][2], B0[2][2], B1[2][2];
    const char* cA = (const char*)g.A + (size_t)cur.pm * tstep + (size_t)S.kt0(cur) * kstep; const char* cB = (const char*)g.Bt + (size_t)cur.pn * tstep + (size_t)S.kt0(cur) * kstep;
    S.a_ready(cur);
    if ((cur.code & 3) == 3) cA += (size_t)(cur.code >> 2) * hstep;
    size_t ahs = (cur.code & 3) == 3 ? 0 : hstep;
    PG8_STAGE(PG8_SB(0, 0), cB, voffB); PG8_STAGE(PG8_SB(0, 1), cB + hstep, voffB); PG8_STAGE(PG8_SA(0, 0), cA, voffA); PG8_STAGE(PG8_SA(0, 1), cA + ahs, voffA);
    if (wr == 1) PG8_BAR;
    PG8_WAIT_V(2); PG8_BAR;
    PG8_STAGE(PG8_SB(1, 0), cB + kstep, voffB); PG8_STAGE(PG8_SA(1, 0), cA + kstep, voffA); PG8_STAGE(PG8_SB(1, 1), cB + hstep + kstep, voffB);
    PG8_WAIT_V(6); PG8_BAR;
    for (;;) {
        const bool has_next = S.next(ui + 1, nxt);
        const char* nA = has_next ? (const char*)g.A + (size_t)nxt.pm * tstep + (size_t)S.kt0(nxt) * kstep : cA; const char* nB = has_next ? (const char*)g.Bt + (size_t)nxt.pn * tstep + (size_t)S.kt0(nxt) * kstep : cB;
        const int nt = S.nkt(cur);
        const bool full = (cur.code & 3) != 3;
        const size_t ahs_n = (has_next && (nxt.code & 3) == 3) ? 0 : (has_next ? hstep : ahs);
        if (has_next && (nxt.code & 3) == 3) nA += (size_t)(nxt.code >> 2) * hstep;
        for (int t = 0; t < nt; t += 2) {
            const bool last = (t == nt - 2);
            const char* a1 = cA + (size_t)(t + 1) * kstep;
            const char* a2 = last ? nA : cA + (size_t)(t + 2) * kstep; const char* b2 = last ? nB : cB + (size_t)(t + 2) * kstep;
            const char* a3 = a2 + kstep; const char* b3 = b2 + kstep;
            if (last && has_next) S.a_ready(nxt);
            PG8_LDB(B0, 0, 0); PG8_LDB(B1, 0, 1); PG8_SCHED; PG8_LDA(At, 0, 0); PG8_STAGE(PG8_SA(1, 1), a1 + ahs, voffA);
            PG8_WAIT_V(8); PG8_WAIT_L(0); PG8_BAR; PG8_MMA(0, 0, At, B0); PG8_MMA(0, 1, At, B1); PG8_BAR; PG8_SCHED;
            PG8_LDA(At, 0, 1); PG8_STAGE(PG8_SB(0, 0), b2, voffB); PG8_STAGE(PG8_SB(0, 1), b2 + hstep, voffB); PG8_STAGE(PG8_SA(0, 0), a2, voffA);
            PG8_WAIT_V(8); PG8_WAIT_L(0); PG8_BAR; if (full) { PG8_MMA(1, 0, At, B0); PG8_MMA(1, 1, At, B1); } PG8_BAR; PG8_SCHED;
            PG8_LDB(B0, 1, 0); PG8_LDB(B1, 1, 1); PG8_SCHED; PG8_LDA(At, 1, 0); PG8_STAGE(PG8_SA(0, 1), a2 + (last ? ahs_n : ahs), voffA);
            PG8_WAIT_V(8); PG8_WAIT_L(0); PG8_BAR; PG8_MMA(0, 0, At, B0); PG8_MMA(0, 1, At, B1); PG8_BAR; PG8_SCHED;
            PG8_LDA(At, 1, 1); PG8_STAGE(PG8_SB(1, 0), b3, voffB); PG8_STAGE(PG8_SB(1, 1), b3 + hstep, voffB); PG8_STAGE(PG8_SA(1, 0), a3, voffA);
            PG8_WAIT_V(8); PG8_WAIT_L(0); PG8_BAR; if (full) { PG8_MMA(1, 0, At, B0); PG8_MMA(1, 1, At, B1); } PG8_BAR; PG8_SCHED;
        }
        if (wr == 0) PG8_BAR;
        const int role = cur.code & 3, slot = cur.code >> 2;
        if (role == 2) {
            f32x4* sp = (f32x4*)(S.wsb + WS_TS_OFS + (size_t)((S.fofs >> 12) + 1) * 33554432u) + (size_t)slot * (32 * 512) + tid;
#pragma unroll
            for (int a = 0; a < 2; ++a)
#pragma unroll
                for (int b = 0; b < 2; ++b)
#pragma unroll
                    for (int m = 0; m < 4; ++m)
#pragma unroll
                        for (int n = 0; n < 2; ++n) asm volatile("global_store_dwordx4 %0, %1, off sc1" :: "v"(sp + (((a * 2 + b) * 4 + m) * 2 + n) * 512), "v"(acc[a][b][m][n]) : "memory");
            asm volatile("s_waitcnt vmcnt(0)" ::: "memory");
            if (lane == 0) __hip_atomic_store((unsigned*)(S.wsb + WS_FLAGS_OFS) + S.fofs + slot * 8 + wid, 1u, __ATOMIC_RELAXED, __HIP_MEMORY_SCOPE_AGENT);
        } else {
            if (role == 1) {
                unsigned spins = 0;
                while (__hip_atomic_load((unsigned*)(S.wsb + WS_FLAGS_OFS) + S.fofs + slot * 8 + wid, __ATOMIC_RELAXED, __HIP_MEMORY_SCOPE_AGENT) == 0u) { __builtin_amdgcn_s_sleep(2); if (++spins > (1u << 22)) break; }
                __builtin_amdgcn_fence(__ATOMIC_ACQUIRE, "agent");
                asm volatile("s_waitcnt vmcnt(0)" ::: "memory");
                const f32x4* sp = (const f32x4*)(S.wsb + WS_TS_OFS + (size_t)((S.fofs >> 12) + 1) * 33554432u) + (size_t)slot * (32 * 512) + tid;
#pragma unroll
                for (int a = 0; a < 2; ++a)
#pragma unroll
                    for (int b = 0; b < 2; ++b)
#pragma unroll
                        for (int m = 0; m < 4; ++m)
#pragma unroll
                            for (int n = 0; n < 2; ++n) { acc[a][b][m][n] += sp[(((a * 2 + b) * 4 + m) * 2 + n) * 512]; asm volatile("" ::: "memory"); }
            }
            E(acc, cur, wr, wc, fr, fq, role == 3 ? slot * 128 : 0, role == 3 ? 1 : 2);
        }
        if (!has_next) break;
#pragma unroll
        for (int a = 0; a < 2; ++a)
#pragma unroll
            for (int b = 0; b < 2; ++b)
#pragma unroll
                for (int m = 0; m < 4; ++m)
#pragma unroll
                    for (int n = 0; n < 2; ++n) acc[a][b][m][n] = (f32x4){0.f, 0.f, 0.f, 0.f};
        cur = nxt; cA = nA; cB = nB; ahs = ahs_n; ++ui;
        if (wr == 1) PG8_BAR;
    }
    PG8_WAIT_V(0);
    PG8_BAR;
    if constexpr (Epi::AFTER_DRAIN) { E.fused(acc, cur, wr, wc, fr, fq, lds, wid, lane); S.done(cur); }
#undef PG8_SA
#undef PG8_SB
#undef PG8_STAGE
#undef PG8_LDA
#undef PG8_LDB
#undef PG8_MMA
#undef PG8_WAIT_V
#undef PG8_WAIT_L
#undef PG8_BAR
#undef PG8_SCHED
}
}

constexpr int D = 2048, MCTX = 8192, MLAT = 4096, MTOT = 12288, FFN = 8192, ABIN = 4608, NQKV = 6144, MODW = 12288;
constexpr float EPS = 1e-6f;
constexpr size_t WS_MOD = 0;
constexpr size_t WS_BAR = 512u << 10;
constexpr size_t WS_WIN = 1u << 20;
constexpr size_t WS_WO0 = WS_WIN + (size_t)ABIN * D * 2;
constexpr size_t WS_WQKV = WS_WO0 + (size_t)D * D * 2;
constexpr size_t WS_WO1 = WS_WQKV + (size_t)NQKV * D * 2;
constexpr size_t WS_W1 = WS_WO1 + (size_t)D * D * 2;
constexpr size_t WS_W2 = WS_W1 + 2 * (size_t)FFN * D * 2;
constexpr size_t WS_XN = WS_W2 + 2 * (size_t)FFN * D * 2;
constexpr size_t WS_H = WS_XN + (size_t)MTOT * D * 2;
constexpr size_t WS_Z = WS_H;
constexpr size_t WS_AB = WS_H + (size_t)MTOT * NQKV * 2;
constexpr size_t WS_Q0 = WS_H + (size_t)MTOT * FFN * 2;
constexpr size_t WS_K0 = WS_Q0 + (size_t)MTOT * 1024 * 2;
constexpr size_t WS_V0 = WS_K0 + (size_t)(MTOT + 1024) * 256 * 2;
constexpr size_t WS_CNK = WS_V0 + (size_t)(MTOT + 1024) * 256 * 2;
constexpr size_t WS_CNV = WS_CNK + (size_t)1024 * 2048 * 2;
constexpr size_t WS_X = WS_CNV + (size_t)1024 * 2048 * 2;
constexpr size_t WS_TS = WS_X + (size_t)MTOT * D * 4;
constexpr size_t WS_END = WS_TS + 3 * (size_t)128 * 32 * 512 * 16;
constexpr size_t WS_FLAGS = WS_BAR + 16384;
static_assert(WS_TS == WS_TS_OFS && WS_FLAGS == WS_FLAGS_OFS, "early offsets");
constexpr int LDS_BYTES = 131072 + 256;

constexpr size_t OUT_YP = 0, OUT_YS = (size_t)MCTX * D, OUT_AK = OUT_YS + (size_t)MLAT * D, OUT_AV = OUT_AK + (size_t)MCTX * 256,
                 OUT_NK = OUT_AV + (size_t)MCTX * 256, OUT_NV = OUT_NK + (size_t)MCTX * D;

struct Params {
    const float* in[23];
    float* out;
    unsigned char* ws;
    int ph_lo, ph_hi;
};

template <int ACT, bool SIDE> struct EpiBf16 {
    static constexpr bool PERM = true, AFTER_DRAIN = false;
    bf16_t* O; int ldc; float* kout; float* vout; int split_tiles; size_t split_stride;
    __device__ __forceinline__ void operator()(const f32x4 (&acc)[2][2][4][2], const pg8::Unit& u, int wr, int wc, int fr, int fq, int rowofs, int nai) const {
        const int row0 = u.pm * 256 + rowofs + wr * 64 + fr, col0 = u.pn * 256 + wc * 32 + 8 * fq;
        const int spt = split_tiles ? u.pn / split_tiles : 0; bf16_t* Ob = O + (size_t)spt * split_stride; const int ocol0 = col0 - spt * split_tiles * 256;
        const bool side = SIDE && (u.pm < 32) && (u.pn >= 8);
        float* sbase = nullptr; int scol0 = 0;
        if (SIDE) { sbase = (u.pn < 16) ? kout : vout; scol0 = col0 - ((u.pn < 16) ? 2048 : 4096); }
#pragma unroll
        for (int ai = 0; ai < 2; ++ai) if (ai < nai)
#pragma unroll
            for (int m = 0; m < 4; ++m) {
                const int row = row0 + ai * 128 + m * 16;
                bf16_t* rowp = Ob + (size_t)row * ldc + ocol0;
#pragma unroll
                for (int bj = 0; bj < 2; ++bj) {
                    f32x4 v0 = acc[ai][bj][m][0], v1 = acc[ai][bj][m][1];
                    if (SIDE) { if (side) { float* sp = sbase + (size_t)row * 2048 + scol0 + bj * 128; *(f32x4*)sp = v0; *(f32x4*)(sp + 4) = v1; } }
                    if (ACT == 1) {
#pragma unroll
                        for (int j = 0; j < 4; ++j) { float a = fmaxf(v0[j], 0.f), b = fmaxf(v1[j], 0.f); v0[j] = a * a; v1[j] = b * b; }
                    }
                    u32x4 o; o.x = cvt_pk_bf16(v0[0], v0[1]); o.y = cvt_pk_bf16(v0[2], v0[3]); o.z = cvt_pk_bf16(v1[0], v1[1]); o.w = cvt_pk_bf16(v1[2], v1[3]);
                    *(u32x4*)(rowp + bj * 128) = o;
                }
            }
    }
};
struct EpiResid {
    static constexpr bool PERM = true, AFTER_DRAIN = false;
    const float* src_lo; const float* src_hi;
    const bf16_t* xsrc; bf16_t* X; const float* gate;
    __device__ __forceinline__ void operator()(const f32x4 (&acc)[2][2][4][2], const pg8::Unit& u, int wr, int wc, int fr, int fq, int rowofs, int nai) const {
        const int row0 = u.pm * 256 + rowofs + wr * 64 + fr, col0 = u.pn * 256 + wc * 32 + 8 * fq;
        const int cond = (u.pm < 32) ? 0 : 1 + ((u.pm - 32) >> 3);
        const float* gp = gate + (size_t)cond * MODW + col0;
        const float* sb = (u.pm < 32) ? src_lo : src_hi;
        f32x4 gv[2][2];
#pragma unroll
        for (int bj = 0; bj < 2; ++bj)
#pragma unroll
            for (int n = 0; n < 2; ++n) gv[bj][n] = *(const f32x4*)(gp + bj * 128 + n * 4);
#pragma unroll
        for (int ai = 0; ai < 2; ++ai) if (ai < nai)
#pragma unroll
            for (int m = 0; m < 4; ++m) {
                const size_t off = (size_t)(row0 + ai * 128 + m * 16) * D + col0;
#pragma unroll
                for (int bj = 0; bj < 2; ++bj) {
                    f32x4 r0, r1;
                    if (xsrc) { const u32x4 rb = *(const u32x4*)(xsrc + off + bj * 128);
                        r0[0] = bf2f(rb.x & 0xffffu); r0[1] = __uint_as_float(rb.x & 0xffff0000u); r0[2] = bf2f(rb.y & 0xffffu); r0[3] = __uint_as_float(rb.y & 0xffff0000u);
                        r1[0] = bf2f(rb.z & 0xffffu); r1[1] = __uint_as_float(rb.z & 0xffff0000u); r1[2] = bf2f(rb.w & 0xffffu); r1[3] = __uint_as_float(rb.w & 0xffff0000u); }
                    else { r0 = *(const f32x4*)(sb + off + bj * 128); r1 = *(const f32x4*)(sb + off + bj * 128 + 4); }
                    const f32x4 x0 = r0 + gv[bj][0] * acc[ai][bj][m][0], x1 = r1 + gv[bj][1] * acc[ai][bj][m][1];
                    u32x4 o; o.x = cvt_pk_bf16(x0[0], x0[1]); o.y = cvt_pk_bf16(x0[2], x0[3]); o.z = cvt_pk_bf16(x1[0], x1[1]); o.w = cvt_pk_bf16(x1[2], x1[3]);
                    *(u32x4*)(X + off + bj * 128) = o;
                }
            }
    }
};

__device__ __forceinline__ unsigned f2bf(float f) { unsigned u = __float_as_uint(f); return (u + 0x7fffu + ((u >> 16) & 1u)) >> 16; }
__device__ __forceinline__ unsigned pk2(float lo, float hi) { return f2bf(lo) | (f2bf(hi) << 16); }
__device__ __forceinline__ void p0_transpose_item(const float* W, int K, int N, bf16_t* WT, LAS float* scr, int item, int lane) {
    (void)scr;
    const int nblk = N / 32, kblk = item / nblk, nb = item % nblk, kb = lane & 7, ng = lane >> 3;
    const int k0 = 64 * kblk + 8 * kb, n0 = 32 * nb + 4 * ng;
    const float* wp = W + (size_t)k0 * N + n0;
    f32x4 r[8];
#pragma unroll
    for (int i = 0; i < 8; ++i) r[i] = *(const f32x4*)(wp + (size_t)i * N);
#pragma unroll
    for (int i = 0; i < 4; ++i) {
        u32x4 o; o.x = cvt_pk_bf16(r[0][i], r[1][i]); o.y = cvt_pk_bf16(r[2][i], r[3][i]); o.z = cvt_pk_bf16(r[4][i], r[5][i]); o.w = cvt_pk_bf16(r[6][i], r[7][i]);
        *(u32x4*)(WT + (size_t)(n0 + i) * K + k0) = o;
    }
}
__device__ __forceinline__ void cvt_linear(const float* src, bf16_t* dst, int n, int gtid, int gthreads) {
    for (int i = gtid * 4; i < n; i += gthreads * 4) { const f32x4 v = *(const f32x4*)(src + i); u32x2 o; o.x = cvt_pk_bf16(v[0], v[1]); o.y = cvt_pk_bf16(v[2], v[3]); *(u32x2*)(dst + i) = o; }
}
__device__ __forceinline__ void p0_prologue(const Params& p, LAS unsigned char* lds) {
    int tid_ = threadIdx.x; asm volatile("" : "+v"(tid_));
    const int tid = tid_, lane = tid & 63, wave = __builtin_amdgcn_readfirstlane(tid >> 6), G = gridDim.x;
    unsigned char* ws = p.ws;
    {
        LAS float* sc = (LAS float*)(lds + 69632);
        LAS float* red = (LAS float*)(lds + 69632 + 24576);
        const float* cvec = p.in[6]; const float* cctx = p.in[7];
        for (int i = tid; i < 3 * 2048; i += 512) { const int c = i >> 11, k = i & 2047; const float x = (c == 0) ? cctx[k] : cvec[(c - 1) * 2048 + k]; sc[i] = x / (1.f + __expf(-x)); }
        __syncthreads();
        float* MOD = (float*)(ws + WS_MOD);
        for (int item = blockIdx.x; item < 256; item += G) {
            const int l = item >> 7, cgp = item & 127, ln = lane < 48 ? lane : 47;
            const float* W = p.in[8] + (size_t)l * 2048 * MODW + cgp * 96 + ln * 2;
            float a00 = 0.f, a01 = 0.f, a10 = 0.f, a11 = 0.f, a20 = 0.f, a21 = 0.f;
            const int kb = wave * 256;
#pragma unroll 8
            for (int k = 0; k < 256; ++k) {
                const f32x2 w = *(const f32x2*)(W + (size_t)(kb + k) * MODW);
                const float s0 = sc[kb + k], s1 = sc[2048 + kb + k], s2 = sc[4096 + kb + k];
                a00 += s0 * w.x; a01 += s0 * w.y; a10 += s1 * w.x; a11 += s1 * w.y; a20 += s2 * w.x; a21 += s2 * w.y;
            }
            if (lane < 48) { LAS float* r = red + wave * 288 + lane * 2; r[0] = a00; r[1] = a01; r[96] = a10; r[97] = a11; r[192] = a20; r[193] = a21; }
            __syncthreads();
            if (tid < 288) { const int c = tid / 96, j = tid % 96; float s = 0.f;
#pragma unroll
                for (int w = 0; w < 8; ++w) s += red[w * 288 + tid];
                MOD[(size_t)(l * 3 + c) * MODW + cgp * 96 + j] = s + p.in[9][l * MODW + cgp * 96 + j]; }
            __syncthreads();
        }
    }
    {
        LAS float* scr = (LAS float*)(lds + wave * 8448);
        const int gw = blockIdx.x * 8 + wave, NGW = G * 8;
        constexpr int I_IN = 32 * (ABIN / 32), I_O = 32 * (D / 32), I_QKV = 32 * (NQKV / 32), I_1 = 32 * (FFN / 32), I_2 = (FFN / 64) * (D / 32);
        constexpr int NITEMS = I_IN + 2 * I_O + I_QKV + 2 * I_1 + 2 * I_2;
        for (int it = gw; it < NITEMS; it += NGW) {
            int r = it;
            if (r < I_IN) { p0_transpose_item(p.in[12], D, ABIN, (bf16_t*)(ws + WS_WIN), scr, r, lane); continue; } r -= I_IN;
            if (r < I_O) { p0_transpose_item(p.in[16], D, D, (bf16_t*)(ws + WS_WO0), scr, r, lane); continue; } r -= I_O;
            if (r < I_QKV) { p0_transpose_item(p.in[17], D, NQKV, (bf16_t*)(ws + WS_WQKV), scr, r, lane); continue; } r -= I_QKV;
            if (r < I_O) { p0_transpose_item(p.in[19], D, D, (bf16_t*)(ws + WS_WO1), scr, r, lane); continue; } r -= I_O;
            if (r < 2 * I_1) { const int l = r / I_1; p0_transpose_item(p.in[20] + (size_t)l * D * FFN, D, FFN, (bf16_t*)(ws + WS_W1) + (size_t)l * FFN * D, scr, r - l * I_1, lane); continue; } r -= 2 * I_1;
            { const int l = r / I_2; p0_transpose_item(p.in[21] + (size_t)l * D * FFN, FFN, D, (bf16_t*)(ws + WS_W2) + (size_t)l * FFN * D, scr, r - l * I_2, lane); }
        }
    }
    {
        const int gtid = blockIdx.x * 512 + tid, gth = G * 512;
        cvt_linear(p.in[2], (bf16_t*)(ws + WS_K0) + (size_t)MTOT * 256, 1024 * 256, gtid, gth);
        cvt_linear(p.in[3], (bf16_t*)(ws + WS_V0) + (size_t)MTOT * 256, 1024 * 256, gtid, gth);
        cvt_linear(p.in[4], (bf16_t*)(ws + WS_CNK), 1024 * 2048, gtid, gth);
        cvt_linear(p.in[5], (bf16_t*)(ws + WS_CNV), 1024 * 2048, gtid, gth);
    }
}

template <bool OUT_F32>
__device__ __forceinline__ void norm_phase(const float* src_lo, const float* src_hi, const bf16_t* xb, const float* gain, const float* mod, int shift_off, int scale_off, bf16_t* dst_bf, float* dst_f) {
    int tid_ = threadIdx.x; asm volatile("" : "+v"(tid_));
    const int tid = tid_, lane = tid & 63, wave = tid >> 6, G = gridDim.x;
    const int gw = blockIdx.x * 8 + wave, NGW = G * 8, per = (MTOT + NGW - 1) / NGW;
    const int r_beg = gw * per, r_end = (r_beg + per < MTOT) ? r_beg + per : MTOT;
    int cur = -1; f32x4 A[8], B[8];
    for (int row = r_beg; row < r_end; ++row) {
        const int cond = (row < MCTX) ? 0 : 1 + ((row - MCTX) >> 11);
        if (cond != cur) {
            cur = cond;
#pragma unroll
            for (int j = 0; j < 8; ++j) {
                const int col = 4 * lane + 256 * j; const f32x4 g = *(const f32x4*)(gain + col);
                if (mod) { const f32x4 sc = *(const f32x4*)(mod + (size_t)cond * MODW + scale_off + col); A[j] = g * (sc + 1.f); B[j] = *(const f32x4*)(mod + (size_t)cond * MODW + shift_off + col); }
                else { A[j] = g; B[j] = (f32x4){0.f, 0.f, 0.f, 0.f}; }
            }
        }
        f32x4 v[8]; float s = 0.f;
        if (xb) {
            const bf16_t* xr = xb + (size_t)row * D + 4 * lane;
#pragma unroll
            for (int j = 0; j < 8; ++j) { const u32x2 rb = *(const u32x2*)(xr + 256 * j); v[j][0] = bf2f(rb.x & 0xffffu); v[j][1] = __uint_as_float(rb.x & 0xffff0000u); v[j][2] = bf2f(rb.y & 0xffffu); v[j][3] = __uint_as_float(rb.y & 0xffff0000u); }
        } else {
            const float* xr = ((row < MCTX) ? src_lo : src_hi) + (size_t)row * D + 4 * lane;
#pragma unroll
            for (int j = 0; j < 8; ++j) v[j] = *(const f32x4*)(xr + 256 * j);
        }
#pragma unroll
        for (int j = 0; j < 8; ++j) s += (v[j].x * v[j].x + v[j].y * v[j].y) + (v[j].z * v[j].z + v[j].w * v[j].w);
        const float rstd = rsqrtf(wave_sum(s) * (1.f / D) + EPS);
#pragma unroll
        for (int j = 0; j < 8; ++j) {
            const f32x4 y = v[j] * rstd * A[j] + B[j];
            if (OUT_F32) *(f32x4*)(dst_f + (size_t)row * D + 4 * lane + 256 * j) = y;
            else { u32x2 o; o.x = cvt_pk_bf16(y[0], y[1]); o.y = cvt_pk_bf16(y[2], y[3]); *(u32x2*)(dst_bf + (size_t)row * D + 4 * lane + 256 * j) = o; }
        }
    }
}

__device__ __forceinline__ void unpack8(const u32x4 r, float (&f)[8]) {
    f[0] = bf2f(r.x & 0xffffu); f[1] = __uint_as_float(r.x & 0xffff0000u); f[2] = bf2f(r.y & 0xffffu); f[3] = __uint_as_float(r.y & 0xffff0000u);
    f[4] = bf2f(r.z & 0xffffu); f[5] = __uint_as_float(r.z & 0xffff0000u); f[6] = bf2f(r.w & 0xffffu); f[7] = __uint_as_float(r.w & 0xffff0000u);
}
__device__ __forceinline__ void ew0_phase(const Params& p) {
    int tid_ = threadIdx.x; asm volatile("" : "+v"(tid_));
    const int tid = tid_, lane = tid & 63, wave = tid >> 6, G = gridDim.x;
    const int gw = blockIdx.x * 8 + wave, NGW = G * 8;
    unsigned char* ws = p.ws;
    const bf16_t* Z = (const bf16_t*)(ws + WS_Z);
    bf16_t* AB = (bf16_t*)(ws + WS_AB); bf16_t* Q0 = (bf16_t*)(ws + WS_Q0); bf16_t* K0 = (bf16_t*)(ws + WS_K0); bf16_t* V0 = (bf16_t*)(ws + WS_V0);
    const float* convw = p.in[13]; const float* qn = p.in[14]; const float* kn = p.in[15];
    const int ri = lane & 31, chunk = lane >> 5, da = chunk * 64 + ri, db = da + 32;
    const float inv = __builtin_amdgcn_exp2f(-(float)ri * (13.287712379549449f / 32.f));
    const float qwa = qn[da], qwb = qn[db], kwa = kn[da], kwb = kn[db];
    for (int tok = gw; tok < MTOT; tok += NGW) {
        const bool lat = tok >= MCTX;
        const int t = lat ? ((tok - MCTX) & 2047) : (tok & 255), slen = lat ? 2048 : 256;
        const bf16_t* zr = Z + (size_t)tok * ABIN;
#pragma unroll
        for (int j = 0; j < 2; ++j) {
            const int ch = j * 512 + lane * 8;
            float gb[8], acc[8];
            unpack8(*(const u32x4*)(zr + ch), gb);
#pragma unroll
            for (int e = 0; e < 8; ++e) acc[e] = 0.f;
#pragma unroll
            for (int dt = -1; dt <= 1; ++dt) {
                if (t + dt >= 0 && t + dt < slen) {
                    float gc[8], xa[8];
                    unpack8(*(const u32x4*)(zr + dt * ABIN + 1024 + ch), gc);
                    unpack8(*(const u32x4*)(zr + dt * ABIN + 2048 + ch), xa);
                    const f32x4 w0 = *(const f32x4*)(convw + (dt + 1) * 1024 + ch), w1 = *(const f32x4*)(convw + (dt + 1) * 1024 + ch + 4);
#pragma unroll
                    for (int e = 0; e < 4; ++e) { acc[e] += w0[e] * (gc[e] * xa[e]); acc[4 + e] += w1[e] * (gc[4 + e] * xa[4 + e]); }
                }
            }
            u32x4 o; o.x = cvt_pk_bf16(gb[0] * acc[0], gb[1] * acc[1]); o.y = cvt_pk_bf16(gb[2] * acc[2], gb[3] * acc[3]);
            o.z = cvt_pk_bf16(gb[4] * acc[4], gb[5] * acc[5]); o.w = cvt_pk_bf16(gb[6] * acc[6], gb[7] * acc[7]);
            *(u32x4*)(AB + (size_t)tok * D + ch) = o;
        }
        float cs = 1.f, sn = 0.f;
        if (lat) { const float pos = (float)(chunk == 0 ? (t >> 6) : (t & 63)); const float ang = pos * inv; cs = __cosf(ang); sn = __sinf(ang); }
#pragma unroll
        for (int hh = 0; hh < 10; ++hh) {
            const bf16_t* hp = zr + 3072 + hh * 128;
            const float va = bf2f(hp[da]), vb = bf2f(hp[db]);
            const float rstd = rsqrtf(wave_sum(va * va + vb * vb) * (1.f / 128.f) + EPS);
            const float na = va * rstd * (hh < 8 ? qwa : kwa), nb = vb * rstd * (hh < 8 ? qwb : kwb);
            const float ra = na * cs - nb * sn, rb = na * sn + nb * cs;
            if (hh < 8) { bf16_t* q = Q0 + (size_t)tok * 1024 + hh * 128; q[da] = (bf16_t)f2bf(ra); q[db] = (bf16_t)f2bf(rb); }
            else {
                const int kvh = hh - 8;
                bf16_t* k = K0 + (size_t)tok * 256 + kvh * 128; k[da] = (bf16_t)f2bf(ra); k[db] = (bf16_t)f2bf(rb);
                if (!lat) { float* ok = p.out + OUT_AK + (size_t)tok * 256 + kvh * 128; ok[da] = na; ok[db] = nb; }
            }
        }
        {
            const u32x2 r = *(const u32x2*)(zr + 4352 + lane * 4);
            *(u32x2*)(V0 + (size_t)tok * 256 + lane * 4) = r;
            if (!lat) { f32x4 o; o[0] = bf2f(r.x & 0xffffu); o[1] = __uint_as_float(r.x & 0xffff0000u); o[2] = bf2f(r.y & 0xffffu); o[3] = __uint_as_float(r.y & 0xffff0000u);
                *(f32x4*)(p.out + OUT_AV + (size_t)tok * 256 + lane * 4) = o; }
        }
    }
}

constexpr int KSTR = 272, VSTR = 288, LDS_KT = 0, LDS_VT = 2 * 64 * KSTR, LDS_BIAS = LDS_VT + 2 * 64 * VSTR;
constexpr float SCL2 = 0.08838834764831845f * 1.4426950408889634f, LOG2E = 1.4426950408889634f;
struct AttnArgs {
    const bf16_t* q; int qstride; int qrow0;
    bf16_t* o; int ostride;
    const bf16_t* kA; const bf16_t* vA; int strideA, ntA;
    const bf16_t* kB; const bf16_t* vB; int strideB, ntB;
    float* kout; float* vout;
    int t0, t1, role; f32x4* xs; unsigned* xf;
    int r0, krlo; const float* bias;
};
__device__ __forceinline__ v4i16_t vtr(const LAS unsigned char* p) { return __builtin_amdgcn_ds_read_tr16_b64_v4i16((LAS v4i16_t*)p); }

__device__ __forceinline__ void store8_f32(float* dst, const u32x4 r) {
    f32x4 a, b; a[0] = bf2f(r.x & 0xffffu); a[1] = __uint_as_float(r.x & 0xffff0000u); a[2] = bf2f(r.y & 0xffffu); a[3] = __uint_as_float(r.y & 0xffff0000u);
    b[0] = bf2f(r.z & 0xffffu); b[1] = __uint_as_float(r.z & 0xffff0000u); b[2] = bf2f(r.w & 0xffffu); b[3] = __uint_as_float(r.w & 0xffff0000u);
    *(f32x4*)dst = a; *(f32x4*)(dst + 4) = b;
}
template <int NA>
__device__ __forceinline__ void attn_run(LAS unsigned char* lds, const AttnArgs& a) {
    int tid_ = threadIdx.x; asm volatile("" : "+v"(tid_));
    const int tid = tid_, lane = tid & 63, wave = __builtin_amdgcn_readfirstlane(tid >> 6), fr = lane & 15, fq = lane >> 4;
    bf16x8 Qf[2][4];
#pragma unroll
    for (int qb = 0; qb < 2; ++qb)
#pragma unroll
        for (int dc = 0; dc < 4; ++dc) Qf[qb][dc] = *(const bf16x8*)(a.q + (size_t)(a.qrow0 + wave * 32 + qb * 16 + fr) * a.qstride + dc * 32 + fq * 8);
    f32x4 O[2][8];
#pragma unroll
    for (int qb = 0; qb < 2; ++qb)
#pragma unroll
        for (int db = 0; db < 8; ++db) O[qb][db] = (f32x4){0.f, 0.f, 0.f, 0.f};
    float mrun[2] = {-1e30f, -1e30f}, lrun[2] = {0.f, 0.f};
    LAS float* biasL = (LAS float*)(lds + LDS_BIAS);
    if (NA) { for (int i = tid; i < 465; i += 512) biasL[i] = a.bias[i]; }
    const int lrow = tid >> 3, lch = tid & 7;
    u32x4 kr0, kr1, vr0, vr1;
#define ATT_GLOAD(t) do { const bool inA = (t) < a.ntA; const int tt = inA ? (t) : (t) - a.ntA; const int st = inA ? a.strideA : a.strideB; \
        const bf16_t* kp = (inA ? a.kA : a.kB) + (size_t)(tt * 64 + lrow) * st + lch * 8; const bf16_t* vp = (inA ? a.vA : a.vB) + (size_t)(tt * 64 + lrow) * st + lch * 8; \
        kr0 = *(const u32x4*)kp; kr1 = *(const u32x4*)(kp + 64); vr0 = *(const u32x4*)vp; vr1 = *(const u32x4*)(vp + 64); } while (0)
#define ATT_LWRITE(b, tt_) do { LAS unsigned char* kd = lds + LDS_KT + (b) * 64 * KSTR + lrow * KSTR + lch * 16; LAS unsigned char* vd = lds + LDS_VT + (b) * 64 * VSTR + lrow * VSTR + lch * 16; \
        *(LAS u32x4*)kd = kr0; *(LAS u32x4*)(kd + 128) = kr1; *(LAS u32x4*)vd = vr0; *(LAS u32x4*)(vd + 128) = vr1; \
        if (a.kout) { float* ko = a.kout + (size_t)((tt_) * 64 + lrow) * 2048 + lch * 8; float* vo = a.vout + (size_t)((tt_) * 64 + lrow) * 2048 + lch * 8; \
            store8_f32(ko, kr0); store8_f32(ko + 64, kr1); store8_f32(vo, vr0); store8_f32(vo + 64, vr1); } } while (0)
    ATT_GLOAD(a.t0); ATT_LWRITE(a.t0 & 1, a.t0); __syncthreads();
    const int rw = NA ? a.r0 + (wave >> 1) : 0;
    const int kr_lo_w = NA ? (rw - 4 < 0 ? 0 : (rw - 4 > 24 ? 24 : rw - 4)) : 0;
    for (int t = a.t0; t < a.t1; ++t) {
        if (t + 1 < a.t1) ATT_GLOAD(t + 1);
        bool active = true; int kr = 0; const bool local = NA && t >= a.ntA;
        if (local) { kr = a.krlo + (t - a.ntA); active = (kr >= kr_lo_w) && (kr < kr_lo_w + 8); }
        if (active) {
            const LAS unsigned char* Kt = lds + LDS_KT + (t & 1) * 64 * KSTR;
            const LAS unsigned char* Vt = lds + LDS_VT + (t & 1) * 64 * VSTR;
            f32x4 S[2][4];
#pragma unroll
            for (int qb = 0; qb < 2; ++qb)
#pragma unroll
                for (int kb = 0; kb < 4; ++kb) S[qb][kb] = (f32x4){0.f, 0.f, 0.f, 0.f};
#pragma unroll
            for (int kb = 0; kb < 4; ++kb)
#pragma unroll
                for (int dc = 0; dc < 4; ++dc) {
                    const bf16x8 kf = *(const LAS bf16x8*)(Kt + (kb * 16 + fr) * KSTR + dc * 64 + fq * 16);
                    S[0][kb] = __builtin_amdgcn_mfma_f32_16x16x32_bf16(kf, Qf[0][dc], S[0][kb], 0, 0, 0);
                    S[1][kb] = __builtin_amdgcn_mfma_f32_16x16x32_bf16(kf, Qf[1][dc], S[1][kb], 0, 0, 0);
                }
            bf16x8 Pf[2][2];
#pragma unroll
            for (int qb = 0; qb < 2; ++qb) {
                if (local) {
                    const int c = (wave & 1) * 32 + qb * 16 + fr;
                    const int kc0 = c - 8 < 0 ? 0 : (c - 8 > 48 ? 48 : c - 8);
                    const LAS float* brow = biasL + (kr - rw + 7) * 31 + 15 - c;
#pragma unroll
                    for (int kb = 0; kb < 4; ++kb)
#pragma unroll
                        for (int j = 0; j < 4; ++j) { const int kc = kb * 16 + 4 * fq + j; const bool ok = (kc >= kc0) && (kc < kc0 + 16);
                            const float bv = brow[ok ? kc : c];
                            S[qb][kb][j] = ok ? (S[qb][kb][j] * SCL2 + bv * LOG2E) : -1e30f; }
                } else {
#pragma unroll
                    for (int kb = 0; kb < 4; ++kb) S[qb][kb] = S[qb][kb] * SCL2;
                }
                float mx = -1e30f;
#pragma unroll
                for (int kb = 0; kb < 4; ++kb) mx = fmaxf(mx, fmaxf(fmaxf(S[qb][kb][0], S[qb][kb][1]), fmaxf(S[qb][kb][2], S[qb][kb][3])));
                mx = fmaxf(mx, __shfl_xor(mx, 16)); mx = fmaxf(mx, __shfl_xor(mx, 32));
                const float mn = fmaxf(mrun[qb], mx), alpha = __builtin_amdgcn_exp2f(mrun[qb] - mn);
                mrun[qb] = mn;
                float rs = 0.f;
#pragma unroll
                for (int kb = 0; kb < 4; ++kb)
#pragma unroll
                    for (int j = 0; j < 4; ++j) { const float pv = __builtin_amdgcn_exp2f(S[qb][kb][j] - mn); S[qb][kb][j] = pv; rs += pv; }
                lrun[qb] = lrun[qb] * alpha + rs;
#pragma unroll
                for (int db = 0; db < 8; ++db) O[qb][db] = O[qb][db] * alpha;
#pragma unroll
                for (int c2 = 0; c2 < 2; ++c2) {
                    u32x4 pk; pk.x = cvt_pk_bf16(S[qb][2 * c2][0], S[qb][2 * c2][1]); pk.y = cvt_pk_bf16(S[qb][2 * c2][2], S[qb][2 * c2][3]);
                    pk.z = cvt_pk_bf16(S[qb][2 * c2 + 1][0], S[qb][2 * c2 + 1][1]); pk.w = cvt_pk_bf16(S[qb][2 * c2 + 1][2], S[qb][2 * c2 + 1][3]);
                    Pf[qb][c2] = __builtin_bit_cast(bf16x8, pk);
                }
            }
            const LAS unsigned char* vb = Vt + (4 * fq + (fr >> 2)) * VSTR + (fr & 3) * 8;
#pragma unroll
            for (int c2 = 0; c2 < 2; ++c2)
#pragma unroll
                for (int db = 0; db < 8; ++db) {
                    const v4i16_t lo = vtr(vb + (c2 * 32) * VSTR + db * 32), hi = vtr(vb + (c2 * 32 + 16) * VSTR + db * 32);
                    bf16x8 vf; vf[0] = lo[0]; vf[1] = lo[1]; vf[2] = lo[2]; vf[3] = lo[3]; vf[4] = hi[0]; vf[5] = hi[1]; vf[6] = hi[2]; vf[7] = hi[3];
                    O[0][db] = __builtin_amdgcn_mfma_f32_16x16x32_bf16(vf, Pf[0][c2], O[0][db], 0, 0, 0);
                    O[1][db] = __builtin_amdgcn_mfma_f32_16x16x32_bf16(vf, Pf[1][c2], O[1][db], 0, 0, 0);
                }
        }
        if (t + 1 < a.t1) ATT_LWRITE((t + 1) & 1, t + 1);
        __syncthreads();
    }
#undef ATT_GLOAD
#undef ATT_LWRITE
    if (a.role == 2) {
        f32x4* sp = a.xs + tid;
#pragma unroll
        for (int qb = 0; qb < 2; ++qb)
#pragma unroll
            for (int db = 0; db < 8; ++db) asm volatile("global_store_dwordx4 %0, %1, off sc1" :: "v"(sp + (qb * 8 + db) * 512), "v"(O[qb][db]) : "memory");
        const f32x4 ml = {mrun[0], mrun[1], lrun[0], lrun[1]};
        asm volatile("global_store_dwordx4 %0, %1, off sc1" :: "v"(sp + 16 * 512), "v"(ml) : "memory");
        asm volatile("s_waitcnt vmcnt(0)" ::: "memory");
        if (lane == 0) __hip_atomic_store(a.xf + wave, 1u, __ATOMIC_RELAXED, __HIP_MEMORY_SCOPE_AGENT);
        return;
    }
    if (a.role == 1) {
        unsigned spins = 0;
        while (__hip_atomic_load(a.xf + wave, __ATOMIC_RELAXED, __HIP_MEMORY_SCOPE_AGENT) == 0u) { __builtin_amdgcn_s_sleep(2); if (++spins > (1u << 22)) break; }
        __builtin_amdgcn_fence(__ATOMIC_ACQUIRE, "agent");
        asm volatile("s_waitcnt vmcnt(0)" ::: "memory");
        const f32x4* sp = a.xs + tid;
        const f32x4 ml = sp[16 * 512];
        float fa[2], fb[2];
#pragma unroll
        for (int qb = 0; qb < 2; ++qb) { const float mo = ml[qb], mn = fmaxf(mrun[qb], mo); fa[qb] = __builtin_amdgcn_exp2f(mrun[qb] - mn); fb[qb] = __builtin_amdgcn_exp2f(mo - mn); lrun[qb] = lrun[qb] * fa[qb] + ml[2 + qb] * fb[qb]; }
#pragma unroll
        for (int qb = 0; qb < 2; ++qb)
#pragma unroll
            for (int db = 0; db < 8; ++db) { const f32x4 o2 = sp[(qb * 8 + db) * 512]; O[qb][db] = O[qb][db] * fa[qb] + o2 * fb[qb]; asm volatile("" ::: "memory"); }
    }
#pragma unroll
    for (int qb = 0; qb < 2; ++qb) {
        float lt = lrun[qb]; lt += __shfl_xor(lt, 16); lt += __shfl_xor(lt, 32);
        const float il = 1.f / lt;
        bf16_t* op = a.o + (size_t)(a.qrow0 + wave * 32 + qb * 16 + fr) * a.ostride + 4 * fq;
#pragma unroll
        for (int db = 0; db < 8; ++db) { const f32x4 v = O[qb][db] * il; u32x2 o; o.x = cvt_pk_bf16(v[0], v[1]); o.y = cvt_pk_bf16(v[2], v[3]); *(u32x2*)(op + db * 16) = o; }
    }
}

__device__ __forceinline__ void attn0_phase(const Params& p, LAS unsigned char* lds) {
    unsigned char* ws = p.ws; const int G = gridDim.x;
    const bf16_t* Q0 = (const bf16_t*)(ws + WS_Q0); const bf16_t* K0 = (const bf16_t*)(ws + WS_K0); const bf16_t* V0 = (const bf16_t*)(ws + WS_V0);
    bf16_t* AB = (bf16_t*)(ws + WS_AB);
    const bool split = (G == 256);
    for (int i = blockIdx.x; i < 512; i += G) {
        AttnArgs a;
        if (i < 256) { const int it = i & 127; const int b = it >> 6, h = (it >> 3) & 7, qblk = it & 7, kvh = h >> 2;
            if (!split && i >= 128) continue;
            a.q = Q0 + h * 128; a.qstride = 1024; a.qrow0 = MCTX + b * 2048 + qblk * 256; a.o = AB + 1024 + h * 128; a.ostride = D;
            a.kA = K0 + (size_t)(MTOT + b * 512) * 256 + kvh * 128; a.vA = V0 + (size_t)(MTOT + b * 512) * 256 + kvh * 128; a.strideA = 256; a.ntA = 8;
            a.kB = K0 + (size_t)(MCTX + b * 2048) * 256 + kvh * 128; a.vB = V0 + (size_t)(MCTX + b * 2048) * 256 + kvh * 128; a.strideB = 256; a.ntB = 32;
            a.t0 = (split && i >= 128) ? 20 : 0; a.t1 = (split && i < 128) ? 20 : 40; a.role = split ? (i < 128 ? 1 : 2) : 0;
            a.xs = (f32x4*)(ws + WS_TS) + (size_t)it * (17 * 512); a.xf = (unsigned*)(ws + WS_FLAGS) + 8 * 1024 + it * 8; a.kout = nullptr; a.vout = nullptr;
        } else { const int j = i - 256, b = j >> 3, h = j & 7, kvh = h >> 2;
            a.q = Q0 + h * 128; a.qstride = 1024; a.qrow0 = b * 256; a.o = AB + 1024 + h * 128; a.ostride = D;
            a.kA = K0 + (size_t)(b * 256) * 256 + kvh * 128; a.vA = V0 + (size_t)(b * 256) * 256 + kvh * 128; a.strideA = 256; a.ntA = 4;
            a.kB = a.kA; a.vB = a.vA; a.strideB = 256; a.ntB = 0;
            a.t0 = 0; a.t1 = 4; a.role = 0; a.xs = nullptr; a.xf = nullptr; a.kout = nullptr; a.vout = nullptr;
        }
        a.r0 = 0; a.krlo = 0; a.bias = nullptr;
        attn_run<0>(lds, a);
    }
}
__device__ __forceinline__ void attn1_phase(const Params& p, LAS unsigned char* lds, bf16_t* AO) {
    unsigned char* ws = p.ws; const int G = gridDim.x;
    const bf16_t* Q1 = (const bf16_t*)(ws + WS_Z); const bf16_t* K1 = Q1 + (size_t)MTOT * D; const bf16_t* V1 = K1 + (size_t)MTOT * D;
    const bf16_t* CNK = (const bf16_t*)(ws + WS_CNK); const bf16_t* CNV = (const bf16_t*)(ws + WS_CNV);
    for (int i = blockIdx.x; i < 256; i += G) {
        AttnArgs a;
        const int b = i >> 7, h = (i >> 3) & 15, rg = i & 7, r0 = rg * 4;
        const int lo = r0 - 4 < 0 ? 0 : (r0 - 4 > 24 ? 24 : r0 - 4), hi0 = r0 - 1 < 0 ? 0 : (r0 - 1 > 24 ? 24 : r0 - 1), hi = hi0 + 7;
        a.q = Q1 + h * 128; a.qstride = D; a.qrow0 = MCTX + b * 2048 + r0 * 64; a.o = AO + h * 128; a.ostride = D;
        a.kA = CNK + (size_t)(b * 512) * 2048 + h * 128; a.vA = CNV + (size_t)(b * 512) * 2048 + h * 128; a.strideA = 2048; a.ntA = 8;
        a.kB = K1 + (size_t)(MCTX + b * 2048 + lo * 64) * D + h * 128; a.vB = V1 + (size_t)(MCTX + b * 2048 + lo * 64) * D + h * 128; a.strideB = D; a.ntB = hi - lo + 1;
        a.r0 = r0; a.krlo = lo; a.bias = p.in[18] + h * 465; a.t0 = 0; a.t1 = a.ntA + a.ntB; a.role = 0; a.xs = nullptr; a.xf = nullptr; a.kout = nullptr; a.vout = nullptr;
        attn_run<1>(lds, a);
    }
    for (int j = blockIdx.x; j < 512; j += G) {
        AttnArgs a;
        const int b = j >> 4, h = j & 15;
        a.q = Q1 + h * 128; a.qstride = D; a.qrow0 = b * 256; a.o = AO + h * 128; a.ostride = D;
        a.kA = K1 + (size_t)(b * 256) * D + h * 128; a.vA = V1 + (size_t)(b * 256) * D + h * 128; a.strideA = D; a.ntA = 4;
        a.kB = a.kA; a.vB = a.vA; a.strideB = D; a.ntB = 0;
        a.r0 = 0; a.krlo = 0; a.bias = nullptr; a.t0 = 0; a.t1 = 4; a.role = 0; a.xs = nullptr; a.xf = nullptr;
        a.kout = p.out + OUT_NK + (size_t)(b * 256) * 2048 + h * 128; a.vout = p.out + OUT_NV + (size_t)(b * 256) * 2048 + h * 128;
        attn_run<0>(lds, a);
    }
}

#define XB_TMO      128
#define XB_XCNT(j)  (256  + 64 * (j))
#define XB_XSUB(j)  (1280 + 64 * (j))
#define XB_XGEN(j)  (2304 + 64 * (j))
#define XB_TOP      3328
#define XB_TOPGEN   3392
#define XCD_BAR_WORDS 3456
#define XB_SPIN_CAP (1u << 18)

__device__ __forceinline__ unsigned xb_ld(unsigned* p)              { return __hip_atomic_load(p, __ATOMIC_RELAXED, __HIP_MEMORY_SCOPE_AGENT); }
__device__ __forceinline__ unsigned xb_add(unsigned* p, unsigned v) { return __hip_atomic_fetch_add(p, v, __ATOMIC_RELAXED, __HIP_MEMORY_SCOPE_AGENT); }
__device__ __forceinline__ unsigned xb_xcc_id() { return (unsigned)__builtin_amdgcn_s_getreg((3 << 11) | 20) & 0xFu; }
#define XB_SPIN(cond, bar) do { unsigned _sp = 0; while (cond) { __builtin_amdgcn_s_sleep(1); \
    if ((++_sp & 255u) == 0u) { if (xb_ld(&(bar)[XB_TMO])) break; if (_sp > XB_SPIN_CAP) { atomicAdd(&(bar)[XB_TMO], 1u); break; } } } } while (0)

struct XcdBarrier {
    unsigned* bar; unsigned x;
    volatile LAS unsigned* st;
};

__device__ __forceinline__ XcdBarrier xcd_barrier_post(unsigned* bar, volatile LAS unsigned* st) {
    XcdBarrier b; b.bar = bar; b.x = xb_xcc_id(); b.st = st;
    if (threadIdx.x == 0) (void)xb_add(&bar[XB_XCNT(b.x)], 1u);
    return b;
}
__device__ __forceinline__ void xcd_barrier_complete(unsigned* bar, unsigned x, unsigned& nloc, unsigned& nx) {
    const unsigned G = gridDim.x * gridDim.y * gridDim.z;
    unsigned sum, cnt, mine, sp = 0u;
    for (;;) {
        sum = 0u; cnt = 0u; mine = 0u;
#pragma unroll
        for (unsigned j = 0; j < 16; ++j) { const unsigned c = xb_ld(&bar[XB_XCNT(j)]); sum += c; cnt += (c > 0u) ? 1u : 0u; mine = (j == x) ? c : mine; }
        if (sum == G) break;
        __builtin_amdgcn_s_sleep(1);
        if ((++sp & 255u) == 0u) { if (xb_ld(&bar[XB_TMO])) break; if (sp > XB_SPIN_CAP) { atomicAdd(&bar[XB_TMO], 1u); break; } }
    }
    nloc = mine > 0u ? mine : 1u; nx = cnt > 0u ? cnt : 1u;
}

__device__ __forceinline__ void xcd_barrier(const XcdBarrier& b) {
    asm volatile("s_waitcnt vmcnt(0)" ::: "memory");
    __syncthreads();
    if (threadIdx.x == 0) {
        unsigned* bar = b.bar;
        __builtin_amdgcn_s_waitcnt(0);
        unsigned nloc = b.st[0], nx = b.st[1];
        if (nloc == 0u) { xcd_barrier_complete(bar, b.x, nloc, nx); b.st[0] = nloc; b.st[1] = nx; }
        const unsigned old = xb_add(&bar[XB_XSUB(b.x)], 1u);
        const unsigned gen = old / nloc;
        if (old + 1u == (gen + 1u) * nloc) {
            __builtin_amdgcn_fence(__ATOMIC_RELEASE, "agent");
            asm volatile("s_waitcnt vmcnt(0)" ::: "memory");
            const unsigned og = xb_add(&bar[XB_TOP], 1u);
            const unsigned tg = og / nx;
            if (og + 1u == (tg + 1u) * nx) xb_add(&bar[XB_TOPGEN], 1u);
            else XB_SPIN(xb_ld(&bar[XB_TOPGEN]) == tg, bar);
            __builtin_amdgcn_fence(__ATOMIC_ACQUIRE, "agent");
            xb_add(&bar[XB_XGEN(b.x)], 1u);
            asm volatile("s_waitcnt vmcnt(0)" ::: "memory");
        } else {
            XB_SPIN(xb_ld(&bar[XB_XGEN(b.x)]) == gen, bar);
            __builtin_amdgcn_fence(__ATOMIC_ACQUIRE, "agent");
            asm volatile("s_waitcnt vmcnt(0)" ::: "memory");
        }
    }
    __syncthreads();
}


constexpr int NPHASE = 18;
__global__ void __launch_bounds__(512, 2) mega_fwd(Params p) {
    extern __shared__ __attribute__((aligned(16))) unsigned char lds_raw[];
    LAS unsigned char* lds = (LAS unsigned char*)lds_raw;
    cg::grid_group grid = cg::this_grid();
    if (threadIdx.x < 64) ((LAS unsigned*)(lds + 131072))[threadIdx.x] = 0u;
    __syncthreads();
    XcdBarrier xbar = xcd_barrier_post((unsigned*)(p.ws + WS_BAR), (volatile LAS unsigned*)(lds + 131072));
    unsigned char* ws = p.ws;
    const int G = gridDim.x;
    float* MOD = (float*)(ws + WS_MOD);
    bf16_t* XN = (bf16_t*)(ws + WS_XN); bf16_t* X = (bf16_t*)(ws + WS_X);
    bf16_t* Z = (bf16_t*)(ws + WS_Z); bf16_t* AB = (bf16_t*)(ws + WS_AB); bf16_t* H = (bf16_t*)(ws + WS_H);
#define RUN(k) (p.ph_lo <= (k) && (k) < p.ph_hi)
#define GRID_SYNC_CG() do { asm volatile("s_waitcnt vmcnt(0) lgkmcnt(0)" ::: "memory"); grid.sync(); __builtin_amdgcn_fence(__ATOMIC_ACQUIRE, "agent"); asm volatile("s_waitcnt vmcnt(0)" ::: "memory"); } while (0)
#define GRID_SYNC() do { xcd_barrier(xbar); } while (0)
#define REPEAT(n, stmt) do { for (int rep_ = 0; rep_ < (n); ++rep_) { stmt; if (rep_ + 1 < (n)) GRID_SYNC(); } } while (0)
#define SEAM(k) do { if (p.ph_lo <= (k) && (k) + 1 < p.ph_hi) GRID_SYNC(); } while (0)
    if (RUN(0)) REPEAT(REP_P0, p0_prologue(p, lds));
    if (p.ph_lo <= 0 && 1 < p.ph_hi) GRID_SYNC_CG();
    for (int l = 0; l < 2; ++l) {
        const int k0 = 1 + 8 * l;
        const float* modl = MOD + (size_t)l * 3 * MODW;
        const float* xin_lo = p.in[0];
        const float* xin_hi = p.in[1] - (size_t)MCTX * D;
        const bf16_t* xres = (l == 0) ? nullptr : X;
        if (RUN(k0)) REPEAT(REP_NORM, norm_phase<false>(xin_lo, xin_hi, xres, p.in[10] + l * D, modl, 0, D, XN, nullptr));
        SEAM(k0);
        if (RUN(k0 + 1)) for (int repg_ = 0; repg_ < REP_G; ++repg_) {
            if (repg_) GRID_SYNC();
            if (l == 0) { pg8::Gemm g{XN, (const bf16_t*)(ws + WS_WIN), MTOT, ABIN, D}; pg8::StaticOrder S; S.init(MTOT, ABIN, G, (int)blockIdx.x, D, ws, -2);
                EpiBf16<0, false> E{Z, ABIN, nullptr, nullptr, 0, 0}; pg8::gemm_phase(lds, g, S, E); }
            else { pg8::Gemm g{XN, (const bf16_t*)(ws + WS_WQKV), MTOT, NQKV, D}; pg8::StaticOrder S; S.init(MTOT, NQKV, G, (int)blockIdx.x, D, ws, -2);
                EpiBf16<0, false> E{Z, D, nullptr, nullptr, 8, (size_t)MTOT * D}; pg8::gemm_phase(lds, g, S, E); }
        }
        SEAM(k0 + 1);
        if (l == 0) { if (RUN(k0 + 2)) REPEAT(REP_EW, ew0_phase(p)); SEAM(k0 + 2); }
        if (RUN(k0 + 3)) REPEAT(REP_ATT, if (l == 0) attn0_phase(p, lds); else attn1_phase(p, lds, AB));
        SEAM(k0 + 3);
        if (RUN(k0 + 4)) { pg8::Gemm g{AB, (const bf16_t*)(ws + (l == 0 ? WS_WO0 : WS_WO1)), MTOT, D, D}; pg8::StaticOrder S; S.init(MTOT, D, G, (int)blockIdx.x, D, ws, -2);
            EpiResid E{xin_lo, xin_hi, xres, X, modl + 2 * D}; pg8::gemm_phase(lds, g, S, E); }
        SEAM(k0 + 4);
        if (RUN(k0 + 5)) REPEAT(REP_NORM, norm_phase<false>(nullptr, nullptr, X, p.in[11] + l * D, modl, 3 * D, 4 * D, XN, nullptr));
        SEAM(k0 + 5);
        if (RUN(k0 + 6)) for (int repg_ = 0; repg_ < REP_G; ++repg_) { if (repg_) GRID_SYNC(); pg8::Gemm g{XN, (const bf16_t*)(ws + WS_W1) + (size_t)l * FFN * D, MTOT, FFN, D}; pg8::StaticOrder S; S.init(MTOT, FFN, G, (int)blockIdx.x, D, ws, -1);
            EpiBf16<1, false> E{H, FFN, nullptr, nullptr, 0, 0}; pg8::gemm_phase(lds, g, S, E); }
        SEAM(k0 + 6);
        if (RUN(k0 + 7)) { pg8::Gemm g{H, (const bf16_t*)(ws + WS_W2) + (size_t)l * FFN * D, MTOT, D, FFN}; pg8::StaticOrder S; S.init(MTOT, D, G, (int)blockIdx.x, FFN, ws, (l * 4 + 3) * 1024);
            EpiResid E{nullptr, nullptr, X, X, modl + 5 * D}; pg8::gemm_phase(lds, g, S, E); }
        SEAM(k0 + 7);
    }
#if PROBE_STOP > 0
    GRID_SYNC();
    {
        const size_t n = (size_t)MTOT * D, gt = (size_t)blockIdx.x * 512 + threadIdx.x, gs = (size_t)G * 512;
        const bf16_t* sb = PROBE_SRC == 1 ? XN : PROBE_SRC == 2 ? AB : PROBE_SRC == 3 ? Z : PROBE_SRC == 5 ? Z + (size_t)4096 * NQKV : (const bf16_t*)(ws + WS_Q0);
#if PROBE_SRC == 6
        attn1_phase(p, lds, XN);
        GRID_SYNC();
        for (size_t i = gt; i < n; i += gs) p.out[i] = bf2f(AB[i]) - bf2f(XN[i]);
#else
        for (size_t i = gt; i < n; i += gs) p.out[i] = (PROBE_SRC == 0) ? bf2f(X[i]) : bf2f(sb[i]);
#endif
#if PROBE_STOP < 4
        for (size_t i = gt; i < (size_t)2 * MCTX * 256; i += gs) p.out[OUT_AK + i] = 0.f;
#endif
        for (size_t i = gt; i < (size_t)2 * MCTX * D; i += gs) p.out[OUT_NK + i] = 0.f;
    }
#else
    if (RUN(17)) REPEAT(REP_NORM, norm_phase<true>(nullptr, nullptr, X, p.in[22], nullptr, 0, 0, nullptr, p.out));
#endif
#undef RUN
#undef SEAM
#undef REPEAT
#undef GRID_SYNC
#undef GRID_SYNC_CG
}

extern "C" void kernel_launch(void* const* d_in, const int* in_sizes, int n_in, void* d_out, int out_size, void* d_ws, size_t ws_size, hipStream_t stream) {
    static int grid = 0;
    if (grid == 0) {
        if (n_in != 23 || ws_size < WS_END) { fprintf(stderr, "kernel_launch: expected 23 inputs and >= %zu bytes of workspace (got %d, %zu)\n", (size_t)WS_END, n_in, ws_size); grid = -1; return; }
        int dev = 0, cus = 0, per_cu = 0;
        (void)hipGetDevice(&dev);
        (void)hipDeviceGetAttribute(&cus, hipDeviceAttributeMultiprocessorCount, dev);
        if (hipFuncSetAttribute((const void*)mega_fwd, hipFuncAttributeMaxDynamicSharedMemorySize, LDS_BYTES) != hipSuccess) { fprintf(stderr, "kernel_launch: hipFuncSetAttribute failed\n"); grid = -1; return; }
        if (hipOccupancyMaxActiveBlocksPerMultiprocessor(&per_cu, (const void*)mega_fwd, 512, LDS_BYTES) != hipSuccess || per_cu < 1) { fprintf(stderr, "kernel_launch: occupancy query failed (%d)\n", per_cu); grid = -1; return; }
        grid = cus * (per_cu > 1 ? 1 : per_cu);
        fprintf(stderr, "kernel_launch: grid %d (cus %d, per_cu %d)\n", grid, cus, per_cu);
    }
    if (grid < 0) return;
    (void)hipMemsetAsync((char*)d_ws + WS_BAR, 0, 65536, stream);
    Params p{};
    for (int i = 0; i < 23; ++i) p.in[i] = (const float*)d_in[i];
    p.out = (float*)d_out; p.ws = (unsigned char*)d_ws;
#if MK_PER_PHASE
    for (int k = 0; k < NPHASE; ++k) {
        if (k == 11) continue;
        p.ph_lo = k; p.ph_hi = k + 1;
        void* args[] = {&p};
        hipError_t e = hipLaunchCooperativeKernel((const void*)mega_fwd, dim3(grid), dim3(512), args, LDS_BYTES, stream);
        if (e != hipSuccess) { fprintf(stderr, "launch %d failed: %s\n", k, hipGetErrorString(e)); break; }
    }
#else
    p.ph_lo = 0; p.ph_hi = PROBE_STOP > 0 ? PROBE_STOP : NPHASE;
    void* args[] = {&p};
    hipError_t e = hipLaunchCooperativeKernel((const void*)mega_fwd, dim3(grid), dim3(512), args, LDS_BYTES, stream);
    if (e != hipSuccess) fprintf(stderr, "cooperative launch failed: %s (grid %d)\n", hipGetErrorString(e), grid);
#endif
}
```
